# Optimizing an MI355X kernel written in HIP

```python
import jax, jax.numpy as jnp
from jax import lax
import numpy as np

D_MODEL = 1024
BATCH = 8
SEQ = 8192
DEPTH = 4

CHUNK = 64
POOL_WIDTH = D_MODEL // 4
POOL_WINDOWS = (2, 4, 8, 16)
POOL_GROUPS = len(POOL_WINDOWS)
POOL_GROUP_DIM = POOL_WIDTH // POOL_GROUPS
CONV_WIDTH = D_MODEL // 4
CONV_KERNEL = 31
ATTN_HEADS = 8
HEAD_DIM = 64
ATTN_WIDTH = ATTN_HEADS * HEAD_DIM
N_BRANCH = 3
Q_BLOCK = 128
D_FF = 2816
N_EXPERTS = 8
TOP_K = 2
D_FF_EXPERT = 3584
EPS = 1e-6
N_DENSE = (DEPTH + 1) // 2
N_MOE = DEPTH // 2

OFF_POOL = 0
OFF_CONV = OFF_POOL + POOL_WIDTH
OFF_Q = OFF_CONV + 2 * CONV_WIDTH
OFF_K = OFF_Q + ATTN_WIDTH
OFF_V = OFF_K + ATTN_WIDTH
OFF_F = OFF_V + ATTN_WIDTH
OFF_G = OFF_F + ATTN_HEADS
IN_COLS = OFF_G + N_BRANCH * D_MODEL

kernel_name = "hybrid_pool_conv_fox_moe_trunk"


def rms_norm(x, g):
    xf = x.astype(jnp.float32)
    y = xf * lax.rsqrt(jnp.mean(xf * xf, axis=-1, keepdims=True) + EPS)
    return (y * g.astype(jnp.float32)).astype(x.dtype)


def layer_norm(x, g, b):
    xf = x.astype(jnp.float32)
    mu = jnp.mean(xf, axis=-1, keepdims=True)
    var = jnp.mean(jnp.square(xf - mu), axis=-1, keepdims=True)
    y = (xf - mu) * lax.rsqrt(var + EPS)
    return (y * g.astype(jnp.float32) + b.astype(jnp.float32)).astype(x.dtype)


def pool_mixer(p, w_group, scale):
    S = p.shape[1]
    pf = p.astype(jnp.float32)
    cs = jnp.cumsum(pf, axis=1)
    t = jnp.arange(1, S + 1, dtype=jnp.float32)
    outs = []
    for g, w in enumerate(POOL_WINDOWS):
        lo, hi = g * POOL_GROUP_DIM, (g + 1) * POOL_GROUP_DIM
        csg = cs[..., lo:hi]
        lagged = jnp.pad(csg, ((0, 0), (w, 0), (0, 0)))[:, :S]
        count = jnp.minimum(t, float(w))[None, :, None]
        pooled = (csg - lagged) / count - pf[..., lo:hi]
        outs.append(jnp.einsum('bsc,cd->bsd', pooled.astype(p.dtype), w_group[g]))
    return jnp.concatenate(outs, axis=-1) * scale


def conv_module(u, conv_w, conv_b, ln_g, ln_b):
    a, gate = jnp.split(u, 2, axis=-1)
    z = a * jax.nn.sigmoid(gate)
    z = lax.conv_general_dilated(
        z, conv_w[:, None, :].astype(z.dtype), window_strides=(1,),
        padding=[(CONV_KERNEL - 1, 0)], dimension_numbers=('NWC', 'WIO', 'NWC'),
        feature_group_count=CONV_WIDTH) + conv_b
    z = layer_norm(z, ln_g, ln_b)
    return jax.nn.silu(z)


def forgetting_attention(q, k, v, f_logit, q_g, k_g):
    B, S, H, Dh = q.shape
    q = rms_norm(q, q_g)
    k = rms_norm(k, k_g)
    logf = jax.nn.log_sigmoid(f_logit.astype(jnp.float32))
    c = jnp.transpose(jnp.cumsum(logf, axis=1), (0, 2, 1))
    nb = S // Q_BLOCK
    qb = q.reshape(B, nb, Q_BLOCK, H, Dh).transpose(1, 0, 3, 2, 4)
    cqb = c.reshape(B, H, nb, Q_BLOCK).transpose(2, 0, 1, 3)
    kpos = jnp.arange(S)
    scale = HEAD_DIM ** -0.5

    def block(args):
        qi, cqi, i = args
        s = jnp.einsum('bhqd,bshd->bhqs', qi, k, preferred_element_type=jnp.float32) * scale
        s = s + (cqi[..., None] - c[:, :, None, :])
        qpos = i * Q_BLOCK + jnp.arange(Q_BLOCK)
        s = jnp.where(kpos[None, :] <= qpos[:, None], s, -jnp.inf)
        prob = jax.nn.softmax(s, axis=-1).astype(v.dtype)
        return jnp.einsum('bhqs,bshd->bhqd', prob, v)

    o = lax.map(block, (qb, cqb, jnp.arange(nb)))
    return o.transpose(1, 0, 3, 2, 4).reshape(B, S, H * Dh)


def swiglu(h, w1, w3, w2):
    a = jnp.einsum('bsd,df->bsf', h, w1)
    b = jnp.einsum('bsd,df->bsf', h, w3)
    return jnp.einsum('bsf,fd->bsd', jax.nn.silu(a) * b, w2)


def moe_ffn(h, w_router, w1, w3, w2):
    logits = jnp.einsum('bsd,de->bse', h, w_router, preferred_element_type=jnp.float32)
    top_val, top_idx = lax.top_k(logits, TOP_K)
    top_w = jax.nn.softmax(top_val, axis=-1)
    gates = jnp.sum(jax.nn.one_hot(top_idx, N_EXPERTS, dtype=jnp.float32) * top_w[..., None], axis=-2)
    gates = gates.astype(h.dtype)
    out = jnp.zeros_like(h)
    for e in range(N_EXPERTS):
        out = out + gates[..., e:e + 1] * swiglu(h, w1[e], w3[e], w2[e])
    return out


def setup_inputs(seed: int = 0) -> dict:
    key = jax.random.key(seed)
    ks = jax.random.split(key, 32)
    L, D = DEPTH, D_MODEL
    nrm = lambda k, shape, fan_in: jax.random.normal(k, shape, jnp.float32) * (fan_in ** -0.5)
    gain = lambda k, shape: 1.0 + 0.05 * jax.random.normal(k, shape, jnp.float32)
    small = lambda k, shape: 0.02 * jax.random.normal(k, shape, jnp.float32)
    return {
        "x": jax.random.normal(ks[0], (BATCH, SEQ, D), jnp.float32),
        "g_mix": gain(ks[1], (L, D)),
        "w_in": nrm(ks[2], (L, D, IN_COLS), D),
        "b_gate": small(ks[3], (L, N_BRANCH * D)),
        "b_forget": jax.random.uniform(ks[4], (L, ATTN_HEADS), jnp.float32, 1.0, 6.0),
        "pool_w": nrm(ks[5], (L, POOL_GROUPS, POOL_GROUP_DIM, POOL_GROUP_DIM), POOL_GROUP_DIM),
        "pool_scale": gain(ks[6], (L, POOL_WIDTH)),
        "conv_w": nrm(ks[7], (L, CONV_KERNEL, CONV_WIDTH), CONV_KERNEL),
        "conv_b": small(ks[8], (L, CONV_WIDTH)),
        "conv_ln_g": gain(ks[9], (L, CONV_WIDTH)),
        "conv_ln_b": small(ks[10], (L, CONV_WIDTH)),
        "q_norm_g": gain(ks[11], (L, HEAD_DIM)),
        "k_norm_g": gain(ks[12], (L, HEAD_DIM)),
        "w_br_pool": nrm(ks[13], (L, POOL_WIDTH, D), POOL_WIDTH),
        "w_br_conv": nrm(ks[14], (L, CONV_WIDTH, D), CONV_WIDTH),
        "w_br_attn": nrm(ks[15], (L, ATTN_WIDTH, D), ATTN_WIDTH),
        "w_out": nrm(ks[16], (L, D, D), D),
        "g_ffn": gain(ks[17], (L, D)),
        "ffn_w1": nrm(ks[18], (N_DENSE, D, D_FF), D),
        "ffn_w3": nrm(ks[19], (N_DENSE, D, D_FF), D),
        "ffn_w2": nrm(ks[20], (N_DENSE, D_FF, D), D_FF),
        "router_w": nrm(ks[21], (N_MOE, D, N_EXPERTS), D),
        "exp_w1": nrm(ks[22], (N_MOE, N_EXPERTS, D, D_FF_EXPERT), D),
        "exp_w3": nrm(ks[23], (N_MOE, N_EXPERTS, D, D_FF_EXPERT), D),
        "exp_w2": nrm(ks[24], (N_MOE, N_EXPERTS, D_FF_EXPERT, D), D_FF_EXPERT),
    }


def reference(x, g_mix, w_in, b_gate, b_forget, pool_w, pool_scale, conv_w, conv_b,
              conv_ln_g, conv_ln_b, q_norm_g, k_norm_g, w_br_pool, w_br_conv, w_br_attn,
              w_out, g_ffn, ffn_w1, ffn_w3, ffn_w2, router_w, exp_w1, exp_w3, exp_w2):
    B, S, D = x.shape
    for l in range(DEPTH):
        h = rms_norm(x, g_mix[l])
        u = jnp.einsum('bsd,dc->bsc', h, w_in[l])
        y_pool = pool_mixer(u[..., OFF_POOL:OFF_CONV], pool_w[l], pool_scale[l])
        y_conv = conv_module(u[..., OFF_CONV:OFF_Q], conv_w[l], conv_b[l], conv_ln_g[l], conv_ln_b[l])
        q = u[..., OFF_Q:OFF_K].reshape(B, S, ATTN_HEADS, HEAD_DIM)
        k = u[..., OFF_K:OFF_V].reshape(B, S, ATTN_HEADS, HEAD_DIM)
        v = u[..., OFF_V:OFF_F].reshape(B, S, ATTN_HEADS, HEAD_DIM)
        f_logit = u[..., OFF_F:OFF_G] + b_forget[l]
        y_attn = forgetting_attention(q, k, v, f_logit, q_norm_g[l], k_norm_g[l])
        gates = jax.nn.sigmoid(u[..., OFF_G:] + b_gate[l]).reshape(B, S, N_BRANCH, D)
        merged = (gates[:, :, 0] * jnp.einsum('bsc,cd->bsd', y_pool, w_br_pool[l])
                  + gates[:, :, 1] * jnp.einsum('bsc,cd->bsd', y_conv, w_br_conv[l])
                  + gates[:, :, 2] * jnp.einsum('bsc,cd->bsd', y_attn, w_br_attn[l]))
        x = x + jnp.einsum('bsd,de->bse', merged, w_out[l])
        h = rms_norm(x, g_ffn[l])
        if l % 2 == 0:
            i = l // 2
            x = x + swiglu(h, ffn_w1[i], ffn_w3[i], ffn_w2[i])
        else:
            i = l // 2
            x = x + moe_ffn(h, router_w[i], exp_w1[i], exp_w3[i], exp_w2[i])
    return x
```

```cpp
#include <hip/hip_runtime.h>
#include <hip/hip_bf16.h>
#include <cstdio>
#include <cstdint>
#include <cmath>

namespace pg8 {
#define PG8_LAS __attribute__((address_space(3)))
typedef unsigned short bf16_t;
typedef short bf16x8 __attribute__((ext_vector_type(8)));
typedef float f32x4 __attribute__((ext_vector_type(4)));
typedef float f32x2 __attribute__((ext_vector_type(2)));
typedef unsigned u32x4 __attribute__((ext_vector_type(4)));
typedef unsigned u32x2 __attribute__((ext_vector_type(2)));
constexpr int BM = 256, BK = 64, HALF = 128, HTB = HALF * BK * 2  , STAGE_BYTES = 8 * HTB, NXCD = 8, WGM = 8;

__host__ __device__ __forceinline__ int lds_byte(int r, int c) { const int st = (r >> 4) * 2 + (c >> 5), rr = r & 15, cc = c & 31, ob = rr * 64 + cc * 2; return st * 1024 + (ob ^ (((ob >> 9) & 1) << 5)); }
__host__ __device__ __forceinline__ void stage_rc(int b, int& R, int& C) { const int st = b / 1024, sb = b % 1024, swz = sb ^ (((sb >> 9) & 1) << 5); R = (st >> 1) * 16 + swz / 64; C = (st & 1) * 32 + (swz % 64) / 2; }
__host__ __device__ __forceinline__ int perm32(int rho) { const int n = rho >> 4, i = rho & 15; return 8 * (i >> 2) + 4 * n + (i & 3); }

struct Unit { int pm, pn, e, koff, nt, lo, nv; };
struct Gemm { const bf16_t* A; const bf16_t* Bt; int K; size_t bstride; const unsigned* list; };

__device__ __forceinline__ void tile_of(int L, int nM, int nN, int& pm, int& pn) {
    const int nwg = nM * nN; int wgid = L;
    { const int q = nwg / NXCD, r = nwg % NXCD, xcd = wgid % NXCD, off = wgid / NXCD; wgid = (xcd < r ? xcd * (q + 1) : r * (q + 1) + (xcd - r) * q) + off; }
    const int nig = WGM * nN, gid = wgid / nig, fm = gid * WGM, gsz = (nM - fm) < WGM ? (nM - fm) : WGM;
    pm = fm + ((wgid % nig) % gsz); pn = (wgid % nig) / gsz;
}
struct SchedPlain {
    int nM, nN, G, c, nt;
    __device__ __forceinline__ bool next(int i, Unit& u) const {
        const long L = (long)i * G + c; if (L >= (long)nM * nN) return false;
        tile_of((int)L, nM, nN, u.pm, u.pn); u.e = 0; u.koff = 0; u.nt = nt; u.lo = 0; u.nv = 256; return true;
    }
};
struct SchedMerge {
    int nM, nN, G, c;
    __device__ __forceinline__ bool next(int i, Unit& u) const {
        const int tile = i / 3, seg = i - 3 * tile; const long L = (long)tile * G + c; if (L >= (long)nM * nN) return false;
        tile_of((int)L, nM, nN, u.pm, u.pn); u.e = seg; u.koff = seg == 0 ? 0 : (seg == 1 ? 256 : 512); u.nt = seg == 2 ? 8 : 4; u.lo = 0; u.nv = 256; return true;
    }
};
struct SchedMoe {
    int nM, nN, G, c, nt, slot; const PG8_LAS unsigned* tab;
    __device__ __forceinline__ bool next(int i, Unit& u) const {
        const long L = (long)i * G + c; if (L >= (long)nM * nN) return false;
        tile_of((int)L, nM, nN, u.pm, u.pn);
        const unsigned w = (unsigned)__builtin_amdgcn_readfirstlane((int)tab[u.pm]);
        u.e = (int)(w & 0xffu); const int j = (int)((w >> 8) & 0xfffu); u.nv = (int)(w >> 20) + 1;
        u.lo = (slot * 8 + u.e) * 65536 + 256 * j; u.koff = 0; u.nt = nt; return true;
    }
};

typedef __bf16 bf16x2_cv __attribute__((ext_vector_type(2)));
__device__ __forceinline__ unsigned cvt_pk_bf16(float lo, float hi) { const f32x2 v = {lo, hi}; const bf16x2_cv b = __builtin_convertvector(v, bf16x2_cv); return __builtin_bit_cast(unsigned, b); }
__device__ __forceinline__ float bf_lo(unsigned w) { return __uint_as_float(w << 16); }
__device__ __forceinline__ float bf_hi(unsigned w) { return __uint_as_float(w & 0xffff0000u); }
__device__ __forceinline__ float sigmoidf_(float x) { return __builtin_amdgcn_rcpf(1.0f + __builtin_amdgcn_exp2f(-1.4426950408889634f * x)); }

template <class Epi, class Sched, bool ALIGN_EPI, bool GATHER>
__device__ __forceinline__ void gemm_phase(PG8_LAS unsigned char* lds, const Gemm g_, const Sched& S, const Epi& E) {
    Gemm g = g_;
    {
        unsigned long long a_ = (unsigned long long)g_.A, b_ = (unsigned long long)g_.Bt, l_ = (unsigned long long)g_.list; asm volatile("" : "+s"(a_), "+s"(b_), "+s"(l_));
        g.A = (const bf16_t*)(const __attribute__((address_space(1))) bf16_t*)a_; g.Bt = (const bf16_t*)(const __attribute__((address_space(1))) bf16_t*)b_; g.list = (const unsigned*)(const __attribute__((address_space(1))) unsigned*)l_; }
    int tid_o = threadIdx.x; asm volatile("" : "+v"(tid_o));
    const int tid = tid_o, wid = __builtin_amdgcn_readfirstlane(tid >> 6), lane = tid & 63, wr = wid >> 2, wc = wid & 3, fr = lane & 15, fq = lane >> 4;
    const int K = g.K;
    unsigned voffA[2], voffB[2];
#pragma unroll
    for (int i = 0; i < 2; ++i) { int R, C; stage_rc(tid * 16 + i * 8192, R, C); const int Rb = Epi::PERM ? ((R & ~31) + perm32(R & 31)) : R;
        voffA[i] = (unsigned)(R * K + C) * 2u; voffB[i] = (unsigned)(Rb * K + C) * 2u; }
    const size_t kstep = (size_t)(BK * 2);
    const size_t hstep = (size_t)HALF * K * 2;
    const size_t tstep = 2 * hstep;
    const unsigned ldsw = (unsigned)wid * 1024u;
    const int aoff = lds_byte(wr * 64 + fr, fq * 8), boff = lds_byte(wc * 32 + fr, fq * 8);
#define PG8_SA(b, h) (((b) * 2 + (h)) * HTB)
#define PG8_SB(b, h) ((4 + (b) * 2 + (h)) * HTB)
#define PG8_GLDS(src, bufoff, i_) __builtin_amdgcn_global_load_lds((const unsigned*)(src), (PG8_LAS unsigned*)(lds + (bufoff) + ldsw + (i_) * 8192), 16, 0, 0)
#define PG8_STAGE_B(bufoff, gbase) do { _Pragma("unroll") for (int _i = 0; _i < 2; ++_i) PG8_GLDS((const char*)(gbase) + voffB[_i], bufoff, _i); } while (0)
#define PG8_STAGE_A(bufoff, ga, h, o0, o1) do { if constexpr (GATHER) { PG8_GLDS((const char*)(ga) + (o0), bufoff, 0); PG8_GLDS((const char*)(ga) + (o1), bufoff, 1); } \
        else { _Pragma("unroll") for (int _i = 0; _i < 2; ++_i) PG8_GLDS((const char*)(ga) + (h) * hstep + voffA[_i], bufoff, _i); } } while (0)
#define PG8_LDA(dst, b, h) do { _Pragma("unroll") for (int m = 0; m < 4; ++m) _Pragma("unroll") for (int k = 0; k < 2; ++k) dst[m][k] = *(const PG8_LAS bf16x8*)(lds + PG8_SA(b, h) + aoff + m * 2048 + k * 1024); } while (0)
#define PG8_LDB(dst, b, h) do { _Pragma("unroll") for (int n = 0; n < 2; ++n) _Pragma("unroll") for (int k = 0; k < 2; ++k) dst[n][k] = *(const PG8_LAS bf16x8*)(lds + PG8_SB(b, h) + boff + n * 2048 + k * 1024); } while (0)
#define PG8_MMA(ai, bj, At, Bt) do { __builtin_amdgcn_s_setprio(1); _Pragma("unroll") for (int m = 0; m < 4; ++m) _Pragma("unroll") for (int n = 0; n < 2; ++n) _Pragma("unroll") for (int k = 0; k < 2; ++k) \
        acc[ai][bj][m][n] = __builtin_amdgcn_mfma_f32_16x16x32_bf16(Bt[n][k], At[m][k], acc[ai][bj][m][n], 0, 0, 0); __builtin_amdgcn_s_setprio(0); } while (0)
#define PG8_WAIT_V(n) asm volatile("s_waitcnt vmcnt(" #n ")" ::: "memory")
#define PG8_WAIT_L(n) asm volatile("s_waitcnt lgkmcnt(" #n ")" ::: "memory")
#define PG8_BAR __builtin_amdgcn_s_barrier()
#define PG8_SCHED __builtin_amdgcn_sched_barrier(0)
    Unit cur, nxt; int ui = 0;
    if (!S.next(0, cur)) return;
    f32x4 acc[2][2][4][2];
#pragma unroll
    for (int a = 0; a < 2; ++a)
#pragma unroll
        for (int b = 0; b < 2; ++b)
#pragma unroll
            for (int m = 0; m < 4; ++m)
#pragma unroll
                for (int n = 0; n < 2; ++n) acc[a][b][m][n] = (f32x4){0.f, 0.f, 0.f, 0.f};
    bf16x8 At[4][2], B0[2][2], B1[2][2];
    unsigned gc00 = 0, gc01 = 0, gc10 = 0, gc11 = 0, gn00 = 0, gn01 = 0, gn10 = 0, gn11 = 0;
#define PG8_GATH(u, o00, o01, o10, o11) do { const unsigned* lp_ = g.list + (u).lo; const int nv_ = (u).nv; \
        int tid_ = threadIdx.x; asm volatile("" : "+v"(tid_)); int R0_, C0_, R1_, C1_; stage_rc(tid_ * 16, R0_, C0_); stage_rc(tid_ * 16 + 8192, R1_, C1_);     \
        const unsigned t00 = R0_ < nv_ ? lp_[R0_] : 0u, t01 = R1_ < nv_ ? lp_[R1_] : 0u, t10 = (128 + R0_) < nv_ ? lp_[128 + R0_] : 0u, t11 = (128 + R1_) < nv_ ? lp_[128 + R1_] : 0u; \
        o00 = t00 * (unsigned)(K * 2) + (unsigned)C0_ * 2u; o01 = t01 * (unsigned)(K * 2) + (unsigned)C1_ * 2u; o10 = t10 * (unsigned)(K * 2) + (unsigned)C0_ * 2u; o11 = t11 * (unsigned)(K * 2) + (unsigned)C1_ * 2u; } while (0)
    const char* cA = GATHER ? (const char*)g.A + (size_t)cur.koff * 2 : (const char*)g.A + (size_t)cur.pm * tstep + (size_t)cur.koff * 2;
    const char* cB = (const char*)g.Bt + (size_t)cur.e * g.bstride + (size_t)cur.pn * tstep + (size_t)cur.koff * 2;
    if constexpr (GATHER) PG8_GATH(cur, gc00, gc01, gc10, gc11);
    PG8_STAGE_B(PG8_SB(0, 0), cB); PG8_STAGE_B(PG8_SB(0, 1), cB + hstep); PG8_STAGE_A(PG8_SA(0, 0), cA, 0, gc00, gc01); PG8_STAGE_A(PG8_SA(0, 1), cA, 1, gc10, gc11);
    if (wr == 1) PG8_BAR;
    PG8_WAIT_V(2); PG8_BAR;
    PG8_STAGE_B(PG8_SB(1, 0), cB + kstep); PG8_STAGE_A(PG8_SA(1, 0), cA + kstep, 0, gc00, gc01); PG8_STAGE_B(PG8_SB(1, 1), cB + hstep + kstep);
    PG8_WAIT_V(6); PG8_BAR;
    for (;;) {
        const bool has_next = S.next(ui + 1, nxt);
        const char* nA = has_next ? (GATHER ? (const char*)g.A + (size_t)nxt.koff * 2 : (const char*)g.A + (size_t)nxt.pm * tstep + (size_t)nxt.koff * 2) : cA;
        const char* nB = has_next ? (const char*)g.Bt + (size_t)nxt.e * g.bstride + (size_t)nxt.pn * tstep + (size_t)nxt.koff * 2 : cB;
        if constexpr (GATHER) { if (has_next) PG8_GATH(nxt, gn00, gn01, gn10, gn11); else { gn00 = gc00; gn01 = gc01; gn10 = gc10; gn11 = gc11; } }
        const int nt = cur.nt;
        for (int t = 0; t < nt; t += 2) {
            const bool last = (t == nt - 2);
            const char* a1 = cA + (size_t)(t + 1) * kstep;
            const char* a2 = last ? nA : cA + (size_t)(t + 2) * kstep; const char* b2 = last ? nB : cB + (size_t)(t + 2) * kstep;
            const char* a3 = a2 + kstep; const char* b3 = b2 + kstep;
            const unsigned s00 = last ? gn00 : gc00, s01 = last ? gn01 : gc01, s10 = last ? gn10 : gc10, s11 = last ? gn11 : gc11;
            PG8_LDB(B0, 0, 0); PG8_LDB(B1, 0, 1); PG8_SCHED; PG8_LDA(At, 0, 0); PG8_STAGE_A(PG8_SA(1, 1), a1, 1, gc10, gc11);
            PG8_WAIT_V(8); PG8_WAIT_L(0); PG8_BAR; PG8_MMA(0, 0, At, B0); PG8_MMA(0, 1, At, B1); PG8_BAR; PG8_SCHED;
            PG8_LDA(At, 0, 1); PG8_STAGE_B(PG8_SB(0, 0), b2); PG8_STAGE_B(PG8_SB(0, 1), b2 + hstep); PG8_STAGE_A(PG8_SA(0, 0), a2, 0, s00, s01);
            PG8_WAIT_V(8); PG8_WAIT_L(0); PG8_BAR; PG8_MMA(1, 0, At, B0); PG8_MMA(1, 1, At, B1); PG8_BAR; PG8_SCHED;
            PG8_LDB(B0, 1, 0); PG8_LDB(B1, 1, 1); PG8_SCHED; PG8_LDA(At, 1, 0); PG8_STAGE_A(PG8_SA(0, 1), a2, 1, s10, s11);
            PG8_WAIT_V(8); PG8_WAIT_L(0); PG8_BAR; PG8_MMA(0, 0, At, B0); PG8_MMA(0, 1, At, B1); PG8_BAR; PG8_SCHED;
            PG8_LDA(At, 1, 1); PG8_STAGE_B(PG8_SB(1, 0), b3); PG8_STAGE_B(PG8_SB(1, 1), b3 + hstep); PG8_STAGE_A(PG8_SA(1, 0), a3, 0, s00, s01);
            PG8_WAIT_V(8); PG8_WAIT_L(0); PG8_BAR; PG8_MMA(1, 0, At, B0); PG8_MMA(1, 1, At, B1); PG8_BAR; PG8_SCHED;
        }
        if constexpr (ALIGN_EPI) { if (wr == 0) PG8_BAR; }
        { int te_ = threadIdx.x; asm volatile("" : "+v"(te_));
          const int we_ = __builtin_amdgcn_readfirstlane(te_ >> 6), le_ = te_ & 63; E(acc, cur, we_ >> 2, we_ & 3, le_ & 15, le_ >> 4); }
        if (!has_next) break;
#pragma unroll
        for (int a = 0; a < 2; ++a)
#pragma unroll
            for (int b = 0; b < 2; ++b)
#pragma unroll
                for (int m = 0; m < 4; ++m)
#pragma unroll
                    for (int n = 0; n < 2; ++n) acc[a][b][m][n] = (f32x4){0.f, 0.f, 0.f, 0.f};
        cur = nxt; cA = nA; cB = nB; ++ui;
        if constexpr (GATHER) { gc00 = gn00; gc01 = gn01; gc10 = gn10; gc11 = gn11; }
        if constexpr (ALIGN_EPI) { if (wr == 1) PG8_BAR; }
    }
    PG8_WAIT_V(0);
    if constexpr (!ALIGN_EPI) { if (wr == 0) PG8_BAR; }
    PG8_BAR;
#undef PG8_SA
#undef PG8_SB
#undef PG8_GLDS
#undef PG8_STAGE_A
#undef PG8_STAGE_B
#undef PG8_LDA
#undef PG8_LDB
#undef PG8_MMA
#undef PG8_WAIT_V
#undef PG8_WAIT_L
#undef PG8_BAR
#undef PG8_SCHED
#undef PG8_GATH
}

__device__ __forceinline__ u32x4 pack8(const f32x4 a, const f32x4 b) { u32x4 w; w.x = cvt_pk_bf16(a[0], a[1]); w.y = cvt_pk_bf16(a[2], a[3]); w.z = cvt_pk_bf16(b[0], b[1]); w.w = cvt_pk_bf16(b[2], b[3]); return w; }
__device__ __forceinline__ u32x2 pack4(const f32x4 a) { u32x2 w; w.x = cvt_pk_bf16(a[0], a[1]); w.y = cvt_pk_bf16(a[2], a[3]); return w; }

constexpr float ATT_C2 = 0.125f * 1.4426950408889634f;
constexpr float NORM_EPS = 1e-6f;

struct EpiInProj {
    static constexpr bool PERM = true;
    bf16_t *P, *Z, *Q, *Kb, *Vb, *G; const float *qg, *kg, *bgate;
    __device__ __forceinline__ void operator()(const f32x4 (&acc)[2][2][4][2], const Unit& u, int wr, int wc, int fr, int fq) const {
        const int row0 = u.pm * BM + wr * 64 + fr; const int pn = u.pn;
        if (pn == 0) {
#pragma unroll
            for (int ai = 0; ai < 2; ++ai)
#pragma unroll
                for (int m = 0; m < 4; ++m) { bf16_t* rowp = P + (size_t)(row0 + ai * HALF + m * 16) * 256 + wc * 32 + 8 * fq;
#pragma unroll
                    for (int bj = 0; bj < 2; ++bj) *(u32x4*)(rowp + bj * HALF) = pack8(acc[ai][bj][m][0], acc[ai][bj][m][1]); asm volatile("" ::: "memory"); }
        } else if (pn <= 2) {
            const int t = pn - 1;
#pragma unroll
            for (int ai = 0; ai < 2; ++ai)
#pragma unroll
                for (int m = 0; m < 4; ++m) { bf16_t* rowp = Z + (size_t)(row0 + ai * HALF + m * 16) * 256 + t * 128 + 16 * wc + 4 * fq;
#pragma unroll
                    for (int bj = 0; bj < 2; ++bj) { const f32x4 a = acc[ai][bj][m][0], gt = acc[ai][bj][m][1]; f32x4 z;
#pragma unroll
                        for (int i = 0; i < 4; ++i) z[i] = a[i] * sigmoidf_(gt[i]);
                        *(u32x2*)(rowp + 64 * bj) = pack4(z); } asm volatile("" ::: "memory"); }
        } else if (pn <= 6) {
            const bool isq = pn <= 4; const int t = isq ? pn - 3 : pn - 5; const float* gs = isq ? qg : kg;
            f32x4 gv[2][2];
#pragma unroll
            for (int bj = 0; bj < 2; ++bj)
#pragma unroll
                for (int n = 0; n < 2; ++n) gv[bj][n] = *(const f32x4*)(gs + 32 * bj + 8 * fq + 4 * n);
            const float sc = isq ? ATT_C2 : 1.0f; const int head = 4 * t + wc;
#pragma unroll
            for (int ai = 0; ai < 2; ++ai)
#pragma unroll
                for (int m = 0; m < 4; ++m) { float ss = 0.f;
#pragma unroll
                    for (int bj = 0; bj < 2; ++bj)
#pragma unroll
                        for (int n = 0; n < 2; ++n) { const f32x4 x = acc[ai][bj][m][n]; ss += (x[0] * x[0] + x[1] * x[1]) + (x[2] * x[2] + x[3] * x[3]); }
                    { const int ln = 16 * fq + fr; ss += __int_as_float(__builtin_amdgcn_ds_bpermute((ln ^ 16) << 2, __float_as_int(ss))); ss += __int_as_float(__builtin_amdgcn_ds_bpermute((ln ^ 32) << 2, __float_as_int(ss))); }
                    const float rs = __builtin_amdgcn_rsqf(ss * (1.0f / 64.0f) + NORM_EPS) * sc;
                    const size_t r = (size_t)(row0 + ai * HALF + m * 16);
                    bf16_t* rowp = isq ? Q + r * 1024 + 64 * head + 8 * fq : Kb + r * 512 + 64 * head + 8 * fq;
#pragma unroll
                    for (int bj = 0; bj < 2; ++bj) *(u32x4*)(rowp + 32 * bj) = pack8(acc[ai][bj][m][0] * rs * gv[bj][0], acc[ai][bj][m][1] * rs * gv[bj][1]); asm volatile("" ::: "memory"); }
        } else if (pn <= 8) {
            const int t = pn - 7;
#pragma unroll
            for (int ai = 0; ai < 2; ++ai)
#pragma unroll
                for (int m = 0; m < 4; ++m) { bf16_t* rowp = Vb + (size_t)(row0 + ai * HALF + m * 16) * 512 + 256 * t + wc * 32 + 8 * fq;
#pragma unroll
                    for (int bj = 0; bj < 2; ++bj) *(u32x4*)(rowp + bj * HALF) = pack8(acc[ai][bj][m][0], acc[ai][bj][m][1]); asm volatile("" ::: "memory"); }
        } else {
            const int c0 = 256 * (pn - 9) + wc * 32 + 8 * fq;
            f32x4 bv[2][2];
#pragma unroll
            for (int bj = 0; bj < 2; ++bj)
#pragma unroll
                for (int n = 0; n < 2; ++n) bv[bj][n] = *(const f32x4*)(bgate + c0 + bj * HALF + 4 * n);
#pragma unroll
            for (int ai = 0; ai < 2; ++ai)
#pragma unroll
                for (int m = 0; m < 4; ++m) { bf16_t* rowp = G + (size_t)(row0 + ai * HALF + m * 16) * 3072 + c0;
#pragma unroll
                    for (int bj = 0; bj < 2; ++bj) { f32x4 v0 = acc[ai][bj][m][0] + bv[bj][0], v1 = acc[ai][bj][m][1] + bv[bj][1];
#pragma unroll
                        for (int i = 0; i < 4; ++i) { v0[i] = sigmoidf_(v0[i]); v1[i] = sigmoidf_(v1[i]); }
                        *(u32x4*)(rowp + bj * HALF) = pack8(v0, v1); } asm volatile("" ::: "memory"); }
        }
    }
};

struct EpiMerge {
    static constexpr bool PERM = true;
    const bf16_t* G; bf16_t* MG;
    __device__ __forceinline__ void operator()(const f32x4 (&acc)[2][2][4][2], const Unit& u, int wr, int wc, int fr, int fq) const {
        const int row0 = u.pm * BM + wr * 64 + fr, col0 = u.pn * BM + wc * 32 + 8 * fq; const int seg = u.e;
#pragma unroll
        for (int ai = 0; ai < 2; ++ai)
#pragma unroll
            for (int m = 0; m < 4; ++m) { const size_t r = (size_t)(row0 + ai * HALF + m * 16);
                const bf16_t* gp = G + r * 3072 + seg * 1024 + col0; bf16_t* mp = MG + r * 1024 + col0;
#pragma unroll
                for (int bj = 0; bj < 2; ++bj) {
                    const u32x4 gw = *(const u32x4*)(gp + bj * HALF);
                    f32x4 v0 = acc[ai][bj][m][0], v1 = acc[ai][bj][m][1];
                    v0[0] *= bf_lo(gw.x); v0[1] *= bf_hi(gw.x); v0[2] *= bf_lo(gw.y); v0[3] *= bf_hi(gw.y);
                    v1[0] *= bf_lo(gw.z); v1[1] *= bf_hi(gw.z); v1[2] *= bf_lo(gw.w); v1[3] *= bf_hi(gw.w);
                    if (seg != 0) { u32x4 pw;
                        { const unsigned long long q0 = __hip_atomic_load((const unsigned long long*)(mp + bj * HALF), __ATOMIC_RELAXED, __HIP_MEMORY_SCOPE_AGENT), q1 = __hip_atomic_load((const unsigned long long*)(mp + bj * HALF) + 1, __ATOMIC_RELAXED, __HIP_MEMORY_SCOPE_AGENT);
                          pw.x = (unsigned)q0; pw.y = (unsigned)(q0 >> 32); pw.z = (unsigned)q1; pw.w = (unsigned)(q1 >> 32); }
                        v0[0] += bf_lo(pw.x); v0[1] += bf_hi(pw.x); v0[2] += bf_lo(pw.y); v0[3] += bf_hi(pw.y);
                        v1[0] += bf_lo(pw.z); v1[1] += bf_hi(pw.z); v1[2] += bf_lo(pw.w); v1[3] += bf_hi(pw.w); }
                    *(u32x4*)(mp + bj * HALF) = pack8(v0, v1); } asm volatile("" ::: "memory"); }
    }
};

struct EpiResid {
    static constexpr bool PERM = false;
    const float* src; float* out;
    __device__ __forceinline__ void operator()(const f32x4 (&acc)[2][2][4][2], const Unit& u, int wr, int wc, int fr, int fq) const {
        const int row0 = u.pm * BM + wr * 64 + fr, col0 = u.pn * BM + wc * 32 + 4 * fq;
#pragma unroll
        for (int ai = 0; ai < 2; ++ai)
#pragma unroll
            for (int m = 0; m < 4; ++m) { const size_t off = (size_t)(row0 + ai * HALF + m * 16) * 1024 + col0;
#pragma unroll
                for (int bj = 0; bj < 2; ++bj)
#pragma unroll
                    for (int n = 0; n < 2; ++n) { const f32x4 b = *(const f32x4*)(src + off + bj * HALF + n * 16); *(f32x4*)(out + off + bj * HALF + n * 16) = b + acc[ai][bj][m][n]; } asm volatile("" ::: "memory"); }
    }
};

struct EpiSwiGLU {
    static constexpr bool PERM = true;
    bf16_t* H; int ldh;
    __device__ __forceinline__ void operator()(const f32x4 (&acc)[2][2][4][2], const Unit& u, int wr, int wc, int fr, int fq) const {
        const int row0 = u.pm * BM + wr * 64 + fr, ch0 = u.pn * 128 + 16 * wc + 4 * fq;
#pragma unroll
        for (int ai = 0; ai < 2; ++ai)
#pragma unroll
            for (int m = 0; m < 4; ++m) { bf16_t* rowp = H + (size_t)(row0 + ai * HALF + m * 16) * ldh + ch0;
#pragma unroll
                for (int bj = 0; bj < 2; ++bj) { const f32x4 a = acc[ai][bj][m][0], b = acc[ai][bj][m][1]; f32x4 z;
#pragma unroll
                    for (int i = 0; i < 4; ++i) z[i] = a[i] * sigmoidf_(a[i]) * b[i];
                    *(u32x2*)(rowp + 64 * bj) = pack4(z); } asm volatile("" ::: "memory"); }
    }
};

struct EpiMoeDown {
    static constexpr bool PERM = false;
    float* x; const unsigned* list; const float* wgt;
    __device__ __forceinline__ void operator()(const f32x4 (&acc)[2][2][4][2], const Unit& u, int wr, int wc, int fr, int fq) const {
        const int col0 = u.pn * BM + wc * 32 + 4 * fq; const unsigned* lp = list + u.lo; const int nv = u.nv;
#pragma unroll
        for (int ai = 0; ai < 2; ++ai)
#pragma unroll
            for (int m = 0; m < 4; ++m) { const int rl = ai * HALF + wr * 64 + m * 16 + fr;
                if (rl < nv) { const unsigned tok = lp[rl]; const float w = wgt[tok]; float* xp = x + (size_t)tok * 1024 + col0;
#pragma unroll
                    for (int bj = 0; bj < 2; ++bj)
#pragma unroll
                        for (int n = 0; n < 2; ++n) { const f32x4 b = *(const f32x4*)(xp + bj * HALF + n * 16); *(f32x4*)(xp + bj * HALF + n * 16) = b + acc[ai][bj][m][n] * w; } } asm volatile("" ::: "memory"); }
    }
};
}
#include <hip/hip_bf16.h>
#include <cmath>
namespace attn_body {
using bf16=__hip_bfloat16;
using bf16x8=__attribute__((ext_vector_type(8)))short;
using s16x4=__attribute__((ext_vector_type(4)))short;
using f32x16=__attribute__((ext_vector_type(16)))float;
using u32x4=__attribute__((ext_vector_type(4)))unsigned;
constexpr int BATCH=8,NHEAD=8,SEQ=8192,D=64,KVP=NHEAD*D,QP=1024;
constexpr int NW=8,QBLK=32,QB=QBLK*NW,KVBLK=64,NQB=SEQ/QB;
constexpr int ATTN_UNIT_ROWS=QB;
__device__ __forceinline__ int crow(int r,int hi){return (r&3)+8*(r>>2)+4*hi;}
#define SBAR() __builtin_amdgcn_sched_barrier(0)
__device__ __forceinline__ void cmask(f32x16&p0,f32x16&p1,int jb,int qrel,int hi){
  const float NEG=-INFINITY; int kb=64*jb+4*hi;
  #pragma unroll
  for(int r=0;r<16;++r){int kv=kb+(r&3)+8*(r>>2); if(kv>qrel)p0[r]=NEG; if(kv+32>qrel)p1[r]=NEG;}
}

constexpr int NSLOT=3, SLOTB=8192;
constexpr int LDS_K=0, LDS_V=NSLOT*SLOTB, LDS_WS=2*NSLOT*SLOTB, LDS_OST=LDS_WS+NW*64*4, LDS_CT=LDS_OST+NW*4096, LDS_BYTES=LDS_CT+SEQ*4;
constexpr float C2=0.125f*1.4426950408889634f;
__device__ __forceinline__ void glds16(const void*gsrc,unsigned lds_dst){unsigned keep;
  asm volatile("s_mov_b32 %0, m0\n\ts_mov_b32 m0, %2\n\ts_nop 0\n\tglobal_load_lds_dwordx4 %1, off\n\ts_mov_b32 m0, %0":"=&s"(keep):"v"(gsrc),"s"(lds_dst):"memory");}
__device__ __forceinline__ float max3f(float a,float b,float c){float r;asm("v_max3_f32 %0, %1, %2, %3":"=v"(r):"v"(a),"v"(b),"v"(c));return r;}
__device__ __forceinline__ float max2f(float a,float b){float r;asm("v_max_f32_e32 %0, %1, %2":"=v"(r):"v"(a),"v"(b));return r;}
__device__ __forceinline__ float fadd_s(float a,float b){float r;asm("v_add_f32_e32 %0, %1, %2":"=v"(r):"v"(a),"v"(b));return r;}
__device__ __forceinline__ float fsub_s(float a,float b){float r;asm("v_sub_f32_e32 %0, %1, %2":"=v"(r):"v"(a),"v"(b));return r;}
typedef float f32x2_t __attribute__((ext_vector_type(2))); typedef __bf16 bf16x2_t __attribute__((ext_vector_type(2)));
__device__ __forceinline__ unsigned cvtpk_s(float lo,float hi){f32x2_t v={lo,hi};bf16x2_t b=__builtin_convertvector(v,bf16x2_t);return __builtin_bit_cast(unsigned,b);}
#define WAIT_BAR(N) asm volatile("s_waitcnt vmcnt(" #N ") lgkmcnt(0)\n\ts_barrier":::"memory")

__device__ __forceinline__ void qkt(f32x16&p0,f32x16&p1,const char*Kslot,const bf16x8*qr,int r32,int hi){
  const char*kb=Kslot+hi*1024+r32*16;
  #pragma unroll
  for(int d0=0;d0<4;++d0){
    const bf16x8 b0=*reinterpret_cast<const bf16x8*>(kb+d0*2048);
    const bf16x8 b1=*reinterpret_cast<const bf16x8*>(kb+d0*2048+512);
    {p0=__builtin_amdgcn_mfma_f32_32x32x16_bf16(b0,qr[d0],p0,0,0,0);p1=__builtin_amdgcn_mfma_f32_32x32x16_bf16(b1,qr[d0],p1,0,0,0);}}
}
typedef __attribute__((address_space(3))) const char* lds_cptr;
typedef short v4i16_t __attribute__((ext_vector_type(4)));
__device__ __forceinline__ void kload8(bf16x8*kf,lds_cptr kp){
  kf[0]=*(const __attribute__((address_space(3))) bf16x8*)(kp);      kf[1]=*(const __attribute__((address_space(3))) bf16x8*)(kp+512);
  kf[2]=*(const __attribute__((address_space(3))) bf16x8*)(kp+2048); kf[3]=*(const __attribute__((address_space(3))) bf16x8*)(kp+2560);
  kf[4]=*(const __attribute__((address_space(3))) bf16x8*)(kp+4096); kf[5]=*(const __attribute__((address_space(3))) bf16x8*)(kp+4608);
  kf[6]=*(const __attribute__((address_space(3))) bf16x8*)(kp+6144); kf[7]=*(const __attribute__((address_space(3))) bf16x8*)(kp+6656);
}
__device__ __forceinline__ void kload2(bf16x8*kf,lds_cptr kp,int j){ kf[2*j]=*(const __attribute__((address_space(3))) bf16x8*)(kp+j*2048); kf[2*j+1]=*(const __attribute__((address_space(3))) bf16x8*)(kp+j*2048+512); }
__device__ __forceinline__ s16x4 vtr(lds_cptr p){ return __builtin_bit_cast(s16x4,__builtin_amdgcn_ds_read_tr16_b64_v4i16((__attribute__((address_space(3))) v4i16_t*)p)); }
__device__ __forceinline__ float rowmax(const f32x16&p0,const f32x16&p1){
  float a=max3f(p0[0],p0[1],p1[0]),b=max3f(p0[2],p0[3],p1[1]);a=max3f(a,p1[2],p1[3]);
  #pragma unroll
  for(int r=4;r<16;r+=4){a=max3f(a,p0[r],p0[r+1]);b=max3f(b,p0[r+2],p0[r+3]);a=max3f(a,p1[r],p1[r+1]);b=max3f(b,p1[r+2],p1[r+3]);}
  const float m=max2f(a,b);
  auto rr=__builtin_amdgcn_permlane32_swap(__float_as_uint(m),__float_as_uint(m),false,false);
  return max2f(__uint_as_float(rr[0]),__uint_as_float(rr[1]));
}
__device__ __forceinline__ void pv(f32x16*o,int vb,bf16x8 pa0,bf16x8 pa1,bf16x8 pa2,bf16x8 pa3){
  #pragma unroll
  for(int d0=0;d0<2;++d0){s16x4 lo[4],hi[4];
    #pragma unroll
    for(int ks=0;ks<4;++ks){
      asm volatile("ds_read_b64_tr_b16 %0,%1 offset:%c2":"=&v"(lo[ks]):"v"(vb),"i"(d0*4096+ks*1024):"memory");
      asm volatile("ds_read_b64_tr_b16 %0,%1 offset:%c2":"=&v"(hi[ks]):"v"(vb),"i"(d0*4096+ks*1024+512):"memory");}
    asm volatile("s_waitcnt lgkmcnt(0)":::"memory");SBAR();
    #define PK(k) (bf16x8){lo[k][0],lo[k][1],lo[k][2],lo[k][3],hi[k][0],hi[k][1],hi[k][2],hi[k][3]}
    o[d0]=__builtin_amdgcn_mfma_f32_32x32x16_bf16(pa0,PK(0),o[d0],0,0,0);
    o[d0]=__builtin_amdgcn_mfma_f32_32x32x16_bf16(pa1,PK(1),o[d0],0,0,0);
    o[d0]=__builtin_amdgcn_mfma_f32_32x32x16_bf16(pa2,PK(2),o[d0],0,0,0);
    o[d0]=__builtin_amdgcn_mfma_f32_32x32x16_bf16(pa3,PK(3),o[d0],0,0,0);
    #undef PK
  }
}

#ifndef ATTN_STORE16
#define ATTN_STORE16(p,v) (*(u32x4*)(p)=(v))
#endif
template<int THRL> __device__ __forceinline__ void attn_unit(int b,int h,int qb,const bf16*Q,const bf16*__restrict__ K,const bf16*__restrict__ V,bf16*O,const float*__restrict__ NCL,char*shm){
  int tid_o=threadIdx.x; asm volatile("":"+v"(tid_o));
  const int tid=tid_o,lane=tid&63,r32=lane&31,hi=lane>>5; const int wid=__builtin_amdgcn_readfirstlane(tid>>6);
  const long rowbase=(long)b*SEQ; const int q0=qb*QB;
  const bf16*Qw=Q+(rowbase+q0+wid*QBLK)*QP+h*D;
  const bf16*Kh=K+rowbase*KVP+h*D,*Vh=V+rowbase*KVP+h*D;
  const unsigned lds0=(unsigned)(uintptr_t)shm;
  float*wsf=(float*)(shm+LDS_WS)+wid*64;
  const bf16*ksrc=Kh+(long)lane*KVP+wid*8;
  const bf16*vsrc=Vh+(long)(16*(wid&3)+(lane>>2))*KVP+(wid>>2)*32+(lane&3)*8;
  const unsigned kdst=lds0+LDS_K+wid*1024, vdst=lds0+LDS_V+wid*1024;
  #define DMA_K(t,slot) glds16(ksrc+(long)(t)*KVBLK*KVP,(unsigned)__builtin_amdgcn_readfirstlane(kdst+(slot)))
  #define DMA_V(t,slot) glds16(vsrc+(long)(t)*KVBLK*KVP,(unsigned)__builtin_amdgcn_readfirstlane(vdst+(slot)))
  const int vb0=(int)(lds0+LDS_V)+((lane>>4)&1)*32+(lane&3)*8+(4*hi+((lane&15)>>2))*64;
  const char*Kbase=shm+LDS_K; bf16x8 kf[8];
  const lds_cptr shm3=(lds_cptr)shm; const lds_cptr kp0=shm3+LDS_K+hi*1024+r32*16; const lds_cptr vp0=shm3+LDS_V+((lane>>4)&1)*32+(lane&3)*8+(4*hi+((lane&15)>>2))*64;
  const int NT=(q0+QB)/KVBLK;
  { typedef float f32x4_t __attribute__((ext_vector_type(4))); __attribute__((address_space(3))) float* ct=(__attribute__((address_space(3))) float*)(shm3+LDS_CT);
    for(int i=tid*4;i<q0+QB;i+=NW*64*4) *(__attribute__((address_space(3))) f32x4_t*)(ct+i)=*(const f32x4_t*)(NCL+i); }
  const __attribute__((address_space(3))) float* ctl=(const __attribute__((address_space(3))) float*)(shm3+LDS_CT)+4*hi;
  #define CINIT(C0,C1,t) do{ typedef float f32x4_t __attribute__((ext_vector_type(4))); const float nm_=-mhat; const __attribute__((address_space(3))) float* cb_=ctl+64*(t); \
    _Pragma("unroll") for(int g_=0;g_<4;++g_){ const f32x4_t b0_=*(const __attribute__((address_space(3))) f32x4_t*)(cb_+8*g_), b1_=*(const __attribute__((address_space(3))) f32x4_t*)(cb_+32+8*g_); \
      _Pragma("unroll") for(int i_=0;i_<4;++i_){ C0[4*g_+i_]=nm_+b0_[i_]; C1[4*g_+i_]=nm_+b1_[i_]; } } }while(0)
  DMA_K(0,0);DMA_V(0,0);DMA_K(1,SLOTB);
  bf16x8 qr[4];
  #pragma unroll
  for(int d0=0;d0<4;++d0)qr[d0]=*reinterpret_cast<const bf16x8*>(&Qw[(long)r32*QP+d0*16+hi*8]);
  float mhat=0.f,l_reg=0.f;f32x16 o[2];o[0]=f32x16{};o[1]=f32x16{};
  const int qrel=wid*QBLK+r32;
  #define CMASK(P0,P1,t) do{int jb_=(t)-(NT-4); if(jb_>=0)cmask(P0,P1,jb_,qrel,hi);}while(0)
  bool resc=false;
  #define START(P0,P1) do{ const float rm=rowmax(P0,P1); resc=false; \
    { const float dl=rm; mhat=fadd_s(mhat,dl); \
      _Pragma("unroll") for(int r=0;r<16;++r){P0[r]=fsub_s(P0[r],dl);P1[r]=fsub_s(P1[r],dl);} \
      } \
    _Pragma("unroll") for(int r=0;r<16;++r)P0[r]=__builtin_amdgcn_exp2f(P0[r]); }while(0)
  #define RESC() do{ if(resc){ asm volatile("s_waitcnt lgkmcnt(0)":::"memory"); \
      _Pragma("unroll") for(int d_=0;d_<2;++d_) _Pragma("unroll") for(int r=0;r<16;++r)o[d_][r]*=wsf[crow(r,hi)]; } }while(0)
  f32x16 pA0,pA1,pB0,pB1;
  int sl_prev=0,sl_cur=0,sl_next=SLOTB;
  #define ROT() do{sl_prev=sl_cur;sl_cur=sl_next;sl_next=(sl_next==(NSLOT-1)*SLOTB)?0:sl_next+SLOTB;}while(0)
  DMA_K(2,2*SLOTB);
  WAIT_BAR(3);
  CINIT(pA0,pA1,0); qkt(pA0,pA1,Kbase,qr,r32,hi);asm volatile("s_nop 15\n\ts_nop 7":"+v"(pA0),"+v"(pA1));CMASK(pA0,pA1,0);
  START(pA0,pA1);
  _Pragma("unroll") for(int r=0;r<16;++r)pA1[r]=__builtin_amdgcn_exp2f(pA1[r]);
  WAIT_BAR(0);
  DMA_K(3,0);DMA_V(1,SLOTB);
  ROT();
  kload8(kf,kp0+sl_cur);
  WAIT_BAR(2);
  s16x4 vlo[8],vhi[8]; u32x4 pw0,pw1,pw2,pw3;
  #define PKW(P,B) cvtpk_s(P[B],P[B+1])
  #define PAF(k) __builtin_bit_cast(bf16x8,pw##k)
  #define VFR(i) (bf16x8){vlo[i][0],vlo[i][1],vlo[i][2],vlo[i][3],vhi[i][0],vhi[i][1],vhi[i][2],vhi[i][3]}
  #define PIN(x) asm volatile("":"+v"(x))
  #define MX3(a,b,c) __builtin_fmaxf(__builtin_fmaxf((a),(b)),(c))
  #define GAPA(MF,A0,A1,A2,A3,W0,W1,PW) do{ MF; sacc+=A0; sacc+=A1; sacc+=A2; sacc+=A3; PIN(sacc); W0; W1; PIN(PW); SBAR(); }while(0)
  #define EX(v) __builtin_amdgcn_exp2f(v)
  #define GAPB(MF,X,B) do{ MF; X[B]=EX(X[B]); X[B+1]=EX(X[B+1]); X[B+2]=EX(X[B+2]); X[B+3]=EX(X[B+3]); PIN(X); SBAR(); }while(0)
  #define VRD(i) do{ vlo[i]=vtr(vp_+(((i)>>2)*4096+((i)&3)*1024)); vhi[i]=vtr(vp_+(((i)>>2)*4096+((i)&3)*1024+512)); }while(0)
  #define KRD(G,j) do{ if(G){ kload2(kf,kp0+sl_next,j); SBAR(); } }while(0)
  #define STEP(C0,C1,P0,P1,t,GK,GV,GL) do{ SBAR(); CINIT(C0,C1,t); SBAR(); \
    const lds_cptr vp_=vp0+sl_prev; \
    VRD(0); SBAR(); float sacc=(P0[0]+P0[1]); \
    GAPA(C0=__builtin_amdgcn_mfma_f32_32x32x16_bf16(kf[0],qr[0],C0,0,0,0), P0[2],P0[3],P0[4],P0[5],     pw0[0]=PKW(P0,0), pw0[1]=PKW(P0,2), pw0); \
    VRD(4); SBAR(); GAPA(C1=__builtin_amdgcn_mfma_f32_32x32x16_bf16(kf[1],qr[0],C1,0,0,0), P0[6],P0[7],P0[8],P0[9],     pw0[2]=PKW(P0,4), pw0[3]=PKW(P0,6), pw0); \
    VRD(1); SBAR(); GAPA(C0=__builtin_amdgcn_mfma_f32_32x32x16_bf16(kf[2],qr[1],C0,0,0,0),   P0[10],P0[11],P0[12],P0[13], pw1[0]=PKW(P0,8), pw1[1]=PKW(P0,10), pw1); \
    VRD(5); SBAR(); GAPA(C1=__builtin_amdgcn_mfma_f32_32x32x16_bf16(kf[3],qr[1],C1,0,0,0),   P0[14],P0[15],P1[0],P1[1],   pw1[2]=PKW(P0,12),pw1[3]=PKW(P0,14), pw1); \
    VRD(2); SBAR(); GAPA(C0=__builtin_amdgcn_mfma_f32_32x32x16_bf16(kf[4],qr[2],C0,0,0,0),   P1[2],P1[3],P1[4],P1[5],     pw2[0]=PKW(P1,0), pw2[1]=PKW(P1,2), pw2); \
    VRD(6); SBAR(); GAPA(C1=__builtin_amdgcn_mfma_f32_32x32x16_bf16(kf[5],qr[2],C1,0,0,0),   P1[6],P1[7],P1[8],P1[9],     pw2[2]=PKW(P1,4), pw2[3]=PKW(P1,6), pw2); \
    VRD(3); SBAR(); GAPA(C0=__builtin_amdgcn_mfma_f32_32x32x16_bf16(kf[6],qr[3],C0,0,0,0),   P1[10],P1[11],P1[12],P1[13], pw3[0]=PKW(P1,8), pw3[1]=PKW(P1,10), pw3); \
    VRD(7); SBAR(); GAPA(C1=__builtin_amdgcn_mfma_f32_32x32x16_bf16(kf[7],qr[3],C1,0,0,0),   P1[14],P1[15],0.f,0.f,       pw3[2]=PKW(P1,12),pw3[3]=PKW(P1,14), pw3); \
    l_reg+=sacc; \
    if(GK){DMA_K((t)+3,sl_cur);} if(GV){DMA_V((t)+1,sl_next);} \
    CMASK(C0,C1,t); \
    { float a=MX3(C0[0],C0[1],C1[0]),b=MX3(C0[2],C0[3],C1[1]); a=MX3(a,C1[2],C1[3]); \
      _Pragma("unroll") for(int r=4;r<16;r+=4){a=MX3(a,C0[r],C0[r+1]);b=MX3(b,C0[r+2],C0[r+3]);a=MX3(a,C1[r],C1[r+1]);b=MX3(b,C1[r+2],C1[r+3]);} \
      float rm=__builtin_fmaxf(a,b); { auto rr=__builtin_amdgcn_permlane32_swap(__float_as_uint(rm),__float_as_uint(rm),false,false); rm=__builtin_fmaxf(__uint_as_float(rr[0]),__uint_as_float(rr[1])); } \
      resc=false; \
      if(__builtin_expect(__any(rm>(float)THRL),0)){ const float dl=__builtin_fmaxf(rm,0.f); mhat+=dl; \
        _Pragma("unroll") for(int r=0;r<16;++r){C0[r]-=dl;C1[r]-=dl;} \
        const float f=__builtin_amdgcn_exp2f(-dl); l_reg*=f; if(hi==0)wsf[r32]=f; resc=true; } } \
    SBAR(); \
    GAPB(o[0]=__builtin_amdgcn_mfma_f32_32x32x16_bf16(PAF(0),VFR(0),o[0],0,0,0), C0,0); \
    GAPB(o[1]=__builtin_amdgcn_mfma_f32_32x32x16_bf16(PAF(0),VFR(4),o[1],0,0,0), C0,4); \
    KRD(GL,0); GAPB(o[0]=__builtin_amdgcn_mfma_f32_32x32x16_bf16(PAF(1),VFR(1),o[0],0,0,0), C0,8); \
    KRD(GL,1); GAPB(o[1]=__builtin_amdgcn_mfma_f32_32x32x16_bf16(PAF(1),VFR(5),o[1],0,0,0), C0,12); \
    KRD(GL,2); GAPB(o[0]=__builtin_amdgcn_mfma_f32_32x32x16_bf16(PAF(2),VFR(2),o[0],0,0,0), C1,0); \
    KRD(GL,3); GAPB(o[1]=__builtin_amdgcn_mfma_f32_32x32x16_bf16(PAF(2),VFR(6),o[1],0,0,0), C1,4); \
    GAPB(o[0]=__builtin_amdgcn_mfma_f32_32x32x16_bf16(PAF(3),VFR(3),o[0],0,0,0), C1,8); \
    GAPB(o[1]=__builtin_amdgcn_mfma_f32_32x32x16_bf16(PAF(3),VFR(7),o[1],0,0,0), C1,12); \
    }while(0)
  int t=1;
  #undef CMASK
  #define CMASK(P0,P1,t) do{}while(0)
  for(;t+5<NT;t+=2){
    STEP(pB0,pB1,pA0,pA1,t,true,true,true);     WAIT_BAR(2); RESC(); ROT();
    STEP(pA0,pA1,pB0,pB1,t+1,true,true,true);   WAIT_BAR(2); RESC(); ROT();
  }
  #undef CMASK
  #define CMASK(P0,P1,t) do{int jb_=(t)-(NT-4); if(jb_>=0)cmask(P0,P1,jb_,qrel,hi);}while(0)
  #define ENDW(tt) do{ if((tt)+3<NT){WAIT_BAR(2);} else if((tt)+2<NT){WAIT_BAR(1);} else {WAIT_BAR(0);} }while(0)
  for(;t+1<NT;t+=2){
    STEP(pB0,pB1,pA0,pA1,t,(t+3<NT),(t+1<NT),(t+1<NT));       ENDW(t);   RESC(); ROT();
    STEP(pA0,pA1,pB0,pB1,t+1,(t+4<NT),(t+2<NT),(t+2<NT));     ENDW(t+1); RESC(); ROT();
  }
  STEP(pB0,pB1,pA0,pA1,NT-1,false,false,false); RESC();
  { float sacc=pB0[0]+pB0[1]; _Pragma("unroll") for(int r=2;r<16;++r)sacc+=pB0[r]; _Pragma("unroll") for(int r=0;r<16;++r)sacc+=pB1[r]; l_reg+=sacc;
    pw0=(u32x4){PKW(pB0,0),PKW(pB0,2),PKW(pB0,4),PKW(pB0,6)};pw1=(u32x4){PKW(pB0,8),PKW(pB0,10),PKW(pB0,12),PKW(pB0,14)};pw2=(u32x4){PKW(pB1,0),PKW(pB1,2),PKW(pB1,4),PKW(pB1,6)};pw3=(u32x4){PKW(pB1,8),PKW(pB1,10),PKW(pB1,12),PKW(pB1,14)};
    SBAR(); pv(o,vb0+sl_cur,PAF(0),PAF(1),PAF(2),PAF(3)); }
  #undef PKW
  #undef PAF
  #undef VFR
  #undef PIN
  #undef MX3
  #undef GAPA
  #undef GAPB
  #undef EX
  #undef VRD
  #undef KRD
  #undef STEP
  #undef ENDW
  {auto rr=__builtin_amdgcn_permlane32_swap(__float_as_uint(l_reg),__float_as_uint(l_reg),false,false);l_reg=__uint_as_float(rr[0])+__uint_as_float(rr[1]);}
  if(hi==0)wsf[32+r32]=l_reg;asm volatile("s_waitcnt lgkmcnt(0)":::"memory");
  float rli[16];
  #pragma unroll
  for(int r=0;r<16;++r)rli[r]=__builtin_amdgcn_rcpf(wsf[32+crow(r,hi)]);
  bf16*Ow=O+(rowbase+q0+wid*QBLK)*QP+h*D;
  { bf16*stg=(bf16*)(shm+LDS_OST)+wid*2048;
    #pragma unroll
    for(int r=0;r<16;++r){const int orow=crow(r,hi);
      #pragma unroll
      for(int d0=0;d0<2;++d0)stg[orow*64+d0*32+r32]=__float2bfloat16(o[d0][r]*rli[r]);}
    asm volatile("s_waitcnt lgkmcnt(0)":::"memory");
    #pragma unroll
    for(int i=0;i<4;++i){const int row=i*8+(lane>>3),ch=lane&7; const u32x4 v=*(const u32x4*)(stg+row*64+ch*8); ATTN_STORE16(Ow+(long)row*QP+ch*8,v);} }
  asm volatile("s_waitcnt lgkmcnt(0)\n\ts_barrier":::"memory");
  #undef DMA_K
  #undef DMA_V
  #undef CMASK
  #undef START
  #undef RESC
  #undef ROT
  #undef CINIT
}
constexpr int ATTN_LDS_BYTES=LDS_BYTES;
struct AttnTensors { const bf16* Q; const bf16* K; const bf16* V; bf16* O; const float* NCL; };
struct AttnUnit { int bh; int qb; };
struct StaticOrder {
  int vcu,G;
  __device__ __forceinline__ explicit StaticOrder(int grid,int block):vcu((grid%8==0)?(block%8)*(grid/8)+block/8:block),G(grid){}
  __device__ __forceinline__ bool next(int i,AttnUnit&u)const{ const int V=vcu+(i>>2)*G; if(V>=BATCH*NHEAD*8)return false; const int s=V&7,ii=i&3; u.bh=V>>3; u.qb=(ii==0)?s:(ii==1)?15-s:(ii==2)?16+s:31-s; return true; }
  __device__ __forceinline__ void a_ready(const AttnUnit&)const{}
  __device__ __forceinline__ void done(const AttnUnit&)const{}
};
template<class Sched,int THRL=8> __device__ __forceinline__ void attn_phase(char*lds,const AttnTensors&T_,const Sched&S){
  AttnTensors T;
  { unsigned long long q_=(unsigned long long)T_.Q,k_=(unsigned long long)T_.K,v_=(unsigned long long)T_.V,o_=(unsigned long long)T_.O,c_=(unsigned long long)T_.NCL; asm volatile("":"+s"(q_),"+s"(k_),"+s"(v_),"+s"(o_),"+s"(c_));
    typedef __attribute__((address_space(1))) bf16 gbf; typedef __attribute__((address_space(1))) float gf;
    T.Q=(const bf16*)(const gbf*)q_; T.K=(const bf16*)(const gbf*)k_; T.V=(const bf16*)(const gbf*)v_; T.O=(bf16*)(gbf*)o_; T.NCL=(const float*)(const gf*)c_; }
  AttnUnit u;
  for(int i=0;S.next(i,u);++i){ S.a_ready(u); attn_unit<THRL>(u.bh/NHEAD,u.bh%NHEAD,u.qb,T.Q,T.K,T.V,T.O,T.NCL+(long)u.bh*SEQ,lds); S.done(u); }
}
#undef SBAR
#undef WAIT_BAR
}

constexpr int NWAVES = 8;
#ifndef MK_PER_PHASE
#define MK_PER_PHASE 0
#endif

constexpr int D = 1024, BATCH = 8, SEQ = 8192, M = BATCH * SEQ, DEPTH = 4;
constexpr int IN_COLS = 5384, OFF_CONV = 256, OFF_Q = 768, OFF_K = 1280, OFF_V = 1792, OFF_F = 2304, OFF_G = 2312;
constexpr int NIN = 5376;
constexpr int DFF = 2816, DFFE = 3584, NEXP = 8, CONVK = 31;
constexpr float LOG2E = 1.4426950408889634f;

constexpr size_t MiB = 1u << 20;
constexpr size_t WS_CTL = 0, CTL_ZERO_BYTES = 256 * 1024;
constexpr size_t WS_NLF = 1 * MiB;
constexpr size_t WS_NCL = 3 * MiB;
constexpr size_t WS_WIN = 5 * MiB;
constexpr size_t WS_WBR = 16 * MiB;
constexpr size_t WS_WOUT = 18 * MiB;
constexpr size_t WS_WFF = 20 * MiB;
constexpr size_t WS_HB = 188 * MiB;
constexpr size_t WS_Y = 316 * MiB;
constexpr size_t WS_K = 444 * MiB, WS_V = 508 * MiB;
constexpr size_t WS_P = 572 * MiB, WS_Z = 604 * MiB;
constexpr size_t WS_G = 636 * MiB;
constexpr size_t WS_HID = 316 * MiB;
constexpr size_t WS_LIST = 800 * MiB;
constexpr size_t WS_MOEW = 808 * MiB;
constexpr size_t WS_END = 1020 * MiB;
constexpr size_t WFF_W2_DENSE = (size_t)2 * DFF * D * 2;
constexpr size_t WFF_W13_E = (size_t)2 * DFFE * D * 2, WFF_W2_E = (size_t)D * DFFE * 2, WFF_W2_MOE = 8 * WFF_W13_E;
static_assert(WS_WIN + (size_t)NIN * D * 2 <= WS_WBR && WS_WFF + WFF_W2_MOE + 8 * WFF_W2_E <= WS_HB && WS_G + (size_t)M * 3072 * 2 <= WS_END && WS_HID + (size_t)264 * 256 * DFFE * 2 <= WS_LIST, "d_ws map");
constexpr int CW_TMO = 0;
constexpr int CW_MOECNT = 64;
constexpr int CW_BAR = 4096;

constexpr int RING_OFF = 0, RING_BYTES = 131072;
constexpr int LDSCTL_OFF = RING_BYTES, MISC_OFF = LDSCTL_OFF + 320;
constexpr int MOETAB_OFF = LDSCTL_OFF + 1024;
constexpr int LDS_BYTES = 147456;
static_assert(MISC_OFF + 128 <= MOETAB_OFF && MOETAB_OFF + 272 * 4 <= LDS_BYTES, "LDS map");

#define GAS __attribute__((address_space(1)))
#define LAS __attribute__((address_space(3)))
typedef unsigned short bf16;
typedef unsigned v4u __attribute__((ext_vector_type(4)));
typedef unsigned v2u __attribute__((ext_vector_type(2)));
typedef float f32x4 __attribute__((ext_vector_type(4)));
typedef GAS unsigned gu32;
#define RLX_AGENT __ATOMIC_RELAXED, __HIP_MEMORY_SCOPE_AGENT
#define LDS_WAIT() asm volatile("s_waitcnt lgkmcnt(0)" ::: "memory")
#define VM_WAIT() asm volatile("s_waitcnt vmcnt(0)" ::: "memory")
__device__ __forceinline__ unsigned f2bf(float f) { unsigned u = __builtin_bit_cast(unsigned, f); return (u + 0x7fffu + ((u >> 16) & 1u)) >> 16; }
__device__ __forceinline__ unsigned pk2(float lo, float hi) { return f2bf(lo) | (f2bf(hi) << 16); }
__device__ __forceinline__ float bflo(unsigned w) { return __uint_as_float(w << 16); }
__device__ __forceinline__ float bfhi(unsigned w) { return __uint_as_float(w & 0xffff0000u); }

#define XB_TMO      128
#define XB_XCNT(j)  (256  + 64 * (j))
#define XB_XSUB(j)  (1280 + 64 * (j))
#define XB_XGEN(j)  (2304 + 64 * (j))
#define XB_TOP      3328
#define XB_TOPGEN   3392
#define XCD_BAR_WORDS 3456
#define XB_SPIN_CAP (1u << 18)

__device__ __forceinline__ unsigned xb_ld(unsigned* p)              { return __hip_atomic_load(p, __ATOMIC_RELAXED, __HIP_MEMORY_SCOPE_AGENT); }
__device__ __forceinline__ unsigned xb_add(unsigned* p, unsigned v) { return __hip_atomic_fetch_add(p, v, __ATOMIC_RELAXED, __HIP_MEMORY_SCOPE_AGENT); }
__device__ __forceinline__ unsigned xb_xcc_id() { return (unsigned)__builtin_amdgcn_s_getreg((3 << 11) | 20) & 0xFu; }
#define XB_SPIN(cond, bar) do { unsigned _sp = 0; while (cond) { __builtin_amdgcn_s_sleep(1); \
    if ((++_sp & 255u) == 0u) { if (xb_ld(&(bar)[XB_TMO])) break; if (_sp > XB_SPIN_CAP) { atomicAdd(&(bar)[XB_TMO], 1u); break; } } } } while (0)

struct XcdBarrier {
    unsigned* bar; unsigned x;
    volatile LAS unsigned* st;
};

__device__ __forceinline__ XcdBarrier xcd_barrier_post(unsigned* bar, volatile LAS unsigned* st) {
    XcdBarrier b; b.bar = bar; b.x = xb_xcc_id(); b.st = st;
    if (threadIdx.x == 0) (void)xb_add(&bar[XB_XCNT(b.x)], 1u);
    return b;
}
__device__ __forceinline__ void xcd_barrier_complete(unsigned* bar, unsigned x, unsigned& nloc, unsigned& nx) {
    const unsigned G = gridDim.x * gridDim.y * gridDim.z;
    unsigned sum, cnt, mine, sp = 0u;
    for (;;) {
        sum = 0u; cnt = 0u; mine = 0u;
#pragma unroll
        for (unsigned j = 0; j < 16; ++j) { const unsigned c = xb_ld(&bar[XB_XCNT(j)]); sum += c; cnt += (c > 0u) ? 1u : 0u; mine = (j == x) ? c : mine; }
        if (sum == G) break;
        __builtin_amdgcn_s_sleep(1);
        if ((++sp & 255u) == 0u) { if (xb_ld(&bar[XB_TMO])) break; if (sp > XB_SPIN_CAP) { atomicAdd(&bar[XB_TMO], 1u); break; } }
    }
    nloc = mine > 0u ? mine : 1u; nx = cnt > 0u ? cnt : 1u;
}

__device__ __forceinline__ void xcd_barrier(const XcdBarrier& b) {
    asm volatile("s_waitcnt vmcnt(0)" ::: "memory");
    __syncthreads();
    if (threadIdx.x == 0) {
        unsigned* bar = b.bar;
        __builtin_amdgcn_s_waitcnt(0);
        unsigned nloc = b.st[0], nx = b.st[1];
        if (nloc == 0u) { xcd_barrier_complete(bar, b.x, nloc, nx); b.st[0] = nloc; b.st[1] = nx; }
        const unsigned old = xb_add(&bar[XB_XSUB(b.x)], 1u);
        const unsigned gen = old / nloc;
        if (old + 1u == (gen + 1u) * nloc) {
            __builtin_amdgcn_fence(__ATOMIC_RELEASE, "agent");
            asm volatile("s_waitcnt vmcnt(0)" ::: "memory");
            const unsigned og = xb_add(&bar[XB_TOP], 1u);
            const unsigned tg = og / nx;
            if (og + 1u == (tg + 1u) * nx) xb_add(&bar[XB_TOPGEN], 1u);
            else XB_SPIN(xb_ld(&bar[XB_TOPGEN]) == tg, bar);
            __builtin_amdgcn_fence(__ATOMIC_ACQUIRE, "agent");
            xb_add(&bar[XB_XGEN(b.x)], 1u);
            asm volatile("s_waitcnt vmcnt(0)" ::: "memory");
        } else {
            XB_SPIN(xb_ld(&bar[XB_XGEN(b.x)]) == gen, bar);
            __builtin_amdgcn_fence(__ATOMIC_ACQUIRE, "agent");
            asm volatile("s_waitcnt vmcnt(0)" ::: "memory");
        }
    }
    __syncthreads();
}

struct Frame {
    LAS unsigned char* lds;
    volatile LAS unsigned* MISC;
    int vcu, G;
};
struct Site {
    gu32* ctl; unsigned char* ws; const float* const __attribute__((address_space(4)))* in; float* out;
    int tid, lane, wave;
};
__device__ __forceinline__ Site make_site() {
    Site P; int t_ = threadIdx.x; asm volatile("" : "+v"(t_)); P.tid = t_; P.lane = t_ & 63; P.wave = __builtin_amdgcn_readfirstlane(t_ >> 6);
    unsigned long long kp_ = (unsigned long long)__builtin_amdgcn_kernarg_segment_ptr(); asm volatile("" : "+s"(kp_));
    P.in = (const float* const __attribute__((address_space(4)))*)kp_;
    P.out = (float*)(GAS float*)(*(const __attribute__((address_space(4))) unsigned long long*)(kp_ + 200));
    P.ws = (unsigned char*)(GAS unsigned char*)(*(const __attribute__((address_space(4))) unsigned long long*)(kp_ + 208));
    P.ctl = (gu32*)(P.ws + WS_CTL);
    return P;
}
__device__ __forceinline__ float wave_sum(float v, int lane) {
#pragma unroll
    for (int o = 1; o < 64; o <<= 1) v += __int_as_float(__builtin_amdgcn_ds_bpermute((lane ^ o) << 2, __float_as_int(v)));
    return v;
}

__device__ __forceinline__ void transpose_item(const float* colp, size_t sstride, bf16* WT, int K, int n0, int k0, LAS float* scr, int lane) {
    const float* sp = colp + (size_t)k0 * sstride;
#pragma unroll 8
    for (int i = 0; i < 32; ++i) { const int kk = 2 * i + (lane >> 5); scr[kk * 33 + (lane & 31)] = sp[(size_t)kk * sstride]; }
    LDS_WAIT(); asm volatile("" ::: "memory");
    const int c = lane & 7;
#pragma unroll
    for (int j = 0; j < 4; ++j) { const int n = (lane >> 3) + 8 * j; const LAS float* s = scr + (8 * c) * 33 + n;
        v4u o; o.x = pk2(s[0 * 33], s[1 * 33]); o.y = pk2(s[2 * 33], s[3 * 33]); o.z = pk2(s[4 * 33], s[5 * 33]); o.w = pk2(s[6 * 33], s[7 * 33]);
        *(GAS v4u*)(WT + (size_t)(n0 + n) * K + k0 + 8 * c) = o; }
    LDS_WAIT(); asm volatile("" ::: "memory");
}
__device__ __forceinline__ int inproj_src_col(int p) {
    const int t = p >> 8, q = p & 255;
    if (t == 0) return q;
    if (t <= 2) { const int ch = (t - 1) * 128 + 4 * (q >> 3) + (q & 3); return OFF_CONV + ((q >> 2) & 1) * 256 + ch; }
    if (t <= 6) { const int base = t <= 4 ? OFF_Q + 256 * (t - 3) : OFF_K + 256 * (t - 5); return base + 64 * ((q >> 5) & 3) + 32 * (q >> 7) + (q & 31); }
    if (t <= 8) return OFF_V + 256 * (t - 7) + q;
    return OFF_G + 256 * (t - 9) + q;
}
__device__ __forceinline__ void convert_layer_weights(const Frame& F, const Site& P, int l) {
    LAS float* scr = (LAS float*)(F.lds + RING_OFF + P.wave * 16384);
    const int gw = F.vcu * NWAVES + P.wave, NGW = F.G * NWAVES, lane = P.lane;
    bf16* WIN = (bf16*)(P.ws + WS_WIN); bf16* WBR = (bf16*)(P.ws + WS_WBR); bf16* WOUT = (bf16*)(P.ws + WS_WOUT);
    const float* w_in = P.in[2] + (size_t)l * D * IN_COLS;
    const float* w_brc = P.in[14] + (size_t)l * 256 * D; const float* w_bra = P.in[15] + (size_t)l * 512 * D; const float* w_out = P.in[16] + (size_t)l * D * D;
    constexpr int I_IN = 16 * (NIN / 32), I_BC = 4 * 32, I_BA = 8 * 32, I_OUT = 16 * 32;
    const bool moe = (l & 1) != 0; const int li = l >> 1;
    constexpr int I_D13 = 16 * (2 * DFF / 32), I_D2 = (DFF / 64) * 32, I_E13 = 16 * (2 * DFFE / 32), I_E2 = (DFFE / 64) * 32;
    const int n_ff = moe ? 8 * (I_E13 + I_E2) : (I_D13 + I_D2);
    const int NITEMS = I_IN + I_BC + I_BA + I_OUT + n_ff;
    for (int it = gw; it < NITEMS; it += NGW) {
        int r = it;
        if (r < I_IN) { const int kb = r / (NIN / 32), nb = r % (NIN / 32); const int p = 32 * nb + (lane & 31);
            transpose_item(w_in + inproj_src_col(p), IN_COLS, WIN, D, 32 * nb, 64 * kb, scr, lane); continue; } r -= I_IN;
        if (r < I_BC) { const int kb = r / 32, nb = r % 32;
            transpose_item(w_brc + 32 * nb + (lane & 31), D, WBR + 256, D, 32 * nb, 64 * kb, scr, lane); continue; } r -= I_BC;
        if (r < I_BA) { const int kb = r / 32, nb = r % 32;
            transpose_item(w_bra + 32 * nb + (lane & 31), D, WBR + 512, D, 32 * nb, 64 * kb, scr, lane); continue; } r -= I_BA;
        if (r < I_OUT) { const int kb = r / 32, nb = r % 32;
            transpose_item(w_out + 32 * nb + (lane & 31), D, WOUT, D, 32 * nb, 64 * kb, scr, lane); continue; } r -= I_OUT;
        if (!moe) {
            const float* w1 = P.in[18] + (size_t)li * D * DFF; const float* w3 = P.in[19] + (size_t)li * D * DFF; const float* w2 = P.in[20] + (size_t)li * DFF * D;
            bf16* W13 = (bf16*)(P.ws + WS_WFF); bf16* W2 = (bf16*)(P.ws + WS_WFF + WFF_W2_DENSE);
            if (r < I_D13) { const int kb = r / (2 * DFF / 32), nb = r % (2 * DFF / 32); const int p = 32 * nb + (lane & 31);
                const int ch = (p >> 8) * 128 + 4 * ((p & 255) >> 3) + (p & 3); const float* src = ((p >> 2) & 1) ? w3 : w1;
                transpose_item(src + ch, DFF, W13, D, 32 * nb, 64 * kb, scr, lane); continue; } r -= I_D13;
            { const int kb = r / 32, nb = r % 32; transpose_item(w2 + 32 * nb + (lane & 31), D, W2, DFF, 32 * nb, 64 * kb, scr, lane); }
        } else {
            const int e = r / (I_E13 + I_E2); r -= e * (I_E13 + I_E2);
            const float* w1 = P.in[22] + ((size_t)li * NEXP + e) * D * DFFE; const float* w3 = P.in[23] + ((size_t)li * NEXP + e) * D * DFFE; const float* w2 = P.in[24] + ((size_t)li * NEXP + e) * DFFE * D;
            bf16* W13 = (bf16*)(P.ws + WS_WFF + (size_t)e * WFF_W13_E); bf16* W2 = (bf16*)(P.ws + WS_WFF + WFF_W2_MOE + (size_t)e * WFF_W2_E);
            if (r < I_E13) { const int kb = r / (2 * DFFE / 32), nb = r % (2 * DFFE / 32); const int p = 32 * nb + (lane & 31);
                const int ch = (p >> 8) * 128 + 4 * ((p & 255) >> 3) + (p & 3); const float* src = ((p >> 2) & 1) ? w3 : w1;
                transpose_item(src + ch, DFFE, W13, D, 32 * nb, 64 * kb, scr, lane); continue; } r -= I_E13;
            { const int kb = r / 32, nb = r % 32; transpose_item(w2 + 32 * nb + (lane & 31), D, W2, DFFE, 32 * nb, 64 * kb, scr, lane); }
        }
    }
    {
        const float* pw = P.in[5] + (size_t)l * 4 * 64 * 64; const float* ps = P.in[6] + (size_t)l * 256; const float* wbp = P.in[13] + (size_t)l * 256 * D;
        const int gt = F.vcu * (NWAVES * 64) + P.tid, NT = F.G * NWAVES * 64;
        for (int item = gt; item < 1024 * 32; item += NT) {
            const int n = item & 1023, kb = item >> 10, k0 = 8 * kb, g = k0 >> 6, c0 = k0 & 63;
            float a[8];
#pragma unroll
            for (int j = 0; j < 8; ++j) a[j] = 0.f;
            for (int cp = 0; cp < 64; ++cp) { const float wv = ps[g * 64 + cp] * wbp[(size_t)(g * 64 + cp) * D + n];
#pragma unroll
                for (int j = 0; j < 8; ++j) a[j] += pw[(size_t)(g * 64 + c0 + j) * 64 + cp] * wv; }
            v4u o; o.x = pk2(a[0], a[1]); o.y = pk2(a[2], a[3]); o.z = pk2(a[4], a[5]); o.w = pk2(a[6], a[7]);
            *(GAS v4u*)(WBR + (size_t)n * D + k0) = o;
        }
    }
}

template <int MODE>
__device__ __forceinline__ void norm_phase(const Frame& F, const Site& P, const float* xsrc, const float* gvec, const float* w8, size_t w8stride, const float* b8, unsigned* gcnt) {
    const int lane = P.lane;
    bf16* HB = (bf16*)(P.ws + WS_HB);
    f32x4 gv[4];
#pragma unroll
    for (int j = 0; j < 4; ++j) gv[j] = *((const f32x4*)gvec + lane + 64 * j);
    float wf[16][8];
    if constexpr (MODE != 1) {
#pragma unroll
        for (int j = 0; j < 4; ++j)
#pragma unroll
            for (int c = 0; c < 4; ++c) { const int k = 4 * lane + 256 * j + c; const f32x4 a = *(const f32x4*)(w8 + (size_t)k * w8stride), b = *(const f32x4*)(w8 + (size_t)k * w8stride + 4);
                const float gk = gv[j][c];
                wf[4 * j + c][0] = a[0] * gk; wf[4 * j + c][1] = a[1] * gk; wf[4 * j + c][2] = a[2] * gk; wf[4 * j + c][3] = a[3] * gk;
                wf[4 * j + c][4] = b[0] * gk; wf[4 * j + c][5] = b[1] * gk; wf[4 * j + c][6] = b[2] * gk; wf[4 * j + c][7] = b[3] * gk; }
    }
    LAS unsigned* lcnt = (LAS unsigned*)(F.lds + RING_OFF);
    float* NLF = (float*)(P.ws + WS_NLF);
    unsigned* list = (unsigned*)(P.ws + WS_LIST); float* moew = (float*)(P.ws + WS_MOEW);
    for (int rb = F.vcu; rb < M / 256; rb += F.G) {
        const int row0 = rb * 256 + P.wave * 32;
        if constexpr (MODE == 2) { if (P.tid < 32) lcnt[P.tid] = 0u; __syncthreads(); }
        int my_e0 = 0, my_e1 = 0; float my_w0 = 0.f, my_w1 = 0.f;
        for (int i = 0; i < 32; ++i) {
            const int row = row0 + i;
            const GAS f32x4* xr = (const GAS f32x4*)(xsrc + (size_t)row * D) + lane;
            f32x4 v[4]; float s = 0.f;
#pragma unroll
            for (int j = 0; j < 4; ++j) { v[j] = xr[64 * j]; s += (v[j].x * v[j].x + v[j].y * v[j].y) + (v[j].z * v[j].z + v[j].w * v[j].w); }
            const float rstd = 1.0f / sqrtf(wave_sum(s, lane) * (1.f / D) + 1e-6f);
            GAS unsigned long long* o8 = (GAS unsigned long long*)(HB + (size_t)row * D) + lane;
#pragma unroll
            for (int j = 0; j < 4; ++j) o8[64 * j] = (unsigned long long)pk2(v[j].x * rstd * gv[j].x, v[j].y * rstd * gv[j].y) | ((unsigned long long)pk2(v[j].z * rstd * gv[j].z, v[j].w * rstd * gv[j].w) << 32);
            if constexpr (MODE != 1) {
                float f[8];
#pragma unroll
                for (int h = 0; h < 8; ++h) f[h] = 0.f;
#pragma unroll
                for (int j = 0; j < 4; ++j)
#pragma unroll
                    for (int c = 0; c < 4; ++c)
#pragma unroll
                        for (int h = 0; h < 8; ++h) f[h] += v[j][c] * wf[4 * j + c][h];
#pragma unroll
                for (int h = 0; h < 8; ++h) f[h] = wave_sum(f[h], lane) * rstd;
                if constexpr (MODE == 0) {
                    float mine = f[0];
#pragma unroll
                    for (int h = 1; h < 8; ++h) mine = (lane == h) ? f[h] : mine;
                    if (lane < 8) { const float z = mine + b8[lane];
                        const float sp = fmaxf(-z, 0.f) + log1pf(__expf(-fabsf(z)));
                        NLF[(size_t)row * 8 + lane] = sp * LOG2E; }
                } else {
                    int e0 = 0; float v0 = f[0];
#pragma unroll
                    for (int h = 1; h < 8; ++h) if (f[h] > v0) { v0 = f[h]; e0 = h; }
                    int e1 = (e0 == 0) ? 1 : 0; float v1 = -INFINITY;
#pragma unroll
                    for (int h = 0; h < 8; ++h) if (h != e0 && f[h] > v1) { v1 = f[h]; e1 = h; }
                    const float w0 = 1.0f / (1.0f + __expf(v1 - v0));
                    if (lane == i) { my_e0 = e0; my_e1 = e1; my_w0 = w0; my_w1 = 1.0f - w0; }
                }
            }
        }
        if constexpr (MODE == 2) {
            unsigned p0 = 0, p1 = 0;
            if (lane < 32) { p0 = __hip_atomic_fetch_add(&lcnt[my_e0], 1u, __ATOMIC_RELAXED, __HIP_MEMORY_SCOPE_WORKGROUP); p1 = __hip_atomic_fetch_add(&lcnt[8 + my_e1], 1u, __ATOMIC_RELAXED, __HIP_MEMORY_SCOPE_WORKGROUP);
                moew[row0 + lane] = my_w0; moew[M + row0 + lane] = my_w1; }
            __syncthreads();
            if (P.tid < 16) lcnt[16 + P.tid] = __hip_atomic_fetch_add(gcnt + P.tid, lcnt[P.tid], RLX_AGENT);
            __syncthreads();
            if (lane < 32) { list[(size_t)my_e0 * M + lcnt[16 + my_e0] + p0] = (unsigned)(row0 + lane); list[(size_t)(8 + my_e1) * M + lcnt[24 + my_e1] + p1] = (unsigned)(row0 + lane); }
            __syncthreads();
        }
    }
}

__device__ __forceinline__ void scan_phase(const Frame& F, const Site& P) {
    const float* NLF = (const float*)(P.ws + WS_NLF); float* NCL = (float*)(P.ws + WS_NCL);
    LAS float* wt = (LAS float*)(F.lds + RING_OFF);
    for (int seq = F.vcu; seq < BATCH * 8; seq += F.G) {
        const int b = seq >> 3, h = seq & 7, t0 = P.tid * 16;
        float v[16]; float s = 0.f;
#pragma unroll
        for (int i = 0; i < 16; ++i) { v[i] = NLF[((size_t)b * SEQ + t0 + i) * 8 + h]; s += v[i]; v[i] = s; }
        float incl = s;
#pragma unroll
        for (int o = 1; o < 64; o <<= 1) { const float up = __int_as_float(__builtin_amdgcn_ds_bpermute((P.lane - o) << 2, __float_as_int(incl))); if (P.lane >= o) incl += up; }
        if (P.lane == 63) wt[P.wave] = incl;
        __syncthreads();
        float base = incl - s;
        for (int w = 0; w < P.wave; ++w) base += wt[w];
        float* dst = NCL + (size_t)seq * SEQ + t0;
#pragma unroll
        for (int i = 0; i < 16; i += 4) *(f32x4*)(dst + i) = (f32x4){base + v[i], base + v[i + 1], base + v[i + 2], base + v[i + 3]};
        __syncthreads();
    }
}

__device__ __forceinline__ void poolconv_phase(const Frame& F, const Site& P, int l) {
    const int lane = P.lane;
    const bf16* PIN = (const bf16*)(P.ws + WS_P); const bf16* Z = (const bf16*)(P.ws + WS_Z); bf16* Y = (bf16*)(P.ws + WS_Y);
    const float* cw = P.in[7] + (size_t)l * CONVK * 256; const float* cb = P.in[8] + (size_t)l * 256; const float* lg = P.in[9] + (size_t)l * 256; const float* lb = P.in[10] + (size_t)l * 256;
    f32x4 w[CONVK];
#pragma unroll
    for (int j = 0; j < CONVK; ++j) w[j] = *(const f32x4*)(cw + j * 256 + 4 * lane);
    const f32x4 cbv = *(const f32x4*)(cb + 4 * lane), lgv = *(const f32x4*)(lg + 4 * lane), lbv = *(const f32x4*)(lb + 4 * lane);
    LAS unsigned char* zt = F.lds + RING_OFF;
    const int pw = 2 << (lane >> 4);
#if defined(DBG_COPY)
    for (int ch = F.vcu; ch < M / 128; ch += F.G) { const int r0 = ch * 128;
        for (int i = 0; i < 16; ++i) { const int row = r0 + 16 * P.wave + i;
            *(GAS v2u*)(Y + (size_t)row * 1024 + 4 * lane) = *(const GAS v2u*)(PIN + (size_t)row * 256 + 4 * lane);
            *(GAS v2u*)(Y + (size_t)row * 1024 + 256 + 4 * lane) = *(const GAS v2u*)(Z + (size_t)row * 256 + 4 * lane); } }
    return;
#endif
    for (int ch = F.vcu; ch < M / 128; ch += F.G) {
        const int r0 = ch * 128; const int tseq0 = r0 & (SEQ - 1);
        for (int p = P.tid; p < 158 * 32; p += NWAVES * 64) { const int lr = p >> 5, c16 = p & 31; const int tr = tseq0 - 30 + lr;
            const int lrc = tr >= 0 ? lr : 30;
            v4u val = *(const GAS v4u*)(Z + (size_t)(r0 - 30 + lrc) * 256 + c16 * 8);
            if (tr < 0) val = (v4u){0u, 0u, 0u, 0u};
            *(LAS v4u*)(zt + lr * 512 + c16 * 16) = val; }
        __syncthreads();
#if defined(DBG_POOLCOPY)
        for (int i = 0; i < 16; ++i) { const int row = r0 + 16 * P.wave + i; *(GAS v2u*)(Y + (size_t)row * 1024 + 4 * lane) = *(const GAS v2u*)(PIN + (size_t)row * 256 + 4 * lane); }
        if (false)
#endif
        { const int rw = r0 + 16 * P.wave, tw = tseq0 + 16 * P.wave;
          for (int i = 0; i < 16; ++i) { const int t = tw + i;
              f32x4 s = (f32x4){0.f, 0.f, 0.f, 0.f}, cur = s;
#pragma unroll
              for (int d = 0; d < 16; ++d) { const int dd = d <= t ? d : t;
                  const v2u q = *(const GAS v2u*)(PIN + (size_t)(rw + i - dd) * 256 + 4 * lane);
                  const f32x4 v = (f32x4){bflo(q.x), bfhi(q.x), bflo(q.y), bfhi(q.y)};
                  if (d == 0) cur = v;
                  const float mk = (d < pw && d <= t) ? 1.0f : 0.0f; s += v * mk; }
              const float inv = 1.0f / (float)((t + 1) < pw ? (t + 1) : pw);
              const f32x4 o = s * inv - cur;
              v2u ov; ov.x = pk2(o[0], o[1]); ov.y = pk2(o[2], o[3]);
              *(GAS v2u*)(Y + (size_t)(rw + i) * 1024 + 4 * lane) = ov; } }
#if defined(DBG_CONVCOPY)
        for (int i = 0; i < 16; ++i) { const int row = r0 + 16 * P.wave + i; *(GAS v2u*)(Y + (size_t)row * 1024 + 256 + 4 * lane) = *(const GAS v2u*)(Z + (size_t)row * 256 + 4 * lane); }
        if (false)
#endif
        for (int grp = 0; grp < 4; ++grp) {
            const int lr0 = 16 * P.wave + 4 * grp;
            f32x4 a[4];
#pragma unroll
            for (int o = 0; o < 4; ++o) a[o] = cbv;
#pragma unroll
            for (int jj = 0; jj < CONVK + 3; ++jj) {
                const v2u q = *(const LAS v2u*)(zt + (lr0 + jj) * 512 + lane * 8); const f32x4 z = (f32x4){bflo(q.x), bfhi(q.x), bflo(q.y), bfhi(q.y)};
#pragma unroll
                for (int o = 0; o < 4; ++o) { const int j = jj - o; if (j >= 0 && j < CONVK) a[o] += w[j] * z; }
            }
#pragma unroll
            for (int o = 0; o < 4; ++o) {
                const float mu = wave_sum((a[o][0] + a[o][1]) + (a[o][2] + a[o][3]), lane) * (1.f / 256.f);
                const f32x4 dv = a[o] - mu;
                const float var = wave_sum((dv[0] * dv[0] + dv[1] * dv[1]) + (dv[2] * dv[2] + dv[3] * dv[3]), lane) * (1.f / 256.f);
                const float rs = 1.0f / sqrtf(var + 1e-6f);
                f32x4 y = dv * rs * lgv + lbv;
#pragma unroll
                for (int c = 0; c < 4; ++c) y[c] = y[c] / (1.0f + __expf(-y[c]));
                v2u ov; ov.x = pk2(y[0], y[1]); ov.y = pk2(y[2], y[3]);
                *(GAS v2u*)(Y + (size_t)(r0 + lr0 + o) * 1024 + 256 + 4 * lane) = ov;
            }
        }
        __syncthreads();
    }
}

#ifndef DBG_MAXPHASE
#define DBG_MAXPHASE 1000
#endif
#ifndef ONLY_SITE
#define ONLY_SITE -1
#endif
#ifndef SITE_OFF_MASK
#define SITE_OFF_MASK 0
#endif
#define SITE(k) ((ONLY_SITE < 0 || ONLY_SITE == (k)) && !((SITE_OFF_MASK >> (k)) & 1))
constexpr int NPH = 10;
struct Args { const float* in[25]; float* out; unsigned char* ws; int ph_lo, ph_hi; };

__global__ void __launch_bounds__(NWAVES * 64, 2) trunk_fwd(Args args) {
    extern __shared__ __attribute__((aligned(16))) unsigned char lds[];
    Frame F;
    F.lds = (LAS unsigned char*)lds;
    F.MISC = (volatile LAS unsigned*)(F.lds + MISC_OFF);
    F.G = gridDim.x; { const int bx = blockIdx.x; F.vcu = (F.G % 8 == 0) ? (bx % 8) * (F.G / 8) + bx / 8 : bx; }
    for (int u = threadIdx.x; u < (LDS_BYTES - LDSCTL_OFF) / 4; u += NWAVES * 64) ((LAS unsigned*)(F.lds + LDSCTL_OFF))[u] = 0u;
    __syncthreads();
    XcdBarrier bar; bar.bar = (unsigned*)((gu32*)(args.ws + WS_CTL) + CW_BAR); bar.x = 0; bar.st = nullptr;
    if (!MK_PER_PHASE) bar = xcd_barrier_post((unsigned*)((gu32*)(args.ws + WS_CTL) + CW_BAR), F.MISC + 8);
    const int lo = args.ph_lo, hi = args.ph_hi;
#define IN(k) (lo <= (k) && (k) < hi)
#define SEAM(k) do { if (IN(k) && IN((k) + 1)) { if (MK_PER_PHASE) { if (threadIdx.x == 0) __hip_atomic_store((gu32*)(args.ws + WS_CTL) + CW_TMO, 0xBADBA0u, RLX_AGENT); } else xcd_barrier(bar); } } while (0)

#define WSB(off) ((bf16*)(P.ws + (off)))
#define INP(k) (P.in[k])
#define XIN() ((l == 0) ? INP(0) : (const float*)P.out)
    const int cgemm = (int)blockIdx.x;

    for (int l = 0; l < DEPTH; ++l) {
        const int pb = l * NPH;
        const bool moe = (l & 1) != 0; const int li = l >> 1;

        if (IN(pb + 0)) { const Site P = make_site();
            if constexpr (SITE(0)) convert_layer_weights(F, P, l);
#if defined(DBG_FILLG)
            { v4u fv = (v4u){0x3f003f00u, 0x3f003f00u, 0x3f003f00u, 0x3f003f00u}; GAS v4u* gp = (GAS v4u*)WSB(WS_G);
              for (size_t i = (size_t)blockIdx.x * 512 + P.tid; i < (size_t)M * 3072 / 8; i += (size_t)F.G * 512) gp[i] = fv; }
#endif
            __syncthreads();
            if constexpr (SITE(1)) norm_phase<0>(F, P, XIN(), INP(1) + (size_t)l * D, INP(2) + (size_t)l * D * IN_COLS + OFF_F, IN_COLS, INP(4) + (size_t)l * 8, nullptr);
        }
        SEAM(pb + 0);

        if (IN(pb + 1)) { const Site P = make_site();
#if !defined(DBG_NOSCAN)
            if constexpr (SITE(2)) scan_phase(F, P);
#endif
            pg8::Gemm g{WSB(WS_HB), WSB(WS_WIN), D, 0, nullptr};
            pg8::SchedPlain S{M / 256, NIN / 256, F.G, cgemm, D / 64};
            pg8::EpiInProj E{WSB(WS_P), WSB(WS_Z), WSB(WS_Y) + 512, WSB(WS_K), WSB(WS_V), WSB(WS_G), INP(11) + (size_t)l * 64, INP(12) + (size_t)l * 64, INP(3) + (size_t)l * 3 * D};
#if defined(DBG_NOALIGN)
            if constexpr (SITE(3)) pg8::gemm_phase<pg8::EpiInProj, pg8::SchedPlain, false, false>(F.lds + RING_OFF, g, S, E);
#else
            if constexpr (SITE(3)) pg8::gemm_phase<pg8::EpiInProj, pg8::SchedPlain, true, false>(F.lds + RING_OFF, g, S, E);
#endif
        }
        SEAM(pb + 1);

        if (IN(pb + 2)) { const Site P = make_site();
            if constexpr (SITE(4)) poolconv_phase(F, P, l);
#if defined(DBG_FENCE)
            asm volatile("s_waitcnt vmcnt(0)" ::: "memory"); __threadfence_system(); asm volatile("s_waitcnt vmcnt(0)" ::: "memory");
#endif
            const attn_body::AttnTensors AT{(const attn_body::bf16*)(WSB(WS_Y) + 512), (const attn_body::bf16*)WSB(WS_K), (const attn_body::bf16*)WSB(WS_V), (attn_body::bf16*)(WSB(WS_Y) + 512), (const float*)(P.ws + WS_NCL)};
            const attn_body::StaticOrder S((int)F.G, (int)blockIdx.x);
            if constexpr (SITE(5)) attn_body::attn_phase<attn_body::StaticOrder>((char*)lds + RING_OFF, AT, S);
        }
        SEAM(pb + 2);

        if (IN(pb + 3)) { const Site P = make_site();
            pg8::Gemm g{WSB(WS_Y), WSB(WS_WBR), D, 0, nullptr};
#if defined(DBG_MERGE1)
            pg8::SchedPlain S{M / 256, D / 256, F.G, cgemm, D / 64};
#else
            pg8::SchedMerge S{M / 256, D / 256, F.G, cgemm};
#endif
            pg8::EpiMerge E{WSB(WS_G), WSB(WS_HB)};
#if defined(DBG_MERGE1)
            if constexpr (SITE(6)) pg8::gemm_phase<pg8::EpiMerge, pg8::SchedPlain, true, false>(F.lds + RING_OFF, g, S, E);
#else
            if constexpr (SITE(6)) pg8::gemm_phase<pg8::EpiMerge, pg8::SchedMerge, true, false>(F.lds + RING_OFF, g, S, E);
#endif
        }
        SEAM(pb + 3);

        if (IN(pb + 4)) { const Site P = make_site();
            pg8::Gemm g{WSB(WS_HB), WSB(WS_WOUT), D, 0, nullptr};
            pg8::SchedPlain S{M / 256, D / 256, F.G, cgemm, D / 64};
            pg8::EpiResid E{XIN(), P.out};
#if defined(DBG_OUTY)
            { const bf16* Yb = (DBG_OUTY == 4) ? WSB(WS_HB) : (DBG_OUTY == 5 || DBG_OUTY >= 8 ? WSB(WS_G) : WSB(WS_Y)); const size_t ypitch = (DBG_OUTY == 5 || DBG_OUTY >= 8) ? 3072 : 1024; for (int rb = F.vcu; rb < M / 256; rb += F.G) for (int i = 0; i < 32; ++i) { const int row = rb * 256 + P.wave * 32 + i;
                for (int c = P.lane; c < 1024; c += 64) { const int cs = (DBG_OUTY == 1) ? 256 + (c & 255) : (DBG_OUTY == 2 ? (c & 255) : c); float vv_ = bflo((unsigned)Yb[(size_t)row * ypitch + cs]); if (DBG_OUTY == 7) vv_ = 0.f; if (DBG_OUTY == 5) vv_ = (vv_ > 1.0f || vv_ < 0.0f) ? 1000.0f : 0.0f; if (DBG_OUTY == 8) vv_ = (vv_ > 1.0f || vv_ < 0.0f) ? 100.0f * (float)(1 + (row >> 8)) : 0.0f; if (DBG_OUTY == 9) vv_ = (vv_ > 1.0f || vv_ < 0.0f) ? 100.0f * (float)(1 + (c >> 3)) : 0.0f; P.out[(size_t)row * 1024 + c] = vv_; } } }
#else
            if constexpr (SITE(7)) pg8::gemm_phase<pg8::EpiResid, pg8::SchedPlain, true, false>(F.lds + RING_OFF, g, S, E);
#endif
        }
        SEAM(pb + 4);

        if (IN(pb + 5)) { const Site P = make_site();
            if constexpr (SITE(8)) { if (!moe) norm_phase<1>(F, P, P.out, INP(17) + (size_t)l * D, nullptr, 0, nullptr, nullptr);
            else norm_phase<2>(F, P, P.out, INP(17) + (size_t)l * D, INP(21) + (size_t)li * D * NEXP, NEXP, nullptr, (unsigned*)(P.ctl + CW_MOECNT + 64 * li)); }
        }
        SEAM(pb + 5);

        if (!moe) {
            if (IN(pb + 6)) { const Site P = make_site();
                    pg8::Gemm g{WSB(WS_HB), WSB(WS_WFF), D, 0, nullptr};
                pg8::SchedPlain S{M / 256, 2 * DFF / 256, F.G, cgemm, D / 64};
                pg8::EpiSwiGLU E{WSB(WS_HID), DFF};
                if constexpr (SITE(9)) pg8::gemm_phase<pg8::EpiSwiGLU, pg8::SchedPlain, true, false>(F.lds + RING_OFF, g, S, E);
            }
            SEAM(pb + 6);
            if (IN(pb + 7)) { const Site P = make_site();
                    pg8::Gemm g{WSB(WS_HID), WSB(WS_WFF + WFF_W2_DENSE), DFF, 0, nullptr};
                pg8::SchedPlain S{M / 256, D / 256, F.G, cgemm, DFF / 64};
                pg8::EpiResid E{P.out, P.out};
                if constexpr (SITE(10)) pg8::gemm_phase<pg8::EpiResid, pg8::SchedPlain, true, false>(F.lds + RING_OFF, g, S, E);
            }
            if (l + 1 < DEPTH) SEAM(pb + 7);
        } else {
            for (int slot = 0; slot < 2; ++slot) {
                const int pu = pb + 6 + 2 * slot, pd = pu + 1;
                int ntiles = 0;
                if (IN(pu) || IN(pd)) { const Site P = make_site();
                    LAS unsigned* tab = (LAS unsigned*)(F.lds + MOETAB_OFF);
                    __syncthreads();
                    int cnt[8];
#pragma unroll
                    for (int e = 0; e < 8; ++e) cnt[e] = __builtin_amdgcn_readfirstlane((int)__hip_atomic_load(P.ctl + CW_MOECNT + 64 * li + slot * 8 + e, RLX_AGENT));
                    int rt = 0;
#pragma unroll
                    for (int e = 0; e < 8; ++e) { const int nte = (cnt[e] + 255) >> 8;
                        for (int j = P.tid; j < nte; j += NWAVES * 64) { const int nv = (cnt[e] - 256 * j) < 256 ? (cnt[e] - 256 * j) : 256; if (rt + j < 264) tab[rt + j] = (unsigned)e | ((unsigned)j << 8) | ((unsigned)(nv - 1) << 20); }
                        rt += nte; }
                    ntiles = rt < 264 ? rt : 264;
                    __syncthreads();
                }
                if (IN(pu)) { const Site P = make_site();
                            pg8::Gemm g{WSB(WS_HB), WSB(WS_WFF), D, WFF_W13_E, (const unsigned*)(P.ws + WS_LIST)};
                    pg8::SchedMoe S{ntiles, 2 * DFFE / 256, F.G, cgemm, D / 64, slot, (const LAS unsigned*)(F.lds + MOETAB_OFF)};
                    pg8::EpiSwiGLU E{WSB(WS_HID), DFFE};
                    if constexpr (SITE(11)) pg8::gemm_phase<pg8::EpiSwiGLU, pg8::SchedMoe, true, true>(F.lds + RING_OFF, g, S, E);
                }
                SEAM(pu);
                if (IN(pd)) { const Site P = make_site();
                            pg8::Gemm g{WSB(WS_HID), WSB(WS_WFF + WFF_W2_MOE), DFFE, WFF_W2_E, nullptr};
                    pg8::SchedMoe S{ntiles, D / 256, F.G, cgemm, DFFE / 64, slot, (const LAS unsigned*)(F.lds + MOETAB_OFF)};
                    pg8::EpiMoeDown E{P.out, (const unsigned*)(P.ws + WS_LIST), (const float*)(P.ws + WS_MOEW) + (size_t)slot * M};
                    if constexpr (SITE(12)) pg8::gemm_phase<pg8::EpiMoeDown, pg8::SchedMoe, true, false>(F.lds + RING_OFF, g, S, E);
                }
                if (slot == 0 || l + 1 < DEPTH) SEAM(pd);
            }
        }
    }
#undef IN
#undef SEAM
#undef WSB
#undef INP
#undef XIN
}

extern "C" void kernel_launch(void* const* d_in, const int* in_sizes, int n_in, void* d_out, int out_size, void* d_ws, size_t ws_size, hipStream_t stream) {
    static int grid = 0;
    if (grid == 0) {
        if (n_in != 25 || in_sizes[0] != M * D || out_size != M * D || ws_size < WS_END) { fprintf(stderr, "kernel_launch: built for 25 inputs, x and out of %d floats, >= %zu bytes of workspace; got n_in %d, in0 %d, out %d, ws %zu; nothing launched\n", M * D, (size_t)WS_END, n_in, n_in > 0 ? in_sizes[0] : -1, out_size, ws_size); grid = -1; return; }
        int dev = 0, cus = 0, per_cu = 0;
        if (hipGetDevice(&dev) != hipSuccess || hipDeviceGetAttribute(&cus, hipDeviceAttributeMultiprocessorCount, dev) != hipSuccess) { fprintf(stderr, "kernel_launch: hipGetDevice / hipDeviceGetAttribute failed; nothing launched\n"); grid = -1; return; }
        if (hipFuncSetAttribute((const void*)trunk_fwd, hipFuncAttributeMaxDynamicSharedMemorySize, LDS_BYTES) != hipSuccess) { fprintf(stderr, "kernel_launch: hipFuncSetAttribute failed\n"); grid = -1; return; }
        if (hipOccupancyMaxActiveBlocksPerMultiprocessor(&per_cu, (const void*)trunk_fwd, NWAVES * 64, LDS_BYTES) != hipSuccess || per_cu < 1)
            fprintf(stderr, "kernel_launch: note: the occupancy query reports %d workgroups per CU\n", per_cu);
        (void)hipGetLastError();
        grid = cus;
    }
    if (grid < 0) return;
    if (hipMemsetAsync((char*)d_ws + WS_CTL, 0, CTL_ZERO_BYTES, stream) != hipSuccess) { fprintf(stderr, "kernel_launch: hipMemsetAsync failed\n"); return; }
    Args a{};
    for (int i = 0; i < 25; ++i) a.in[i] = (const float*)d_in[i];
    a.out = (float*)d_out; a.ws = (unsigned char*)d_ws;
#if MK_PER_PHASE
    for (int l = 0; l < DEPTH; ++l) { const int np = (l & 1) ? 10 : 8;
        for (int p = 0; p < np; ++p) { a.ph_lo = l * NPH + p; a.ph_hi = a.ph_lo + 1; if (a.ph_lo > DBG_MAXPHASE) continue; hipLaunchKernelGGL(trunk_fwd, dim3(grid), dim3(NWAVES * 64), LDS_BYTES, stream, a); } }
#else
    a.ph_lo = 0; a.ph_hi = DEPTH * NPH;
    hipLaunchKernelGGL(trunk_fwd, dim3(grid), dim3(NWAVES * 64), LDS_BYTES, stream, a);
#endif
    const hipError_t le = hipPeekAtLastError();
    if (le != hipSuccess) fprintf(stderr, "kernel_launch: launch failed: %s (grid %d x %d threads, %d B LDS)\n", hipGetErrorName(le), grid, NWAVES * 64, LDS_BYTES);
}
```

```cpp
#include <hip/hip_runtime.h>
#include <hip/hip_bf16.h>
#include <cstdio>
#include <cstdint>
#include <cmath>

namespace pg8 {
#define PG8_LAS __attribute__((address_space(3)))
typedef unsigned short bf16_t;
typedef short bf16x8 __attribute__((ext_vector_type(8)));
typedef float f32x4 __attribute__((ext_vector_type(4)));
typedef float f32x2 __attribute__((ext_vector_type(2)));
typedef unsigned u32x4 __attribute__((ext_vector_type(4)));
typedef unsigned u32x2 __attribute__((ext_vector_type(2)));
constexpr int BM = 256, BK = 64, HALF = 128, HTB = HALF * BK * 2  , STAGE_BYTES = 8 * HTB, NXCD = 8, WGM = 8;

__host__ __device__ __forceinline__ int lds_byte(int r, int c) { const int st = (r >> 4) * 2 + (c >> 5), rr = r & 15, cc = c & 31, ob = rr * 64 + cc * 2; return st * 1024 + (ob ^ (((ob >> 9) & 1) << 5)); }
__host__ __device__ __forceinline__ void stage_rc(int b, int& R, int& C) { const int st = b / 1024, sb = b % 1024, swz = sb ^ (((sb >> 9) & 1) << 5); R = (st >> 1) * 16 + swz / 64; C = (st & 1) * 32 + (swz % 64) / 2; }
__host__ __device__ __forceinline__ int perm32(int rho) { const int n = rho >> 4, i = rho & 15; return 8 * (i >> 2) + 4 * n + (i & 3); }

struct Unit { int pm, pn, e, koff, nt, lo, nv; };
struct Gemm { const bf16_t* A; const bf16_t* Bt; int K; size_t bstride; const unsigned* list; };

__device__ __forceinline__ void tile_of(int L, int nM, int nN, int& pm, int& pn) {
    const int nwg = nM * nN; int wgid = L;
    { const int q = nwg / NXCD, r = nwg % NXCD, xcd = wgid % NXCD, off = wgid / NXCD; wgid = (xcd < r ? xcd * (q + 1) : r * (q + 1) + (xcd - r) * q) + off; }
    const int nig = WGM * nN, gid = wgid / nig, fm = gid * WGM, gsz = (nM - fm) < WGM ? (nM - fm) : WGM;
    pm = fm + ((wgid % nig) % gsz); pn = (wgid % nig) / gsz;
}
struct SchedPlain {
    int nM, nN, G, c, nt;
    __device__ __forceinline__ bool next(int i, Unit& u) const {
        const long L = (long)i * G + c; if (L >= (long)nM * nN) return false;
        tile_of((int)L, nM, nN, u.pm, u.pn); u.e = 0; u.koff = 0; u.nt = nt; u.lo = 0; u.nv = 256; return true;
    }
};
struct SchedMerge {
    int nM, nN, G, c;
    __device__ __forceinline__ bool next(int i, Unit& u) const {
        const int tile = i / 3, seg = i - 3 * tile; const long L = (long)tile * G + c; if (L >= (long)nM * nN) return false;
        tile_of((int)L, nM, nN, u.pm, u.pn); u.e = seg; u.koff = seg == 0 ? 0 : (seg == 1 ? 256 : 512); u.nt = seg == 2 ? 8 : 4; u.lo = 0; u.nv = 256; return true;
    }
};
struct SchedMoe {
    int nM, nN, G, c, nt, slot; const PG8_LAS unsigned* tab;
    __device__ __forceinline__ bool next(int i, Unit& u) const {
        const long L = (long)i * G + c; if (L >= (long)nM * nN) return false;
        tile_of((int)L, nM, nN, u.pm, u.pn);
        const unsigned w = (unsigned)__builtin_amdgcn_readfirstlane((int)tab[u.pm]);
        u.e = (int)(w & 0xffu); const int j = (int)((w >> 8) & 0xfffu); u.nv = (int)(w >> 20) + 1;
        u.lo = (slot * 8 + u.e) * 65536 + 256 * j; u.koff = 0; u.nt = nt; return true;
    }
};

typedef __bf16 bf16x2_cv __attribute__((ext_vector_type(2)));
__device__ __forceinline__ unsigned cvt_pk_bf16(float lo, float hi) { const f32x2 v = {lo, hi}; const bf16x2_cv b = __builtin_convertvector(v, bf16x2_cv); return __builtin_bit_cast(unsigned, b); }
__device__ __forceinline__ float bf_lo(unsigned w) { return __uint_as_float(w << 16); }
__device__ __forceinline__ float bf_hi(unsigned w) { return __uint_as_float(w & 0xffff0000u); }
__device__ __forceinline__ float sigmoidf_(float x) { return __builtin_amdgcn_rcpf(1.0f + __builtin_amdgcn_exp2f(-1.4426950408889634f * x)); }

template <class Epi, class Sched, bool ALIGN_EPI, bool GATHER>
__device__ __forceinline__ void gemm_phase(PG8_LAS unsigned char* lds, const Gemm g_, const Sched& S, const Epi& E) {
    Gemm g = g_;
    {
        unsigned long long a_ = (unsigned long long)g_.A, b_ = (unsigned long long)g_.Bt, l_ = (unsigned long long)g_.list; asm volatile("" : "+s"(a_), "+s"(b_), "+s"(l_));
        g.A = (const bf16_t*)(const __attribute__((address_space(1))) bf16_t*)a_; g.Bt = (const bf16_t*)(const __attribute__((address_space(1))) bf16_t*)b_; g.list = (const unsigned*)(const __attribute__((address_space(1))) unsigned*)l_; }
    int tid_o = threadIdx.x; asm volatile("" : "+v"(tid_o));
    const int tid = tid_o, wid = __builtin_amdgcn_readfirstlane(tid >> 6), lane = tid & 63, wr = wid >> 2, wc = wid & 3, fr = lane & 15, fq = lane >> 4;
    const int K = g.K;
    unsigned voffA[2], voffB[2];
#pragma unroll
    for (int i = 0; i < 2; ++i) { int R, C; stage_rc(tid * 16 + i * 8192, R, C); const int Rb = Epi::PERM ? ((R & ~31) + perm32(R & 31)) : R;
        voffA[i] = (unsigned)(R * K + C) * 2u; voffB[i] = (unsigned)(Rb * K + C) * 2u; }
    const size_t kstep = (size_t)(BK * 2);
    const size_t hstep = (size_t)HALF * K * 2;
    const size_t tstep = 2 * hstep;
    const unsigned ldsw = (unsigned)wid * 1024u;
    const int aoff = lds_byte(wr * 64 + fr, fq * 8), boff = lds_byte(wc * 32 + fr, fq * 8);
#define PG8_SA(b, h) (((b) * 2 + (h)) * HTB)
#define PG8_SB(b, h) ((4 + (b) * 2 + (h)) * HTB)
#define PG8_GLDS(src, bufoff, i_) __builtin_amdgcn_global_load_lds((const unsigned*)(src), (PG8_LAS unsigned*)(lds + (bufoff) + ldsw + (i_) * 8192), 16, 0, 0)
#define PG8_STAGE_B(bufoff, gbase) do { _Pragma("unroll") for (int _i = 0; _i < 2; ++_i) PG8_GLDS((const char*)(gbase) + voffB[_i], bufoff, _i); } while (0)
#define PG8_STAGE_A(bufoff, ga, h, o0, o1) do { if constexpr (GATHER) { PG8_GLDS((const char*)(ga) + (o0), bufoff, 0); PG8_GLDS((const char*)(ga) + (o1), bufoff, 1); } \
        else { _Pragma("unroll") for (int _i = 0; _i < 2; ++_i) PG8_GLDS((const char*)(ga) + (h) * hstep + voffA[_i], bufoff, _i); } } while (0)
#define PG8_LDA(dst, b, h) do { _Pragma("unroll") for (int m = 0; m < 4; ++m) _Pragma("unroll") for (int k = 0; k < 2; ++k) dst[m][k] = *(const PG8_LAS bf16x8*)(lds + PG8_SA(b, h) + aoff + m * 2048 + k * 1024); } while (0)
#define PG8_LDB(dst, b, h) do { _Pragma("unroll") for (int n = 0; n < 2; ++n) _Pragma("unroll") for (int k = 0; k < 2; ++k) dst[n][k] = *(const PG8_LAS bf16x8*)(lds + PG8_SB(b, h) + boff + n * 2048 + k * 1024); } while (0)
#define PG8_MMA(ai, bj, At, Bt) do { __builtin_amdgcn_s_setprio(1); _Pragma("unroll") for (int m = 0; m < 4; ++m) _Pragma("unroll") for (int n = 0; n < 2; ++n) _Pragma("unroll") for (int k = 0; k < 2; ++k) \
        acc[ai][bj][m][n] = __builtin_amdgcn_mfma_f32_16x16x32_bf16(Bt[n][k], At[m][k], acc[ai][bj][m][n], 0, 0, 0); __builtin_amdgcn_s_setprio(0); } while (0)
#define PG8_WAIT_V(n) asm volatile("s_waitcnt vmcnt(" #n ")" ::: "memory")
#define PG8_WAIT_L(n) asm volatile("s_waitcnt lgkmcnt(" #n ")" ::: "memory")
#define PG8_BAR __builtin_amdgcn_s_barrier()
#define PG8_SCHED __builtin_amdgcn_sched_barrier(0)
    Unit cur, nxt; int ui = 0;
    if (!S.next(0, cur)) return;
    f32x4 acc[2][2][4][2];
#pragma unroll
    for (int a = 0; a < 2; ++a)
#pragma unroll
        for (int b = 0; b < 2; ++b)
#pragma unroll
            for (int m = 0; m < 4; ++m)
#pragma unroll
                for (int n = 0; n < 2; ++n) acc[a][b][m][n] = (f32x4){0.f, 0.f, 0.f, 0.f};
    bf16x8 At[4][2], B0[2][2], B1[2][2];
    unsigned gc00 = 0, gc01 = 0, gc10 = 0, gc11 = 0, gn00 = 0, gn01 = 0, gn10 = 0, gn11 = 0;
#define PG8_GATH(u, o00, o01, o10, o11) do { const unsigned* lp_ = g.list + (u).lo; const int nv_ = (u).nv; \
        int tid_ = threadIdx.x; asm volatile("" : "+v"(tid_)); int R0_, C0_, R1_, C1_; stage_rc(tid_ * 16, R0_, C0_); stage_rc(tid_ * 16 + 8192, R1_, C1_);     \
        const unsigned t00 = R0_ < nv_ ? lp_[R0_] : 0u, t01 = R1_ < nv_ ? lp_[R1_] : 0u, t10 = (128 + R0_) < nv_ ? lp_[128 + R0_] : 0u, t11 = (128 + R1_) < nv_ ? lp_[128 + R1_] : 0u; \
        o00 = t00 * (unsigned)(K * 2) + (unsigned)C0_ * 2u; o01 = t01 * (unsigned)(K * 2) + (unsigned)C1_ * 2u; o10 = t10 * (unsigned)(K * 2) + (unsigned)C0_ * 2u; o11 = t11 * (unsigned)(K * 2) + (unsigned)C1_ * 2u; } while (0)
    const char* cA = GATHER ? (const char*)g.A + (size_t)cur.koff * 2 : (const char*)g.A + (size_t)cur.pm * tstep + (size_t)cur.koff * 2;
    const char* cB = (const char*)g.Bt + (size_t)cur.e * g.bstride + (size_t)cur.pn * tstep + (size_t)cur.koff * 2;
    if constexpr (GATHER) PG8_GATH(cur, gc00, gc01, gc10, gc11);
    PG8_STAGE_B(PG8_SB(0, 0), cB); PG8_STAGE_B(PG8_SB(0, 1), cB + hstep); PG8_STAGE_A(PG8_SA(0, 0), cA, 0, gc00, gc01); PG8_STAGE_A(PG8_SA(0, 1), cA, 1, gc10, gc11);
    if (wr == 1) PG8_BAR;
    PG8_WAIT_V(2); PG8_BAR;
    PG8_STAGE_B(PG8_SB(1, 0), cB + kstep); PG8_STAGE_A(PG8_SA(1, 0), cA + kstep, 0, gc00, gc01); PG8_STAGE_B(PG8_SB(1, 1), cB + hstep + kstep);
    PG8_WAIT_V(6); PG8_BAR;
    for (;;) {
        const bool has_next = S.next(ui + 1, nxt);
        const char* nA = has_next ? (GATHER ? (const char*)g.A + (size_t)nxt.koff * 2 : (const char*)g.A + (size_t)nxt.pm * tstep + (size_t)nxt.koff * 2) : cA;
        const char* nB = has_next ? (const char*)g.Bt + (size_t)nxt.e * g.bstride + (size_t)nxt.pn * tstep + (size_t)nxt.koff * 2 : cB;
        if constexpr (GATHER) { if (has_next) PG8_GATH(nxt, gn00, gn01, gn10, gn11); else { gn00 = gc00; gn01 = gc01; gn10 = gc10; gn11 = gc11; } }
        const int nt = cur.nt;
        for (int t = 0; t < nt; t += 2) {
            const bool last = (t == nt - 2);
            const char* a1 = cA + (size_t)(t + 1) * kstep;
            const char* a2 = last ? nA : cA + (size_t)(t + 2) * kstep; const char* b2 = last ? nB : cB + (size_t)(t + 2) * kstep;
            const char* a3 = a2 + kstep; const char* b3 = b2 + kstep;
            const unsigned s00 = last ? gn00 : gc00, s01 = last ? gn01 : gc01, s10 = last ? gn10 : gc10, s11 = last ? gn11 : gc11;
            PG8_LDB(B0, 0, 0); PG8_LDB(B1, 0, 1); PG8_SCHED; PG8_LDA(At, 0, 0); PG8_STAGE_A(PG8_SA(1, 1), a1, 1, gc10, gc11);
            PG8_WAIT_V(8); PG8_WAIT_L(0); PG8_BAR; PG8_MMA(0, 0, At, B0); PG8_MMA(0, 1, At, B1); PG8_BAR; PG8_SCHED;
            PG8_LDA(At, 0, 1); PG8_STAGE_B(PG8_SB(0, 0), b2); PG8_STAGE_B(PG8_SB(0, 1), b2 + hstep); PG8_STAGE_A(PG8_SA(0, 0), a2, 0, s00, s01);
            PG8_WAIT_V(8); PG8_WAIT_L(0); PG8_BAR; PG8_MMA(1, 0, At, B0); PG8_MMA(1, 1, At, B1); PG8_BAR; PG8_SCHED;
            PG8_LDB(B0, 1, 0); PG8_LDB(B1, 1, 1); PG8_SCHED; PG8_LDA(At, 1, 0); PG8_STAGE_A(PG8_SA(0, 1), a2, 1, s10, s11);
            PG8_WAIT_V(8); PG8_WAIT_L(0); PG8_BAR; PG8_MMA(0, 0, At, B0); PG8_MMA(0, 1, At, B1); PG8_BAR; PG8_SCHED;
            PG8_LDA(At, 1, 1); PG8_STAGE_B(PG8_SB(1, 0), b3); PG8_STAGE_B(PG8_SB(1, 1), b3 + hstep); PG8_STAGE_A(PG8_SA(1, 0), a3, 0, s00, s01);
            PG8_WAIT_V(8); PG8_WAIT_L(0); PG8_BAR; PG8_MMA(1, 0, At, B0); PG8_MMA(1, 1, At, B1); PG8_BAR; PG8_SCHED;
        }
        if constexpr (ALIGN_EPI) { if (wr == 0) PG8_BAR; }
        { int te_ = threadIdx.x; asm volatile("" : "+v"(te_));
          const int we_ = __builtin_amdgcn_readfirstlane(te_ >> 6), le_ = te_ & 63; E(acc, cur, we_ >> 2, we_ & 3, le_ & 15, le_ >> 4); }
        if (!has_next) break;
#pragma unroll
        for (int a = 0; a < 2; ++a)
#pragma unroll
            for (int b = 0; b < 2; ++b)
#pragma unroll
                for (int m = 0; m < 4; ++m)
#pragma unroll
                    for (int n = 0; n < 2; ++n) acc[a][b][m][n] = (f32x4){0.f, 0.f, 0.f, 0.f};
        cur = nxt; cA = nA; cB = nB; ++ui;
        if constexpr (GATHER) { gc00 = gn00; gc01 = gn01; gc10 = gn10; gc11 = gn11; }
        if constexpr (ALIGN_EPI) { if (wr == 1) PG8_BAR; }
    }
    PG8_WAIT_V(0);
    if constexpr (!ALIGN_EPI) { if (wr == 0) PG8_BAR; }
    PG8_BAR;
#undef PG8_SA
#undef PG8_SB
#undef PG8_GLDS
#undef PG8_STAGE_A
#undef PG8_STAGE_B
#undef PG8_LDA
#undef PG8_LDB
#undef PG8_MMA
#undef PG8_WAIT_V
#undef PG8_WAIT_L
#undef PG8_BAR
#undef PG8_SCHED
#undef PG8_GATH
}

__device__ __forceinline__ u32x4 pack8(const f32x4 a, const f32x4 b) { u32x4 w; w.x = cvt_pk_bf16(a[0], a[1]); w.y = cvt_pk_bf16(a[2], a[3]); w.z = cvt_pk_bf16(b[0], b[1]); w.w = cvt_pk_bf16(b[2], b[3]); return w; }
__device__ __forceinline__ u32x2 pack4(const f32x4 a) { u32x2 w; w.x = cvt_pk_bf16(a[0], a[1]); w.y = cvt_pk_bf16(a[2], a[3]); return w; }

constexpr float ATT_C2 = 0.125f * 1.4426950408889634f;
constexpr float NORM_EPS = 1e-6f;

struct EpiInProj {
    static constexpr bool PERM = true;
    bf16_t *P, *Z, *Q, *Kb, *Vb, *G; const float *qg, *kg, *bgate;
    __device__ __forceinline__ void operator()(const f32x4 (&acc)[2][2][4][2], const Unit& u, int wr, int wc, int fr, int fq) const {
        const int row0 = u.pm * BM + wr * 64 + fr; const int pn = u.pn;
        if (pn == 0) {
#pragma unroll
            for (int ai = 0; ai < 2; ++ai)
#pragma unroll
                for (int m = 0; m < 4; ++m) { bf16_t* rowp = P + (size_t)(row0 + ai * HALF + m * 16) * 256 + wc * 32 + 8 * fq;
#pragma unroll
                    for (int bj = 0; bj < 2; ++bj) *(u32x4*)(rowp + bj * HALF) = pack8(acc[ai][bj][m][0], acc[ai][bj][m][1]); asm volatile("" ::: "memory"); }
        } else if (pn <= 2) {
            const int t = pn - 1;
#pragma unroll
            for (int ai = 0; ai < 2; ++ai)
#pragma unroll
                for (int m = 0; m < 4; ++m) { bf16_t* rowp = Z + (size_t)(row0 + ai * HALF + m * 16) * 256 + t * 128 + 16 * wc + 4 * fq;
#pragma unroll
                    for (int bj = 0; bj < 2; ++bj) { const f32x4 a = acc[ai][bj][m][0], gt = acc[ai][bj][m][1]; f32x4 z;
#pragma unroll
                        for (int i = 0; i < 4; ++i) z[i] = a[i] * sigmoidf_(gt[i]);
                        *(u32x2*)(rowp + 64 * bj) = pack4(z); } asm volatile("" ::: "memory"); }
        } else if (pn <= 6) {
            const bool isq = pn <= 4; const int t = isq ? pn - 3 : pn - 5; const float* gs = isq ? qg : kg;
            f32x4 gv[2][2];
#pragma unroll
            for (int bj = 0; bj < 2; ++bj)
#pragma unroll
                for (int n = 0; n < 2; ++n) gv[bj][n] = *(const f32x4*)(gs + 32 * bj + 8 * fq + 4 * n);
            const float sc = isq ? ATT_C2 : 1.0f; const int head = 4 * t + wc;
#pragma unroll
            for (int ai = 0; ai < 2; ++ai)
#pragma unroll
                for (int m = 0; m < 4; ++m) { float ss = 0.f;
#pragma unroll
                    for (int bj = 0; bj < 2; ++bj)
#pragma unroll
                        for (int n = 0; n < 2; ++n) { const f32x4 x = acc[ai][bj][m][n]; ss += (x[0] * x[0] + x[1] * x[1]) + (x[2] * x[2] + x[3] * x[3]); }
                    { const int ln = 16 * fq + fr; ss += __int_as_float(__builtin_amdgcn_ds_bpermute((ln ^ 16) << 2, __float_as_int(ss))); ss += __int_as_float(__builtin_amdgcn_ds_bpermute((ln ^ 32) << 2, __float_as_int(ss))); }
                    const float rs = __builtin_amdgcn_rsqf(ss * (1.0f / 64.0f) + NORM_EPS) * sc;
                    const size_t r = (size_t)(row0 + ai * HALF + m * 16);
                    bf16_t* rowp = isq ? Q + r * 1024 + 64 * head + 8 * fq : Kb + r * 512 + 64 * head + 8 * fq;
#pragma unroll
                    for (int bj = 0; bj < 2; ++bj) *(u32x4*)(rowp + 32 * bj) = pack8(acc[ai][bj][m][0] * rs * gv[bj][0], acc[ai][bj][m][1] * rs * gv[bj][1]); asm volatile("" ::: "memory"); }
        } else if (pn <= 8) {
            const int t = pn - 7;
#pragma unroll
            for (int ai = 0; ai < 2; ++ai)
#pragma unroll
                for (int m = 0; m < 4; ++m) { bf16_t* rowp = Vb + (size_t)(row0 + ai * HALF + m * 16) * 512 + 256 * t + wc * 32 + 8 * fq;
#pragma unroll
                    for (int bj = 0; bj < 2; ++bj) *(u32x4*)(rowp + bj * HALF) = pack8(acc[ai][bj][m][0], acc[ai][bj][m][1]); asm volatile("" ::: "memory"); }
        } else {
            const int c0 = 256 * (pn - 9) + wc * 32 + 8 * fq;
            f32x4 bv[2][2];
#pragma unroll
            for (int bj = 0; bj < 2; ++bj)
#pragma unroll
                for (int n = 0; n < 2; ++n) bv[bj][n] = *(const f32x4*)(bgate + c0 + bj * HALF + 4 * n);
#pragma unroll
            for (int ai = 0; ai < 2; ++ai)
#pragma unroll
                for (int m = 0; m < 4; ++m) { bf16_t* rowp = G + (size_t)(row0 + ai * HALF + m * 16) * 3072 + c0;
#pragma unroll
                    for (int bj = 0; bj < 2; ++bj) { f32x4 v0 = acc[ai][bj][m][0] + bv[bj][0], v1 = acc[ai][bj][m][1] + bv[bj][1];
#pragma unroll
                        for (int i = 0; i < 4; ++i) { v0[i] = sigmoidf_(v0[i]); v1[i] = sigmoidf_(v1[i]); }
                        *(u32x4*)(rowp + bj * HALF) = pack8(v0, v1); } asm volatile("" ::: "memory"); }
        }
    }
};

struct EpiMerge {
    static constexpr bool PERM = true;
    const bf16_t* G; bf16_t* MG;
    __device__ __forceinline__ void operator()(const f32x4 (&acc)[2][2][4][2], const Unit& u, int wr, int wc, int fr, int fq) const {
        const int row0 = u.pm * BM + wr * 64 + fr, col0 = u.pn * BM + wc * 32 + 8 * fq; const int seg = u.e;
#pragma unroll
        for (int ai = 0; ai < 2; ++ai)
#pragma unroll
            for (int m = 0; m < 4; ++m) { const size_t r = (size_t)(row0 + ai * HALF + m * 16);
                const bf16_t* gp = G + r * 3072 + seg * 1024 + col0; bf16_t* mp = MG + r * 1024 + col0;
#pragma unroll
                for (int bj = 0; bj < 2; ++bj) {
                    const u32x4 gw = *(const u32x4*)(gp + bj * HALF);
                    f32x4 v0 = acc[ai][bj][m][0], v1 = acc[ai][bj][m][1];
                    v0[0] *= bf_lo(gw.x); v0[1] *= bf_hi(gw.x); v0[2] *= bf_lo(gw.y); v0[3] *= bf_hi(gw.y);
                    v1[0] *= bf_lo(gw.z); v1[1] *= bf_hi(gw.z); v1[2] *= bf_lo(gw.w); v1[3] *= bf_hi(gw.w);
                    if (seg != 0) { u32x4 pw;
                        { const unsigned long long q0 = __hip_atomic_load((const unsigned long long*)(mp + bj * HALF), __ATOMIC_RELAXED, __HIP_MEMORY_SCOPE_AGENT), q1 = __hip_atomic_load((const unsigned long long*)(mp + bj * HALF) + 1, __ATOMIC_RELAXED, __HIP_MEMORY_SCOPE_AGENT);
                          pw.x = (unsigned)q0; pw.y = (unsigned)(q0 >> 32); pw.z = (unsigned)q1; pw.w = (unsigned)(q1 >> 32); }
                        v0[0] += bf_lo(pw.x); v0[1] += bf_hi(pw.x); v0[2] += bf_lo(pw.y); v0[3] += bf_hi(pw.y);
                        v1[0] += bf_lo(pw.z); v1[1] += bf_hi(pw.z); v1[2] += bf_lo(pw.w); v1[3] += bf_hi(pw.w); }
                    *(u32x4*)(mp + bj * HALF) = pack8(v0, v1); } asm volatile("" ::: "memory"); }
    }
};

struct EpiResid {
    static constexpr bool PERM = false;
    const float* src; float* out;
    __device__ __forceinline__ void operator()(const f32x4 (&acc)[2][2][4][2], const Unit& u, int wr, int wc, int fr, int fq) const {
        const int row0 = u.pm * BM + wr * 64 + fr, col0 = u.pn * BM + wc * 32 + 4 * fq;
#pragma unroll
        for (int ai = 0; ai < 2; ++ai)
#pragma unroll
            for (int m = 0; m < 4; ++m) { const size_t off = (size_t)(row0 + ai * HALF + m * 16) * 1024 + col0;
#pragma unroll
                for (int bj = 0; bj < 2; ++bj)
#pragma unroll
                    for (int n = 0; n < 2; ++n) { const f32x4 b = *(const f32x4*)(src + off + bj * HALF + n * 16); *(f32x4*)(out + off + bj * HALF + n * 16) = b + acc[ai][bj][m][n]; } asm volatile("" ::: "memory"); }
    }
};

struct EpiSwiGLU {
    static constexpr bool PERM = true;
    bf16_t* H; int ldh;
    __device__ __forceinline__ void operator()(const f32x4 (&acc)[2][2][4][2], const Unit& u, int wr, int wc, int fr, int fq) const {
        const int row0 = u.pm * BM + wr * 64 + fr, ch0 = u.pn * 128 + 16 * wc + 4 * fq;
#pragma unroll
        for (int ai = 0; ai < 2; ++ai)
#pragma unroll
            for (int m = 0; m < 4; ++m) { bf16_t* rowp = H + (size_t)(row0 + ai * HALF + m * 16) * ldh + ch0;
#pragma unroll
                for (int bj = 0; bj < 2; ++bj) { const f32x4 a = acc[ai][bj][m][0], b = acc[ai][bj][m][1]; f32x4 z;
#pragma unroll
                    for (int i = 0; i < 4; ++i) z[i] = a[i] * sigmoidf_(a[i]) * b[i];
                    *(u32x2*)(rowp + 64 * bj) = pack4(z); } asm volatile("" ::: "memory"); }
    }
};

struct EpiMoeDown {
    static constexpr bool PERM = false;
    float* x; const unsigned* list; const float* wgt;
    __device__ __forceinline__ void operator()(const f32x4 (&acc)[2][2][4][2], const Unit& u, int wr, int wc, int fr, int fq) const {
        const int col0 = u.pn * BM + wc * 32 + 4 * fq; const unsigned* lp = list + u.lo; const int nv = u.nv;
#pragma unroll
        for (int ai = 0; ai < 2; ++ai)
#pragma unroll
            for (int m = 0; m < 4; ++m) { const int rl = ai * HALF + wr * 64 + m * 16 + fr;
                if (rl < nv) { const unsigned tok = lp[rl]; const float w = wgt[tok]; float* xp = x + (size_t)tok * 1024 + col0;
#pragma unroll
                    for (int bj = 0; bj < 2; ++bj)
#pragma unroll
                        for (int n = 0; n < 2; ++n) { const f32x4 b = *(const f32x4*)(xp + bj * HALF + n * 16); *(f32x4*)(xp + bj * HALF + n * 16) = b + acc[ai][bj][m][n] * w; } } asm volatile("" ::: "memory"); }
    }
};
}
#include <hip/hip_bf16.h>
#include <cmath>
namespace attn_body {
using bf16=__hip_bfloat16;
using bf16x8=__attribute__((ext_vector_type(8)))short;
using s16x4=__attribute__((ext_vector_type(4)))short;
using f32x16=__attribute__((ext_vector_type(16)))float;
using u32x4=__attribute__((ext_vector_type(4)))unsigned;
constexpr int BATCH=8,NHEAD=8,SEQ=8192,D=64,KVP=NHEAD*D,QP=1024;
constexpr int NW=8,QBLK=32,QB=QBLK*NW,KVBLK=64,NQB=SEQ/QB;
constexpr int ATTN_UNIT_ROWS=QB;
__device__ __forceinline__ int crow(int r,int hi){return (r&3)+8*(r>>2)+4*hi;}
#define SBAR() __builtin_amdgcn_sched_barrier(0)
__device__ __forceinline__ void cmask(f32x16&p0,f32x16&p1,int jb,int qrel,int hi){
  const float NEG=-INFINITY; int kb=64*jb+4*hi;
  #pragma unroll
  for(int r=0;r<16;++r){int kv=kb+(r&3)+8*(r>>2); if(kv>qrel)p0[r]=NEG; if(kv+32>qrel)p1[r]=NEG;}
}

constexpr int NSLOT=3, SLOTB=8192;
constexpr int LDS_K=0, LDS_V=NSLOT*SLOTB, LDS_WS=2*NSLOT*SLOTB, LDS_OST=LDS_WS+NW*64*4, LDS_CT=LDS_OST+NW*4096, LDS_BYTES=LDS_CT+SEQ*4;
constexpr float C2=0.125f*1.4426950408889634f;
__device__ __forceinline__ void glds16(const void*gsrc,unsigned lds_dst){unsigned keep;
  asm volatile("s_mov_b32 %0, m0\n\ts_mov_b32 m0, %2\n\ts_nop 0\n\tglobal_load_lds_dwordx4 %1, off\n\ts_mov_b32 m0, %0":"=&s"(keep):"v"(gsrc),"s"(lds_dst):"memory");}
__device__ __forceinline__ float max3f(float a,float b,float c){float r;asm("v_max3_f32 %0, %1, %2, %3":"=v"(r):"v"(a),"v"(b),"v"(c));return r;}
__device__ __forceinline__ float max2f(float a,float b){float r;asm("v_max_f32_e32 %0, %1, %2":"=v"(r):"v"(a),"v"(b));return r;}
__device__ __forceinline__ float fadd_s(float a,float b){float r;asm("v_add_f32_e32 %0, %1, %2":"=v"(r):"v"(a),"v"(b));return r;}
__device__ __forceinline__ float fsub_s(float a,float b){float r;asm("v_sub_f32_e32 %0, %1, %2":"=v"(r):"v"(a),"v"(b));return r;}
typedef float f32x2_t __attribute__((ext_vector_type(2))); typedef __bf16 bf16x2_t __attribute__((ext_vector_type(2)));
__device__ __forceinline__ unsigned cvtpk_s(float lo,float hi){f32x2_t v={lo,hi};bf16x2_t b=__builtin_convertvector(v,bf16x2_t);return __builtin_bit_cast(unsigned,b);}
#define WAIT_BAR(N) asm volatile("s_waitcnt vmcnt(" #N ") lgkmcnt(0)\n\ts_barrier":::"memory")

__device__ __forceinline__ void qkt(f32x16&p0,f32x16&p1,const char*Kslot,const bf16x8*qr,int r32,int hi){
  const char*kb=Kslot+hi*1024+r32*16;
  #pragma unroll
  for(int d0=0;d0<4;++d0){
    const bf16x8 b0=*reinterpret_cast<const bf16x8*>(kb+d0*2048);
    const bf16x8 b1=*reinterpret_cast<const bf16x8*>(kb+d0*2048+512);
    {p0=__builtin_amdgcn_mfma_f32_32x32x16_bf16(b0,qr[d0],p0,0,0,0);p1=__builtin_amdgcn_mfma_f32_32x32x16_bf16(b1,qr[d0],p1,0,0,0);}}
}
typedef __attribute__((address_space(3))) const char* lds_cptr;
typedef short v4i16_t __attribute__((ext_vector_type(4)));
__device__ __forceinline__ void kload8(bf16x8*kf,lds_cptr kp){
  kf[0]=*(const __attribute__((address_space(3))) bf16x8*)(kp);      kf[1]=*(const __attribute__((address_space(3))) bf16x8*)(kp+512);
  kf[2]=*(const __attribute__((address_space(3))) bf16x8*)(kp+2048); kf[3]=*(const __attribute__((address_space(3))) bf16x8*)(kp+2560);
  kf[4]=*(const __attribute__((address_space(3))) bf16x8*)(kp+4096); kf[5]=*(const __attribute__((address_space(3))) bf16x8*)(kp+4608);
  kf[6]=*(const __attribute__((address_space(3))) bf16x8*)(kp+6144); kf[7]=*(const __attribute__((address_space(3))) bf16x8*)(kp+6656);
}
__device__ __forceinline__ void kload2(bf16x8*kf,lds_cptr kp,int j){ kf[2*j]=*(const __attribute__((address_space(3))) bf16x8*)(kp+j*2048); kf[2*j+1]=*(const __attribute__((address_space(3))) bf16x8*)(kp+j*2048+512); }
__device__ __forceinline__ s16x4 vtr(lds_cptr p){ return __builtin_bit_cast(s16x4,__builtin_amdgcn_ds_read_tr16_b64_v4i16((__attribute__((address_space(3))) v4i16_t*)p)); }
__device__ __forceinline__ float rowmax(const f32x16&p0,const f32x16&p1){
  float a=max3f(p0[0],p0[1],p1[0]),b=max3f(p0[2],p0[3],p1[1]);a=max3f(a,p1[2],p1[3]);
  #pragma unroll
  for(int r=4;r<16;r+=4){a=max3f(a,p0[r],p0[r+1]);b=max3f(b,p0[r+2],p0[r+3]);a=max3f(a,p1[r],p1[r+1]);b=max3f(b,p1[r+2],p1[r+3]);}
  const float m=max2f(a,b);
  auto rr=__builtin_amdgcn_permlane32_swap(__float_as_uint(m),__float_as_uint(m),false,false);
  return max2f(__uint_as_float(rr[0]),__uint_as_float(rr[1]));
}
__device__ __forceinline__ void pv(f32x16*o,int vb,bf16x8 pa0,bf16x8 pa1,bf16x8 pa2,bf16x8 pa3){
  #pragma unroll
  for(int d0=0;d0<2;++d0){s16x4 lo[4],hi[4];
    #pragma unroll
    for(int ks=0;ks<4;++ks){
      asm volatile("ds_read_b64_tr_b16 %0,%1 offset:%c2":"=&v"(lo[ks]):"v"(vb),"i"(d0*4096+ks*1024):"memory");
      asm volatile("ds_read_b64_tr_b16 %0,%1 offset:%c2":"=&v"(hi[ks]):"v"(vb),"i"(d0*4096+ks*1024+512):"memory");}
    asm volatile("s_waitcnt lgkmcnt(0)":::"memory");SBAR();
    #define PK(k) (bf16x8){lo[k][0],lo[k][1],lo[k][2],lo[k][3],hi[k][0],hi[k][1],hi[k][2],hi[k][3]}
    o[d0]=__builtin_amdgcn_mfma_f32_32x32x16_bf16(pa0,PK(0),o[d0],0,0,0);
    o[d0]=__builtin_amdgcn_mfma_f32_32x32x16_bf16(pa1,PK(1),o[d0],0,0,0);
    o[d0]=__builtin_amdgcn_mfma_f32_32x32x16_bf16(pa2,PK(2),o[d0],0,0,0);
    o[d0]=__builtin_amdgcn_mfma_f32_32x32x16_bf16(pa3,PK(3),o[d0],0,0,0);
    #undef PK
  }
}

#ifndef ATTN_STORE16
#define ATTN_STORE16(p,v) (*(u32x4*)(p)=(v))
#endif
template<int THRL> __device__ __forceinline__ void attn_unit(int b,int h,int qb,int t0,const bf16*Q,const bf16*__restrict__ K,const bf16*__restrict__ V,bf16*O,const float*__restrict__ NCL,char*shm){
  int tid_o=threadIdx.x; asm volatile("":"+v"(tid_o));
  const int tid=tid_o,lane=tid&63,r32=lane&31,hi=lane>>5; const int wid=__builtin_amdgcn_readfirstlane(tid>>6);
  const long rowbase=(long)b*SEQ; const int q0=qb*QB;
  const bf16*Qw=Q+(rowbase+q0+wid*QBLK)*QP+h*D;
  const bf16*Kh=K+(rowbase+(long)t0*KVBLK)*KVP+h*D,*Vh=V+(rowbase+(long)t0*KVBLK)*KVP+h*D;
  const unsigned lds0=(unsigned)(uintptr_t)shm;
  float*wsf=(float*)(shm+LDS_WS)+wid*64;
  const bf16*ksrc=Kh+(long)lane*KVP+wid*8;
  const bf16*vsrc=Vh+(long)(16*(wid&3)+(lane>>2))*KVP+(wid>>2)*32+(lane&3)*8;
  const unsigned kdst=lds0+LDS_K+wid*1024, vdst=lds0+LDS_V+wid*1024;
  #define DMA_K(t,slot) glds16(ksrc+(long)(t)*KVBLK*KVP,(unsigned)__builtin_amdgcn_readfirstlane(kdst+(slot)))
  #define DMA_V(t,slot) glds16(vsrc+(long)(t)*KVBLK*KVP,(unsigned)__builtin_amdgcn_readfirstlane(vdst+(slot)))
  const int vb0=(int)(lds0+LDS_V)+((lane>>4)&1)*32+(lane&3)*8+(4*hi+((lane&15)>>2))*64;
  const char*Kbase=shm+LDS_K; bf16x8 kf[8];
  const lds_cptr shm3=(lds_cptr)shm; const lds_cptr kp0=shm3+LDS_K+hi*1024+r32*16; const lds_cptr vp0=shm3+LDS_V+((lane>>4)&1)*32+(lane&3)*8+(4*hi+((lane&15)>>2))*64;
  const int NT=(q0+QB)/KVBLK-t0;
  { typedef float f32x4_t __attribute__((ext_vector_type(4))); __attribute__((address_space(3))) float* ct=(__attribute__((address_space(3))) float*)(shm3+LDS_CT);
    for(int i=t0*KVBLK+tid*4;i<q0+QB;i+=NW*64*4) *(__attribute__((address_space(3))) f32x4_t*)(ct+i)=*(const f32x4_t*)(NCL+i); }
  const __attribute__((address_space(3))) float* ctl=(const __attribute__((address_space(3))) float*)(shm3+LDS_CT)+t0*KVBLK+4*hi;
  #define CINIT(C0,C1,t) do{ typedef float f32x4_t __attribute__((ext_vector_type(4))); const float nm_=-mhat; const __attribute__((address_space(3))) float* cb_=ctl+64*(t); \
    _Pragma("unroll") for(int g_=0;g_<4;++g_){ const f32x4_t b0_=*(const __attribute__((address_space(3))) f32x4_t*)(cb_+8*g_), b1_=*(const __attribute__((address_space(3))) f32x4_t*)(cb_+32+8*g_); \
      _Pragma("unroll") for(int i_=0;i_<4;++i_){ C0[4*g_+i_]=nm_+b0_[i_]; C1[4*g_+i_]=nm_+b1_[i_]; } } }while(0)
  DMA_K(0,0);DMA_V(0,0);DMA_K(1,SLOTB);
  bf16x8 qr[4];
  #pragma unroll
  for(int d0=0;d0<4;++d0)qr[d0]=*reinterpret_cast<const bf16x8*>(&Qw[(long)r32*QP+d0*16+hi*8]);
  float mhat=0.f,l_reg=0.f;f32x16 o[2];o[0]=f32x16{};o[1]=f32x16{};
  const int qrel=wid*QBLK+r32;
  #define CMASK(P0,P1,t) do{int jb_=(t)-(NT-4); if(jb_>=0)cmask(P0,P1,jb_,qrel,hi);}while(0)
  bool resc=false;
  #define START(P0,P1) do{ const float rm=rowmax(P0,P1); resc=false; \
    { const float dl=rm; mhat=fadd_s(mhat,dl); \
      _Pragma("unroll") for(int r=0;r<16;++r){P0[r]=fsub_s(P0[r],dl);P1[r]=fsub_s(P1[r],dl);} \
      } \
    _Pragma("unroll") for(int r=0;r<16;++r)P0[r]=__builtin_amdgcn_exp2f(P0[r]); }while(0)
  #define RESC() do{ if(resc){ asm volatile("s_waitcnt lgkmcnt(0)":::"memory"); \
      _Pragma("unroll") for(int d_=0;d_<2;++d_) _Pragma("unroll") for(int r=0;r<16;++r)o[d_][r]*=wsf[crow(r,hi)]; } }while(0)
  f32x16 pA0,pA1,pB0,pB1;
  int sl_prev=0,sl_cur=0,sl_next=SLOTB;
  #define ROT() do{sl_prev=sl_cur;sl_cur=sl_next;sl_next=(sl_next==(NSLOT-1)*SLOTB)?0:sl_next+SLOTB;}while(0)
  DMA_K(2,2*SLOTB);
  WAIT_BAR(3);
  CINIT(pA0,pA1,0); qkt(pA0,pA1,Kbase,qr,r32,hi);asm volatile("s_nop 15\n\ts_nop 7":"+v"(pA0),"+v"(pA1));CMASK(pA0,pA1,0);
  START(pA0,pA1);
  _Pragma("unroll") for(int r=0;r<16;++r)pA1[r]=__builtin_amdgcn_exp2f(pA1[r]);
  WAIT_BAR(0);
  DMA_K(3,0);DMA_V(1,SLOTB);
  ROT();
  kload8(kf,kp0+sl_cur);
  WAIT_BAR(2);
  s16x4 vlo[8],vhi[8]; u32x4 pw0,pw1,pw2,pw3;
  #define PKW(P,B) cvtpk_s(P[B],P[B+1])
  #define PAF(k) __builtin_bit_cast(bf16x8,pw##k)
  #define VFR(i) (bf16x8){vlo[i][0],vlo[i][1],vlo[i][2],vlo[i][3],vhi[i][0],vhi[i][1],vhi[i][2],vhi[i][3]}
  #define PIN(x) asm volatile("":"+v"(x))
  #define MX3(a,b,c) __builtin_fmaxf(__builtin_fmaxf((a),(b)),(c))
  #define GAPA(MF,A0,A1,A2,A3,W0,W1,PW) do{ MF; sacc+=A0; sacc+=A1; sacc+=A2; sacc+=A3; PIN(sacc); W0; W1; PIN(PW); SBAR(); }while(0)
  #define EX(v) __builtin_amdgcn_exp2f(v)
  #define GAPB(MF,X,B) do{ MF; X[B]=EX(X[B]); X[B+1]=EX(X[B+1]); X[B+2]=EX(X[B+2]); X[B+3]=EX(X[B+3]); PIN(X); SBAR(); }while(0)
  #define VRD(i) do{ vlo[i]=vtr(vp_+(((i)>>2)*4096+((i)&3)*1024)); vhi[i]=vtr(vp_+(((i)>>2)*4096+((i)&3)*1024+512)); }while(0)
  #define KRD(G,j) do{ if(G){ kload2(kf,kp0+sl_next,j); SBAR(); } }while(0)
  #define STEP(C0,C1,P0,P1,t,GK,GV,GL) do{ SBAR(); CINIT(C0,C1,t); SBAR(); \
    const lds_cptr vp_=vp0+sl_prev; \
    VRD(0); SBAR(); float sacc=(P0[0]+P0[1]); \
    GAPA(C0=__builtin_amdgcn_mfma_f32_32x32x16_bf16(kf[0],qr[0],C0,0,0,0), P0[2],P0[3],P0[4],P0[5],     pw0[0]=PKW(P0,0), pw0[1]=PKW(P0,2), pw0); \
    VRD(4); SBAR(); GAPA(C1=__builtin_amdgcn_mfma_f32_32x32x16_bf16(kf[1],qr[0],C1,0,0,0), P0[6],P0[7],P0[8],P0[9],     pw0[2]=PKW(P0,4), pw0[3]=PKW(P0,6), pw0); \
    VRD(1); SBAR(); GAPA(C0=__builtin_amdgcn_mfma_f32_32x32x16_bf16(kf[2],qr[1],C0,0,0,0),   P0[10],P0[11],P0[12],P0[13], pw1[0]=PKW(P0,8), pw1[1]=PKW(P0,10), pw1); \
    VRD(5); SBAR(); GAPA(C1=__builtin_amdgcn_mfma_f32_32x32x16_bf16(kf[3],qr[1],C1,0,0,0),   P0[14],P0[15],P1[0],P1[1],   pw1[2]=PKW(P0,12),pw1[3]=PKW(P0,14), pw1); \
    VRD(2); SBAR(); GAPA(C0=__builtin_amdgcn_mfma_f32_32x32x16_bf16(kf[4],qr[2],C0,0,0,0),   P1[2],P1[3],P1[4],P1[5],     pw2[0]=PKW(P1,0), pw2[1]=PKW(P1,2), pw2); \
    VRD(6); SBAR(); GAPA(C1=__builtin_amdgcn_mfma_f32_32x32x16_bf16(kf[5],qr[2],C1,0,0,0),   P1[6],P1[7],P1[8],P1[9],     pw2[2]=PKW(P1,4), pw2[3]=PKW(P1,6), pw2); \
    VRD(3); SBAR(); GAPA(C0=__builtin_amdgcn_mfma_f32_32x32x16_bf16(kf[6],qr[3],C0,0,0,0),   P1[10],P1[11],P1[12],P1[13], pw3[0]=PKW(P1,8), pw3[1]=PKW(P1,10), pw3); \
    VRD(7); SBAR(); GAPA(C1=__builtin_amdgcn_mfma_f32_32x32x16_bf16(kf[7],qr[3],C1,0,0,0),   P1[14],P1[15],0.f,0.f,       pw3[2]=PKW(P1,12),pw3[3]=PKW(P1,14), pw3); \
    l_reg+=sacc; \
    if(GK){DMA_K((t)+3,sl_cur);} if(GV){DMA_V((t)+1,sl_next);} \
    CMASK(C0,C1,t); \
    { float a=MX3(C0[0],C0[1],C1[0]),b=MX3(C0[2],C0[3],C1[1]); a=MX3(a,C1[2],C1[3]); \
      _Pragma("unroll") for(int r=4;r<16;r+=4){a=MX3(a,C0[r],C0[r+1]);b=MX3(b,C0[r+2],C0[r+3]);a=MX3(a,C1[r],C1[r+1]);b=MX3(b,C1[r+2],C1[r+3]);} \
      float rm=__builtin_fmaxf(a,b); { auto rr=__builtin_amdgcn_permlane32_swap(__float_as_uint(rm),__float_as_uint(rm),false,false); rm=__builtin_fmaxf(__uint_as_float(rr[0]),__uint_as_float(rr[1])); } \
      resc=false; \
      if(__builtin_expect(__any(rm>(float)THRL),0)){ const float dl=__builtin_fmaxf(rm,0.f); mhat+=dl; \
        _Pragma("unroll") for(int r=0;r<16;++r){C0[r]-=dl;C1[r]-=dl;} \
        const float f=__builtin_amdgcn_exp2f(-dl); l_reg*=f; if(hi==0)wsf[r32]=f; resc=true; } } \
    SBAR(); \
    GAPB(o[0]=__builtin_amdgcn_mfma_f32_32x32x16_bf16(PAF(0),VFR(0),o[0],0,0,0), C0,0); \
    GAPB(o[1]=__builtin_amdgcn_mfma_f32_32x32x16_bf16(PAF(0),VFR(4),o[1],0,0,0), C0,4); \
    KRD(GL,0); GAPB(o[0]=__builtin_amdgcn_mfma_f32_32x32x16_bf16(PAF(1),VFR(1),o[0],0,0,0), C0,8); \
    KRD(GL,1); GAPB(o[1]=__builtin_amdgcn_mfma_f32_32x32x16_bf16(PAF(1),VFR(5),o[1],0,0,0), C0,12); \
    KRD(GL,2); GAPB(o[0]=__builtin_amdgcn_mfma_f32_32x32x16_bf16(PAF(2),VFR(2),o[0],0,0,0), C1,0); \
    KRD(GL,3); GAPB(o[1]=__builtin_amdgcn_mfma_f32_32x32x16_bf16(PAF(2),VFR(6),o[1],0,0,0), C1,4); \
    GAPB(o[0]=__builtin_amdgcn_mfma_f32_32x32x16_bf16(PAF(3),VFR(3),o[0],0,0,0), C1,8); \
    GAPB(o[1]=__builtin_amdgcn_mfma_f32_32x32x16_bf16(PAF(3),VFR(7),o[1],0,0,0), C1,12); \
    }while(0)
  int t=1;
  #undef CMASK
  #define CMASK(P0,P1,t) do{}while(0)
  for(;t+5<NT;t+=2){
    STEP(pB0,pB1,pA0,pA1,t,true,true,true);     WAIT_BAR(2); RESC(); ROT();
    STEP(pA0,pA1,pB0,pB1,t+1,true,true,true);   WAIT_BAR(2); RESC(); ROT();
  }
  #undef CMASK
  #define CMASK(P0,P1,t) do{int jb_=(t)-(NT-4); if(jb_>=0)cmask(P0,P1,jb_,qrel,hi);}while(0)
  #define ENDW(tt) do{ if((tt)+3<NT){WAIT_BAR(2);} else if((tt)+2<NT){WAIT_BAR(1);} else {WAIT_BAR(0);} }while(0)
  for(;t+1<NT;t+=2){
    STEP(pB0,pB1,pA0,pA1,t,(t+3<NT),(t+1<NT),(t+1<NT));       ENDW(t);   RESC(); ROT();
    STEP(pA0,pA1,pB0,pB1,t+1,(t+4<NT),(t+2<NT),(t+2<NT));     ENDW(t+1); RESC(); ROT();
  }
  STEP(pB0,pB1,pA0,pA1,NT-1,false,false,false); RESC();
  { float sacc=pB0[0]+pB0[1]; _Pragma("unroll") for(int r=2;r<16;++r)sacc+=pB0[r]; _Pragma("unroll") for(int r=0;r<16;++r)sacc+=pB1[r]; l_reg+=sacc;
    pw0=(u32x4){PKW(pB0,0),PKW(pB0,2),PKW(pB0,4),PKW(pB0,6)};pw1=(u32x4){PKW(pB0,8),PKW(pB0,10),PKW(pB0,12),PKW(pB0,14)};pw2=(u32x4){PKW(pB1,0),PKW(pB1,2),PKW(pB1,4),PKW(pB1,6)};pw3=(u32x4){PKW(pB1,8),PKW(pB1,10),PKW(pB1,12),PKW(pB1,14)};
    SBAR(); pv(o,vb0+sl_cur,PAF(0),PAF(1),PAF(2),PAF(3)); }
  #undef PKW
  #undef PAF
  #undef VFR
  #undef PIN
  #undef MX3
  #undef GAPA
  #undef GAPB
  #undef EX
  #undef VRD
  #undef KRD
  #undef STEP
  #undef ENDW
  {auto rr=__builtin_amdgcn_permlane32_swap(__float_as_uint(l_reg),__float_as_uint(l_reg),false,false);l_reg=__uint_as_float(rr[0])+__uint_as_float(rr[1]);}
  if(hi==0)wsf[32+r32]=l_reg;asm volatile("s_waitcnt lgkmcnt(0)":::"memory");
  float rli[16];
  #pragma unroll
  for(int r=0;r<16;++r)rli[r]=__builtin_amdgcn_rcpf(wsf[32+crow(r,hi)]);
  bf16*Ow=O+(rowbase+q0+wid*QBLK)*QP+h*D;
  { bf16*stg=(bf16*)(shm+LDS_OST)+wid*2048;
    #pragma unroll
    for(int r=0;r<16;++r){const int orow=crow(r,hi);
      #pragma unroll
      for(int d0=0;d0<2;++d0)stg[orow*64+d0*32+r32]=__float2bfloat16(o[d0][r]*rli[r]);}
    asm volatile("s_waitcnt lgkmcnt(0)":::"memory");
    #pragma unroll
    for(int i=0;i<4;++i){const int row=i*8+(lane>>3),ch=lane&7; const u32x4 v=*(const u32x4*)(stg+row*64+ch*8); ATTN_STORE16(Ow+(long)row*QP+ch*8,v);} }
  asm volatile("s_waitcnt lgkmcnt(0)\n\ts_barrier":::"memory");
  #undef DMA_K
  #undef DMA_V
  #undef CMASK
  #undef START
  #undef RESC
  #undef ROT
  #undef CINIT
}
constexpr int ATTN_LDS_BYTES=LDS_BYTES;
struct AttnTensors { const bf16* Q; const bf16* K; const bf16* V; bf16* O; const float* NCL; };
struct AttnUnit { int bh; int qb; };
struct AttnQueue { unsigned* cnt; float th; int xcc; volatile __attribute__((address_space(3))) unsigned* slot; };
template<int THRL=8> __device__ __forceinline__ void attn_phase_dyn(char*lds,const AttnTensors&T_,const AttnQueue&Qd){
  AttnTensors T;
  { unsigned long long q_=(unsigned long long)T_.Q,k_=(unsigned long long)T_.K,v_=(unsigned long long)T_.V,o_=(unsigned long long)T_.O,c_=(unsigned long long)T_.NCL; asm volatile("":"+s"(q_),"+s"(k_),"+s"(v_),"+s"(o_),"+s"(c_));
    typedef __attribute__((address_space(1))) bf16 gbf; typedef __attribute__((address_space(1))) float gf;
    T.Q=(const bf16*)(const gbf*)q_; T.K=(const bf16*)(const gbf*)k_; T.V=(const bf16*)(const gbf*)v_; T.O=(bf16*)(gbf*)o_; T.NCL=(const float*)(const gf*)c_; }
  int it=0;
  for(int qq=0;qq<BATCH;++qq){ const int b=(Qd.xcc+qq)&(BATCH-1);
    for(;;++it){
      int tid_=threadIdx.x; asm volatile("":"+v"(tid_));
      if(tid_==0) Qd.slot[it&1]=__hip_atomic_fetch_add(Qd.cnt+64*b,1u,__ATOMIC_RELAXED,__HIP_MEMORY_SCOPE_AGENT);
      __syncthreads();
      const int u=__builtin_amdgcn_readfirstlane((int)Qd.slot[it&1]);
      if(u>=NHEAD*NQB) break;
      const int qb=NQB-1-(u>>3),h=u&(NHEAD-1),bh=b*NHEAD+h;
      const float* nrow=T.NCL+(long)bh*SEQ; const int ntile=4*(qb+1),lane_=tid_&63;
      const float ref=nrow[qb*QB]-Qd.th;
      const bool ok0=(lane_<ntile)&&(nrow[(lane_<ntile?lane_:0)*KVBLK+KVBLK-1]<=ref), ok1=(lane_+64<ntile)&&(nrow[(lane_+64<ntile?lane_+64:0)*KVBLK+KVBLK-1]<=ref);
      int t0=__builtin_popcountll(__ballot(ok0))+__builtin_popcountll(__ballot(ok1)); t0&=~1; if(t0>ntile-4)t0=ntile-4;
      t0=__builtin_amdgcn_readfirstlane(t0);
      attn_unit<THRL>(b,h,qb,t0,T.Q,T.K,T.V,T.O,nrow,lds);
    }
    ++it;
  }
}
#undef SBAR
#undef WAIT_BAR
}

constexpr int NWAVES = 8;
#ifndef MK_PER_PHASE
#define MK_PER_PHASE 0
#endif

constexpr int D = 1024, BATCH = 8, SEQ = 8192, M = BATCH * SEQ, DEPTH = 4;
constexpr int IN_COLS = 5384, OFF_CONV = 256, OFF_Q = 768, OFF_K = 1280, OFF_V = 1792, OFF_F = 2304, OFF_G = 2312;
constexpr int NIN = 5376;
constexpr int DFF = 2816, DFFE = 3584, NEXP = 8, CONVK = 31;
constexpr float LOG2E = 1.4426950408889634f;

constexpr size_t MiB = 1u << 20;
constexpr size_t WS_CTL = 0, CTL_ZERO_BYTES = 256 * 1024;
constexpr size_t WS_NLF = 1 * MiB;
constexpr size_t WS_NCL = 3 * MiB;
constexpr size_t WS_WIN = 5 * MiB;
constexpr size_t WS_WBR = 16 * MiB;
constexpr size_t WS_WOUT = 18 * MiB;
constexpr size_t WS_WFF = 20 * MiB;
constexpr size_t WS_HB = 188 * MiB;
constexpr size_t WS_Y = 316 * MiB;
constexpr size_t WS_K = 444 * MiB, WS_V = 508 * MiB;
constexpr size_t WS_P = 572 * MiB, WS_Z = 604 * MiB;
constexpr size_t WS_G = 636 * MiB;
constexpr size_t WS_HID = 316 * MiB;
constexpr size_t WS_LIST = 800 * MiB;
constexpr size_t WS_MOEW = 808 * MiB;
constexpr size_t WS_END = 1020 * MiB;
constexpr size_t WFF_W2_DENSE = (size_t)2 * DFF * D * 2;
constexpr size_t WFF_W13_E = (size_t)2 * DFFE * D * 2, WFF_W2_E = (size_t)D * DFFE * 2, WFF_W2_MOE = 8 * WFF_W13_E;
static_assert(WS_WIN + (size_t)NIN * D * 2 <= WS_WBR && WS_WFF + WFF_W2_MOE + 8 * WFF_W2_E <= WS_HB && WS_G + (size_t)M * 3072 * 2 <= WS_END && WS_HID + (size_t)264 * 256 * DFFE * 2 <= WS_LIST, "d_ws map");
constexpr int CW_TMO = 0;
constexpr int CW_MOECNT = 64;
constexpr int CW_ATTQ = 8192;
constexpr int CW_BAR = 4096;

constexpr int RING_OFF = 0, RING_BYTES = 131072;
constexpr int LDSCTL_OFF = RING_BYTES, MISC_OFF = LDSCTL_OFF + 320;
constexpr int MOETAB_OFF = LDSCTL_OFF + 1024;
constexpr int LDS_BYTES = 147456;
static_assert(MISC_OFF + 128 <= MOETAB_OFF && MOETAB_OFF + 272 * 4 <= LDS_BYTES, "LDS map");

#define GAS __attribute__((address_space(1)))
#define LAS __attribute__((address_space(3)))
typedef unsigned short bf16;
typedef unsigned v4u __attribute__((ext_vector_type(4)));
typedef unsigned v2u __attribute__((ext_vector_type(2)));
typedef float f32x4 __attribute__((ext_vector_type(4)));
typedef GAS unsigned gu32;
#define RLX_AGENT __ATOMIC_RELAXED, __HIP_MEMORY_SCOPE_AGENT
#define LDS_WAIT() asm volatile("s_waitcnt lgkmcnt(0)" ::: "memory")
#define VM_WAIT() asm volatile("s_waitcnt vmcnt(0)" ::: "memory")
__device__ __forceinline__ unsigned f2bf(float f) { unsigned u = __builtin_bit_cast(unsigned, f); return (u + 0x7fffu + ((u >> 16) & 1u)) >> 16; }
__device__ __forceinline__ unsigned pk2(float lo, float hi) { return f2bf(lo) | (f2bf(hi) << 16); }
__device__ __forceinline__ float bflo(unsigned w) { return __uint_as_float(w << 16); }
__device__ __forceinline__ float bfhi(unsigned w) { return __uint_as_float(w & 0xffff0000u); }

#define XB_TMO      128
#define XB_XCNT(j)  (256  + 64 * (j))
#define XB_XSUB(j)  (1280 + 64 * (j))
#define XB_XGEN(j)  (2304 + 64 * (j))
#define XB_TOP      3328
#define XB_TOPGEN   3392
#define XCD_BAR_WORDS 3456
#define XB_SPIN_CAP (1u << 18)

__device__ __forceinline__ unsigned xb_ld(unsigned* p)              { return __hip_atomic_load(p, __ATOMIC_RELAXED, __HIP_MEMORY_SCOPE_AGENT); }
__device__ __forceinline__ unsigned xb_add(unsigned* p, unsigned v) { return __hip_atomic_fetch_add(p, v, __ATOMIC_RELAXED, __HIP_MEMORY_SCOPE_AGENT); }
__device__ __forceinline__ unsigned xb_xcc_id() { return (unsigned)__builtin_amdgcn_s_getreg((3 << 11) | 20) & 0xFu; }
#define XB_SPIN(cond, bar) do { unsigned _sp = 0; while (cond) { __builtin_amdgcn_s_sleep(1); \
    if ((++_sp & 255u) == 0u) { if (xb_ld(&(bar)[XB_TMO])) break; if (_sp > XB_SPIN_CAP) { atomicAdd(&(bar)[XB_TMO], 1u); break; } } } } while (0)

struct XcdBarrier {
    unsigned* bar; unsigned x;
    volatile LAS unsigned* st;
};

__device__ __forceinline__ XcdBarrier xcd_barrier_post(unsigned* bar, volatile LAS unsigned* st) {
    XcdBarrier b; b.bar = bar; b.x = xb_xcc_id(); b.st = st;
    if (threadIdx.x == 0) (void)xb_add(&bar[XB_XCNT(b.x)], 1u);
    return b;
}
__device__ __forceinline__ void xcd_barrier_complete(unsigned* bar, unsigned x, unsigned& nloc, unsigned& nx) {
    const unsigned G = gridDim.x * gridDim.y * gridDim.z;
    unsigned sum, cnt, mine, sp = 0u;
    for (;;) {
        sum = 0u; cnt = 0u; mine = 0u;
#pragma unroll
        for (unsigned j = 0; j < 16; ++j) { const unsigned c = xb_ld(&bar[XB_XCNT(j)]); sum += c; cnt += (c > 0u) ? 1u : 0u; mine = (j == x) ? c : mine; }
        if (sum == G) break;
        __builtin_amdgcn_s_sleep(1);
        if ((++sp & 255u) == 0u) { if (xb_ld(&bar[XB_TMO])) break; if (sp > XB_SPIN_CAP) { atomicAdd(&bar[XB_TMO], 1u); break; } }
    }
    nloc = mine > 0u ? mine : 1u; nx = cnt > 0u ? cnt : 1u;
}

__device__ __forceinline__ void xcd_barrier(const XcdBarrier& b) {
    asm volatile("s_waitcnt vmcnt(0)" ::: "memory");
    __syncthreads();
    if (threadIdx.x == 0) {
        unsigned* bar = b.bar;
        __builtin_amdgcn_s_waitcnt(0);
        unsigned nloc = b.st[0], nx = b.st[1];
        if (nloc == 0u) { xcd_barrier_complete(bar, b.x, nloc, nx); b.st[0] = nloc; b.st[1] = nx; }
        const unsigned old = xb_add(&bar[XB_XSUB(b.x)], 1u);
        const unsigned gen = old / nloc;
        if (old + 1u == (gen + 1u) * nloc) {
            __builtin_amdgcn_fence(__ATOMIC_RELEASE, "agent");
            asm volatile("s_waitcnt vmcnt(0)" ::: "memory");
            const unsigned og = xb_add(&bar[XB_TOP], 1u);
            const unsigned tg = og / nx;
            if (og + 1u == (tg + 1u) * nx) xb_add(&bar[XB_TOPGEN], 1u);
            else XB_SPIN(xb_ld(&bar[XB_TOPGEN]) == tg, bar);
            __builtin_amdgcn_fence(__ATOMIC_ACQUIRE, "agent");
            xb_add(&bar[XB_XGEN(b.x)], 1u);
            asm volatile("s_waitcnt vmcnt(0)" ::: "memory");
        } else {
            XB_SPIN(xb_ld(&bar[XB_XGEN(b.x)]) == gen, bar);
            __builtin_amdgcn_fence(__ATOMIC_ACQUIRE, "agent");
            asm volatile("s_waitcnt vmcnt(0)" ::: "memory");
        }
    }
    __syncthreads();
}

struct Frame {
    LAS unsigned char* lds;
    volatile LAS unsigned* MISC;
    int vcu, G;
};
struct Site {
    gu32* ctl; unsigned char* ws; const float* const __attribute__((address_space(4)))* in; float* out;
    int tid, lane, wave;
};
__device__ __forceinline__ Site make_site() {
    Site P; int t_ = threadIdx.x; asm volatile("" : "+v"(t_)); P.tid = t_; P.lane = t_ & 63; P.wave = __builtin_amdgcn_readfirstlane(t_ >> 6);
    unsigned long long kp_ = (unsigned long long)__builtin_amdgcn_kernarg_segment_ptr(); asm volatile("" : "+s"(kp_));
    P.in = (const float* const __attribute__((address_space(4)))*)kp_;
    P.out = (float*)(GAS float*)(*(const __attribute__((address_space(4))) unsigned long long*)(kp_ + 200));
    P.ws = (unsigned char*)(GAS unsigned char*)(*(const __attribute__((address_space(4))) unsigned long long*)(kp_ + 208));
    P.ctl = (gu32*)(P.ws + WS_CTL);
    return P;
}
__device__ __forceinline__ float wave_sum(float v, int lane) {
#pragma unroll
    for (int o = 1; o < 64; o <<= 1) v += __int_as_float(__builtin_amdgcn_ds_bpermute((lane ^ o) << 2, __float_as_int(v)));
    return v;
}

__device__ __forceinline__ void transpose_item(const float* colp, size_t sstride, bf16* WT, int K, int n0, int k0, LAS float* scr, int lane) {
    const float* sp = colp + (size_t)k0 * sstride;
    const float* lp = sp + (size_t)(lane >> 5) * sstride;
    LAS float* sq = scr + (lane >> 5) * 33 + (lane & 31);
#pragma unroll
    for (int hb = 0; hb < 2; ++hb) { float tv[16];
#pragma unroll
        for (int i = 0; i < 16; ++i) { tv[i] = *lp; lp += 2 * sstride; }
#pragma unroll
        for (int i = 0; i < 16; ++i) sq[(2 * (16 * hb + i)) * 33] = tv[i]; }
    LDS_WAIT(); asm volatile("" ::: "memory");
    const int c = lane & 7;
#pragma unroll
    for (int j = 0; j < 4; ++j) { const int n = (lane >> 3) + 8 * j; const LAS float* s = scr + (8 * c) * 33 + n;
        v4u o; o.x = pk2(s[0 * 33], s[1 * 33]); o.y = pk2(s[2 * 33], s[3 * 33]); o.z = pk2(s[4 * 33], s[5 * 33]); o.w = pk2(s[6 * 33], s[7 * 33]);
        *(GAS v4u*)(WT + (size_t)(n0 + n) * K + k0 + 8 * c) = o; }
    LDS_WAIT(); asm volatile("" ::: "memory");
}
__device__ __forceinline__ int inproj_src_col(int p) {
    const int t = p >> 8, q = p & 255;
    if (t == 0) return q;
    if (t <= 2) { const int ch = (t - 1) * 128 + 4 * (q >> 3) + (q & 3); return OFF_CONV + ((q >> 2) & 1) * 256 + ch; }
    if (t <= 6) { const int base = t <= 4 ? OFF_Q + 256 * (t - 3) : OFF_K + 256 * (t - 5); return base + 64 * ((q >> 5) & 3) + 32 * (q >> 7) + (q & 31); }
    if (t <= 8) return OFF_V + 256 * (t - 7) + q;
    return OFF_G + 256 * (t - 9) + q;
}
__device__ __forceinline__ void convert_layer_weights(const Frame& F, const Site& P, int l) {
    LAS float* scr = (LAS float*)(F.lds + RING_OFF + P.wave * 16384);
    const int gw = F.vcu * NWAVES + P.wave, NGW = F.G * NWAVES, lane = P.lane;
    bf16* WIN = (bf16*)(P.ws + WS_WIN); bf16* WBR = (bf16*)(P.ws + WS_WBR); bf16* WOUT = (bf16*)(P.ws + WS_WOUT);
    const float* w_in = P.in[2] + (size_t)l * D * IN_COLS;
    const float* w_brc = P.in[14] + (size_t)l * 256 * D; const float* w_bra = P.in[15] + (size_t)l * 512 * D; const float* w_out = P.in[16] + (size_t)l * D * D;
    constexpr int I_IN = 16 * (NIN / 32), I_BC = 4 * 32, I_BA = 8 * 32, I_OUT = 16 * 32;
    const bool moe = (l & 1) != 0; const int li = l >> 1;
    constexpr int I_D13 = 16 * (2 * DFF / 32), I_D2 = (DFF / 64) * 32, I_E13 = 16 * (2 * DFFE / 32), I_E2 = (DFFE / 64) * 32;
    const int n_ff = moe ? 8 * (I_E13 + I_E2) : (I_D13 + I_D2);
    const int NITEMS = I_IN + I_BC + I_BA + I_OUT + n_ff;
    for (int it = gw; it < NITEMS; it += NGW) {
        int r = it;
        if (r < I_IN) { const int kb = r / (NIN / 32), nb = r % (NIN / 32); const int p = 32 * nb + (lane & 31);
            transpose_item(w_in + inproj_src_col(p), IN_COLS, WIN, D, 32 * nb, 64 * kb, scr, lane); continue; } r -= I_IN;
        if (r < I_BC) { const int kb = r / 32, nb = r % 32;
            transpose_item(w_brc + 32 * nb + (lane & 31), D, WBR + 256, D, 32 * nb, 64 * kb, scr, lane); continue; } r -= I_BC;
        if (r < I_BA) { const int kb = r / 32, nb = r % 32;
            transpose_item(w_bra + 32 * nb + (lane & 31), D, WBR + 512, D, 32 * nb, 64 * kb, scr, lane); continue; } r -= I_BA;
        if (r < I_OUT) { const int kb = r / 32, nb = r % 32;
            transpose_item(w_out + 32 * nb + (lane & 31), D, WOUT, D, 32 * nb, 64 * kb, scr, lane); continue; } r -= I_OUT;
        if (!moe) {
            const float* w1 = P.in[18] + (size_t)li * D * DFF; const float* w3 = P.in[19] + (size_t)li * D * DFF; const float* w2 = P.in[20] + (size_t)li * DFF * D;
            bf16* W13 = (bf16*)(P.ws + WS_WFF); bf16* W2 = (bf16*)(P.ws + WS_WFF + WFF_W2_DENSE);
            if (r < I_D13) { const int kb = r / (2 * DFF / 32), nb = r % (2 * DFF / 32); const int p = 32 * nb + (lane & 31);
                const int ch = (p >> 8) * 128 + 4 * ((p & 255) >> 3) + (p & 3); const float* src = ((p >> 2) & 1) ? w3 : w1;
                transpose_item(src + ch, DFF, W13, D, 32 * nb, 64 * kb, scr, lane); continue; } r -= I_D13;
            { const int kb = r / 32, nb = r % 32; transpose_item(w2 + 32 * nb + (lane & 31), D, W2, DFF, 32 * nb, 64 * kb, scr, lane); }
        } else {
            const int e = r / (I_E13 + I_E2); r -= e * (I_E13 + I_E2);
            const float* w1 = P.in[22] + ((size_t)li * NEXP + e) * D * DFFE; const float* w3 = P.in[23] + ((size_t)li * NEXP + e) * D * DFFE; const float* w2 = P.in[24] + ((size_t)li * NEXP + e) * DFFE * D;
            bf16* W13 = (bf16*)(P.ws + WS_WFF + (size_t)e * WFF_W13_E); bf16* W2 = (bf16*)(P.ws + WS_WFF + WFF_W2_MOE + (size_t)e * WFF_W2_E);
            if (r < I_E13) { const int kb = r / (2 * DFFE / 32), nb = r % (2 * DFFE / 32); const int p = 32 * nb + (lane & 31);
                const int ch = (p >> 8) * 128 + 4 * ((p & 255) >> 3) + (p & 3); const float* src = ((p >> 2) & 1) ? w3 : w1;
                transpose_item(src + ch, DFFE, W13, D, 32 * nb, 64 * kb, scr, lane); continue; } r -= I_E13;
            { const int kb = r / 32, nb = r % 32; transpose_item(w2 + 32 * nb + (lane & 31), D, W2, DFFE, 32 * nb, 64 * kb, scr, lane); }
        }
    }
    {
        const float* pw = P.in[5] + (size_t)l * 4 * 64 * 64; const float* ps = P.in[6] + (size_t)l * 256; const float* wbp = P.in[13] + (size_t)l * 256 * D;
        const int gt = F.vcu * (NWAVES * 64) + P.tid, NT = F.G * NWAVES * 64;
        for (int item = gt; item < 1024 * 32; item += NT) {
            const int n = item & 1023, kb = item >> 10, k0 = 8 * kb, g = k0 >> 6, c0 = k0 & 63;
            float a[8];
#pragma unroll
            for (int j = 0; j < 8; ++j) a[j] = 0.f;
            for (int cp = 0; cp < 64; ++cp) { const float wv = ps[g * 64 + cp] * wbp[(size_t)(g * 64 + cp) * D + n];
#pragma unroll
                for (int j = 0; j < 8; ++j) a[j] += pw[(size_t)(g * 64 + c0 + j) * 64 + cp] * wv; }
            v4u o; o.x = pk2(a[0], a[1]); o.y = pk2(a[2], a[3]); o.z = pk2(a[4], a[5]); o.w = pk2(a[6], a[7]);
            *(GAS v4u*)(WBR + (size_t)n * D + k0) = o;
        }
    }
}

template <int MODE>
__device__ __forceinline__ void norm_phase(const Frame& F, const Site& P, const float* xsrc, const float* gvec, const float* w8, size_t w8stride, const float* b8, unsigned* gcnt) {
    const int lane = P.lane;
    bf16* HB = (bf16*)(P.ws + WS_HB);
    f32x4 gv[4];
#pragma unroll
    for (int j = 0; j < 4; ++j) gv[j] = *((const f32x4*)gvec + lane + 64 * j);
    LAS unsigned* lcnt = (LAS unsigned*)(F.lds + RING_OFF);
    LAS float* wfs = (LAS float*)(F.lds + RING_OFF + 1024);
    if constexpr (MODE != 1) {
        for (int idx = P.tid; idx < 8 * D; idx += NWAVES * 64) { const int k = idx >> 3, h = idx & 7; wfs[h * D + k] = w8[(size_t)k * w8stride + h] * gvec[k]; }
        __syncthreads();
    }
    float* NLF = (float*)(P.ws + WS_NLF);
    unsigned* list = (unsigned*)(P.ws + WS_LIST); float* moew = (float*)(P.ws + WS_MOEW);
    for (int rb = F.vcu; rb < M / 256; rb += F.G) {
        const int row0 = rb * 256 + P.wave * 32;
        if constexpr (MODE == 2) { if (P.tid < 32) lcnt[P.tid] = 0u; __syncthreads(); }
        int my_e0 = 0, my_e1 = 0; float my_w0 = 0.f, my_w1 = 0.f;
        f32x4 n0[4], n1[4], n2[4];
        { const GAS f32x4* xr0 = (const GAS f32x4*)(xsrc + (size_t)row0 * D) + lane;
#pragma unroll
          for (int j = 0; j < 4; ++j) { n0[j] = xr0[64 * j]; n1[j] = xr0[64 * j + 256]; n2[j] = xr0[64 * j + 512]; } }
#pragma unroll 1
        for (int i = 0; i < 32; ++i) {
            f32x4 v[4]; float s = 0.f;
            { constexpr int AH = (MODE == 1) ? 3 : 2; const GAS f32x4* xr = (const GAS f32x4*)(xsrc + (size_t)(row0 + (i + AH < 32 ? i + AH : 31)) * D) + lane;
#pragma unroll
              for (int j = 0; j < 4; ++j) { v[j] = n0[j]; n0[j] = n1[j]; if constexpr (MODE == 1) { n1[j] = n2[j]; n2[j] = xr[64 * j]; } else n1[j] = xr[64 * j]; } }
            {
            const int row = row0 + i;
#pragma unroll
            for (int j = 0; j < 4; ++j) s += (v[j].x * v[j].x + v[j].y * v[j].y) + (v[j].z * v[j].z + v[j].w * v[j].w);
            const float rstd = 1.0f / sqrtf(wave_sum(s, lane) * (1.f / D) + 1e-6f);
            GAS unsigned long long* o8 = (GAS unsigned long long*)(HB + (size_t)row * D) + lane;
#pragma unroll
            for (int j = 0; j < 4; ++j) o8[64 * j] = (unsigned long long)pk2(v[j].x * rstd * gv[j].x, v[j].y * rstd * gv[j].y) | ((unsigned long long)pk2(v[j].z * rstd * gv[j].z, v[j].w * rstd * gv[j].w) << 32);
            if constexpr (MODE != 1) {
                float f[8];
#pragma unroll
                for (int h = 0; h < 8; ++h) f[h] = 0.f;
#pragma unroll
                for (int h = 0; h < 8; ++h)
#pragma unroll
                    for (int j = 0; j < 4; ++j) { const f32x4 w4 = *((const LAS f32x4*)(wfs + h * D) + lane + 64 * j); f[h] += (v[j][0] * w4[0] + v[j][1] * w4[1]) + (v[j][2] * w4[2] + v[j][3] * w4[3]); }
#pragma unroll
                for (int h = 0; h < 8; ++h) f[h] = wave_sum(f[h], lane) * rstd;
                if constexpr (MODE == 0) {
                    float mine = f[0];
#pragma unroll
                    for (int h = 1; h < 8; ++h) mine = (lane == h) ? f[h] : mine;
                    if (lane < 8) { const float z = mine + b8[lane];
                        const float sp = fmaxf(-z, 0.f) + log1pf(__expf(-fabsf(z)));
                        NLF[(size_t)row * 8 + lane] = sp * LOG2E; }
                } else {
                    int e0 = 0; float v0 = f[0];
#pragma unroll
                    for (int h = 1; h < 8; ++h) if (f[h] > v0) { v0 = f[h]; e0 = h; }
                    int e1 = (e0 == 0) ? 1 : 0; float v1 = -INFINITY;
#pragma unroll
                    for (int h = 0; h < 8; ++h) if (h != e0 && f[h] > v1) { v1 = f[h]; e1 = h; }
                    const float w0 = 1.0f / (1.0f + __expf(v1 - v0));
                    if (lane == i) { my_e0 = e0; my_e1 = e1; my_w0 = w0; my_w1 = 1.0f - w0; }
                }
            }
            }
        }
        if constexpr (MODE == 2) {
            unsigned p0 = 0, p1 = 0;
            if (lane < 32) { p0 = __hip_atomic_fetch_add(&lcnt[my_e0], 1u, __ATOMIC_RELAXED, __HIP_MEMORY_SCOPE_WORKGROUP); p1 = __hip_atomic_fetch_add(&lcnt[8 + my_e1], 1u, __ATOMIC_RELAXED, __HIP_MEMORY_SCOPE_WORKGROUP);
                moew[row0 + lane] = my_w0; moew[M + row0 + lane] = my_w1; }
            __syncthreads();
            if (P.tid < 16) lcnt[16 + P.tid] = __hip_atomic_fetch_add(gcnt + P.tid, lcnt[P.tid], RLX_AGENT);
            __syncthreads();
            if (lane < 32) { list[(size_t)my_e0 * M + lcnt[16 + my_e0] + p0] = (unsigned)(row0 + lane); list[(size_t)(8 + my_e1) * M + lcnt[24 + my_e1] + p1] = (unsigned)(row0 + lane); }
            __syncthreads();
        }
    }
}

__device__ __forceinline__ void scan_phase(const Frame& F, const Site& P) {
    const float* NLF = (const float*)(P.ws + WS_NLF); float* NCL = (float*)(P.ws + WS_NCL);
    LAS float* wt = (LAS float*)(F.lds + RING_OFF);
    for (int seq = F.vcu; seq < BATCH * 8; seq += F.G) {
        const int b = seq >> 3, h = seq & 7, t0 = P.tid * 16;
        float v[16]; float s = 0.f;
#pragma unroll
        for (int i = 0; i < 16; ++i) { v[i] = NLF[((size_t)b * SEQ + t0 + i) * 8 + h]; s += v[i]; v[i] = s; }
        float incl = s;
#pragma unroll
        for (int o = 1; o < 64; o <<= 1) { const float up = __int_as_float(__builtin_amdgcn_ds_bpermute((P.lane - o) << 2, __float_as_int(incl))); if (P.lane >= o) incl += up; }
        if (P.lane == 63) wt[P.wave] = incl;
        __syncthreads();
        float base = incl - s;
        for (int w = 0; w < P.wave; ++w) base += wt[w];
        float* dst = NCL + (size_t)seq * SEQ + t0;
#pragma unroll
        for (int i = 0; i < 16; i += 4) *(f32x4*)(dst + i) = (f32x4){base + v[i], base + v[i + 1], base + v[i + 2], base + v[i + 3]};
        __syncthreads();
    }
}

__device__ __forceinline__ void poolconv_phase(const Frame& F, const Site& P, int l) {
    const int lane = P.lane;
    const bf16* PIN = (const bf16*)(P.ws + WS_P); const bf16* Z = (const bf16*)(P.ws + WS_Z); bf16* Y = (bf16*)(P.ws + WS_Y);
    const float* cw = P.in[7] + (size_t)l * CONVK * 256; const float* cb = P.in[8] + (size_t)l * 256; const float* lg = P.in[9] + (size_t)l * 256; const float* lb = P.in[10] + (size_t)l * 256;
    f32x4 w[CONVK];
#pragma unroll
    for (int j = 0; j < CONVK; ++j) w[j] = *(const f32x4*)(cw + j * 256 + 4 * lane);
    const f32x4 cbv = *(const f32x4*)(cb + 4 * lane), lgv = *(const f32x4*)(lg + 4 * lane), lbv = *(const f32x4*)(lb + 4 * lane);
    LAS unsigned char* zt = F.lds + RING_OFF;
    const int pw = 2 << (lane >> 4);
#if defined(DBG_COPY)
    for (int ch = F.vcu; ch < M / 128; ch += F.G) { const int r0 = ch * 128;
        for (int i = 0; i < 16; ++i) { const int row = r0 + 16 * P.wave + i;
            *(GAS v2u*)(Y + (size_t)row * 1024 + 4 * lane) = *(const GAS v2u*)(PIN + (size_t)row * 256 + 4 * lane);
            *(GAS v2u*)(Y + (size_t)row * 1024 + 256 + 4 * lane) = *(const GAS v2u*)(Z + (size_t)row * 256 + 4 * lane); } }
    return;
#endif
    for (int ch = F.vcu; ch < M / 128; ch += F.G) {
        const int r0 = ch * 128; const int tseq0 = r0 & (SEQ - 1);
        for (int p = P.tid; p < 158 * 32; p += NWAVES * 64) { const int lr = p >> 5, c16 = p & 31; const int tr = tseq0 - 30 + lr;
            const int lrc = tr >= 0 ? lr : 30;
            v4u val = *(const GAS v4u*)(Z + (size_t)(r0 - 30 + lrc) * 256 + c16 * 8);
            if (tr < 0) val = (v4u){0u, 0u, 0u, 0u};
            *(LAS v4u*)(zt + lr * 512 + c16 * 16) = val; }
        __syncthreads();
#if defined(DBG_POOLCOPY)
        for (int i = 0; i < 16; ++i) { const int row = r0 + 16 * P.wave + i; *(GAS v2u*)(Y + (size_t)row * 1024 + 4 * lane) = *(const GAS v2u*)(PIN + (size_t)row * 256 + 4 * lane); }
        if (false)
#endif
        { const int rw = r0 + 16 * P.wave, tw = tseq0 + 16 * P.wave;
          for (int i = 0; i < 16; ++i) { const int t = tw + i;
              f32x4 s = (f32x4){0.f, 0.f, 0.f, 0.f}, cur = s;
#pragma unroll
              for (int d = 0; d < 16; ++d) { const int dd = d <= t ? d : t;
                  const v2u q = *(const GAS v2u*)(PIN + (size_t)(rw + i - dd) * 256 + 4 * lane);
                  const f32x4 v = (f32x4){bflo(q.x), bfhi(q.x), bflo(q.y), bfhi(q.y)};
                  if (d == 0) cur = v;
                  const float mk = (d < pw && d <= t) ? 1.0f : 0.0f; s += v * mk; }
              const float inv = 1.0f / (float)((t + 1) < pw ? (t + 1) : pw);
              const f32x4 o = s * inv - cur;
              v2u ov; ov.x = pk2(o[0], o[1]); ov.y = pk2(o[2], o[3]);
              *(GAS v2u*)(Y + (size_t)(rw + i) * 1024 + 4 * lane) = ov; } }
#if defined(DBG_CONVCOPY)
        for (int i = 0; i < 16; ++i) { const int row = r0 + 16 * P.wave + i; *(GAS v2u*)(Y + (size_t)row * 1024 + 256 + 4 * lane) = *(const GAS v2u*)(Z + (size_t)row * 256 + 4 * lane); }
        if (false)
#endif
        for (int grp = 0; grp < 4; ++grp) {
            const int lr0 = 16 * P.wave + 4 * grp;
            f32x4 a[4];
#pragma unroll
            for (int o = 0; o < 4; ++o) a[o] = cbv;
#pragma unroll
            for (int jj = 0; jj < CONVK + 3; ++jj) {
                const v2u q = *(const LAS v2u*)(zt + (lr0 + jj) * 512 + lane * 8); const f32x4 z = (f32x4){bflo(q.x), bfhi(q.x), bflo(q.y), bfhi(q.y)};
#pragma unroll
                for (int o = 0; o < 4; ++o) { const int j = jj - o; if (j >= 0 && j < CONVK) a[o] += w[j] * z; }
            }
#pragma unroll
            for (int o = 0; o < 4; ++o) {
                const float mu = wave_sum((a[o][0] + a[o][1]) + (a[o][2] + a[o][3]), lane) * (1.f / 256.f);
                const f32x4 dv = a[o] - mu;
                const float var = wave_sum((dv[0] * dv[0] + dv[1] * dv[1]) + (dv[2] * dv[2] + dv[3] * dv[3]), lane) * (1.f / 256.f);
                const float rs = 1.0f / sqrtf(var + 1e-6f);
                f32x4 y = dv * rs * lgv + lbv;
#pragma unroll
                for (int c = 0; c < 4; ++c) y[c] = y[c] / (1.0f + __expf(-y[c]));
                v2u ov; ov.x = pk2(y[0], y[1]); ov.y = pk2(y[2], y[3]);
                *(GAS v2u*)(Y + (size_t)(r0 + lr0 + o) * 1024 + 256 + 4 * lane) = ov;
            }
        }
        __syncthreads();
    }
}

#ifndef DBG_MAXPHASE
#define DBG_MAXPHASE 1000
#endif
#ifndef ONLY_SITE
#define ONLY_SITE -1
#endif
#ifndef DBL_MASK
#define DBL_MASK 0
#endif
#define DBL(k) for (int rep_ = 0; rep_ < (((DBL_MASK >> (k)) & 1) ? 2 : 1); ++rep_)
#ifndef SITE_OFF_MASK
#define SITE_OFF_MASK 0
#endif
#define SITE(k) ((ONLY_SITE < 0 || ONLY_SITE == (k)) && !((SITE_OFF_MASK >> (k)) & 1))
constexpr int NPH = 10;
struct Args { const float* in[25]; float* out; unsigned char* ws; int ph_lo, ph_hi; };

__global__ void __launch_bounds__(NWAVES * 64, 2) trunk_fwd(Args args) {
    extern __shared__ __attribute__((aligned(16))) unsigned char lds[];
    Frame F;
    F.lds = (LAS unsigned char*)lds;
    F.MISC = (volatile LAS unsigned*)(F.lds + MISC_OFF);
    F.G = gridDim.x; { const int bx = blockIdx.x; F.vcu = (F.G % 8 == 0) ? (bx % 8) * (F.G / 8) + bx / 8 : bx; }
    for (int u = threadIdx.x; u < (LDS_BYTES - LDSCTL_OFF) / 4; u += NWAVES * 64) ((LAS unsigned*)(F.lds + LDSCTL_OFF))[u] = 0u;
    __syncthreads();
    XcdBarrier bar; bar.bar = (unsigned*)((gu32*)(args.ws + WS_CTL) + CW_BAR); bar.x = 0; bar.st = nullptr;
    if (!MK_PER_PHASE) bar = xcd_barrier_post((unsigned*)((gu32*)(args.ws + WS_CTL) + CW_BAR), F.MISC + 8);
    const int lo = args.ph_lo, hi = args.ph_hi;
#define IN(k) (lo <= (k) && (k) < hi)
#define SEAM(k) do { if (IN(k) && IN((k) + 1)) { if (MK_PER_PHASE) { if (threadIdx.x == 0) __hip_atomic_store((gu32*)(args.ws + WS_CTL) + CW_TMO, 0xBADBA0u, RLX_AGENT); } else xcd_barrier(bar); } } while (0)

#define WSB(off) ((bf16*)(P.ws + (off)))
#define INP(k) (P.in[k])
#define XIN() ((l == 0) ? INP(0) : (const float*)P.out)
    const int cgemm = (int)blockIdx.x;

    for (int l = 0; l < DEPTH; ++l) {
        const int pb = l * NPH;
        const bool moe = (l & 1) != 0; const int li = l >> 1;

        if (IN(pb + 0)) { const Site P = make_site();
            DBL(0) if constexpr (SITE(0)) convert_layer_weights(F, P, l);
#if defined(DBG_FILLG)
            { v4u fv = (v4u){0x3f003f00u, 0x3f003f00u, 0x3f003f00u, 0x3f003f00u}; GAS v4u* gp = (GAS v4u*)WSB(WS_G);
              for (size_t i = (size_t)blockIdx.x * 512 + P.tid; i < (size_t)M * 3072 / 8; i += (size_t)F.G * 512) gp[i] = fv; }
#endif
            __syncthreads();
            DBL(1) if constexpr (SITE(1)) norm_phase<0>(F, P, XIN(), INP(1) + (size_t)l * D, INP(2) + (size_t)l * D * IN_COLS + OFF_F, IN_COLS, INP(4) + (size_t)l * 8, nullptr);
        }
        SEAM(pb + 0);

        if (IN(pb + 1)) { const Site P = make_site();
#if !defined(DBG_NOSCAN)
            if constexpr (SITE(2)) scan_phase(F, P);
#endif
            pg8::Gemm g{WSB(WS_HB), WSB(WS_WIN), D, 0, nullptr};
            pg8::SchedPlain S{M / 256, NIN / 256, F.G, cgemm, D / 64};
            pg8::EpiInProj E{WSB(WS_P), WSB(WS_Z), WSB(WS_Y) + 512, WSB(WS_K), WSB(WS_V), WSB(WS_G), INP(11) + (size_t)l * 64, INP(12) + (size_t)l * 64, INP(3) + (size_t)l * 3 * D};
#if defined(DBG_NOALIGN)
            if constexpr (SITE(3)) pg8::gemm_phase<pg8::EpiInProj, pg8::SchedPlain, false, false>(F.lds + RING_OFF, g, S, E);
#else
            DBL(3) if constexpr (SITE(3)) pg8::gemm_phase<pg8::EpiInProj, pg8::SchedPlain, true, false>(F.lds + RING_OFF, g, S, E);
#endif
        }
        SEAM(pb + 1);

        if (IN(pb + 2)) { const Site P = make_site();
            DBL(4) if constexpr (SITE(4)) poolconv_phase(F, P, l);
#if defined(DBG_FENCE)
            asm volatile("s_waitcnt vmcnt(0)" ::: "memory"); __threadfence_system(); asm volatile("s_waitcnt vmcnt(0)" ::: "memory");
#endif
            const attn_body::AttnTensors AT{(const attn_body::bf16*)(WSB(WS_Y) + 512), (const attn_body::bf16*)WSB(WS_K), (const attn_body::bf16*)WSB(WS_V), (attn_body::bf16*)(WSB(WS_Y) + 512), (const float*)(P.ws + WS_NCL)};
            float gq = fabsf(INP(11)[(size_t)l * 64 + P.lane]), gk = fabsf(INP(12)[(size_t)l * 64 + P.lane]);
#pragma unroll
            for (int o = 1; o < 64; o <<= 1) { gq = fmaxf(gq, __int_as_float(__builtin_amdgcn_ds_bpermute((P.lane ^ o) << 2, __float_as_int(gq)))); gk = fmaxf(gk, __int_as_float(__builtin_amdgcn_ds_bpermute((P.lane ^ o) << 2, __float_as_int(gk)))); }
            const float th = 2.0f * (64.0f * gq * gk * pg8::ATT_C2 * 1.02f) + 38.0f;
            const attn_body::AttnQueue Qd{(unsigned*)(P.ctl + CW_ATTQ + l * 8 * 64), __int_as_float(__builtin_amdgcn_readfirstlane(__float_as_int(th))), (int)(xb_xcc_id() & 7u), F.MISC + 16};
            if constexpr (SITE(5)) attn_body::attn_phase_dyn((char*)lds + RING_OFF, AT, Qd);
        }
        SEAM(pb + 2);

        if (IN(pb + 3)) { const Site P = make_site();
            pg8::Gemm g{WSB(WS_Y), WSB(WS_WBR), D, 0, nullptr};
#if defined(DBG_MERGE1)
            pg8::SchedPlain S{M / 256, D / 256, F.G, cgemm, D / 64};
#else
            pg8::SchedMerge S{M / 256, D / 256, F.G, cgemm};
#endif
            pg8::EpiMerge E{WSB(WS_G), WSB(WS_HB)};
#if defined(DBG_MERGE1)
            if constexpr (SITE(6)) pg8::gemm_phase<pg8::EpiMerge, pg8::SchedPlain, true, false>(F.lds + RING_OFF, g, S, E);
#else
            if constexpr (SITE(6)) pg8::gemm_phase<pg8::EpiMerge, pg8::SchedMerge, true, false>(F.lds + RING_OFF, g, S, E);
#endif
        }
        SEAM(pb + 3);

        if (IN(pb + 4)) { const Site P = make_site();
            pg8::Gemm g{WSB(WS_HB), WSB(WS_WOUT), D, 0, nullptr};
            pg8::SchedPlain S{M / 256, D / 256, F.G, cgemm, D / 64};
            pg8::EpiResid E{XIN(), P.out};
#if defined(DBG_OUTY)
            { const bf16* Yb = (DBG_OUTY == 4) ? WSB(WS_HB) : (DBG_OUTY == 5 || DBG_OUTY >= 8 ? WSB(WS_G) : WSB(WS_Y)); const size_t ypitch = (DBG_OUTY == 5 || DBG_OUTY >= 8) ? 3072 : 1024; for (int rb = F.vcu; rb < M / 256; rb += F.G) for (int i = 0; i < 32; ++i) { const int row = rb * 256 + P.wave * 32 + i;
                for (int c = P.lane; c < 1024; c += 64) { const int cs = (DBG_OUTY == 1) ? 256 + (c & 255) : (DBG_OUTY == 2 ? (c & 255) : c); float vv_ = bflo((unsigned)Yb[(size_t)row * ypitch + cs]); if (DBG_OUTY == 7) vv_ = 0.f; if (DBG_OUTY == 5) vv_ = (vv_ > 1.0f || vv_ < 0.0f) ? 1000.0f : 0.0f; if (DBG_OUTY == 8) vv_ = (vv_ > 1.0f || vv_ < 0.0f) ? 100.0f * (float)(1 + (row >> 8)) : 0.0f; if (DBG_OUTY == 9) vv_ = (vv_ > 1.0f || vv_ < 0.0f) ? 100.0f * (float)(1 + (c >> 3)) : 0.0f; P.out[(size_t)row * 1024 + c] = vv_; } } }
#else
            if constexpr (SITE(7)) pg8::gemm_phase<pg8::EpiResid, pg8::SchedPlain, true, false>(F.lds + RING_OFF, g, S, E);
#endif
        }
        SEAM(pb + 4);

        if (IN(pb + 5)) { const Site P = make_site();
            if constexpr (SITE(8)) { if (!moe) DBL(8) norm_phase<1>(F, P, P.out, INP(17) + (size_t)l * D, nullptr, 0, nullptr, nullptr);
            else norm_phase<2>(F, P, P.out, INP(17) + (size_t)l * D, INP(21) + (size_t)li * D * NEXP, NEXP, nullptr, (unsigned*)(P.ctl + CW_MOECNT + 64 * li)); }
        }
        SEAM(pb + 5);

        if (!moe) {
            if (IN(pb + 6)) { const Site P = make_site();
                    pg8::Gemm g{WSB(WS_HB), WSB(WS_WFF), D, 0, nullptr};
                pg8::SchedPlain S{M / 256, 2 * DFF / 256, F.G, cgemm, D / 64};
                pg8::EpiSwiGLU E{WSB(WS_HID), DFF};
                if constexpr (SITE(9)) pg8::gemm_phase<pg8::EpiSwiGLU, pg8::SchedPlain, true, false>(F.lds + RING_OFF, g, S, E);
            }
            SEAM(pb + 6);
            if (IN(pb + 7)) { const Site P = make_site();
                    pg8::Gemm g{WSB(WS_HID), WSB(WS_WFF + WFF_W2_DENSE), DFF, 0, nullptr};
                pg8::SchedPlain S{M / 256, D / 256, F.G, cgemm, DFF / 64};
                pg8::EpiResid E{P.out, P.out};
                if constexpr (SITE(10)) pg8::gemm_phase<pg8::EpiResid, pg8::SchedPlain, true, false>(F.lds + RING_OFF, g, S, E);
            }
            if (l + 1 < DEPTH) SEAM(pb + 7);
        } else {
            for (int slot = 0; slot < 2; ++slot) {
                const int pu = pb + 6 + 2 * slot, pd = pu + 1;
                int ntiles = 0;
                if (IN(pu) || IN(pd)) { const Site P = make_site();
                    LAS unsigned* tab = (LAS unsigned*)(F.lds + MOETAB_OFF);
                    __syncthreads();
                    int cnt[8];
#pragma unroll
                    for (int e = 0; e < 8; ++e) cnt[e] = __builtin_amdgcn_readfirstlane((int)__hip_atomic_load(P.ctl + CW_MOECNT + 64 * li + slot * 8 + e, RLX_AGENT));
                    int rt = 0;
#pragma unroll
                    for (int e = 0; e < 8; ++e) { const int nte = (cnt[e] + 255) >> 8;
                        for (int j = P.tid; j < nte; j += NWAVES * 64) { const int nv = (cnt[e] - 256 * j) < 256 ? (cnt[e] - 256 * j) : 256; if (rt + j < 264) tab[rt + j] = (unsigned)e | ((unsigned)j << 8) | ((unsigned)(nv - 1) << 20); }
                        rt += nte; }
                    ntiles = rt < 264 ? rt : 264;
                    __syncthreads();
                }
                if (IN(pu)) { const Site P = make_site();
                            pg8::Gemm g{WSB(WS_HB), WSB(WS_WFF), D, WFF_W13_E, (const unsigned*)(P.ws + WS_LIST)};
                    pg8::SchedMoe S{ntiles, 2 * DFFE / 256, F.G, cgemm, D / 64, slot, (const LAS unsigned*)(F.lds + MOETAB_OFF)};
                    pg8::EpiSwiGLU E{WSB(WS_HID), DFFE};
                    DBL(11) if constexpr (SITE(11)) pg8::gemm_phase<pg8::EpiSwiGLU, pg8::SchedMoe, true, true>(F.lds + RING_OFF, g, S, E);
                }
                SEAM(pu);
                if (IN(pd)) { const Site P = make_site();
                            pg8::Gemm g{WSB(WS_HID), WSB(WS_WFF + WFF_W2_MOE), DFFE, WFF_W2_E, nullptr};
                    pg8::SchedMoe S{ntiles, D / 256, F.G, cgemm, DFFE / 64, slot, (const LAS unsigned*)(F.lds + MOETAB_OFF)};
                    pg8::EpiMoeDown E{P.out, (const unsigned*)(P.ws + WS_LIST), (const float*)(P.ws + WS_MOEW) + (size_t)slot * M};
                    if constexpr (SITE(12)) pg8::gemm_phase<pg8::EpiMoeDown, pg8::SchedMoe, true, false>(F.lds + RING_OFF, g, S, E);
                }
                if (slot == 0 || l + 1 < DEPTH) SEAM(pd);
            }
        }
    }
#undef IN
#undef SEAM
#undef WSB
#undef INP
#undef XIN
}

extern "C" void kernel_launch(void* const* d_in, const int* in_sizes, int n_in, void* d_out, int out_size, void* d_ws, size_t ws_size, hipStream_t stream) {
    static int grid = 0;
    if (grid == 0) {
        if (n_in != 25 || in_sizes[0] != M * D || out_size != M * D || ws_size < WS_END) { fprintf(stderr, "kernel_launch: built for 25 inputs, x and out of %d floats, >= %zu bytes of workspace; got n_in %d, in0 %d, out %d, ws %zu; nothing launched\n", M * D, (size_t)WS_END, n_in, n_in > 0 ? in_sizes[0] : -1, out_size, ws_size); grid = -1; return; }
        int dev = 0, cus = 0, per_cu = 0;
        if (hipGetDevice(&dev) != hipSuccess || hipDeviceGetAttribute(&cus, hipDeviceAttributeMultiprocessorCount, dev) != hipSuccess) { fprintf(stderr, "kernel_launch: hipGetDevice / hipDeviceGetAttribute failed; nothing launched\n"); grid = -1; return; }
        if (hipFuncSetAttribute((const void*)trunk_fwd, hipFuncAttributeMaxDynamicSharedMemorySize, LDS_BYTES) != hipSuccess) { fprintf(stderr, "kernel_launch: hipFuncSetAttribute failed\n"); grid = -1; return; }
        if (hipOccupancyMaxActiveBlocksPerMultiprocessor(&per_cu, (const void*)trunk_fwd, NWAVES * 64, LDS_BYTES) != hipSuccess || per_cu < 1)
            fprintf(stderr, "kernel_launch: note: the occupancy query reports %d workgroups per CU\n", per_cu);
        (void)hipGetLastError();
        grid = cus;
    }
    if (grid < 0) return;
    if (hipMemsetAsync((char*)d_ws + WS_CTL, 0, CTL_ZERO_BYTES, stream) != hipSuccess) { fprintf(stderr, "kernel_launch: hipMemsetAsync failed\n"); return; }
    Args a{};
    for (int i = 0; i < 25; ++i) a.in[i] = (const float*)d_in[i];
    a.out = (float*)d_out; a.ws = (unsigned char*)d_ws;
#if MK_PER_PHASE
    for (int l = 0; l < DEPTH; ++l) { const int np = (l & 1) ? 10 : 8;
        for (int p = 0; p < np; ++p) { a.ph_lo = l * NPH + p; a.ph_hi = a.ph_lo + 1; if (a.ph_lo > DBG_MAXPHASE) continue; hipLaunchKernelGGL(trunk_fwd, dim3(grid), dim3(NWAVES * 64), LDS_BYTES, stream, a); } }
#else
    a.ph_lo = 0; a.ph_hi = DEPTH * NPH;
    hipLaunchKernelGGL(trunk_fwd, dim3(grid), dim3(NWAVES * 64), LDS_BYTES, stream, a);
#endif
    const hipError_t le = hipPeekAtLastError();
    if (le != hipSuccess) fprintf(stderr, "kernel_launch: launch failed: %s (grid %d x %d threads, %d B LDS)\n", hipGetErrorName(le), grid, NWAVES * 64, LDS_BYTES);
}
```

```cpp
#include <hip/hip_runtime.h>
#include <hip/hip_bf16.h>
#include <cstdio>
#include <cstdint>
#include <cmath>

namespace pg8 {
#define PG8_LAS __attribute__((address_space(3)))
typedef unsigned short bf16_t;
typedef short bf16x8 __attribute__((ext_vector_type(8)));
typedef float f32x4 __attribute__((ext_vector_type(4)));
typedef float f32x2 __attribute__((ext_vector_type(2)));
typedef unsigned u32x4 __attribute__((ext_vector_type(4)));
typedef unsigned u32x2 __attribute__((ext_vector_type(2)));
typedef int i32x4 __attribute__((ext_vector_type(4)));
typedef int i32x8 __attribute__((ext_vector_type(8)));
constexpr int BM = 256, BK = 64, HALF = 128, HTB = HALF * BK * 2  , STAGE_BYTES = 8 * HTB, NXCD = 8, WGM = 8;

__host__ __device__ __forceinline__ int lds_byte(int r, int c) { const int st = (r >> 4) * 2 + (c >> 5), rr = r & 15, cc = c & 31, ob = rr * 64 + cc * 2; return st * 1024 + (ob ^ (((ob >> 9) & 1) << 5)); }
__host__ __device__ __forceinline__ void stage_rc(int b, int& R, int& C) { const int st = b / 1024, sb = b % 1024, swz = sb ^ (((sb >> 9) & 1) << 5); R = (st >> 1) * 16 + swz / 64; C = (st & 1) * 32 + (swz % 64) / 2; }
__host__ __device__ __forceinline__ int perm32(int rho) { const int n = rho >> 4, i = rho & 15; return 8 * (i >> 2) + 4 * n + (i & 3); }

struct Unit { int pm, pn, e, koff, nt, lo, nv; };
struct Gemm { const bf16_t* A; const bf16_t* Bt; int K; size_t bstride; const unsigned* list; int stagger; };

__device__ __forceinline__ void tile_of(int L, int nM, int nN, int& pm, int& pn) {
    const int nwg = nM * nN; int wgid = L;
    { const int q = nwg / NXCD, r = nwg % NXCD, xcd = wgid % NXCD, off = wgid / NXCD; wgid = (xcd < r ? xcd * (q + 1) : r * (q + 1) + (xcd - r) * q) + off; }
    const int nig = WGM * nN, gid = wgid / nig, fm = gid * WGM, gsz = (nM - fm) < WGM ? (nM - fm) : WGM;
    pm = fm + ((wgid % nig) % gsz); pn = (wgid % nig) / gsz;
}
struct SchedPlain {
    int nM, nN, G, c, nt;
    __device__ __forceinline__ bool next(int i, Unit& u) const {
        const long L = (long)i * G + c; if (L >= (long)nM * nN) return false;
        tile_of((int)L, nM, nN, u.pm, u.pn); u.e = 0; u.koff = 0; u.nt = nt; u.lo = 0; u.nv = 256; return true;
    }
};
struct SchedPanel {
    int nM, nN, G, c, nt;
    __device__ __forceinline__ bool next(int i, Unit& u) const {
        const int j = i / nN; u.pn = i - j * nN; u.pm = c + G * j; if (u.pm >= nM) return false;
        u.e = 0; u.koff = 0; u.nt = nt; u.lo = 0; u.nv = 256; return true;
    }
};
struct SchedMerge {
    int nM, nN, G, c;
    __device__ __forceinline__ bool next(int i, Unit& u) const {
        const int tile = i / 3, seg = i - 3 * tile; const long L = (long)tile * G + c; if (L >= (long)nM * nN) return false;
        tile_of((int)L, nM, nN, u.pm, u.pn); u.e = seg; u.koff = seg == 0 ? 0 : (seg == 1 ? 256 : 512); u.nt = seg == 2 ? 8 : 4; u.lo = 0; u.nv = 256; return true;
    }
};
struct SchedMoe {
    int nM, nN, G, c, nt, slot; const PG8_LAS unsigned* tab; int skipc, skipr;
    __device__ __forceinline__ bool next(int i, Unit& u) const {
        const int nwg = nM * nN;
        const int r = (c < skipc) ? i + skipr : i;
        const long L0 = (r < skipr) ? (long)r * (G - skipc) + (c - skipc) : (long)skipr * (G - skipc) + (long)(r - skipr) * G + c;
        if (L0 >= nwg) return false;
        const int L = (int)L0;
        tile_of(L, nM, nN, u.pm, u.pn);
        const unsigned w = (unsigned)__builtin_amdgcn_readfirstlane((int)tab[u.pm]);
        u.e = (int)(w & 0xffu); const int j = (int)((w >> 8) & 0xfffu); u.nv = (int)(w >> 20) + 1;
        u.lo = (slot * 8 + u.e) * 65536 + 256 * j; u.nt = nt; u.koff = 0; return true;
    }
};

typedef __bf16 bf16x2_cv __attribute__((ext_vector_type(2)));
__device__ __forceinline__ unsigned cvt_pk_bf16(float lo, float hi) { const f32x2 v = {lo, hi}; const bf16x2_cv b = __builtin_convertvector(v, bf16x2_cv); return __builtin_bit_cast(unsigned, b); }
__device__ __forceinline__ float bf_lo(unsigned w) { return __uint_as_float(w << 16); }
__device__ __forceinline__ float bf_hi(unsigned w) { return __uint_as_float(w & 0xffff0000u); }
__device__ __forceinline__ float sigmoidf_(float x) { return __builtin_amdgcn_rcpf(1.0f + __builtin_amdgcn_exp2f(-1.4426950408889634f * x)); }
__device__ __forceinline__ f32x4 rsig4_(const f32x4 x) { const f32x4 t = x * -1.4426950408889634f; f32x4 e; e[0] = __builtin_amdgcn_exp2f(t[0]); e[1] = __builtin_amdgcn_exp2f(t[1]); e[2] = __builtin_amdgcn_exp2f(t[2]); e[3] = __builtin_amdgcn_exp2f(t[3]);
    const f32x4 d = e + 1.0f; return (f32x4){__builtin_amdgcn_rcpf(d[0]), __builtin_amdgcn_rcpf(d[1]), __builtin_amdgcn_rcpf(d[2]), __builtin_amdgcn_rcpf(d[3])}; }

template <class Epi, class Sched, bool ALIGN_EPI, bool GATHER, bool F8 = false>
__device__ __forceinline__ void gemm_phase(PG8_LAS unsigned char* lds, const Gemm g_, const Sched& S, const Epi& E) {
    Gemm g = g_;
    {
        unsigned long long a_ = (unsigned long long)g_.A, b_ = (unsigned long long)g_.Bt, l_ = (unsigned long long)g_.list; asm volatile("" : "+s"(a_), "+s"(b_), "+s"(l_));
        g.A = (const bf16_t*)(const __attribute__((address_space(1))) bf16_t*)a_; g.Bt = (const bf16_t*)(const __attribute__((address_space(1))) bf16_t*)b_; g.list = (const unsigned*)(const __attribute__((address_space(1))) unsigned*)l_; }
    int tid_o = threadIdx.x; asm volatile("" : "+v"(tid_o));
    const int tid = tid_o, wid = __builtin_amdgcn_readfirstlane(tid >> 6), lane = tid & 63, wr = wid >> 2, wc = wid & 3, fr = lane & 15, fq = lane >> 4;
    const int K = g.K;
    unsigned voffA[2], voffB[2];
#pragma unroll
    for (int i = 0; i < 2; ++i) { int R, C; stage_rc(tid * 16 + i * 8192, R, C); const int Rb = Epi::PERM ? ((R & ~31) + perm32(R & 31)) : R;
        voffA[i] = (unsigned)(R * K + C) * 2u; voffB[i] = (unsigned)(Rb * K + C) * 2u; }
    const size_t kstep = (size_t)(BK * 2);
    const size_t hstep = (size_t)HALF * K * 2;
    const size_t tstep = 2 * hstep;
    const unsigned ldsw = (unsigned)wid * 1024u;
    const int aoff = lds_byte(wr * 64 + fr, fq * 8), boff = lds_byte(wc * 32 + fr, fq * 8);
#define PG8_SA(b, h) (((b) * 2 + (h)) * HTB)
#define PG8_SB(b, h) ((4 + (b) * 2 + (h)) * HTB)
#define PG8_GLDS(src, bufoff, i_) __builtin_amdgcn_global_load_lds((const unsigned*)(src), (PG8_LAS unsigned*)(lds + (bufoff) + ldsw + (i_) * 8192), 16, 0, 0)
#define PG8_STAGE_B(bufoff, gbase) do { _Pragma("unroll") for (int _i = 0; _i < 2; ++_i) PG8_GLDS((const char*)(gbase) + voffB[_i], bufoff, _i); } while (0)
#define PG8_STAGE_A(bufoff, ga, h, o0, o1) do { if constexpr (GATHER) { PG8_GLDS((const char*)(ga) + (o0), bufoff, 0); PG8_GLDS((const char*)(ga) + (o1), bufoff, 1); } \
        else { _Pragma("unroll") for (int _i = 0; _i < 2; ++_i) PG8_GLDS((const char*)(ga) + (h) * hstep + voffA[_i], bufoff, _i); } } while (0)
#define PG8_LDA(dst, b, h) do { _Pragma("unroll") for (int m = 0; m < 4; ++m) { if constexpr (F8) { dst##8[m].lo = *(const PG8_LAS i32x4*)(lds + PG8_SA(b, h) + aoff + m * 2048); dst##8[m].hi = *(const PG8_LAS i32x4*)(lds + PG8_SA(b, h) + aoff + m * 2048 + 1024); } \
        else { _Pragma("unroll") for (int k = 0; k < 2; ++k) dst[m][k] = *(const PG8_LAS bf16x8*)(lds + PG8_SA(b, h) + aoff + m * 2048 + k * 1024); } } } while (0)
#define PG8_LDB(dst, b, h) do { _Pragma("unroll") for (int n = 0; n < 2; ++n) { if constexpr (F8) { dst##8[n].lo = *(const PG8_LAS i32x4*)(lds + PG8_SB(b, h) + boff + n * 2048); dst##8[n].hi = *(const PG8_LAS i32x4*)(lds + PG8_SB(b, h) + boff + n * 2048 + 1024); } \
        else { _Pragma("unroll") for (int k = 0; k < 2; ++k) dst[n][k] = *(const PG8_LAS bf16x8*)(lds + PG8_SB(b, h) + boff + n * 2048 + k * 1024); } } } while (0)
#define PG8_CAT8(x0, x1) __builtin_shufflevector(__builtin_bit_cast(i32x4, x0), __builtin_bit_cast(i32x4, x1), 0, 1, 2, 3, 4, 5, 6, 7)
#define PG8_MMA(ai, bj, At, Bt) do { __builtin_amdgcn_s_setprio(1); _Pragma("unroll") for (int m = 0; m < 4; ++m) _Pragma("unroll") for (int n = 0; n < 2; ++n) { \
        if constexpr (F8) asm volatile("v_mfma_scale_f32_16x16x128_f8f6f4 %0, %1, %2, %0, %3, %4 op_sel_hi:[0,0,0]" : "+v"(acc[ai][bj][m][n]) : "v"(Bt##8[n]), "v"(At##8[m]), "v"(sc_w), "v"(sc_a));   \
        else { _Pragma("unroll") for (int k = 0; k < 2; ++k) acc[ai][bj][m][n] = __builtin_amdgcn_mfma_f32_16x16x32_bf16(Bt[n][k], At[m][k], acc[ai][bj][m][n], 0, 0, 0); } } __builtin_amdgcn_s_setprio(0); } while (0)
#define PG8_MMA0(ai, bj, At, Bt) do { __builtin_amdgcn_s_setprio(1); _Pragma("unroll") for (int m = 0; m < 4; ++m) _Pragma("unroll") for (int n = 0; n < 2; ++n) \
        asm volatile("v_mfma_scale_f32_16x16x128_f8f6f4 %0, %1, %2, 0, %3, %4 op_sel_hi:[0,0,0]" : "=v"(acc[ai][bj][m][n]) : "v"(Bt##8[n]), "v"(At##8[m]), "v"(sc_w), "v"(sc_a));   \
        __builtin_amdgcn_s_setprio(0); } while (0)
#define PG8_WAIT_V(n) asm volatile("s_waitcnt vmcnt(" #n ")" ::: "memory")
#define PG8_WAIT_L(n) asm volatile("s_waitcnt lgkmcnt(" #n ")" ::: "memory")
#define PG8_WAIT_V8F(f) do { if constexpr (Epi::NST == 32) asm volatile("s_cmp_eq_u32 %0, 0\n\ts_cbranch_scc1 .LWV%=A\n\ts_waitcnt vmcnt(40)\n\ts_branch .LWV%=B\n.LWV%=A:\n\ts_waitcnt vmcnt(8)\n.LWV%=B:" :: "s"(f) : "memory", "scc"); \
        else if constexpr (Epi::NST == 16) asm volatile("s_cmp_eq_u32 %0, 0\n\ts_cbranch_scc1 .LWV%=A\n\ts_waitcnt vmcnt(24)\n\ts_branch .LWV%=B\n.LWV%=A:\n\ts_waitcnt vmcnt(8)\n.LWV%=B:" :: "s"(f) : "memory", "scc"); \
        else asm volatile("s_waitcnt vmcnt(8)" ::: "memory"); } while (0)
#define PG8_BAR __builtin_amdgcn_s_barrier()
#define PG8_SCHED __builtin_amdgcn_sched_barrier(0)
    Unit cur, nxt; int ui = 0;
    if (!S.next(0, cur)) return;
    if (g.stagger > 0) { const unsigned long long t0_ = __builtin_amdgcn_s_memrealtime(); while (__builtin_amdgcn_s_memrealtime() - t0_ < (unsigned long long)g.stagger) __builtin_amdgcn_s_sleep(8); }
    f32x4 acc[2][2][4][2];
    if constexpr (!F8) {
#pragma unroll
    for (int a = 0; a < 2; ++a)
#pragma unroll
        for (int b = 0; b < 2; ++b)
#pragma unroll
            for (int m = 0; m < 4; ++m)
#pragma unroll
                for (int n = 0; n < 2; ++n) acc[a][b][m][n] = (f32x4){0.f, 0.f, 0.f, 0.f};
    }
    bf16x8 At[4][2], B0[2][2], B1[2][2];
    i32x8 At8[4], B08[2], B18[2];
    int sc_w = 122, sc_a = 127; asm volatile("" : "+v"(sc_w), "+v"(sc_a));
    unsigned gc00 = 0, gc01 = 0, gc10 = 0, gc11 = 0, gn00 = 0, gn01 = 0, gn10 = 0, gn11 = 0;
#define PG8_TOK(u, t00, t01, t10, t11) do { const unsigned* lp_ = g.list + (u).lo; const int nv_ = (u).nv; \
        int tid_ = threadIdx.x; asm volatile("" : "+v"(tid_)); int R0_, C0_, R1_, C1_; stage_rc(tid_ * 16, R0_, C0_); stage_rc(tid_ * 16 + 8192, R1_, C1_);     \
        t00 = R0_ < nv_ ? lp_[R0_] : 0u; t01 = R1_ < nv_ ? lp_[R1_] : 0u; t10 = (128 + R0_) < nv_ ? lp_[128 + R0_] : 0u; t11 = (128 + R1_) < nv_ ? lp_[128 + R1_] : 0u; } while (0)
#define PG8_OFFS(t00, t01, t10, t11, o00, o01, o10, o11) do { \
        int tid_ = threadIdx.x; asm volatile("" : "+v"(tid_)); int R0_, C0_, R1_, C1_; stage_rc(tid_ * 16, R0_, C0_); stage_rc(tid_ * 16 + 8192, R1_, C1_); \
        o00 = (t00) * (unsigned)(K * 2) + (unsigned)C0_ * 2u; o01 = (t01) * (unsigned)(K * 2) + (unsigned)C1_ * 2u; o10 = (t10) * (unsigned)(K * 2) + (unsigned)C0_ * 2u; o11 = (t11) * (unsigned)(K * 2) + (unsigned)C1_ * 2u; } while (0)
#define PG8_GATH(u, o00, o01, o10, o11) do { unsigned q00_, q01_, q10_, q11_; PG8_TOK(u, q00_, q01_, q10_, q11_); PG8_OFFS(q00_, q01_, q10_, q11_, o00, o01, o10, o11); } while (0)
    unsigned tk00 = 0, tk01 = 0, tk10 = 0, tk11 = 0;
    const char* cA = GATHER ? (const char*)g.A + (size_t)cur.koff * 2 : (const char*)g.A + (size_t)cur.pm * tstep + (size_t)cur.koff * 2;
    const char* cB = (const char*)g.Bt + (size_t)cur.e * g.bstride + (size_t)cur.pn * tstep + (size_t)cur.koff * 2;
    if constexpr (GATHER) { PG8_GATH(cur, gc00, gc01, gc10, gc11); Unit n1_; if (S.next(1, n1_)) PG8_TOK(n1_, tk00, tk01, tk10, tk11); }
    PG8_STAGE_B(PG8_SB(0, 0), cB); PG8_STAGE_B(PG8_SB(0, 1), cB + hstep); PG8_STAGE_A(PG8_SA(0, 0), cA, 0, gc00, gc01); PG8_STAGE_A(PG8_SA(0, 1), cA, 1, gc10, gc11);
    if (wr == 1) PG8_BAR;
    PG8_WAIT_V(2); PG8_BAR;
    PG8_STAGE_B(PG8_SB(1, 0), cB + kstep); PG8_STAGE_A(PG8_SA(1, 0), cA + kstep, 0, gc00, gc01); PG8_STAGE_B(PG8_SB(1, 1), cB + hstep + kstep);
    PG8_WAIT_V(6); PG8_BAR;
    for (;;) {
        const bool has_next = S.next(ui + 1, nxt);
        const char* nA = has_next ? (GATHER ? (const char*)g.A + (size_t)nxt.koff * 2 : (const char*)g.A + (size_t)nxt.pm * tstep + (size_t)nxt.koff * 2) : cA;
        const char* nB = has_next ? (const char*)g.Bt + (size_t)nxt.e * g.bstride + (size_t)nxt.pn * tstep + (size_t)nxt.koff * 2 : cB;
        if constexpr (GATHER) { if (has_next) PG8_OFFS(tk00, tk01, tk10, tk11, gn00, gn01, gn10, gn11); else { gn00 = gc00; gn01 = gc01; gn10 = gc10; gn11 = gc11; }
            Unit n2_; if (S.next(ui + 2, n2_)) PG8_TOK(n2_, tk00, tk01, tk10, tk11); }
        const int nt = cur.nt;
        for (int t = 0; t < nt; t += 2) {
            const bool last = (t == nt - 2);
            const char* a1 = cA + (size_t)(t + 1) * kstep;
            const char* a2 = last ? nA : cA + (size_t)(t + 2) * kstep; const char* b2 = last ? nB : cB + (size_t)(t + 2) * kstep;
            const char* a3 = a2 + kstep; const char* b3 = b2 + kstep;
            const unsigned s00 = last ? gn00 : gc00, s01 = last ? gn01 : gc01, s10 = last ? gn10 : gc10, s11 = last ? gn11 : gc11;
            const int fresh = __builtin_amdgcn_readfirstlane(((Epi::NST > 0) && (ui > 0) && (t == 0)) ? 1 : 0);
            PG8_LDB(B0, 0, 0); PG8_LDB(B1, 0, 1); PG8_SCHED; PG8_LDA(At, 0, 0); PG8_STAGE_A(PG8_SA(1, 1), a1, 1, gc10, gc11);
            PG8_WAIT_V8F(fresh);
            PG8_WAIT_L(0); PG8_BAR; if (F8 && t == 0) { PG8_MMA0(0, 0, At, B0); PG8_MMA0(0, 1, At, B1); } else { PG8_MMA(0, 0, At, B0); PG8_MMA(0, 1, At, B1); } PG8_BAR; PG8_SCHED;
            PG8_LDA(At, 0, 1); PG8_STAGE_B(PG8_SB(0, 0), b2); PG8_STAGE_B(PG8_SB(0, 1), b2 + hstep); PG8_STAGE_A(PG8_SA(0, 0), a2, 0, s00, s01);
            PG8_WAIT_V8F(fresh);
            PG8_WAIT_L(0); PG8_BAR; if (F8 && t == 0) { PG8_MMA0(1, 0, At, B0); PG8_MMA0(1, 1, At, B1); } else { PG8_MMA(1, 0, At, B0); PG8_MMA(1, 1, At, B1); } PG8_BAR; PG8_SCHED;
            PG8_LDB(B0, 1, 0); PG8_LDB(B1, 1, 1); PG8_SCHED; PG8_LDA(At, 1, 0); PG8_STAGE_A(PG8_SA(0, 1), a2, 1, s10, s11);
            PG8_WAIT_V(8); PG8_WAIT_L(0); PG8_BAR; PG8_MMA(0, 0, At, B0); PG8_MMA(0, 1, At, B1); PG8_BAR; PG8_SCHED;
            PG8_LDA(At, 1, 1); PG8_STAGE_B(PG8_SB(1, 0), b3); PG8_STAGE_B(PG8_SB(1, 1), b3 + hstep); PG8_STAGE_A(PG8_SA(1, 0), a3, 0, s00, s01);
            PG8_WAIT_V(8); PG8_WAIT_L(0); PG8_BAR; PG8_MMA(1, 0, At, B0); PG8_MMA(1, 1, At, B1); PG8_BAR; PG8_SCHED;
        }
        if constexpr (ALIGN_EPI) { if (wr == 0) PG8_BAR; }
        if constexpr (F8) asm volatile("s_nop 15\n\ts_nop 7" ::: "memory");
        { int te_ = threadIdx.x; asm volatile("" : "+v"(te_));
          const int we_ = __builtin_amdgcn_readfirstlane(te_ >> 6), le_ = te_ & 63; E(acc, cur, we_ >> 2, we_ & 3, le_ & 15, le_ >> 4); }
        if (!has_next) break;
        bool zero_acc = true; if constexpr (Epi::KEEPS) zero_acc = !E.keep(cur);
        if (!F8 && zero_acc) {
#pragma unroll
        for (int a = 0; a < 2; ++a)
#pragma unroll
            for (int b = 0; b < 2; ++b)
#pragma unroll
                for (int m = 0; m < 4; ++m)
#pragma unroll
                    for (int n = 0; n < 2; ++n) acc[a][b][m][n] = (f32x4){0.f, 0.f, 0.f, 0.f};
        }
        cur = nxt; cA = nA; cB = nB; ++ui;
        if constexpr (GATHER) { gc00 = gn00; gc01 = gn01; gc10 = gn10; gc11 = gn11; }
        if constexpr (ALIGN_EPI) { if (wr == 1) PG8_BAR; }
    }
    PG8_WAIT_V(0);
    if constexpr (!ALIGN_EPI) { if (wr == 0) PG8_BAR; }
    PG8_BAR;
#undef PG8_SA
#undef PG8_SB
#undef PG8_GLDS
#undef PG8_STAGE_A
#undef PG8_STAGE_B
#undef PG8_LDA
#undef PG8_LDB
#undef PG8_MMA
#undef PG8_MMA0
#undef PG8_CAT8
#undef PG8_WAIT_V
#undef PG8_WAIT_L
#undef PG8_WAIT_V8F
#undef PG8_BAR
#undef PG8_SCHED
#undef PG8_GATH
#undef PG8_TOK
#undef PG8_OFFS
}

__device__ __forceinline__ u32x4 pack8(const f32x4 a, const f32x4 b) { u32x4 w; w.x = cvt_pk_bf16(a[0], a[1]); w.y = cvt_pk_bf16(a[2], a[3]); w.z = cvt_pk_bf16(b[0], b[1]); w.w = cvt_pk_bf16(b[2], b[3]); return w; }
__device__ __forceinline__ u32x2 pack4(const f32x4 a) { u32x2 w; w.x = cvt_pk_bf16(a[0], a[1]); w.y = cvt_pk_bf16(a[2], a[3]); return w; }

__device__ __forceinline__ size_t gfrag(int pm, int pg, int wid, int k, int lane) { return ((((size_t)(pm * 12 + pg) * 8 + wid) * 16 + k) * 64 + lane) * 8; }
__device__ __forceinline__ size_t gfrag8(int pm, int pg, int wid, int k, int lane) { return ((((size_t)(pm * 12 + pg) * 8 + wid) * 8 + k) * 64 + lane) * 16; }
constexpr float ATT_C2 = 0.125f * 1.4426950408889634f;
constexpr float NORM_EPS = 1e-6f;

struct EpiInProj {
    static constexpr bool PERM = true; static constexpr int NST = 0; static constexpr bool KEEPS = false;
    bf16_t *P, *Z, *Q, *Kb, *Vb; const PG8_LAS float *qg, *kg;
    __device__ __forceinline__ void operator()(const f32x4 (&acc)[2][2][4][2], const Unit& u, int wr, int wc, int fr, int fq) const {
        const int row0 = u.pm * BM + wr * 64 + fr; const int pn = u.pn;
        if (pn == 0) {
#pragma unroll
            for (int ai = 0; ai < 2; ++ai)
#pragma unroll
                for (int m = 0; m < 4; ++m) { bf16_t* rowp = P + (size_t)(row0 + ai * HALF + m * 16) * 256 + wc * 32 + 8 * fq;
#pragma unroll
                    for (int bj = 0; bj < 2; ++bj) *(u32x4*)(rowp + bj * HALF) = pack8(acc[ai][bj][m][0], acc[ai][bj][m][1]); asm volatile("" ::: "memory"); }
        } else if (pn <= 2) {
            const int t = pn - 1;
#pragma unroll
            for (int ai = 0; ai < 2; ++ai)
#pragma unroll
                for (int m = 0; m < 4; ++m) { bf16_t* rowp = Z + (size_t)(row0 + ai * HALF + m * 16) * 256 + t * 128 + 16 * wc + 4 * fq;
#pragma unroll
                    for (int bj = 0; bj < 2; ++bj) { const f32x4 a = acc[ai][bj][m][0], gt = acc[ai][bj][m][1]; f32x4 z;
                        z = a * rsig4_(gt);
                        *(u32x2*)(rowp + 64 * bj) = pack4(z); } asm volatile("" ::: "memory"); }
        } else if (pn <= 6) {
            const bool isq = pn <= 4; const int t = isq ? pn - 3 : pn - 5; const PG8_LAS float* gs = isq ? qg : kg;
            f32x4 gv[2][2];
#pragma unroll
            for (int bj = 0; bj < 2; ++bj)
#pragma unroll
                for (int n = 0; n < 2; ++n) gv[bj][n] = *(const PG8_LAS f32x4*)(gs + 32 * bj + 8 * fq + 4 * n);
            const float sc = isq ? ATT_C2 : 1.0f; const int head = 4 * t + wc;
#pragma unroll
            for (int ai = 0; ai < 2; ++ai)
#pragma unroll
                for (int m = 0; m < 4; ++m) { float ss = 0.f;
#pragma unroll
                    for (int bj = 0; bj < 2; ++bj)
#pragma unroll
                        for (int n = 0; n < 2; ++n) { const f32x4 x = acc[ai][bj][m][n]; ss += (x[0] * x[0] + x[1] * x[1]) + (x[2] * x[2] + x[3] * x[3]); }
                    { const int ln = 16 * fq + fr; ss += __int_as_float(__builtin_amdgcn_ds_bpermute((ln ^ 16) << 2, __float_as_int(ss))); ss += __int_as_float(__builtin_amdgcn_ds_bpermute((ln ^ 32) << 2, __float_as_int(ss))); }
                    const float rs = __builtin_amdgcn_rsqf(ss * (1.0f / 64.0f) + NORM_EPS) * sc;
                    const size_t r = (size_t)(row0 + ai * HALF + m * 16);
                    bf16_t* rowp = isq ? Q + r * 1024 + 64 * head + 8 * fq : Kb + r * 512 + 64 * head + 8 * fq;
#pragma unroll
                    for (int bj = 0; bj < 2; ++bj) *(u32x4*)(rowp + 32 * bj) = pack8(acc[ai][bj][m][0] * rs * gv[bj][0], acc[ai][bj][m][1] * rs * gv[bj][1]); asm volatile("" ::: "memory"); }
        } else {
            const int t = pn - 7;
#pragma unroll
            for (int ai = 0; ai < 2; ++ai)
#pragma unroll
                for (int m = 0; m < 4; ++m) { bf16_t* rowp = Vb + (size_t)(row0 + ai * HALF + m * 16) * 512 + 256 * t + wc * 32 + 8 * fq;
#pragma unroll
                    for (int bj = 0; bj < 2; ++bj) *(u32x4*)(rowp + bj * HALF) = pack8(acc[ai][bj][m][0], acc[ai][bj][m][1]); asm volatile("" ::: "memory"); }

        }
    }
};

constexpr float GATE_EMAX = 448.0f;
struct EpiGate {
    static constexpr bool PERM = true; static constexpr int NST = 0; static constexpr bool KEEPS = false;
    unsigned char* G8; const PG8_LAS float* bgate;
    __device__ __forceinline__ void operator()(const f32x4 (&acc)[2][2][4][2], const Unit& u, int wr, int wc, int fr, int fq) const {
        const int c0 = 256 * u.pn + wc * 32 + 8 * fq;
        f32x4 bv[2][2];
#pragma unroll
        for (int bj = 0; bj < 2; ++bj)
#pragma unroll
            for (int n = 0; n < 2; ++n) bv[bj][n] = *(const PG8_LAS f32x4*)(bgate + c0 + bj * HALF + 4 * n);
#pragma unroll
        for (int ai = 0; ai < 2; ++ai)
#pragma unroll
            for (int m = 0; m < 4; ++m) { int w[4];
#pragma unroll
                for (int bj = 0; bj < 2; ++bj) { f32x4 v0 = acc[ai][bj][m][0] + bv[bj][0], v1 = acc[ai][bj][m][1] + bv[bj][1];
#pragma unroll
                    for (int i = 0; i < 4; ++i) { v0[i] = fminf(__builtin_amdgcn_exp2f(-v0[i]), GATE_EMAX); v1[i] = fminf(__builtin_amdgcn_exp2f(-v1[i]), GATE_EMAX); }
                    int lo = 0, hi = 0;
                    lo = __builtin_amdgcn_cvt_pk_fp8_f32(v0[0], v0[1], lo, false); lo = __builtin_amdgcn_cvt_pk_fp8_f32(v0[2], v0[3], lo, true);
                    hi = __builtin_amdgcn_cvt_pk_fp8_f32(v1[0], v1[1], hi, false); hi = __builtin_amdgcn_cvt_pk_fp8_f32(v1[2], v1[3], hi, true);
                    w[2 * bj] = lo; w[2 * bj + 1] = hi; }
                *(u32x4*)(G8 + gfrag8(u.pm, u.pn, wr * 4 + wc, ai * 4 + m, fq * 16 + fr)) = (u32x4){(unsigned)w[0], (unsigned)w[1], (unsigned)w[2], (unsigned)w[3]}; asm volatile("" ::: "memory"); }
    }
};
struct EpiInProjNS {
    static constexpr bool PERM = true; static constexpr int NST = 0; static constexpr bool KEEPS = false;
    bf16_t *P, *Z, *Q, *Kb, *Vb, *G; const float *qg, *kg, *bgate;
    __device__ __forceinline__ void operator()(const f32x4 (&acc)[2][2][4][2], const Unit& u, int wr, int wc, int fr, int fq) const {
        const int row0 = u.pm * BM + wr * 64 + fr; const int pn = u.pn;
        if (pn == 0) {
#pragma unroll
            for (int ai = 0; ai < 2; ++ai)
#pragma unroll
                for (int m = 0; m < 4; ++m) { bf16_t* rowp = P + (size_t)(row0 + ai * HALF + m * 16) * 256 + wc * 32 + 8 * fq;
#pragma unroll
                    for (int bj = 0; bj < 2; ++bj) { const u32x4 t_ = pack8(acc[ai][bj][m][0], acc[ai][bj][m][1]); asm volatile("" :: "v"(t_)); } asm volatile("" ::: "memory"); }
        } else if (pn <= 2) {
            const int t = pn - 1;
#pragma unroll
            for (int ai = 0; ai < 2; ++ai)
#pragma unroll
                for (int m = 0; m < 4; ++m) { bf16_t* rowp = Z + (size_t)(row0 + ai * HALF + m * 16) * 256 + t * 128 + 16 * wc + 4 * fq;
#pragma unroll
                    for (int bj = 0; bj < 2; ++bj) { const f32x4 a = acc[ai][bj][m][0], gt = acc[ai][bj][m][1]; f32x4 z;
#pragma unroll
                        for (int i = 0; i < 4; ++i) z[i] = a[i] * sigmoidf_(gt[i]);
                        { const u32x2 t_ = pack4(z); asm volatile("" :: "v"(t_)); } } asm volatile("" ::: "memory"); }
        } else if (pn <= 6) {
            const bool isq = pn <= 4; const int t = isq ? pn - 3 : pn - 5; const float* gs = isq ? qg : kg;
            f32x4 gv[2][2];
#pragma unroll
            for (int bj = 0; bj < 2; ++bj)
#pragma unroll
                for (int n = 0; n < 2; ++n) gv[bj][n] = *(const f32x4*)(gs + 32 * bj + 8 * fq + 4 * n);
            const float sc = isq ? ATT_C2 : 1.0f; const int head = 4 * t + wc;
#pragma unroll
            for (int ai = 0; ai < 2; ++ai)
#pragma unroll
                for (int m = 0; m < 4; ++m) { float ss = 0.f;
#pragma unroll
                    for (int bj = 0; bj < 2; ++bj)
#pragma unroll
                        for (int n = 0; n < 2; ++n) { const f32x4 x = acc[ai][bj][m][n]; ss += (x[0] * x[0] + x[1] * x[1]) + (x[2] * x[2] + x[3] * x[3]); }
                    { const int ln = 16 * fq + fr; ss += __int_as_float(__builtin_amdgcn_ds_bpermute((ln ^ 16) << 2, __float_as_int(ss))); ss += __int_as_float(__builtin_amdgcn_ds_bpermute((ln ^ 32) << 2, __float_as_int(ss))); }
                    const float rs = __builtin_amdgcn_rsqf(ss * (1.0f / 64.0f) + NORM_EPS) * sc;
                    const size_t r = (size_t)(row0 + ai * HALF + m * 16);
                    bf16_t* rowp = isq ? Q + r * 1024 + 64 * head + 8 * fq : Kb + r * 512 + 64 * head + 8 * fq;
#pragma unroll
                    for (int bj = 0; bj < 2; ++bj) { const u32x4 t_ = pack8(acc[ai][bj][m][0] * rs * gv[bj][0], acc[ai][bj][m][1] * rs * gv[bj][1]); asm volatile("" :: "v"(t_)); } asm volatile("" ::: "memory"); }
        } else if (pn <= 8) {
            const int t = pn - 7;
#pragma unroll
            for (int ai = 0; ai < 2; ++ai)
#pragma unroll
                for (int m = 0; m < 4; ++m) { bf16_t* rowp = Vb + (size_t)(row0 + ai * HALF + m * 16) * 512 + 256 * t + wc * 32 + 8 * fq;
#pragma unroll
                    for (int bj = 0; bj < 2; ++bj) { const u32x4 t_ = pack8(acc[ai][bj][m][0], acc[ai][bj][m][1]); asm volatile("" :: "v"(t_)); } asm volatile("" ::: "memory"); }
        } else {
            const int c0 = 256 * (pn - 9) + wc * 32 + 8 * fq;
            f32x4 bv[2][2];
#pragma unroll
            for (int bj = 0; bj < 2; ++bj)
#pragma unroll
                for (int n = 0; n < 2; ++n) bv[bj][n] = *(const f32x4*)(bgate + c0 + bj * HALF + 4 * n);
#pragma unroll
            for (int ai = 0; ai < 2; ++ai)
#pragma unroll
                for (int m = 0; m < 4; ++m) { bf16_t* rowp = G + (size_t)(row0 + ai * HALF + m * 16) * 3072 + c0;
#pragma unroll
                    for (int bj = 0; bj < 2; ++bj) { f32x4 v0 = acc[ai][bj][m][0] + bv[bj][0], v1 = acc[ai][bj][m][1] + bv[bj][1];
#pragma unroll
                        for (int i = 0; i < 4; ++i) { v0[i] = sigmoidf_(v0[i]); v1[i] = sigmoidf_(v1[i]); }
                        { const u32x4 t_ = pack8(v0, v1); asm volatile("" :: "v"(t_)); } } asm volatile("" ::: "memory"); }
        }
    }
};

template <int LINEAR> struct EpiStoreProbe {
    static constexpr bool PERM = true; static constexpr int NST = 0; static constexpr bool KEEPS = false;
    bf16_t* S;
    __device__ __forceinline__ void operator()(const f32x4 (&acc)[2][2][4][2], const Unit& u, int wr, int wc, int fr, int fq) const {
        const int row0 = wr * 64 + fr; const size_t tbase = ((size_t)(blockIdx.x) * 256) * 256;
        const int wid = wr * 4 + wc, lane = fq * 16 + fr;
#pragma unroll
        for (int ai = 0; ai < 2; ++ai)
#pragma unroll
            for (int m = 0; m < 4; ++m)
#pragma unroll
                for (int bj = 0; bj < 2; ++bj) {
                    bf16_t* p = LINEAR ? S + tbase + (size_t)(((ai * 4 + m) * 2 + bj) * 8 + wid) * 512 + lane * 8
                                       : S + tbase + (size_t)(row0 + ai * HALF + m * 16) * 256 + bj * HALF + wc * 32 + 8 * fq;
                    *(u32x4*)p = pack8(acc[ai][bj][m][0], acc[ai][bj][m][1]); }
    }
};
struct EpiNull {
    static constexpr bool PERM = true; static constexpr int NST = 0; static constexpr bool KEEPS = false;
    __device__ __forceinline__ void operator()(const f32x4 (&acc)[2][2][4][2], const Unit& u, int wr, int wc, int fr, int fq) const {
#pragma unroll
        for (int a = 0; a < 2; ++a)
#pragma unroll
            for (int b = 0; b < 2; ++b)
#pragma unroll
                for (int m = 0; m < 4; ++m)
#pragma unroll
                    for (int n = 0; n < 2; ++n) asm volatile("" :: "v"(acc[a][b][m][n])); }
};
struct EpiMerge {
    static constexpr bool PERM = true; static constexpr int NST = 0; static constexpr bool KEEPS = true;
    const unsigned char* G8; bf16_t* MG;
    __device__ __forceinline__ bool keep(const Unit& u) const { return u.e != 2; }
    __device__ __forceinline__ void operator()(f32x4 (&acc)[2][2][4][2], const Unit& u, int wr, int wc, int fr, int fq) const {
        const int row0 = u.pm * BM + wr * 64 + fr, col0 = u.pn * BM + wc * 32 + 8 * fq; const int seg = u.e;
        const int wid = wr * 4 + wc, ln = fq * 16 + fr;
        const unsigned char* Ga = G8 + gfrag8(u.pm, seg * 4 + u.pn, wid, 0, ln);
        const unsigned char* Gb = G8 + gfrag8(u.pm, (seg != 2 ? seg + 1 : seg) * 4 + u.pn, wid, 0, ln);
        u32x4 ga[2][4], gb[2][4];
#pragma unroll
        for (int ai = 0; ai < 2; ++ai)
#pragma unroll
            for (int m = 0; m < 4; ++m) { const int k = ai * 4 + m; ga[ai][m] = *(const u32x4*)(Ga + 1024 * k); if (seg != 2) gb[ai][m] = *(const u32x4*)(Gb + 1024 * k); else gb[ai][m] = (u32x4){0u, 0u, 0u, 0u}; }
        asm volatile("" ::: "memory");
#define EM_UNPACK8(wx, wy, lo4, hi4) f32x4 lo4, hi4; { const f32x2 p0_ = __builtin_amdgcn_cvt_pk_f32_fp8((int)(wx), false), p1_ = __builtin_amdgcn_cvt_pk_f32_fp8((int)(wx), true), p2_ = __builtin_amdgcn_cvt_pk_f32_fp8((int)(wy), false), p3_ = __builtin_amdgcn_cvt_pk_f32_fp8((int)(wy), true); \
            lo4 = (f32x4){p0_[0], p0_[1], p1_[0], p1_[1]}; hi4 = (f32x4){p2_[0], p2_[1], p3_[0], p3_[1]}; }
#pragma unroll
        for (int ai = 0; ai < 2; ++ai)
#pragma unroll
            for (int m = 0; m < 4; ++m) { bf16_t* mp = MG + (size_t)(row0 + ai * HALF + m * 16) * 1024 + col0;
#pragma unroll
                for (int bj = 0; bj < 2; ++bj) { const u32x4 a4 = ga[ai][m], b4 = gb[ai][m];
                    EM_UNPACK8(bj ? a4.z : a4.x, bj ? a4.w : a4.y, na0, na1); EM_UNPACK8(bj ? b4.z : b4.x, bj ? b4.w : b4.y, nb0, nb1);
                    { const f32x4 da0 = na0 + 1.0f, da1 = na1 + 1.0f;
                      const f32x4 ra0 = (f32x4){__builtin_amdgcn_rcpf(da0[0]), __builtin_amdgcn_rcpf(da0[1]), __builtin_amdgcn_rcpf(da0[2]), __builtin_amdgcn_rcpf(da0[3])}, ra1 = (f32x4){__builtin_amdgcn_rcpf(da1[0]), __builtin_amdgcn_rcpf(da1[1]), __builtin_amdgcn_rcpf(da1[2]), __builtin_amdgcn_rcpf(da1[3])};
                      acc[ai][bj][m][0] *= (nb0 + 1.0f) * ra0; acc[ai][bj][m][1] *= (nb1 + 1.0f) * ra1; }
                    if (seg == 2) *(u32x4*)(mp + bj * HALF) = pack8(acc[ai][bj][m][0], acc[ai][bj][m][1]); }
                asm volatile("" ::: "memory"); }
#undef EM_UNPACK8
    }
};

template <bool SRC_F32> struct EpiResid {
    static constexpr bool PERM = true; static constexpr int NST = 0; static constexpr bool KEEPS = false;
    const void* src; bf16_t* out;
    __device__ __forceinline__ void operator()(const f32x4 (&acc)[2][2][4][2], const Unit& u, int wr, int wc, int fr, int fq) const {
        const int row0 = u.pm * BM + wr * 64 + fr, col0 = u.pn * BM + wc * 32 + 8 * fq;
        if constexpr (SRC_F32) {
#pragma unroll
        for (int ai = 0; ai < 2; ++ai) {
            f32x4 b[4][2][2];
#pragma unroll
            for (int m = 0; m < 4; ++m) { const size_t off = (size_t)(row0 + ai * HALF + m * 16) * 1024 + col0;
#pragma unroll
                for (int bj = 0; bj < 2; ++bj) { b[m][bj][0] = *(const f32x4*)((const float*)src + off + bj * HALF); b[m][bj][1] = *(const f32x4*)((const float*)src + off + bj * HALF + 4); } }
#pragma unroll
            for (int m = 0; m < 4; ++m) { const size_t off = (size_t)(row0 + ai * HALF + m * 16) * 1024 + col0;
#pragma unroll
                for (int bj = 0; bj < 2; ++bj) *(u32x4*)(out + off + bj * HALF) = pack8(b[m][bj][0] + acc[ai][bj][m][0], b[m][bj][1] + acc[ai][bj][m][1]); }
            asm volatile("" ::: "memory");
        }
        } else {
            u32x4 b[2][4][2];
#pragma unroll
            for (int ai = 0; ai < 2; ++ai)
#pragma unroll
                for (int m = 0; m < 4; ++m) { const size_t off = (size_t)(row0 + ai * HALF + m * 16) * 1024 + col0;
#pragma unroll
                    for (int bj = 0; bj < 2; ++bj) b[ai][m][bj] = *(const u32x4*)((const bf16_t*)src + off + bj * HALF); }
            asm volatile("" ::: "memory");
#pragma unroll
            for (int ai = 0; ai < 2; ++ai) {
#pragma unroll
                for (int m = 0; m < 4; ++m) { const size_t off = (size_t)(row0 + ai * HALF + m * 16) * 1024 + col0;
#pragma unroll
                    for (int bj = 0; bj < 2; ++bj) { const u32x4 w = b[ai][m][bj];
                        const f32x4 lo = (f32x4){bf_lo(w.x), bf_hi(w.x), bf_lo(w.y), bf_hi(w.y)}, hi = (f32x4){bf_lo(w.z), bf_hi(w.z), bf_lo(w.w), bf_hi(w.w)};
                        *(u32x4*)(out + off + bj * HALF) = pack8(lo + acc[ai][bj][m][0], hi + acc[ai][bj][m][1]); } }
                asm volatile("" ::: "memory"); }
        }
    }
};

struct EpiSwiGLU {
    static constexpr bool PERM = true; static constexpr int NST = 0; static constexpr bool KEEPS = false;
    bf16_t* H; int ldh;
    __device__ __forceinline__ void operator()(const f32x4 (&acc)[2][2][4][2], const Unit& u, int wr, int wc, int fr, int fq) const {
        const int row0 = u.pm * BM + wr * 64 + fr, ch0 = u.pn * 128 + 32 * wc + 8 * fq;
#pragma unroll
        for (int ai = 0; ai < 2; ++ai)
#pragma unroll
            for (int m = 0; m < 4; ++m) { f32x4 z[2];
#pragma unroll
                for (int n = 0; n < 2; ++n) { const f32x4 a = acc[ai][0][m][n], b = acc[ai][1][m][n];
                    z[n] = (a * b) * rsig4_(a); }
                *(u32x4*)(H + (size_t)(row0 + ai * HALF + m * 16) * ldh + ch0) = pack8(z[0], z[1]); asm volatile("" ::: "memory"); }
    }
};

struct EpiSwiGLU8 {
    static constexpr bool PERM = true; static constexpr int NST = 0; static constexpr bool KEEPS = false;
    unsigned char* H8; int ldh;
    __device__ __forceinline__ void operator()(const f32x4 (&acc)[2][2][4][2], const Unit& u, int wr, int wc, int fr, int fq) const {
        const int row0 = u.pm * BM + wr * 64 + fr, ch0 = u.pn * 128 + 32 * wc + 8 * fq;
#pragma unroll
        for (int ai = 0; ai < 2; ++ai)
#pragma unroll
            for (int m = 0; m < 4; ++m) { int w[2];
#pragma unroll
                for (int n = 0; n < 2; ++n) { const f32x4 a = acc[ai][0][m][n], b = acc[ai][1][m][n]; f32x4 z;
                    z = (a * b) * rsig4_(a);
                    int t = 0; t = __builtin_amdgcn_cvt_pk_fp8_f32(z[0], z[1], t, false); t = __builtin_amdgcn_cvt_pk_fp8_f32(z[2], z[3], t, true); w[n] = t; }
                *(u32x2*)(H8 + (size_t)(row0 + ai * HALF + m * 16) * ldh + ch0) = (u32x2){(unsigned)w[0], (unsigned)w[1]}; asm volatile("" ::: "memory"); }
    }
};

template <bool DST_F32> struct EpiMoeDown {
    static constexpr bool PERM = true; static constexpr int NST = 0; static constexpr bool KEEPS = false;
    const bf16_t* xb; void* out; const unsigned* list; const float* wgt; int ntfull;
    __device__ __forceinline__ void operator()(const f32x4 (&acc)[2][2][4][2], const Unit& u, int wr, int wc, int fr, int fq) const {
        const int col0 = u.pn * BM + wc * 32 + 8 * fq; const unsigned* lp = list + u.lo; const int nv = u.nv;
        unsigned tok[2][4]; float w[2][4];
#pragma unroll
        for (int ai = 0; ai < 2; ++ai)
#pragma unroll
            for (int m = 0; m < 4; ++m) { const int rl = ai * HALF + wr * 64 + m * 16 + fr; tok[ai][m] = rl < nv ? lp[rl] : 0u; }
#pragma unroll
        for (int ai = 0; ai < 2; ++ai)
#pragma unroll
            for (int m = 0; m < 4; ++m) w[ai][m] = wgt[tok[ai][m]];
        u32x4 b[4][2];
#pragma unroll
        for (int m = 0; m < 4; ++m) { const bf16_t* xp = xb + (size_t)tok[0][m] * 1024 + col0;
#pragma unroll
            for (int bj = 0; bj < 2; ++bj) b[m][bj] = *(const u32x4*)(xp + bj * HALF); }
        asm volatile("" ::: "memory");
#pragma unroll
        for (int ai = 0; ai < 2; ++ai) {
#pragma unroll
            for (int m = 0; m < 4; ++m) { const int rl = ai * HALF + wr * 64 + m * 16 + fr; const size_t off = (size_t)tok[ai][m] * 1024 + col0;
                const u32x4 q0 = b[m][0], q1 = b[m][1];
                if (ai == 0) { const bf16_t* xp = xb + (size_t)tok[1][m] * 1024 + col0; b[m][0] = *(const u32x4*)xp; b[m][1] = *(const u32x4*)(xp + HALF); }
                if (rl < nv) {
#pragma unroll
                    for (int bj = 0; bj < 2; ++bj) { const u32x4 q = bj ? q1 : q0;
                        const f32x4 v0 = (f32x4){bf_lo(q.x), bf_hi(q.x), bf_lo(q.y), bf_hi(q.y)} + acc[ai][bj][m][0] * w[ai][m], v1 = (f32x4){bf_lo(q.z), bf_hi(q.z), bf_lo(q.w), bf_hi(q.w)} + acc[ai][bj][m][1] * w[ai][m];
                        if constexpr (DST_F32) { *(f32x4*)((float*)out + off + bj * HALF) = v0; *(f32x4*)((float*)out + off + bj * HALF + 4) = v1; }
                        else *(u32x4*)((bf16_t*)out + off + bj * HALF) = pack8(v0, v1); } }
                asm volatile("" ::: "memory"); }
        }
    }
};
}
#include <hip/hip_bf16.h>
#include <cmath>
namespace attn_body {
using bf16=__hip_bfloat16;
using bf16x8=__attribute__((ext_vector_type(8)))short;
using s16x4=__attribute__((ext_vector_type(4)))short;
using f32x16=__attribute__((ext_vector_type(16)))float;
using u32x4=__attribute__((ext_vector_type(4)))unsigned;
constexpr int BATCH=8,NHEAD=8,SEQ=8192,D=64,KVP=NHEAD*D,QP=1024;
constexpr int NW=8,QBLK=32,QB=QBLK*NW,KVBLK=64,NQB=SEQ/QB;
constexpr int ATTN_UNIT_ROWS=QB;
__device__ __forceinline__ int crow(int r,int hi){return (r&3)+8*(r>>2)+4*hi;}
#define SBAR() __builtin_amdgcn_sched_barrier(0)
__device__ __forceinline__ void cmask(f32x16&p0,f32x16&p1,int jb,int qrel,int hi){
  const float NEG=-INFINITY; int kb=64*jb+4*hi;
  #pragma unroll
  for(int r=0;r<16;++r){int kv=kb+(r&3)+8*(r>>2); if(kv>qrel)p0[r]=NEG; if(kv+32>qrel)p1[r]=NEG;}
}

constexpr int NSLOT=3, SLOTB=8192;
constexpr int LDS_K=0, LDS_V=NSLOT*SLOTB, LDS_WS=2*NSLOT*SLOTB, LDS_OST=LDS_WS+NW*64*4, LDS_CT=LDS_OST+NW*4096, LDS_BYTES=LDS_CT+SEQ*4;
constexpr float C2=0.125f*1.4426950408889634f;
__device__ __forceinline__ void glds16(const void*gsrc,unsigned lds_dst){unsigned keep;
  asm volatile("s_mov_b32 %0, m0\n\ts_mov_b32 m0, %2\n\ts_nop 0\n\tglobal_load_lds_dwordx4 %1, off\n\ts_mov_b32 m0, %0":"=&s"(keep):"v"(gsrc),"s"(lds_dst):"memory");}
__device__ __forceinline__ float max3f(float a,float b,float c){float r;asm("v_max3_f32 %0, %1, %2, %3":"=v"(r):"v"(a),"v"(b),"v"(c));return r;}
__device__ __forceinline__ float max2f(float a,float b){float r;asm("v_max_f32_e32 %0, %1, %2":"=v"(r):"v"(a),"v"(b));return r;}
__device__ __forceinline__ float fadd_s(float a,float b){float r;asm("v_add_f32_e32 %0, %1, %2":"=v"(r):"v"(a),"v"(b));return r;}
__device__ __forceinline__ float fsub_s(float a,float b){float r;asm("v_sub_f32_e32 %0, %1, %2":"=v"(r):"v"(a),"v"(b));return r;}
typedef float f32x2_t __attribute__((ext_vector_type(2))); typedef __bf16 bf16x2_t __attribute__((ext_vector_type(2)));
__device__ __forceinline__ unsigned cvtpk_s(float lo,float hi){f32x2_t v={lo,hi};bf16x2_t b=__builtin_convertvector(v,bf16x2_t);return __builtin_bit_cast(unsigned,b);}
#define WAIT_BAR(N) asm volatile("s_waitcnt vmcnt(" #N ") lgkmcnt(0)\n\ts_barrier":::"memory")

__device__ __forceinline__ void qkt(f32x16&p0,f32x16&p1,const char*Kslot,const bf16x8*qr,int r32,int hi){
  const char*kb=Kslot+hi*1024+r32*16;
  #pragma unroll
  for(int d0=0;d0<4;++d0){
    const bf16x8 b0=*reinterpret_cast<const bf16x8*>(kb+d0*2048);
    const bf16x8 b1=*reinterpret_cast<const bf16x8*>(kb+d0*2048+512);
    {p0=__builtin_amdgcn_mfma_f32_32x32x16_bf16(b0,qr[d0],p0,0,0,0);p1=__builtin_amdgcn_mfma_f32_32x32x16_bf16(b1,qr[d0],p1,0,0,0);}}
}
typedef __attribute__((address_space(3))) const char* lds_cptr;
typedef short v4i16_t __attribute__((ext_vector_type(4)));
__device__ __forceinline__ void kload8(bf16x8*kf,lds_cptr kp){
  kf[0]=*(const __attribute__((address_space(3))) bf16x8*)(kp);      kf[1]=*(const __attribute__((address_space(3))) bf16x8*)(kp+512);
  kf[2]=*(const __attribute__((address_space(3))) bf16x8*)(kp+2048); kf[3]=*(const __attribute__((address_space(3))) bf16x8*)(kp+2560);
  kf[4]=*(const __attribute__((address_space(3))) bf16x8*)(kp+4096); kf[5]=*(const __attribute__((address_space(3))) bf16x8*)(kp+4608);
  kf[6]=*(const __attribute__((address_space(3))) bf16x8*)(kp+6144); kf[7]=*(const __attribute__((address_space(3))) bf16x8*)(kp+6656);
}
__device__ __forceinline__ void kload2(bf16x8*kf,lds_cptr kp,int j){ kf[2*j]=*(const __attribute__((address_space(3))) bf16x8*)(kp+j*2048); kf[2*j+1]=*(const __attribute__((address_space(3))) bf16x8*)(kp+j*2048+512); }
__device__ __forceinline__ s16x4 vtr(lds_cptr p){ return __builtin_bit_cast(s16x4,__builtin_amdgcn_ds_read_tr16_b64_v4i16((__attribute__((address_space(3))) v4i16_t*)p)); }
__device__ __forceinline__ float rowmax(const f32x16&p0,const f32x16&p1){
  float a=max3f(p0[0],p0[1],p1[0]),b=max3f(p0[2],p0[3],p1[1]);a=max3f(a,p1[2],p1[3]);
  #pragma unroll
  for(int r=4;r<16;r+=4){a=max3f(a,p0[r],p0[r+1]);b=max3f(b,p0[r+2],p0[r+3]);a=max3f(a,p1[r],p1[r+1]);b=max3f(b,p1[r+2],p1[r+3]);}
  const float m=max2f(a,b);
  auto rr=__builtin_amdgcn_permlane32_swap(__float_as_uint(m),__float_as_uint(m),false,false);
  return max2f(__uint_as_float(rr[0]),__uint_as_float(rr[1]));
}
__device__ __forceinline__ void pv(f32x16*o,int vb,bf16x8 pa0,bf16x8 pa1,bf16x8 pa2,bf16x8 pa3){
  #pragma unroll
  for(int d0=0;d0<2;++d0){s16x4 lo[4],hi[4];
    #pragma unroll
    for(int ks=0;ks<4;++ks){
      asm volatile("ds_read_b64_tr_b16 %0,%1 offset:%c2":"=&v"(lo[ks]):"v"(vb),"i"(d0*4096+ks*1024):"memory");
      asm volatile("ds_read_b64_tr_b16 %0,%1 offset:%c2":"=&v"(hi[ks]):"v"(vb),"i"(d0*4096+ks*1024+512):"memory");}
    asm volatile("s_waitcnt lgkmcnt(0)":::"memory");SBAR();
    #define PK(k) (bf16x8){lo[k][0],lo[k][1],lo[k][2],lo[k][3],hi[k][0],hi[k][1],hi[k][2],hi[k][3]}
    o[d0]=__builtin_amdgcn_mfma_f32_32x32x16_bf16(pa0,PK(0),o[d0],0,0,0);
    o[d0]=__builtin_amdgcn_mfma_f32_32x32x16_bf16(pa1,PK(1),o[d0],0,0,0);
    o[d0]=__builtin_amdgcn_mfma_f32_32x32x16_bf16(pa2,PK(2),o[d0],0,0,0);
    o[d0]=__builtin_amdgcn_mfma_f32_32x32x16_bf16(pa3,PK(3),o[d0],0,0,0);
    #undef PK
  }
}

#ifndef ATTN_STORE16
#define ATTN_STORE16(p,v) (*(u32x4*)(p)=(v))
#endif
template<int THRL> __device__ __forceinline__ void attn_unit(int b,int h,int qb,int t0,const bf16*Q,const bf16*__restrict__ K,const bf16*__restrict__ V,bf16*O,const float*__restrict__ NCL,char*shm){
  int tid_o=threadIdx.x; asm volatile("":"+v"(tid_o));
  const int tid=tid_o,lane=tid&63,r32=lane&31,hi=lane>>5; const int wid=__builtin_amdgcn_readfirstlane(tid>>6);
  const long rowbase=(long)b*SEQ; const int q0=qb*QB;
  const bf16*Qw=Q+(rowbase+q0+wid*QBLK)*QP+h*D;
  const bf16*Kh=K+(rowbase+(long)t0*KVBLK)*KVP+h*D,*Vh=V+(rowbase+(long)t0*KVBLK)*KVP+h*D;
  const unsigned lds0=(unsigned)(uintptr_t)shm;
  float*wsf=(float*)(shm+LDS_WS)+wid*64;
  const bf16*ksrc=Kh+(long)lane*KVP+wid*8;
  const bf16*vsrc=Vh+(long)(16*(wid&3)+(lane>>2))*KVP+(wid>>2)*32+(lane&3)*8;
  const unsigned kdst=lds0+LDS_K+wid*1024, vdst=lds0+LDS_V+wid*1024;
  #define DMA_K(t,slot) glds16(ksrc+(long)(t)*KVBLK*KVP,(unsigned)__builtin_amdgcn_readfirstlane(kdst+(slot)))
  #define DMA_V(t,slot) glds16(vsrc+(long)(t)*KVBLK*KVP,(unsigned)__builtin_amdgcn_readfirstlane(vdst+(slot)))
  const int vb0=(int)(lds0+LDS_V)+((lane>>4)&1)*32+(lane&3)*8+(4*hi+((lane&15)>>2))*64;
  const char*Kbase=shm+LDS_K; bf16x8 kf[8];
  const lds_cptr shm3=(lds_cptr)shm; const lds_cptr kp0=shm3+LDS_K+hi*1024+r32*16; const lds_cptr vp0=shm3+LDS_V+((lane>>4)&1)*32+(lane&3)*8+(4*hi+((lane&15)>>2))*64;
  const int NT=(q0+QB)/KVBLK-t0;
  DMA_K(0,0);DMA_V(0,0);DMA_K(1,SLOTB);
  { typedef float f32x4_t __attribute__((ext_vector_type(4))); __attribute__((address_space(3))) float* ct=(__attribute__((address_space(3))) float*)(shm3+LDS_CT);
    const int i0_=t0*KVBLK+tid*4, iend_=q0+QB; f32x4_t tv_[4];
    _Pragma("unroll") for(int k_=0;k_<4;++k_){ const int i=i0_+k_*(NW*64*4); tv_[k_]=(i<iend_)?*(const f32x4_t*)(NCL+i):(f32x4_t){0.f,0.f,0.f,0.f}; }
    _Pragma("unroll") for(int k_=0;k_<4;++k_){ const int i=i0_+k_*(NW*64*4); if(i<iend_) *(__attribute__((address_space(3))) f32x4_t*)(ct+i)=tv_[k_]; } }
  const __attribute__((address_space(3))) float* ctl=(const __attribute__((address_space(3))) float*)(shm3+LDS_CT)+t0*KVBLK+4*hi;
  #define CINIT(C0,C1,t) do{ typedef float f32x4_t __attribute__((ext_vector_type(4))); const float nm_=-mhat; const __attribute__((address_space(3))) float* cb_=ctl+64*(t); \
    _Pragma("unroll") for(int g_=0;g_<4;++g_){ const f32x4_t b0_=*(const __attribute__((address_space(3))) f32x4_t*)(cb_+8*g_), b1_=*(const __attribute__((address_space(3))) f32x4_t*)(cb_+32+8*g_); \
      _Pragma("unroll") for(int i_=0;i_<4;++i_){ C0[4*g_+i_]=nm_+b0_[i_]; C1[4*g_+i_]=nm_+b1_[i_]; } } }while(0)
  bf16x8 qr[4];
  #pragma unroll
  for(int d0=0;d0<4;++d0)qr[d0]=*reinterpret_cast<const bf16x8*>(&Qw[(long)r32*QP+d0*16+hi*8]);
  float mhat=0.f,l_reg=0.f;f32x16 o[2];o[0]=f32x16{};o[1]=f32x16{};
  const int qrel=wid*QBLK+r32;
  #define CMASK(P0,P1,t) do{int jb_=(t)-(NT-4); if(jb_>=0)cmask(P0,P1,jb_,qrel,hi);}while(0)
  bool resc=false;
  #define START(P0,P1) do{ const float rm=rowmax(P0,P1); resc=false; \
    { const float dl=rm; mhat=fadd_s(mhat,dl); \
      _Pragma("unroll") for(int r=0;r<16;++r){P0[r]=fsub_s(P0[r],dl);P1[r]=fsub_s(P1[r],dl);} \
      } \
    _Pragma("unroll") for(int r=0;r<16;++r)P0[r]=__builtin_amdgcn_exp2f(P0[r]); }while(0)
  #define RESC() do{ if(resc){ asm volatile("s_waitcnt lgkmcnt(0)":::"memory"); \
      _Pragma("unroll") for(int d_=0;d_<2;++d_) _Pragma("unroll") for(int r=0;r<16;++r)o[d_][r]*=wsf[crow(r,hi)]; } }while(0)
  f32x16 pA0,pA1,pB0,pB1;
  int sl_prev=0,sl_cur=0,sl_next=SLOTB;
  #define ROT() do{sl_prev=sl_cur;sl_cur=sl_next;sl_next=(sl_next==(NSLOT-1)*SLOTB)?0:sl_next+SLOTB;}while(0)
  DMA_K(2,2*SLOTB);
  WAIT_BAR(3);
  CINIT(pA0,pA1,0); qkt(pA0,pA1,Kbase,qr,r32,hi);asm volatile("s_nop 15\n\ts_nop 7":"+v"(pA0),"+v"(pA1));CMASK(pA0,pA1,0);
  START(pA0,pA1);
  _Pragma("unroll") for(int r=0;r<16;++r)pA1[r]=__builtin_amdgcn_exp2f(pA1[r]);
  WAIT_BAR(0);
  DMA_K(3,0);DMA_V(1,SLOTB);
  ROT();
  kload8(kf,kp0+sl_cur);
  WAIT_BAR(2);
  s16x4 vlo[8],vhi[8]; u32x4 pw0,pw1,pw2,pw3;
  #define PKW(P,B) cvtpk_s(P[B],P[B+1])
  #define PAF(k) __builtin_bit_cast(bf16x8,pw##k)
  #define VFR(i) (bf16x8){vlo[i][0],vlo[i][1],vlo[i][2],vlo[i][3],vhi[i][0],vhi[i][1],vhi[i][2],vhi[i][3]}
  #define PIN(x) asm volatile("":"+v"(x))
  #define MX3(a,b,c) __builtin_fmaxf(__builtin_fmaxf((a),(b)),(c))
  #define GAPA(MF,A0,A1,A2,A3,W0,W1,PW) do{ MF; sacc+=A0; sacc+=A1; sacc+=A2; sacc+=A3; PIN(sacc); W0; W1; PIN(PW); SBAR(); }while(0)
  #define EX(v) __builtin_amdgcn_exp2f(v)
  #define GAPB(MF,X,B) do{ MF; X[B]=EX(X[B]); X[B+1]=EX(X[B+1]); X[B+2]=EX(X[B+2]); X[B+3]=EX(X[B+3]); PIN(X); SBAR(); }while(0)
  #define VRD(i) do{ vlo[i]=vtr(vp_+(((i)>>2)*4096+((i)&3)*1024)); vhi[i]=vtr(vp_+(((i)>>2)*4096+((i)&3)*1024+512)); }while(0)
  #define KRD(G,j) do{ if(G){ kload2(kf,kp0+sl_next,j); SBAR(); } }while(0)
  #define STEP(C0,C1,P0,P1,t,GK,GV,GL) do{ SBAR(); CINIT(C0,C1,t); SBAR(); \
    const lds_cptr vp_=vp0+sl_prev; \
    VRD(0); SBAR(); float sacc=(P0[0]+P0[1]); \
    GAPA(C0=__builtin_amdgcn_mfma_f32_32x32x16_bf16(kf[0],qr[0],C0,0,0,0), P0[2],P0[3],P0[4],P0[5],     pw0[0]=PKW(P0,0), pw0[1]=PKW(P0,2), pw0); \
    VRD(4); SBAR(); GAPA(C1=__builtin_amdgcn_mfma_f32_32x32x16_bf16(kf[1],qr[0],C1,0,0,0), P0[6],P0[7],P0[8],P0[9],     pw0[2]=PKW(P0,4), pw0[3]=PKW(P0,6), pw0); \
    VRD(1); SBAR(); GAPA(C0=__builtin_amdgcn_mfma_f32_32x32x16_bf16(kf[2],qr[1],C0,0,0,0),   P0[10],P0[11],P0[12],P0[13], pw1[0]=PKW(P0,8), pw1[1]=PKW(P0,10), pw1); \
    VRD(5); SBAR(); GAPA(C1=__builtin_amdgcn_mfma_f32_32x32x16_bf16(kf[3],qr[1],C1,0,0,0),   P0[14],P0[15],P1[0],P1[1],   pw1[2]=PKW(P0,12),pw1[3]=PKW(P0,14), pw1); \
    VRD(2); SBAR(); GAPA(C0=__builtin_amdgcn_mfma_f32_32x32x16_bf16(kf[4],qr[2],C0,0,0,0),   P1[2],P1[3],P1[4],P1[5],     pw2[0]=PKW(P1,0), pw2[1]=PKW(P1,2), pw2); \
    VRD(6); SBAR(); GAPA(C1=__builtin_amdgcn_mfma_f32_32x32x16_bf16(kf[5],qr[2],C1,0,0,0),   P1[6],P1[7],P1[8],P1[9],     pw2[2]=PKW(P1,4), pw2[3]=PKW(P1,6), pw2); \
    VRD(3); SBAR(); GAPA(C0=__builtin_amdgcn_mfma_f32_32x32x16_bf16(kf[6],qr[3],C0,0,0,0),   P1[10],P1[11],P1[12],P1[13], pw3[0]=PKW(P1,8), pw3[1]=PKW(P1,10), pw3); \
    VRD(7); SBAR(); GAPA(C1=__builtin_amdgcn_mfma_f32_32x32x16_bf16(kf[7],qr[3],C1,0,0,0),   P1[14],P1[15],0.f,0.f,       pw3[2]=PKW(P1,12),pw3[3]=PKW(P1,14), pw3); \
    l_reg+=sacc; \
    if(GK){DMA_K((t)+3,sl_cur);} if(GV){DMA_V((t)+1,sl_next);} \
    CMASK(C0,C1,t); \
    { float a=MX3(C0[0],C0[1],C1[0]),b=MX3(C0[2],C0[3],C1[1]); a=MX3(a,C1[2],C1[3]); \
      _Pragma("unroll") for(int r=4;r<16;r+=4){a=MX3(a,C0[r],C0[r+1]);b=MX3(b,C0[r+2],C0[r+3]);a=MX3(a,C1[r],C1[r+1]);b=MX3(b,C1[r+2],C1[r+3]);} \
      float rm=__builtin_fmaxf(a,b); { auto rr=__builtin_amdgcn_permlane32_swap(__float_as_uint(rm),__float_as_uint(rm),false,false); rm=__builtin_fmaxf(__uint_as_float(rr[0]),__uint_as_float(rr[1])); } \
      resc=false; \
      if(__builtin_expect(__any(rm>(float)THRL),0)){ const float dl=__builtin_fmaxf(rm,0.f); mhat+=dl; \
        _Pragma("unroll") for(int r=0;r<16;++r){C0[r]-=dl;C1[r]-=dl;} \
        const float f=__builtin_amdgcn_exp2f(-dl); l_reg*=f; if(hi==0)wsf[r32]=f; resc=true; } } \
    SBAR(); \
    GAPB(o[0]=__builtin_amdgcn_mfma_f32_32x32x16_bf16(PAF(0),VFR(0),o[0],0,0,0), C0,0); \
    GAPB(o[1]=__builtin_amdgcn_mfma_f32_32x32x16_bf16(PAF(0),VFR(4),o[1],0,0,0), C0,4); \
    KRD(GL,0); GAPB(o[0]=__builtin_amdgcn_mfma_f32_32x32x16_bf16(PAF(1),VFR(1),o[0],0,0,0), C0,8); \
    KRD(GL,1); GAPB(o[1]=__builtin_amdgcn_mfma_f32_32x32x16_bf16(PAF(1),VFR(5),o[1],0,0,0), C0,12); \
    KRD(GL,2); GAPB(o[0]=__builtin_amdgcn_mfma_f32_32x32x16_bf16(PAF(2),VFR(2),o[0],0,0,0), C1,0); \
    KRD(GL,3); GAPB(o[1]=__builtin_amdgcn_mfma_f32_32x32x16_bf16(PAF(2),VFR(6),o[1],0,0,0), C1,4); \
    GAPB(o[0]=__builtin_amdgcn_mfma_f32_32x32x16_bf16(PAF(3),VFR(3),o[0],0,0,0), C1,8); \
    GAPB(o[1]=__builtin_amdgcn_mfma_f32_32x32x16_bf16(PAF(3),VFR(7),o[1],0,0,0), C1,12); \
    }while(0)
  int t=1;
  #undef CMASK
  #define CMASK(P0,P1,t) do{}while(0)
  for(;t+5<NT;t+=2){
    STEP(pB0,pB1,pA0,pA1,t,true,true,true);     WAIT_BAR(2); RESC(); ROT();
    STEP(pA0,pA1,pB0,pB1,t+1,true,true,true);   WAIT_BAR(2); RESC(); ROT();
  }
  #undef CMASK
  #define CMASK(P0,P1,t) do{int jb_=(t)-(NT-4); if(jb_>=0)cmask(P0,P1,jb_,qrel,hi);}while(0)
  #define ENDW(tt) do{ if((tt)+3<NT){WAIT_BAR(2);} else if((tt)+2<NT){WAIT_BAR(1);} else {WAIT_BAR(0);} }while(0)
  for(;t+1<NT;t+=2){
    STEP(pB0,pB1,pA0,pA1,t,(t+3<NT),(t+1<NT),(t+1<NT));       ENDW(t);   RESC(); ROT();
    STEP(pA0,pA1,pB0,pB1,t+1,(t+4<NT),(t+2<NT),(t+2<NT));     ENDW(t+1); RESC(); ROT();
  }
  STEP(pB0,pB1,pA0,pA1,NT-1,false,false,false); RESC();
  { float sacc=pB0[0]+pB0[1]; _Pragma("unroll") for(int r=2;r<16;++r)sacc+=pB0[r]; _Pragma("unroll") for(int r=0;r<16;++r)sacc+=pB1[r]; l_reg+=sacc;
    pw0=(u32x4){PKW(pB0,0),PKW(pB0,2),PKW(pB0,4),PKW(pB0,6)};pw1=(u32x4){PKW(pB0,8),PKW(pB0,10),PKW(pB0,12),PKW(pB0,14)};pw2=(u32x4){PKW(pB1,0),PKW(pB1,2),PKW(pB1,4),PKW(pB1,6)};pw3=(u32x4){PKW(pB1,8),PKW(pB1,10),PKW(pB1,12),PKW(pB1,14)};
    SBAR(); pv(o,vb0+sl_cur,PAF(0),PAF(1),PAF(2),PAF(3)); }
  #undef PKW
  #undef PAF
  #undef VFR
  #undef PIN
  #undef MX3
  #undef GAPA
  #undef GAPB
  #undef EX
  #undef VRD
  #undef KRD
  #undef STEP
  #undef ENDW
  {auto rr=__builtin_amdgcn_permlane32_swap(__float_as_uint(l_reg),__float_as_uint(l_reg),false,false);l_reg=__uint_as_float(rr[0])+__uint_as_float(rr[1]);}
  if(hi==0)wsf[32+r32]=l_reg;asm volatile("s_waitcnt lgkmcnt(0)":::"memory");
  float rli[16];
  #pragma unroll
  for(int r=0;r<16;++r)rli[r]=__builtin_amdgcn_rcpf(wsf[32+crow(r,hi)]);
  bf16*Ow=O+(rowbase+q0+wid*QBLK)*QP+h*D;
  { bf16*stg=(bf16*)(shm+LDS_OST)+wid*2048;
    #pragma unroll
    for(int r=0;r<16;++r){const int orow=crow(r,hi);
      #pragma unroll
      for(int d0=0;d0<2;++d0)stg[orow*64+d0*32+r32]=__float2bfloat16(o[d0][r]*rli[r]);}
    asm volatile("s_waitcnt lgkmcnt(0)":::"memory");
    #pragma unroll
    for(int i=0;i<4;++i){const int row=i*8+(lane>>3),ch=lane&7; const u32x4 v=*(const u32x4*)(stg+row*64+ch*8); ATTN_STORE16(Ow+(long)row*QP+ch*8,v);} }
  asm volatile("s_waitcnt lgkmcnt(0)\n\ts_barrier":::"memory");
  #undef DMA_K
  #undef DMA_V
  #undef CMASK
  #undef START
  #undef RESC
  #undef ROT
  #undef CINIT
}
constexpr int ATTN_LDS_BYTES=LDS_BYTES;
struct AttnTensors { const bf16* Q; const bf16* K; const bf16* V; bf16* O; const float* NCL; };
struct AttnUnit { int bh; int qb; };
struct AttnQueue { unsigned* cnt; float th; int xcc; volatile __attribute__((address_space(3))) unsigned* slot; };
template<int THRL=8,class Hook> __device__ __forceinline__ void attn_phase_dyn(char*lds,const AttnTensors&T_,const AttnQueue&Qd,const Hook&hook){
  AttnTensors T;
  { unsigned long long q_=(unsigned long long)T_.Q,k_=(unsigned long long)T_.K,v_=(unsigned long long)T_.V,o_=(unsigned long long)T_.O,c_=(unsigned long long)T_.NCL; asm volatile("":"+s"(q_),"+s"(k_),"+s"(v_),"+s"(o_),"+s"(c_));
    typedef __attribute__((address_space(1))) bf16 gbf; typedef __attribute__((address_space(1))) float gf;
    T.Q=(const bf16*)(const gbf*)q_; T.K=(const bf16*)(const gbf*)k_; T.V=(const bf16*)(const gbf*)v_; T.O=(bf16*)(gbf*)o_; T.NCL=(const float*)(const gf*)c_; }
  int it=0;
  for(int qq=0;qq<BATCH;++qq){ const int b=(Qd.xcc+qq)&(BATCH-1);
    for(;;++it){
      int tid_=threadIdx.x; asm volatile("":"+v"(tid_));
      if(tid_==0) Qd.slot[it&1]=__hip_atomic_fetch_add(Qd.cnt+64*b,1u,__ATOMIC_RELAXED,__HIP_MEMORY_SCOPE_AGENT);
      __syncthreads();
      const int u=__builtin_amdgcn_readfirstlane((int)Qd.slot[it&1]);
      if(u>=NHEAD*NQB) break;
      const int qb=NQB-1-(u>>3),h=u&(NHEAD-1),bh=b*NHEAD+h;
      const float* nrow=T.NCL+(long)bh*SEQ; const int ntile=4*(qb+1),lane_=tid_&63;
      const float ref=nrow[qb*QB]-Qd.th;
      const bool ok0=(lane_<ntile)&&(nrow[(lane_<ntile?lane_:0)*KVBLK+KVBLK-1]<=ref), ok1=(lane_+64<ntile)&&(nrow[(lane_+64<ntile?lane_+64:0)*KVBLK+KVBLK-1]<=ref);
      int t0=__builtin_popcountll(__ballot(ok0))+__builtin_popcountll(__ballot(ok1)); t0&=~1; if(t0>ntile-4)t0=ntile-4;
      t0=__builtin_amdgcn_readfirstlane(t0);
      attn_unit<THRL>(b,h,qb,t0,T.Q,T.K,T.V,T.O,nrow,lds);
      hook(b,u);
    }
    ++it;
  }
}
#undef SBAR
#undef WAIT_BAR
}

constexpr int NWAVES = 8;
#ifndef MK_PER_PHASE
#define MK_PER_PHASE 0
#endif

constexpr int D = 1024, BATCH = 8, SEQ = 8192, M = BATCH * SEQ, DEPTH = 4;
constexpr int IN_COLS = 5384, OFF_CONV = 256, OFF_Q = 768, OFF_K = 1280, OFF_V = 1792, OFF_F = 2304, OFF_G = 2312;
constexpr int NIN = 5376;
constexpr int DFF = 2816, DFFE = 3584, NEXP = 8, CONVK = 31;
constexpr float LOG2E = 1.4426950408889634f;

constexpr size_t MiB = 1u << 20;
constexpr size_t WS_CTL = 0, CTL_ZERO_BYTES = 256 * 1024;
constexpr size_t WS_NLF = 1 * MiB;
constexpr size_t WS_NCL = 3 * MiB;
constexpr size_t WS_WIN = 5 * MiB;
constexpr size_t WS_WBR = 16 * MiB;
constexpr size_t WS_WOUT = 18 * MiB;
constexpr size_t WS_WFF = 20 * MiB;
constexpr size_t WS_HB = 188 * MiB;
constexpr size_t WS_Y = 316 * MiB;
constexpr size_t WS_K = 444 * MiB, WS_V = 508 * MiB;
constexpr size_t WS_P = 572 * MiB, WS_Z = 604 * MiB;
constexpr size_t WS_G = 636 * MiB;
constexpr size_t WS_HID = 316 * MiB;
constexpr size_t HID_SLOT = 232 * MiB;
constexpr int MOE_SKIPR = 3;
static_assert((size_t)264 * 256 * DFFE <= HID_SLOT && WS_HID + 2 * HID_SLOT <= 800 * MiB, "MoE hidden slots");
constexpr size_t WS_LIST = 800 * MiB;
constexpr size_t WS_MOEW = 808 * MiB;
constexpr size_t WS_XBW = 820 * MiB;
constexpr size_t WS_END = 1020 * MiB;
constexpr size_t WFF_W2_DENSE = (size_t)2 * DFF * D * 2;
constexpr size_t WFF_W13_E = (size_t)2 * DFFE * D * 2, WFF_W2_E = (size_t)D * DFFE * 2, WFF_W2_MOE = 8 * WFF_W13_E;
constexpr size_t WS_WG8 = WS_WIN + (size_t)2304 * D * 2;
constexpr size_t WS_H8 = WS_WFF + 100 * MiB;
constexpr int DENSE8_FROM = 2;
constexpr size_t WFF8_W2_DENSE = (size_t)2 * DFF * D;
constexpr size_t WFF8_W13_E = (size_t)2 * DFFE * D, WFF8_W2_E = (size_t)D * DFFE, WFF8_W2_OFF = 8 * WFF8_W13_E;
static_assert(WS_WIN + (size_t)NIN * D * 2 <= WS_WBR && WS_WFF + WFF_W2_MOE + 8 * WFF_W2_E <= WS_HB && WS_G + (size_t)M * 3072 * 2 <= WS_END && WS_HID + (size_t)264 * 256 * DFFE * 2 <= WS_LIST, "d_ws map");
constexpr int CW_TMO = 0;
constexpr int CW_MOECNT = 64;
constexpr int CW_ATTQ = 8192;
constexpr int CW_BAR = 4096;

constexpr int RING_OFF = 0, RING_BYTES = 131072;
constexpr int LDSCTL_OFF = RING_BYTES, MISC_OFF = LDSCTL_OFF + 320;
constexpr int MOETAB_OFF = LDSCTL_OFF + 1024;
constexpr int LDS_BYTES = 147456;
constexpr int GBIAS_OFF = MOETAB_OFF + 272 * 4;
static_assert(MISC_OFF + 128 <= MOETAB_OFF && GBIAS_OFF % 16 == 0 && GBIAS_OFF + (3072 + 128) * 4 <= LDS_BYTES, "LDS map");

#define GAS __attribute__((address_space(1)))
#define LAS __attribute__((address_space(3)))
typedef unsigned short bf16;
typedef unsigned v4u __attribute__((ext_vector_type(4)));
typedef unsigned v2u __attribute__((ext_vector_type(2)));
typedef float f32x4 __attribute__((ext_vector_type(4)));
typedef GAS unsigned gu32;
#define RLX_AGENT __ATOMIC_RELAXED, __HIP_MEMORY_SCOPE_AGENT
#define LDS_WAIT() asm volatile("s_waitcnt lgkmcnt(0)" ::: "memory")
#define VM_WAIT() asm volatile("s_waitcnt vmcnt(0)" ::: "memory")
__device__ __forceinline__ unsigned f2bf(float f) { unsigned u = __builtin_bit_cast(unsigned, f); return (u + 0x7fffu + ((u >> 16) & 1u)) >> 16; }
__device__ __forceinline__ unsigned pk2(float lo, float hi) { return f2bf(lo) | (f2bf(hi) << 16); }
__device__ __forceinline__ float bflo(unsigned w) { return __uint_as_float(w << 16); }
__device__ __forceinline__ float bfhi(unsigned w) { return __uint_as_float(w & 0xffff0000u); }

#define XB_TMO      128
#define XB_XCNT(j)  (256  + 64 * (j))
#define XB_XSUB(j)  (1280 + 64 * (j))
#define XB_XGEN(j)  (2304 + 64 * (j))
#define XB_TOP      3328
#define XB_TOPGEN   3392
#define XCD_BAR_WORDS 3456
#define XB_SPIN_CAP (1u << 18)

__device__ __forceinline__ unsigned xb_ld(unsigned* p)              { return __hip_atomic_load(p, __ATOMIC_RELAXED, __HIP_MEMORY_SCOPE_AGENT); }
__device__ __forceinline__ unsigned xb_add(unsigned* p, unsigned v) { return __hip_atomic_fetch_add(p, v, __ATOMIC_RELAXED, __HIP_MEMORY_SCOPE_AGENT); }
__device__ __forceinline__ unsigned xb_xcc_id() { return (unsigned)__builtin_amdgcn_s_getreg((3 << 11) | 20) & 0xFu; }
#define XB_SPIN(cond, bar) do { unsigned _sp = 0; while (cond) { __builtin_amdgcn_s_sleep(1); \
    if ((++_sp & 255u) == 0u) { if (xb_ld(&(bar)[XB_TMO])) break; if (_sp > XB_SPIN_CAP) { atomicAdd(&(bar)[XB_TMO], 1u); break; } } } } while (0)

struct XcdBarrier {
    unsigned* bar; unsigned x;
    volatile LAS unsigned* st;
};

__device__ __forceinline__ XcdBarrier xcd_barrier_post(unsigned* bar, volatile LAS unsigned* st) {
    XcdBarrier b; b.bar = bar; b.x = xb_xcc_id(); b.st = st;
    if (threadIdx.x == 0) (void)xb_add(&bar[XB_XCNT(b.x)], 1u);
    return b;
}
__device__ __forceinline__ void xcd_barrier_complete(unsigned* bar, unsigned x, unsigned& nloc, unsigned& nx) {
    const unsigned G = gridDim.x * gridDim.y * gridDim.z;
    unsigned sum, cnt, mine, sp = 0u;
    for (;;) {
        sum = 0u; cnt = 0u; mine = 0u;
#pragma unroll
        for (unsigned j = 0; j < 16; ++j) { const unsigned c = xb_ld(&bar[XB_XCNT(j)]); sum += c; cnt += (c > 0u) ? 1u : 0u; mine = (j == x) ? c : mine; }
        if (sum == G) break;
        __builtin_amdgcn_s_sleep(1);
        if ((++sp & 255u) == 0u) { if (xb_ld(&bar[XB_TMO])) break; if (sp > XB_SPIN_CAP) { atomicAdd(&bar[XB_TMO], 1u); break; } }
    }
    nloc = mine > 0u ? mine : 1u; nx = cnt > 0u ? cnt : 1u;
}

__device__ __forceinline__ void xcd_barrier(const XcdBarrier& b) {
    asm volatile("s_waitcnt vmcnt(0)" ::: "memory");
    __syncthreads();
    if (threadIdx.x == 0) {
        unsigned* bar = b.bar;
        __builtin_amdgcn_s_waitcnt(0);
        unsigned nloc = b.st[0], nx = b.st[1];
        if (nloc == 0u) { xcd_barrier_complete(bar, b.x, nloc, nx); b.st[0] = nloc; b.st[1] = nx; }
        const unsigned old = xb_add(&bar[XB_XSUB(b.x)], 1u);
        const unsigned gen = old / nloc;
        if (old + 1u == (gen + 1u) * nloc) {
            __builtin_amdgcn_fence(__ATOMIC_RELEASE, "agent");
            asm volatile("s_waitcnt vmcnt(0)" ::: "memory");
            const unsigned og = xb_add(&bar[XB_TOP], 1u);
            const unsigned tg = og / nx;
            if (og + 1u == (tg + 1u) * nx) xb_add(&bar[XB_TOPGEN], 1u);
            else XB_SPIN(xb_ld(&bar[XB_TOPGEN]) == tg, bar);
            __builtin_amdgcn_fence(__ATOMIC_ACQUIRE, "agent");
            xb_add(&bar[XB_XGEN(b.x)], 1u);
            asm volatile("s_waitcnt vmcnt(0)" ::: "memory");
        } else {
            XB_SPIN(xb_ld(&bar[XB_XGEN(b.x)]) == gen, bar);
            __builtin_amdgcn_fence(__ATOMIC_ACQUIRE, "agent");
            asm volatile("s_waitcnt vmcnt(0)" ::: "memory");
        }
    }
    __syncthreads();
}

struct Frame {
    LAS unsigned char* lds;
    volatile LAS unsigned* MISC;
    int vcu, G;
};
struct Site {
    gu32* ctl; unsigned char* ws; const float* const __attribute__((address_space(4)))* in; float* out;
    int tid, lane, wave;
};
__device__ __forceinline__ Site make_site() {
    Site P; int t_ = threadIdx.x; asm volatile("" : "+v"(t_)); P.tid = t_; P.lane = t_ & 63; P.wave = __builtin_amdgcn_readfirstlane(t_ >> 6);
    unsigned long long kp_ = (unsigned long long)__builtin_amdgcn_kernarg_segment_ptr(); asm volatile("" : "+s"(kp_));
    P.in = (const float* const __attribute__((address_space(4)))*)kp_;
    P.out = (float*)(GAS float*)(*(const __attribute__((address_space(4))) unsigned long long*)(kp_ + 200));
    P.ws = (unsigned char*)(GAS unsigned char*)(*(const __attribute__((address_space(4))) unsigned long long*)(kp_ + 208));
    P.ctl = (gu32*)(P.ws + WS_CTL);
    return P;
}
__device__ __forceinline__ float wave_sum(float v, int lane) {
    (void)lane;
    v += __int_as_float(__builtin_amdgcn_update_dpp(0, __float_as_int(v), 0xB1, 0xF, 0xF, true));
    v += __int_as_float(__builtin_amdgcn_update_dpp(0, __float_as_int(v), 0x4E, 0xF, 0xF, true));
    v += __int_as_float(__builtin_amdgcn_update_dpp(0, __float_as_int(v), 0x141, 0xF, 0xF, true));
    v += __int_as_float(__builtin_amdgcn_update_dpp(0, __float_as_int(v), 0x140, 0xF, 0xF, true));
    v += __int_as_float(__builtin_amdgcn_update_dpp(0, __float_as_int(v), 0x142, 0xA, 0xF, false));
    v += __int_as_float(__builtin_amdgcn_update_dpp(0, __float_as_int(v), 0x143, 0xC, 0xF, false));
    return __int_as_float(__builtin_amdgcn_readlane(__float_as_int(v), 63));
}

__device__ __forceinline__ void transpose_item(const float* colp, size_t sstride, bf16* WT, int K, int n0, int k0, LAS float* scr, int lane) {
    const float* sp = colp + (size_t)k0 * sstride;
    const float* lp = sp + (size_t)(lane >> 5) * sstride;
    LAS float* sq = scr + (lane >> 5) * 33 + (lane & 31);
#pragma unroll
    for (int hb = 0; hb < 2; ++hb) { float tv[16];
#pragma unroll
        for (int i = 0; i < 16; ++i) { tv[i] = *lp; lp += 2 * sstride; }
#pragma unroll
        for (int i = 0; i < 16; ++i) sq[(2 * (16 * hb + i)) * 33] = tv[i]; }
    LDS_WAIT(); asm volatile("" ::: "memory");
    const int c = lane & 7;
#pragma unroll
    for (int j = 0; j < 4; ++j) { const int n = (lane >> 3) + 8 * j; const LAS float* s = scr + (8 * c) * 33 + n;
        v4u o; o.x = pk2(s[0 * 33], s[1 * 33]); o.y = pk2(s[2 * 33], s[3 * 33]); o.z = pk2(s[4 * 33], s[5 * 33]); o.w = pk2(s[6 * 33], s[7 * 33]);
        *(GAS v4u*)(WT + (size_t)(n0 + n) * K + k0 + 8 * c) = o; }
    LDS_WAIT(); asm volatile("" ::: "memory");
}
__device__ __forceinline__ void transpose_item8(const float* colp, size_t sstride, unsigned char* WT8, int K, int n0, int k0, LAS float* scr, int lane, const float sc) {
    const float* sp = colp + (size_t)k0 * sstride;
    const float* lp = sp + (size_t)(lane >> 5) * sstride;
    LAS float* sq = scr + (lane >> 5) * 33 + (lane & 31);
#pragma unroll
    for (int hb = 0; hb < 2; ++hb) { float tv[16];
#pragma unroll
        for (int i = 0; i < 16; ++i) { tv[i] = *lp; lp += 2 * sstride; }
#pragma unroll
        for (int i = 0; i < 16; ++i) sq[(2 * (16 * hb + i)) * 33] = tv[i]; }
    LDS_WAIT(); asm volatile("" ::: "memory");
    const int c = lane & 7;
#pragma unroll
    for (int j = 0; j < 4; ++j) { const int n = (lane >> 3) + 8 * j; const LAS float* s = scr + (8 * c) * 33 + n;
        int lo = 0, hi = 0;
        lo = __builtin_amdgcn_cvt_pk_fp8_f32(s[0 * 33] * sc, s[1 * 33] * sc, lo, false); lo = __builtin_amdgcn_cvt_pk_fp8_f32(s[2 * 33] * sc, s[3 * 33] * sc, lo, true);
        hi = __builtin_amdgcn_cvt_pk_fp8_f32(s[4 * 33] * sc, s[5 * 33] * sc, hi, false); hi = __builtin_amdgcn_cvt_pk_fp8_f32(s[6 * 33] * sc, s[7 * 33] * sc, hi, true);
        *(GAS v2u*)(WT8 + (size_t)(n0 + n) * K + k0 + 8 * c) = (v2u){(unsigned)lo, (unsigned)hi}; }
    LDS_WAIT(); asm volatile("" ::: "memory");
}
__device__ __forceinline__ int inproj_src_col(int p) {
    const int t = p >> 8, q = p & 255;
    if (t == 0) return q;
    if (t <= 2) { const int ch = (t - 1) * 128 + 4 * (q >> 3) + (q & 3); return OFF_CONV + ((q >> 2) & 1) * 256 + ch; }
    if (t <= 6) { const int base = t <= 4 ? OFF_Q + 256 * (t - 3) : OFF_K + 256 * (t - 5); return base + 64 * ((q >> 5) & 3) + 32 * (q >> 7) + (q & 31); }
    if (t <= 8) return OFF_V + 256 * (t - 7) + q;
    return OFF_G + 256 * (t - 9) + q;
}
template <bool F8> __device__ __forceinline__ void convert_block64(const float* sp, size_t ss, unsigned char* dp) {
    float v[64];
#pragma unroll
    for (int j = 0; j < 64; ++j) { v[j] = *sp; sp += ss; }
    if constexpr (F8) {
#pragma unroll
        for (int q = 0; q < 4; ++q) { int t[4];
#pragma unroll
            for (int c = 0; c < 4; ++c) { const int i = 16 * q + 4 * c; int w = 0;
                w = __builtin_amdgcn_cvt_pk_fp8_f32(v[i] * 32.f, v[i + 1] * 32.f, w, false); w = __builtin_amdgcn_cvt_pk_fp8_f32(v[i + 2] * 32.f, v[i + 3] * 32.f, w, true); t[c] = w; }
            *(GAS v4u*)(dp + 16 * q) = (v4u){(unsigned)t[0], (unsigned)t[1], (unsigned)t[2], (unsigned)t[3]}; }
    } else {
#pragma unroll
        for (int q = 0; q < 8; ++q) { const int i = 8 * q; v4u o; o.x = pk2(v[i], v[i + 1]); o.y = pk2(v[i + 2], v[i + 3]); o.z = pk2(v[i + 4], v[i + 5]); o.w = pk2(v[i + 6], v[i + 7]);
            *(GAS v4u*)(dp + 16 * q) = o; }
    }
}
__device__ __forceinline__ void convert_ffn_slice(const Site& P, int l, int slice) {
    const bool moe = (l & 1) != 0; const int li = l >> 1, lane = P.lane;
    if (!moe) {
        constexpr int I13 = 16 * (2 * DFF / 64), I2 = (DFF / 64) * 16;
        const int it = slice * 8 + P.wave; if (it >= I13 + I2) return;
        const float* w1 = P.in[18] + (size_t)li * D * DFF; const float* w3 = P.in[19] + (size_t)li * D * DFF; const float* w2 = P.in[20] + (size_t)li * DFF * D;
        const bool d8 = l >= DENSE8_FROM;
        unsigned char* W13 = P.ws + WS_WFF; unsigned char* W2 = P.ws + WS_WFF + (d8 ? WFF8_W2_DENSE : WFF_W2_DENSE);
        const float* sp; size_t ss; size_t doff; unsigned char* db;
        if (it < I13) { const int kb = it / (2 * DFF / 64), nb = it % (2 * DFF / 64); const int p = 64 * nb + lane; const int ch = (p >> 8) * 128 + (p & 127);
            sp = (((p >> 7) & 1) ? w3 : w1) + (size_t)(64 * kb) * DFF + ch; ss = DFF; db = W13; doff = (size_t)p * D + 64 * kb; }
        else { const int r = it - I13; const int kb = r / 16, nb = r % 16; const int n = 64 * nb + lane;
            sp = w2 + (size_t)(64 * kb) * D + n; ss = D; db = W2; doff = (size_t)n * DFF + 64 * kb; }
        if (d8) convert_block64<true>(sp, ss, db + doff); else convert_block64<false>(sp, ss, db + 2 * doff);
    } else {
        constexpr int I13 = 16 * (2 * DFFE / 64), I2 = (DFFE / 64) * 16, IE = I13 + I2;
        for (int j = 0; j < 2; ++j) { const int it = slice * 16 + j * 8 + P.wave; if (it >= 8 * IE) break;
            const int e = it / IE; const int r = it - e * IE;
            const float* w1 = P.in[22] + ((size_t)li * NEXP + e) * D * DFFE; const float* w3 = P.in[23] + ((size_t)li * NEXP + e) * D * DFFE; const float* w2 = P.in[24] + ((size_t)li * NEXP + e) * DFFE * D;
            unsigned char* W13 = P.ws + WS_WFF + (size_t)e * WFF8_W13_E; unsigned char* W2 = P.ws + WS_WFF + WFF8_W2_OFF + (size_t)e * WFF8_W2_E;
            const float* sp; size_t ss; unsigned char* dp;
            if (r < I13) { const int kb = r / (2 * DFFE / 64), nb = r % (2 * DFFE / 64); const int p = 64 * nb + lane; const int ch = (p >> 8) * 128 + (p & 127);
                sp = (((p >> 7) & 1) ? w3 : w1) + (size_t)(64 * kb) * DFFE + ch; ss = DFFE; dp = W13 + (size_t)p * D + 64 * kb; }
            else { const int r2 = r - I13; const int kb = r2 / 16, nb = r2 % 16; const int n = 64 * nb + lane;
                sp = w2 + (size_t)(64 * kb) * D + n; ss = D; dp = W2 + (size_t)n * DFFE + 64 * kb; }
            convert_block64<true>(sp, ss, dp); }
    }
}
__device__ __forceinline__ void convert_layer_weights(const Frame& F, const Site& P, int l) {
    LAS float* scr = (LAS float*)(F.lds + RING_OFF + P.wave * 16384);
    const int gw = F.vcu * NWAVES + P.wave, NGW = F.G * NWAVES, lane = P.lane;
    bf16* WIN = (bf16*)(P.ws + WS_WIN); bf16* WBR = (bf16*)(P.ws + WS_WBR); bf16* WOUT = (bf16*)(P.ws + WS_WOUT);
    const float* w_in = P.in[2] + (size_t)l * D * IN_COLS;
    const float* w_brc = P.in[14] + (size_t)l * 256 * D; const float* w_bra = P.in[15] + (size_t)l * 512 * D; const float* w_out = P.in[16] + (size_t)l * D * D;
    constexpr int I_IN = 16 * (NIN / 32), I_BC = 4 * 32, I_BA = 8 * 32, I_OUT = 16 * 32;
    const int NITEMS = I_IN + I_BC + I_BA + I_OUT;
    for (int it = gw; it < NITEMS; it += NGW) {
        int r = it;
        if (r < I_IN) { const int kb = r / (NIN / 32), nb = r % (NIN / 32); const int p = 32 * nb + (lane & 31);
            if (nb < 2304 / 32) transpose_item(w_in + inproj_src_col(p), IN_COLS, WIN, D, 32 * nb, 64 * kb, scr, lane);
            else transpose_item8(w_in + inproj_src_col(p), IN_COLS, P.ws + WS_WG8, D, 32 * nb - 2304, 64 * kb, scr, lane, 32.f * LOG2E);
            continue; } r -= I_IN;
        if (r < I_BC) { const int kb = r / 32, nb = r % 32;
            transpose_item(w_brc + 32 * nb + (lane & 31), D, WBR + 256, D, 32 * nb, 64 * kb, scr, lane); continue; } r -= I_BC;
        if (r < I_BA) { const int kb = r / 32, nb = r % 32;
            transpose_item(w_bra + 32 * nb + (lane & 31), D, WBR + 512, D, 32 * nb, 64 * kb, scr, lane); continue; } r -= I_BA;
        if (r < I_OUT) { const int kb = r / 32, nb = r % 32;
            transpose_item(w_out + 32 * nb + (lane & 31), D, WOUT, D, 32 * nb, 64 * kb, scr, lane); }
    }
    {
        const float* pw = P.in[5] + (size_t)l * 4 * 64 * 64; const float* ps = P.in[6] + (size_t)l * 256; const float* wbp = P.in[13] + (size_t)l * 256 * D;
        const int gt = F.vcu * (NWAVES * 64) + P.tid, NT = F.G * NWAVES * 64;
        for (int item = gt; item < 1024 * 32; item += NT) {
            const int n = item & 1023, kb = item >> 10, k0 = 8 * kb, g = k0 >> 6, c0 = k0 & 63;
            float a[8];
#pragma unroll
            for (int j = 0; j < 8; ++j) a[j] = 0.f;
            for (int cp = 0; cp < 64; ++cp) { const float wv = ps[g * 64 + cp] * wbp[(size_t)(g * 64 + cp) * D + n];
#pragma unroll
                for (int j = 0; j < 8; ++j) a[j] += pw[(size_t)(g * 64 + c0 + j) * 64 + cp] * wv; }
            v4u o; o.x = pk2(a[0], a[1]); o.y = pk2(a[2], a[3]); o.z = pk2(a[4], a[5]); o.w = pk2(a[6], a[7]);
            *(GAS v4u*)(WBR + (size_t)n * D + k0) = o;
        }
    }
}

template <bool XBF> struct RowRaw;
template <> struct RowRaw<false> { f32x4 a[4]; };
template <> struct RowRaw<true> { v4u a[2]; };
template <bool XBF> __device__ __forceinline__ RowRaw<XBF> load_row(const void* xsrc, int row, int lane) {
    RowRaw<XBF> r;
    if constexpr (XBF) { const GAS v4u* p = (const GAS v4u*)((const bf16*)xsrc + (size_t)row * D) + lane; r.a[0] = p[0]; r.a[1] = p[64]; }
    else { const GAS f32x4* p = (const GAS f32x4*)((const float*)xsrc + (size_t)row * D) + lane;
#pragma unroll
        for (int j = 0; j < 4; ++j) r.a[j] = p[64 * j]; }
    return r;
}
template <bool XBF> __device__ __forceinline__ void unpack_row(const RowRaw<XBF>& r, f32x4 (&v)[4]) {
    if constexpr (XBF) {
#pragma unroll
        for (int j2 = 0; j2 < 2; ++j2) { const v4u w = r.a[j2]; v[2 * j2] = (f32x4){bflo(w.x), bfhi(w.x), bflo(w.y), bfhi(w.y)}; v[2 * j2 + 1] = (f32x4){bflo(w.z), bfhi(w.z), bflo(w.w), bfhi(w.w)}; } }
    else {
#pragma unroll
        for (int j = 0; j < 4; ++j) v[j] = r.a[j]; }
}
#ifndef NORM_AHEAD
#define NORM_AHEAD 4
#endif
template <int MODE, bool XBF, bool H8 = (MODE == 2)>
__device__ __forceinline__ void norm_phase(const Frame& F, const Site& P, const void* xsrc, const float* gvec, const float* w8, size_t w8stride, const float* b8, unsigned* gcnt) {
    const int lane = P.lane;
    bf16* HB = (bf16*)(P.ws + WS_HB);
    int kb[4];
#pragma unroll
    for (int j = 0; j < 4; ++j) kb[j] = XBF ? 8 * lane + 512 * (j >> 1) + 4 * (j & 1) : 4 * lane + 256 * j;
    f32x4 gv[4];
#pragma unroll
    for (int j = 0; j < 4; ++j) gv[j] = *(const f32x4*)(gvec + kb[j]);
    LAS unsigned* lcnt = (LAS unsigned*)(F.lds + RING_OFF);
    LAS float* wfs = (LAS float*)(F.lds + RING_OFF + 1024);
    if constexpr (MODE != 1) {
        for (int idx = P.tid; idx < 8 * D; idx += NWAVES * 64) { const int k = idx >> 3, h = idx & 7; wfs[h * D + k] = w8[(size_t)k * w8stride + h] * gvec[k]; }
        __syncthreads();
    }
    float* NLF = (float*)(P.ws + WS_NLF);
    unsigned* list = (unsigned*)(P.ws + WS_LIST); float* moew = (float*)(P.ws + WS_MOEW);
    for (int rb = F.vcu; rb < M / 256; rb += F.G) {
        const int row0 = rb * 256 + P.wave * 32;
        if constexpr (MODE == 2) { if (P.tid < 32) lcnt[P.tid] = 0u; __syncthreads(); }
        int my_e0 = 0, my_e1 = 0; float my_w0 = 0.f, my_w1 = 0.f;
        constexpr int AH = XBF ? NORM_AHEAD : 2;
        RowRaw<XBF> nr[AH];
#pragma unroll
        for (int a = 0; a < AH; ++a) nr[a] = load_row<XBF>(xsrc, row0 + a, lane);
#pragma unroll 1
        for (int i = 0; i < 32; ++i) {
            f32x4 v[4]; float s = 0.f;
            { unpack_row<XBF>(nr[0], v);
#pragma unroll
              for (int a = 0; a + 1 < AH; ++a) nr[a] = nr[a + 1];
              nr[AH - 1] = load_row<XBF>(xsrc, row0 + (i + AH < 32 ? i + AH : 31), lane); }
            {
            const int row = row0 + i;
#pragma unroll
            for (int j = 0; j < 4; ++j) s += (v[j].x * v[j].x + v[j].y * v[j].y) + (v[j].z * v[j].z + v[j].w * v[j].w);
            const float rstd = __builtin_amdgcn_rsqf(wave_sum(s, lane) * (1.f / D) + 1e-6f);
            if constexpr (XBF) {
                v2u q8[2];
#pragma unroll
                for (int j2 = 0; j2 < 2; ++j2) { const f32x4 a = v[2 * j2] * rstd * gv[2 * j2], b = v[2 * j2 + 1] * rstd * gv[2 * j2 + 1];
                    if constexpr (H8 || MODE == 0) { int lo = 0, hi = 0;
                        lo = __builtin_amdgcn_cvt_pk_fp8_f32(a.x, a.y, lo, false); lo = __builtin_amdgcn_cvt_pk_fp8_f32(a.z, a.w, lo, true);
                        hi = __builtin_amdgcn_cvt_pk_fp8_f32(b.x, b.y, hi, false); hi = __builtin_amdgcn_cvt_pk_fp8_f32(b.z, b.w, hi, true);
                        q8[j2] = (v2u){(unsigned)lo, (unsigned)hi}; }
                    if constexpr (!H8) *((GAS v4u*)(HB + (size_t)row * D) + lane + 64 * j2) = (v4u){pk2(a.x, a.y), pk2(a.z, a.w), pk2(b.x, b.y), pk2(b.z, b.w)}; }
                if constexpr (H8 || MODE == 0) {
                    unsigned char* r8 = (H8 ? (unsigned char*)HB : P.ws + WS_H8) + (size_t)row * D;
                    const bool odd = (lane & 1) != 0;
                    const unsigned s0 = odd ? q8[0].x : q8[1].x, s1 = odd ? q8[0].y : q8[1].y;
                    const unsigned g0 = (unsigned)__builtin_amdgcn_update_dpp(0, (int)s0, 0xB1, 0xF, 0xF, true), g1 = (unsigned)__builtin_amdgcn_update_dpp(0, (int)s1, 0xB1, 0xF, 0xF, true);
                    const v4u o = odd ? (v4u){g0, g1, q8[1].x, q8[1].y} : (v4u){q8[0].x, q8[0].y, g0, g1};
                    *(GAS v4u*)(r8 + (odd ? 512 : 0) + 8 * (lane & ~1)) = o; }
            } else {
                GAS unsigned long long* o8 = (GAS unsigned long long*)(HB + (size_t)row * D) + lane;
#pragma unroll
                for (int j = 0; j < 4; ++j) o8[64 * j] = (unsigned long long)pk2(v[j].x * rstd * gv[j].x, v[j].y * rstd * gv[j].y) | ((unsigned long long)pk2(v[j].z * rstd * gv[j].z, v[j].w * rstd * gv[j].w) << 32);
                if constexpr (MODE == 0) {
#pragma unroll
                    for (int j = 0; j < 4; ++j) { const f32x4 a = v[j] * rstd * gv[j]; int w = 0; w = __builtin_amdgcn_cvt_pk_fp8_f32(a.x, a.y, w, false); w = __builtin_amdgcn_cvt_pk_fp8_f32(a.z, a.w, w, true);
                        *((GAS unsigned*)(P.ws + WS_H8 + (size_t)row * D) + lane + 64 * j) = (unsigned)w; } }
            }
            if constexpr (MODE != 1) {
                float f[8];
#pragma unroll
                for (int h = 0; h < 8; ++h) { f32x4 fa = v[0] * *(const LAS f32x4*)(wfs + h * D + kb[0]);
#pragma unroll
                    for (int j = 1; j < 4; ++j) fa += v[j] * *(const LAS f32x4*)(wfs + h * D + kb[j]);
                    f[h] = (fa[0] + fa[1]) + (fa[2] + fa[3]); }
                float red;
                { const bool b5 = (lane & 32) != 0, b4 = (lane & 16) != 0, b3 = (lane & 8) != 0;
#define XCH(v, o) __int_as_float(__builtin_amdgcn_ds_bpermute((lane ^ (o)) << 2, __float_as_int(v)))
                  float g4[4];
#pragma unroll
                  for (int j = 0; j < 4; ++j) { const float send = b5 ? f[j] : f[4 + j], keep = b5 ? f[4 + j] : f[j]; g4[j] = keep + XCH(send, 32); }
                  float g2[2];
#pragma unroll
                  for (int j = 0; j < 2; ++j) { const float send = b4 ? g4[j] : g4[2 + j], keep = b4 ? g4[2 + j] : g4[j]; g2[j] = keep + XCH(send, 16); }
                  { const float send = b3 ? g2[0] : g2[1], keep = b3 ? g2[1] : g2[0]; red = keep + XCH(send, 8); }
                  red += XCH(red, 4); red += XCH(red, 2); red += XCH(red, 1);
#undef XCH
                  red *= rstd; }
                if constexpr (MODE == 0) {
                    if ((lane & 7) == 0) { const int h = lane >> 3; const float z = red + b8[h];
                        NLF[(size_t)row * 8 + h] = fmaxf(-z, 0.f) * LOG2E + __builtin_amdgcn_logf(1.0f + __builtin_amdgcn_exp2f(-fabsf(z) * LOG2E)); }
                } else {
#pragma unroll
                    for (int h = 0; h < 8; ++h) f[h] = __int_as_float(__builtin_amdgcn_readlane(__float_as_int(red), 8 * h));
                    int e0 = 0; float v0 = f[0];
#pragma unroll
                    for (int h = 1; h < 8; ++h) if (f[h] > v0) { v0 = f[h]; e0 = h; }
                    int e1 = (e0 == 0) ? 1 : 0; float v1 = -INFINITY;
#pragma unroll
                    for (int h = 0; h < 8; ++h) if (h != e0 && f[h] > v1) { v1 = f[h]; e1 = h; }
                    const float w0 = __builtin_amdgcn_rcpf(1.0f + __builtin_amdgcn_exp2f((v1 - v0) * LOG2E));
                    if (lane == i) { my_e0 = e0; my_e1 = e1; my_w0 = w0; my_w1 = 1.0f - w0; }
                }
            }
            }
        }
        if constexpr (MODE == 2) {
            unsigned p0 = 0, p1 = 0;
            if (lane < 32) { p0 = __hip_atomic_fetch_add(&lcnt[my_e0], 1u, __ATOMIC_RELAXED, __HIP_MEMORY_SCOPE_WORKGROUP); p1 = __hip_atomic_fetch_add(&lcnt[8 + my_e1], 1u, __ATOMIC_RELAXED, __HIP_MEMORY_SCOPE_WORKGROUP);
                moew[row0 + lane] = my_w0; moew[M + row0 + lane] = my_w1; }
            __syncthreads();
            if (P.tid < 16) lcnt[16 + P.tid] = __hip_atomic_fetch_add(gcnt + P.tid, lcnt[P.tid], RLX_AGENT);
            __syncthreads();
            if (lane < 32) { list[(size_t)my_e0 * M + lcnt[16 + my_e0] + p0] = (unsigned)(row0 + lane); list[(size_t)(8 + my_e1) * M + lcnt[24 + my_e1] + p1] = (unsigned)(row0 + lane); }
            __syncthreads();
        }
    }
}

__device__ __forceinline__ void scan_phase(const Frame& F, const Site& P) {
    const float* NLF = (const float*)(P.ws + WS_NLF); float* NCL = (float*)(P.ws + WS_NCL);
    LAS float* wt = (LAS float*)(F.lds + RING_OFF);
    for (int seq = F.vcu; seq < BATCH * 8; seq += F.G) {
        const int b = seq >> 3, h = seq & 7, t0 = P.tid * 16;
        float v[16]; float s = 0.f;
#pragma unroll
        for (int i = 0; i < 16; ++i) { v[i] = NLF[((size_t)b * SEQ + t0 + i) * 8 + h]; s += v[i]; v[i] = s; }
        float incl = s;
#pragma unroll
        for (int o = 1; o < 64; o <<= 1) { const float up = __int_as_float(__builtin_amdgcn_ds_bpermute((P.lane - o) << 2, __float_as_int(incl))); if (P.lane >= o) incl += up; }
        if (P.lane == 63) wt[P.wave] = incl;
        __syncthreads();
        float base = incl - s;
        for (int w = 0; w < P.wave; ++w) base += wt[w];
        float* dst = NCL + (size_t)seq * SEQ + t0;
#pragma unroll
        for (int i = 0; i < 16; i += 4) *(f32x4*)(dst + i) = (f32x4){base + v[i], base + v[i + 1], base + v[i + 2], base + v[i + 3]};
        __syncthreads();
    }
}

__device__ __forceinline__ void store_row_pair(bf16* base, int lane, v2u ra, v2u rb) {
    const bool odd = (lane & 1) != 0;
    const unsigned s0 = odd ? ra.x : rb.x, s1 = odd ? ra.y : rb.y;
    const unsigned g0 = (unsigned)__builtin_amdgcn_update_dpp(0, (int)s0, 0xB1, 0xF, 0xF, true), g1 = (unsigned)__builtin_amdgcn_update_dpp(0, (int)s1, 0xB1, 0xF, 0xF, true);
    const v4u o = odd ? (v4u){g0, g1, rb.x, rb.y} : (v4u){ra.x, ra.y, g0, g1};
    *(GAS v4u*)(base + (size_t)(odd ? 1024 : 0) + 4 * (lane & ~1)) = o;
}
__device__ __forceinline__ void poolconv_phase(const Frame& F, const Site& P, int l) {
    const int lane = P.lane;
    const bf16* PIN = (const bf16*)(P.ws + WS_P); const bf16* Z = (const bf16*)(P.ws + WS_Z); bf16* Y = (bf16*)(P.ws + WS_Y);
    const float* cw = P.in[7] + (size_t)l * CONVK * 256; const float* cb = P.in[8] + (size_t)l * 256; const float* lg = P.in[9] + (size_t)l * 256; const float* lb = P.in[10] + (size_t)l * 256;
    f32x4 w[CONVK];
#pragma unroll
    for (int j = 0; j < CONVK; ++j) w[j] = *(const f32x4*)(cw + j * 256 + 4 * lane);
    const f32x4 cbv = *(const f32x4*)(cb + 4 * lane), lgv = *(const f32x4*)(lg + 4 * lane), lbv = *(const f32x4*)(lb + 4 * lane);
    LAS unsigned char* zt = F.lds + RING_OFF;
    const int pw = 2 << (lane >> 4);
#if defined(DBG_COPY)
    for (int ch = F.vcu; ch < M / 128; ch += F.G) { const int r0 = ch * 128;
        for (int i = 0; i < 16; ++i) { const int row = r0 + 16 * P.wave + i;
            *(GAS v2u*)(Y + (size_t)row * 1024 + 4 * lane) = *(const GAS v2u*)(PIN + (size_t)row * 256 + 4 * lane);
            *(GAS v2u*)(Y + (size_t)row * 1024 + 256 + 4 * lane) = *(const GAS v2u*)(Z + (size_t)row * 256 + 4 * lane); } }
    return;
#endif
    for (int ch = F.vcu; ch < M / 128; ch += F.G) {
        const int r0 = ch * 128; const int tseq0 = r0 & (SEQ - 1);
        { v4u sv[10];
#pragma unroll
          for (int k = 0; k < 10; ++k) { const int p0 = P.tid + k * (NWAVES * 64); const int p = p0 < 158 * 32 ? p0 : 158 * 32 - 1; const int lr = p >> 5, c16 = p & 31; const int tr = tseq0 - 30 + lr;
              const int lrc = tr >= 0 ? lr : 30;
              sv[k] = *(const GAS v4u*)(Z + (size_t)(r0 - 30 + lrc) * 256 + c16 * 8);
              if (tr < 0) sv[k] = (v4u){0u, 0u, 0u, 0u}; }
#pragma unroll
          for (int k = 0; k < 10; ++k) { const int p = P.tid + k * (NWAVES * 64); if (p < 158 * 32) *(LAS v4u*)(zt + (p >> 5) * 512 + (p & 31) * 16) = sv[k]; } }
        __syncthreads();
#if defined(DBG_POOLCOPY)
        for (int i = 0; i < 16; ++i) { const int row = r0 + 16 * P.wave + i; *(GAS v2u*)(Y + (size_t)row * 1024 + 4 * lane) = *(const GAS v2u*)(PIN + (size_t)row * 256 + 4 * lane); }
        if (false)
#endif
        { const int rw = r0 + 16 * P.wave, tw = tseq0 + 16 * P.wave;
          auto ldp = [&](int rrow) -> f32x4 { const v2u q = *(const GAS v2u*)(PIN + (size_t)rrow * 256 + 4 * lane); return (f32x4){bflo(q.x), bfhi(q.x), bflo(q.y), bfhi(q.y)}; };
          f32x4 s = (f32x4){0.f, 0.f, 0.f, 0.f};
#pragma unroll
          for (int d = 1; d < 16; ++d) { const int dd = d <= tw ? d : tw; const float mk = (d < pw && d <= tw) ? 1.0f : 0.0f; s += ldp(rw - dd) * mk; }
          v2u ovp = (v2u){0u, 0u};
#pragma unroll
          for (int i = 0; i < 16; ++i) { const int t = tw + i;
              const f32x4 cur = ldp(rw + i);
              s += cur;
              const float inv = 1.0f / (float)((t + 1) < pw ? (t + 1) : pw);
              const f32x4 o = s * inv - cur;
              v2u ov; ov.x = pk2(o[0], o[1]); ov.y = pk2(o[2], o[3]);
              if (i & 1) store_row_pair(Y + (size_t)(rw + i - 1) * 1024, lane, ovp, ov); else ovp = ov;
              const int told = t - pw + 1; const int back = told >= 0 ? pw - 1 : t;
              s -= ldp(rw + i - back) * (told >= 0 ? 1.0f : 0.0f); } }
#if defined(DBG_CONVCOPY)
        for (int i = 0; i < 16; ++i) { const int row = r0 + 16 * P.wave + i; *(GAS v2u*)(Y + (size_t)row * 1024 + 256 + 4 * lane) = *(const GAS v2u*)(Z + (size_t)row * 256 + 4 * lane); }
        if (false)
#endif
        for (int grp = 0; grp < 4; ++grp) {
            const int lr0 = 16 * P.wave + 4 * grp;
            f32x4 a[4];
#pragma unroll
            for (int o = 0; o < 4; ++o) a[o] = cbv;
#pragma unroll
            for (int jj = 0; jj < CONVK + 3; ++jj) {
                const v2u q = *(const LAS v2u*)(zt + (lr0 + jj) * 512 + lane * 8); const f32x4 z = (f32x4){bflo(q.x), bfhi(q.x), bflo(q.y), bfhi(q.y)};
#pragma unroll
                for (int o = 0; o < 4; ++o) { const int j = jj - o; if (j >= 0 && j < CONVK) a[o] += w[j] * z; }
            }
            v2u ovc = (v2u){0u, 0u};
#pragma unroll
            for (int o = 0; o < 4; ++o) {
                const float mu = wave_sum((a[o][0] + a[o][1]) + (a[o][2] + a[o][3]), lane) * (1.f / 256.f);
                const f32x4 dv = a[o] - mu;
                const float var = wave_sum((dv[0] * dv[0] + dv[1] * dv[1]) + (dv[2] * dv[2] + dv[3] * dv[3]), lane) * (1.f / 256.f);
                const float rs = __builtin_amdgcn_rsqf(var + 1e-6f);
                f32x4 y = dv * rs * lgv + lbv;
#pragma unroll
                for (int c = 0; c < 4; ++c) y[c] = y[c] * __builtin_amdgcn_rcpf(1.0f + __builtin_amdgcn_exp2f(-1.4426950408889634f * y[c]));
                v2u ov; ov.x = pk2(y[0], y[1]); ov.y = pk2(y[2], y[3]);
                if (o & 1) store_row_pair(Y + (size_t)(r0 + lr0 + o - 1) * 1024 + 256, lane, ovc, ov); else ovc = ov;
            }
        }
        __syncthreads();
    }
}

#ifndef DBG_MAXPHASE
#define DBG_MAXPHASE 1000
#endif
#ifndef ONLY_SITE
#define ONLY_SITE -1
#endif
#ifndef DBL_MASK
#define DBL_MASK 0
#endif
#define DBL(k) for (int rep_ = 0; rep_ < (((DBL_MASK >> (k)) & 1) ? 2 : 1); ++rep_)
#ifndef SITE_OFF_MASK
#define SITE_OFF_MASK 0
#endif
#define SITE(k) ((ONLY_SITE < 0 || ONLY_SITE == (k)) && !((SITE_OFF_MASK >> (k)) & 1))
#ifndef STAGGER_TICKS
#define STAGGER_TICKS 1500
#endif
constexpr int NPH = 10;
struct Args { const float* in[25]; float* out; unsigned char* ws; int ph_lo, ph_hi; };

struct FfnConvHook { const Site* P; int l; __device__ __forceinline__ void operator()(int b, int u) const { convert_ffn_slice(*P, l, u * 8 + b); } };

__global__ void __launch_bounds__(NWAVES * 64, 2) trunk_fwd(Args args) {
    extern __shared__ __attribute__((aligned(16))) unsigned char lds[];
    Frame F;
    F.lds = (LAS unsigned char*)lds;
    F.MISC = (volatile LAS unsigned*)(F.lds + MISC_OFF);
    F.G = gridDim.x; { const int bx = blockIdx.x; F.vcu = (F.G % 8 == 0) ? (bx % 8) * (F.G / 8) + bx / 8 : bx; }
    for (int u = threadIdx.x; u < (LDS_BYTES - LDSCTL_OFF) / 4; u += NWAVES * 64) ((LAS unsigned*)(F.lds + LDSCTL_OFF))[u] = 0u;
    __syncthreads();
    XcdBarrier bar; bar.bar = (unsigned*)((gu32*)(args.ws + WS_CTL) + CW_BAR); bar.x = 0; bar.st = nullptr;
    if (!MK_PER_PHASE) bar = xcd_barrier_post((unsigned*)((gu32*)(args.ws + WS_CTL) + CW_BAR), F.MISC + 8);
    const int lo = args.ph_lo, hi = args.ph_hi;
#define IN(k) (lo <= (k) && (k) < hi)
#define SEAM(k) do { if (IN(k) && IN((k) + 1)) { if (MK_PER_PHASE) { if (threadIdx.x == 0) __hip_atomic_store((gu32*)(args.ws + WS_CTL) + CW_TMO, 0xBADBA0u, RLX_AGENT); } else xcd_barrier(bar); } } while (0)

#define WSB(off) ((bf16*)(P.ws + (off)))
#define INP(k) (P.in[k])
#define XBD() ((bf16*)P.out)
#define XBW() WSB(WS_XBW)
    const int cgemm = (int)blockIdx.x;

    for (int l = 0; l < DEPTH; ++l) {
        const int pb = l * NPH;
        const bool moe = (l & 1) != 0; const int li = l >> 1;

        if (IN(pb + 0)) { const Site P = make_site();
            DBL(0) if constexpr (SITE(0)) convert_layer_weights(F, P, l);
#if defined(DBG_FILLG)
            { v4u fv = (v4u){0x3f003f00u, 0x3f003f00u, 0x3f003f00u, 0x3f003f00u}; GAS v4u* gp = (GAS v4u*)WSB(WS_G);
              for (size_t i = (size_t)blockIdx.x * 512 + P.tid; i < (size_t)M * 3072 / 8; i += (size_t)F.G * 512) gp[i] = fv; }
#endif
            __syncthreads();
            if constexpr (SITE(1)) { if (l == 0) norm_phase<0, false>(F, P, INP(0), INP(1) + (size_t)l * D, INP(2) + (size_t)l * D * IN_COLS + OFF_F, IN_COLS, INP(4) + (size_t)l * 8, nullptr);
                else norm_phase<0, true>(F, P, XBD(), INP(1) + (size_t)l * D, INP(2) + (size_t)l * D * IN_COLS + OFF_F, IN_COLS, INP(4) + (size_t)l * 8, nullptr); }
        }
        SEAM(pb + 0);

        if (IN(pb + 1)) { const Site P = make_site();
#if !defined(DBG_NOSCAN)
            if constexpr (SITE(2)) scan_phase(F, P);
#endif
            LAS float* bl = (LAS float*)(F.lds + GBIAS_OFF); LAS float* gl = bl + 3 * D;
            for (int i = P.tid; i < 3 * D; i += NWAVES * 64) bl[i] = INP(3)[(size_t)l * 3 * D + i] * LOG2E;
            if (P.tid < 128) gl[P.tid] = P.tid < 64 ? INP(11)[(size_t)l * 64 + P.tid] : INP(12)[(size_t)l * 64 + P.tid - 64];
            __syncthreads();
            {
                pg8::Gemm g{WSB(WS_HB), WSB(WS_WIN), D, 0, nullptr, 0};
                pg8::SchedPlain S{M / 256, 2304 / 256, F.G, cgemm, D / 64};
                pg8::EpiInProj E{WSB(WS_P), WSB(WS_Z), WSB(WS_Y) + 512, WSB(WS_K), WSB(WS_V), (const LAS float*)gl, (const LAS float*)(gl + 64)};
                if constexpr (SITE(3)) pg8::gemm_phase<pg8::EpiInProj, pg8::SchedPlain, true, false>(F.lds + RING_OFF, g, S, E);
            }
            {   pg8::Gemm g8{(const bf16*)(P.ws + WS_H8), (const bf16*)(P.ws + WS_WG8), D / 2, 0, nullptr, 0};
                pg8::SchedPlain S8{M / 256, 3072 / 256, F.G, cgemm, D / 128};
                pg8::EpiGate E8{P.ws + WS_G, (const LAS float*)bl};
                if constexpr (SITE(3)) pg8::gemm_phase<pg8::EpiGate, pg8::SchedPlain, true, false, true>(F.lds + RING_OFF, g8, S8, E8);
            }
        }
        SEAM(pb + 1);

        if (IN(pb + 2)) { const Site P = make_site();
            DBL(4) if constexpr (SITE(4)) poolconv_phase(F, P, l);
#if defined(DBG_FENCE)
            asm volatile("s_waitcnt vmcnt(0)" ::: "memory"); __threadfence_system(); asm volatile("s_waitcnt vmcnt(0)" ::: "memory");
#endif
            const attn_body::AttnTensors AT{(const attn_body::bf16*)(WSB(WS_Y) + 512), (const attn_body::bf16*)WSB(WS_K), (const attn_body::bf16*)WSB(WS_V), (attn_body::bf16*)(WSB(WS_Y) + 512), (const float*)(P.ws + WS_NCL)};
            float gq = fabsf(INP(11)[(size_t)l * 64 + P.lane]), gk = fabsf(INP(12)[(size_t)l * 64 + P.lane]);
#pragma unroll
            for (int o = 1; o < 64; o <<= 1) { gq = fmaxf(gq, __int_as_float(__builtin_amdgcn_ds_bpermute((P.lane ^ o) << 2, __float_as_int(gq)))); gk = fmaxf(gk, __int_as_float(__builtin_amdgcn_ds_bpermute((P.lane ^ o) << 2, __float_as_int(gk)))); }
            const float th = 2.0f * (64.0f * gq * gk * pg8::ATT_C2 * 1.02f) + 38.0f;
            const attn_body::AttnQueue Qd{(unsigned*)(P.ctl + CW_ATTQ + l * 8 * 64), __int_as_float(__builtin_amdgcn_readfirstlane(__float_as_int(th))), (int)(xb_xcc_id() & 7u), F.MISC + 16};
            const FfnConvHook hook{&P, l};
            if constexpr (SITE(5)) attn_body::attn_phase_dyn<8>((char*)lds + RING_OFF, AT, Qd, hook);
        }
        SEAM(pb + 2);

        if (IN(pb + 3)) { const Site P = make_site();
            pg8::Gemm g{WSB(WS_Y), WSB(WS_WBR), D, 0, nullptr, 0};
#if defined(DBG_MERGE1)
            pg8::SchedPlain S{M / 256, D / 256, F.G, cgemm, D / 64};
#else
            pg8::SchedMerge S{M / 256, D / 256, F.G, cgemm};
#endif
            pg8::EpiMerge E{P.ws + WS_G, WSB(WS_HB)};
#if defined(DBG_MERGE1)
            if constexpr (SITE(6)) pg8::gemm_phase<pg8::EpiMerge, pg8::SchedPlain, true, false>(F.lds + RING_OFF, g, S, E);
#else
            DBL(6) if constexpr (SITE(6)) pg8::gemm_phase<pg8::EpiMerge, pg8::SchedMerge, true, false>(F.lds + RING_OFF, g, S, E);
#endif
        }
        SEAM(pb + 3);

        if (IN(pb + 4)) { const Site P = make_site();
            pg8::Gemm g{WSB(WS_HB), WSB(WS_WOUT), D, 0, nullptr, 0};
            pg8::SchedPlain S{M / 256, D / 256, F.G, cgemm, D / 64};
            bf16* xdst = (l == DEPTH - 1) ? XBW() : XBD();
            if constexpr (SITE(7)) { if (l == 0) { pg8::EpiResid<true> E{INP(0), xdst}; pg8::gemm_phase<pg8::EpiResid<true>, pg8::SchedPlain, true, false>(F.lds + RING_OFF, g, S, E); }
                else { pg8::EpiResid<false> E{XBD(), xdst}; pg8::gemm_phase<pg8::EpiResid<false>, pg8::SchedPlain, true, false>(F.lds + RING_OFF, g, S, E); } }
        }
        SEAM(pb + 4);

        if (IN(pb + 5)) { const Site P = make_site();
            const bf16* xcur = (l == DEPTH - 1) ? XBW() : XBD();
            if constexpr (SITE(8)) { if (!moe && l >= DENSE8_FROM) norm_phase<1, true, true>(F, P, xcur, INP(17) + (size_t)l * D, nullptr, 0, nullptr, nullptr);
            else if (!moe) norm_phase<1, true, false>(F, P, xcur, INP(17) + (size_t)l * D, nullptr, 0, nullptr, nullptr);
            else norm_phase<2, true>(F, P, xcur, INP(17) + (size_t)l * D, INP(21) + (size_t)li * D * NEXP, NEXP, nullptr, (unsigned*)(P.ctl + CW_MOECNT + 64 * li)); }
        }
        SEAM(pb + 5);

        if (!moe) {
            if (IN(pb + 6)) { const Site P = make_site();
                if (l >= DENSE8_FROM) {
                pg8::Gemm g{WSB(WS_HB), WSB(WS_WFF), D / 2, 0, nullptr, 0};
                pg8::SchedPlain S{M / 256, 2 * DFF / 256, F.G, cgemm, D / 128};
                pg8::EpiSwiGLU8 E{P.ws + WS_HID, DFF};
                if constexpr (SITE(9)) pg8::gemm_phase<pg8::EpiSwiGLU8, pg8::SchedPlain, true, false, true>(F.lds + RING_OFF, g, S, E);
                } else {
                pg8::Gemm g{WSB(WS_HB), WSB(WS_WFF), D, 0, nullptr, 0};
                pg8::SchedPlain S{M / 256, 2 * DFF / 256, F.G, cgemm, D / 64};
                pg8::EpiSwiGLU E{WSB(WS_HID), DFF};
                if constexpr (SITE(9)) pg8::gemm_phase<pg8::EpiSwiGLU, pg8::SchedPlain, true, false>(F.lds + RING_OFF, g, S, E);
                }
            }
            SEAM(pb + 6);
            if (IN(pb + 7)) { const Site P = make_site();
                pg8::EpiResid<false> E{XBD(), XBD()};
                if (l >= DENSE8_FROM) {
                pg8::Gemm g{WSB(WS_HID), WSB(WS_WFF + WFF8_W2_DENSE), DFF / 2, 0, nullptr, 0};
                pg8::SchedPlain S{M / 256, D / 256, F.G, cgemm, DFF / 128};
                if constexpr (SITE(10)) pg8::gemm_phase<pg8::EpiResid<false>, pg8::SchedPlain, true, false, true>(F.lds + RING_OFF, g, S, E);
                } else {
                pg8::Gemm g{WSB(WS_HID), WSB(WS_WFF + WFF_W2_DENSE), DFF, 0, nullptr, 0};
                pg8::SchedPlain S{M / 256, D / 256, F.G, cgemm, DFF / 64};
                if constexpr (SITE(10)) pg8::gemm_phase<pg8::EpiResid<false>, pg8::SchedPlain, true, false>(F.lds + RING_OFF, g, S, E);
                }
            }
            if (l + 1 < DEPTH) SEAM(pb + 7);
        } else {
#define MOE_TAB(slot_, ntiles_) do { LAS unsigned* tab = (LAS unsigned*)(F.lds + MOETAB_OFF);     \
                __syncthreads(); \
                int cnt[8]; \
                _Pragma("unroll") for (int e = 0; e < 8; ++e) cnt[e] = __builtin_amdgcn_readfirstlane((int)__hip_atomic_load(P.ctl + CW_MOECNT + 64 * li + (slot_) * 8 + e, RLX_AGENT)); \
                int rt = 0; \
                _Pragma("unroll") for (int e = 0; e < 8; ++e) { const int nte = (cnt[e] + 255) >> 8; \
                    for (int j = P.tid; j < nte; j += NWAVES * 64) { const int nv = (cnt[e] - 256 * j) < 256 ? (cnt[e] - 256 * j) : 256; if (rt + j < 264) tab[rt + j] = (unsigned)e | ((unsigned)j << 8) | ((unsigned)(nv - 1) << 20); } \
                    rt += nte; } \
                ntiles_ = rt < 264 ? rt : 264; \
                __syncthreads(); } while (0)
#define MOE_UP(slot_, ntiles_, skipc_, skipr_) do { \
                  \
                pg8::Gemm g{WSB(WS_HB), WSB(WS_WFF), D / 2, WFF8_W13_E, (const unsigned*)(P.ws + WS_LIST), 0}; \
                pg8::SchedMoe S{ntiles_, 2 * DFFE / 256, F.G, cgemm, D / 128, slot_, (const LAS unsigned*)(F.lds + MOETAB_OFF), skipc_, skipr_}; \
                pg8::EpiSwiGLU8 E{P.ws + WS_HID + (size_t)(slot_) * HID_SLOT, DFFE}; \
                if constexpr (SITE(11)) pg8::gemm_phase<pg8::EpiSwiGLU8, pg8::SchedMoe, true, true, true>(F.lds + RING_OFF, g, S, E); } while (0)
#define MOE_DOWN(slot_, ntiles_) do { \
                pg8::Gemm g{(const bf16*)(P.ws + WS_HID + (size_t)(slot_) * HID_SLOT), WSB(WS_WFF + WFF8_W2_OFF), DFFE / 2, WFF8_W2_E, nullptr, 0};     \
                pg8::SchedMoe S{ntiles_, D / 256, F.G, cgemm, DFFE / 128, slot_, (const LAS unsigned*)(F.lds + MOETAB_OFF), 0, 0};     \
                bf16* xcur = (l == DEPTH - 1) ? XBW() : XBD(); \
                if constexpr (SITE(12)) { \
                    if (l == DEPTH - 1 && (slot_) == 1) { pg8::EpiMoeDown<true> E{xcur, P.out, (const unsigned*)(P.ws + WS_LIST), (const float*)(P.ws + WS_MOEW) + (size_t)(slot_) * M, DFFE / 128};     \
                        pg8::gemm_phase<pg8::EpiMoeDown<true>, pg8::SchedMoe, true, false, true>(F.lds + RING_OFF, g, S, E); } \
                    else { pg8::EpiMoeDown<false> E{xcur, xcur, (const unsigned*)(P.ws + WS_LIST), (const float*)(P.ws + WS_MOEW) + (size_t)(slot_) * M, DFFE / 128}; \
                        pg8::gemm_phase<pg8::EpiMoeDown<false>, pg8::SchedMoe, true, false, true>(F.lds + RING_OFF, g, S, E); } } } while (0)
            if (IN(pb + 6)) { const Site P = make_site(); int nt0 = 0; MOE_TAB(0, nt0); MOE_UP(0, nt0, 0, 0); }
            SEAM(pb + 6);
            if (IN(pb + 7)) { int skipc = 0;
                { const Site P = make_site(); int nt0 = 0; MOE_TAB(0, nt0); MOE_DOWN(0, nt0);
                  const int xd = (nt0 * (D / 256)) % F.G; skipc = (xd + 7) & ~7; if (skipc > F.G) skipc = F.G; }
                { const Site P = make_site(); int nt1 = 0; MOE_TAB(1, nt1); MOE_UP(1, nt1, skipc, MOE_SKIPR); }
            }
            SEAM(pb + 7);
            if (IN(pb + 8)) { const Site P = make_site(); int nt1 = 0; MOE_TAB(1, nt1); MOE_DOWN(1, nt1); }
            if (l + 1 < DEPTH) SEAM(pb + 8);
#undef MOE_TAB
#undef MOE_UP
#undef MOE_DOWN
        }
    }
#undef IN
#undef SEAM
#undef WSB
#undef INP
#undef XBD
#undef XBW
}

extern "C" void kernel_launch(void* const* d_in, const int* in_sizes, int n_in, void* d_out, int out_size, void* d_ws, size_t ws_size, hipStream_t stream) {
    static int grid = 0;
    if (grid == 0) {
        if (n_in != 25 || in_sizes[0] != M * D || out_size != M * D || ws_size < WS_END) { fprintf(stderr, "kernel_launch: built for 25 inputs, x and out of %d floats, >= %zu bytes of workspace; got n_in %d, in0 %d, out %d, ws %zu; nothing launched\n", M * D, (size_t)WS_END, n_in, n_in > 0 ? in_sizes[0] : -1, out_size, ws_size); grid = -1; return; }
        int dev = 0, cus = 0, per_cu = 0;
        if (hipGetDevice(&dev) != hipSuccess || hipDeviceGetAttribute(&cus, hipDeviceAttributeMultiprocessorCount, dev) != hipSuccess) { fprintf(stderr, "kernel_launch: hipGetDevice / hipDeviceGetAttribute failed; nothing launched\n"); grid = -1; return; }
        if (hipFuncSetAttribute((const void*)trunk_fwd, hipFuncAttributeMaxDynamicSharedMemorySize, LDS_BYTES) != hipSuccess) { fprintf(stderr, "kernel_launch: hipFuncSetAttribute failed\n"); grid = -1; return; }
        if (hipOccupancyMaxActiveBlocksPerMultiprocessor(&per_cu, (const void*)trunk_fwd, NWAVES * 64, LDS_BYTES) != hipSuccess || per_cu < 1)
            fprintf(stderr, "kernel_launch: note: the occupancy query reports %d workgroups per CU\n", per_cu);
        (void)hipGetLastError();
        grid = cus;
    }
    if (grid < 0) return;
    if (hipMemsetAsync((char*)d_ws + WS_CTL, 0, CTL_ZERO_BYTES, stream) != hipSuccess) { fprintf(stderr, "kernel_launch: hipMemsetAsync failed\n"); return; }
    Args a{};
    for (int i = 0; i < 25; ++i) a.in[i] = (const float*)d_in[i];
    a.out = (float*)d_out; a.ws = (unsigned char*)d_ws;
#if MK_PER_PHASE
    for (int l = 0; l < DEPTH; ++l) { const int np = (l & 1) ? 10 : 8;
        for (int p = 0; p < np; ++p) { a.ph_lo = l * NPH + p; a.ph_hi = a.ph_lo + 1; if (a.ph_lo > DBG_MAXPHASE) continue; hipLaunchKernelGGL(trunk_fwd, dim3(grid), dim3(NWAVES * 64), LDS_BYTES, stream, a); } }
#else
    a.ph_lo = 0; a.ph_hi = DEPTH * NPH;
    hipLaunchKernelGGL(trunk_fwd, dim3(grid), dim3(NWAVES * 64), LDS_BYTES, stream, a);
#endif
    const hipError_t le = hipPeekAtLastError();
    if (le != hipSuccess) fprintf(stderr, "kernel_launch: launch failed: %s (grid %d x %d threads, %d B LDS)\n", hipGetErrorName(le), grid, NWAVES * 64, LDS_BYTES);
}
```

```cpp
#include <hip/hip_runtime.h>
#include <hip/hip_bf16.h>
#include <cstdio>
#include <cstdint>
#include <cmath>

namespace pg8 {
#define PG8_LAS __attribute__((address_space(3)))
typedef unsigned short bf16_t;
typedef short bf16x8 __attribute__((ext_vector_type(8)));
typedef float f32x4 __attribute__((ext_vector_type(4)));
typedef float f32x2 __attribute__((ext_vector_type(2)));
typedef unsigned u32x4 __attribute__((ext_vector_type(4)));
typedef unsigned u32x2 __attribute__((ext_vector_type(2)));
typedef int i32x4 __attribute__((ext_vector_type(4)));
typedef int i32x8 __attribute__((ext_vector_type(8)));
constexpr int BM = 256, BK = 64, HALF = 128, HTB = HALF * BK * 2  , STAGE_BYTES = 8 * HTB, NXCD = 8, WGM = 8;

__host__ __device__ __forceinline__ int lds_byte(int r, int c) { const int st = (r >> 4) * 2 + (c >> 5), rr = r & 15, cc = c & 31, ob = rr * 64 + cc * 2; return st * 1024 + (ob ^ (((ob >> 9) & 1) << 5)); }
__host__ __device__ __forceinline__ void stage_rc(int b, int& R, int& C) { const int st = b / 1024, sb = b % 1024, swz = sb ^ (((sb >> 9) & 1) << 5); R = (st >> 1) * 16 + swz / 64; C = (st & 1) * 32 + (swz % 64) / 2; }
__host__ __device__ __forceinline__ int perm32(int rho) { const int n = rho >> 4, i = rho & 15; return 8 * (i >> 2) + 4 * n + (i & 3); }

struct Unit { int pm, pn, e, koff, nt, lo, nv; };
struct Gemm { const bf16_t* A; const bf16_t* Bt; int K; size_t bstride; const unsigned* list; int stagger; };

__device__ __forceinline__ void tile_of(int L, int nM, int nN, int& pm, int& pn) {
    const int nwg = nM * nN; int wgid = L;
    { const int q = nwg / NXCD, r = nwg % NXCD, xcd = wgid % NXCD, off = wgid / NXCD; wgid = (xcd < r ? xcd * (q + 1) : r * (q + 1) + (xcd - r) * q) + off; }
    const int nig = WGM * nN, gid = wgid / nig, fm = gid * WGM, gsz = (nM - fm) < WGM ? (nM - fm) : WGM;
    pm = fm + ((wgid % nig) % gsz); pn = (wgid % nig) / gsz;
}
struct SchedPlain {
    int nM, nN, G, c, nt;
    __device__ __forceinline__ bool next(int i, Unit& u) const {
        const long L = (long)i * G + c; if (L >= (long)nM * nN) return false;
        tile_of((int)L, nM, nN, u.pm, u.pn); u.e = 0; u.koff = 0; u.nt = nt; u.lo = 0; u.nv = 256; return true;
    }
};
struct SchedPanel {
    int nM, nN, G, c, nt;
    __device__ __forceinline__ bool next(int i, Unit& u) const {
        const int j = i / nN; u.pn = i - j * nN; u.pm = c + G * j; if (u.pm >= nM) return false;
        u.e = 0; u.koff = 0; u.nt = nt; u.lo = 0; u.nv = 256; return true;
    }
};
struct SchedMerge {
    int nM, nN, G, c;
    __device__ __forceinline__ bool next(int i, Unit& u) const {
        const int tile = i / 3, seg = i - 3 * tile; const long L = (long)tile * G + c; if (L >= (long)nM * nN) return false;
        tile_of((int)L, nM, nN, u.pm, u.pn); u.e = seg; u.koff = seg == 0 ? 0 : (seg == 1 ? 256 : 512); u.nt = seg == 2 ? 8 : 4; u.lo = 0; u.nv = 256; return true;
    }
};
struct SchedMoe {
    int nM, nN, G, c, nt, slot; const PG8_LAS unsigned* tab; int skipc, skipr;
    __device__ __forceinline__ bool next(int i, Unit& u) const {
        const int nwg = nM * nN;
        const int r = (c < skipc) ? i + skipr : i;
        const long L0 = (r < skipr) ? (long)r * (G - skipc) + (c - skipc) : (long)skipr * (G - skipc) + (long)(r - skipr) * G + c;
        if (L0 >= nwg) return false;
        const int L = (int)L0;
        tile_of(L, nM, nN, u.pm, u.pn);
        const unsigned w = (unsigned)__builtin_amdgcn_readfirstlane((int)tab[u.pm]);
        u.e = (int)(w & 0xffu); const int j = (int)((w >> 8) & 0xfffu); u.nv = (int)(w >> 20) + 1;
        u.lo = (slot * 8 + u.e) * 65536 + 256 * j; u.nt = nt; u.koff = 0; return true;
    }
};

typedef __bf16 bf16x2_cv __attribute__((ext_vector_type(2)));
__device__ __forceinline__ unsigned cvt_pk_bf16(float lo, float hi) { const f32x2 v = {lo, hi}; const bf16x2_cv b = __builtin_convertvector(v, bf16x2_cv); return __builtin_bit_cast(unsigned, b); }
__device__ __forceinline__ float bf_lo(unsigned w) { return __uint_as_float(w << 16); }
__device__ __forceinline__ float bf_hi(unsigned w) { return __uint_as_float(w & 0xffff0000u); }
__device__ __forceinline__ float sigmoidf_(float x) { return __builtin_amdgcn_rcpf(1.0f + __builtin_amdgcn_exp2f(-1.4426950408889634f * x)); }
__device__ __forceinline__ f32x4 rsig4_(const f32x4 x) { const f32x4 t = x * -1.4426950408889634f; f32x4 e; e[0] = __builtin_amdgcn_exp2f(t[0]); e[1] = __builtin_amdgcn_exp2f(t[1]); e[2] = __builtin_amdgcn_exp2f(t[2]); e[3] = __builtin_amdgcn_exp2f(t[3]);
    const f32x4 d = e + 1.0f; return (f32x4){__builtin_amdgcn_rcpf(d[0]), __builtin_amdgcn_rcpf(d[1]), __builtin_amdgcn_rcpf(d[2]), __builtin_amdgcn_rcpf(d[3])}; }

template <class Epi, class Sched, bool ALIGN_EPI, bool GATHER, bool F8 = false>
__device__ __forceinline__ void gemm_phase(PG8_LAS unsigned char* lds, const Gemm g_, const Sched& S, const Epi& E) {
    Gemm g = g_;
    {
        unsigned long long a_ = (unsigned long long)g_.A, b_ = (unsigned long long)g_.Bt, l_ = (unsigned long long)g_.list; asm volatile("" : "+s"(a_), "+s"(b_), "+s"(l_));
        g.A = (const bf16_t*)(const __attribute__((address_space(1))) bf16_t*)a_; g.Bt = (const bf16_t*)(const __attribute__((address_space(1))) bf16_t*)b_; g.list = (const unsigned*)(const __attribute__((address_space(1))) unsigned*)l_; }
    int tid_o = threadIdx.x; asm volatile("" : "+v"(tid_o));
    const int tid = tid_o, wid = __builtin_amdgcn_readfirstlane(tid >> 6), lane = tid & 63, wr = wid >> 2, wc = wid & 3, fr = lane & 15, fq = lane >> 4;
    const int K = g.K;
    unsigned voffA[2], voffB[2];
#pragma unroll
    for (int i = 0; i < 2; ++i) { int R, C; stage_rc(tid * 16 + i * 8192, R, C); const int Rb = Epi::PERM ? ((R & ~31) + perm32(R & 31)) : R;
        voffA[i] = (unsigned)(R * K + C) * 2u; voffB[i] = (unsigned)(Rb * K + C) * 2u; }
    const size_t kstep = (size_t)(BK * 2);
    const size_t hstep = (size_t)HALF * K * 2;
    const size_t tstep = 2 * hstep;
    const unsigned ldsw = (unsigned)wid * 1024u;
    const int aoff = lds_byte(wr * 64 + fr, fq * 8), boff = lds_byte(wc * 32 + fr, fq * 8);
#define PG8_SA(b, h) (((b) * 2 + (h)) * HTB)
#define PG8_SB(b, h) ((4 + (b) * 2 + (h)) * HTB)
#define PG8_GLDS(src, bufoff, i_) __builtin_amdgcn_global_load_lds((const unsigned*)(src), (PG8_LAS unsigned*)(lds + (bufoff) + ldsw + (i_) * 8192), 16, 0, 0)
#define PG8_STAGE_B(bufoff, gbase) do { _Pragma("unroll") for (int _i = 0; _i < 2; ++_i) PG8_GLDS((const char*)(gbase) + voffB[_i], bufoff, _i); } while (0)
#define PG8_STAGE_A(bufoff, ga, h, o0, o1) do { if constexpr (GATHER) { PG8_GLDS((const char*)(ga) + (o0), bufoff, 0); PG8_GLDS((const char*)(ga) + (o1), bufoff, 1); } \
        else { _Pragma("unroll") for (int _i = 0; _i < 2; ++_i) PG8_GLDS((const char*)(ga) + (h) * hstep + voffA[_i], bufoff, _i); } } while (0)
#define PG8_LDA(dst, b, h) do { _Pragma("unroll") for (int m = 0; m < 4; ++m) { if constexpr (F8) { dst##8[m].lo = *(const PG8_LAS i32x4*)(lds + PG8_SA(b, h) + aoff + m * 2048); dst##8[m].hi = *(const PG8_LAS i32x4*)(lds + PG8_SA(b, h) + aoff + m * 2048 + 1024); } \
        else { _Pragma("unroll") for (int k = 0; k < 2; ++k) dst[m][k] = *(const PG8_LAS bf16x8*)(lds + PG8_SA(b, h) + aoff + m * 2048 + k * 1024); } } } while (0)
#define PG8_LDB(dst, b, h) do { _Pragma("unroll") for (int n = 0; n < 2; ++n) { if constexpr (F8) { dst##8[n].lo = *(const PG8_LAS i32x4*)(lds + PG8_SB(b, h) + boff + n * 2048); dst##8[n].hi = *(const PG8_LAS i32x4*)(lds + PG8_SB(b, h) + boff + n * 2048 + 1024); } \
        else { _Pragma("unroll") for (int k = 0; k < 2; ++k) dst[n][k] = *(const PG8_LAS bf16x8*)(lds + PG8_SB(b, h) + boff + n * 2048 + k * 1024); } } } while (0)
#define PG8_CAT8(x0, x1) __builtin_shufflevector(__builtin_bit_cast(i32x4, x0), __builtin_bit_cast(i32x4, x1), 0, 1, 2, 3, 4, 5, 6, 7)
#define PG8_MMA(ai, bj, At, Bt) do { __builtin_amdgcn_s_setprio(1); _Pragma("unroll") for (int m = 0; m < 4; ++m) _Pragma("unroll") for (int n = 0; n < 2; ++n) { \
        if constexpr (F8) asm volatile("v_mfma_scale_f32_16x16x128_f8f6f4 %0, %1, %2, %0, %3, %4 op_sel_hi:[0,0,0]" : "+v"(acc[ai][bj][m][n]) : "v"(Bt##8[n]), "v"(At##8[m]), "v"(sc_w), "v"(sc_a));   \
        else { _Pragma("unroll") for (int k = 0; k < 2; ++k) acc[ai][bj][m][n] = __builtin_amdgcn_mfma_f32_16x16x32_bf16(Bt[n][k], At[m][k], acc[ai][bj][m][n], 0, 0, 0); } } __builtin_amdgcn_s_setprio(0); } while (0)
#define PG8_MMA0(ai, bj, At, Bt) do { __builtin_amdgcn_s_setprio(1); _Pragma("unroll") for (int m = 0; m < 4; ++m) _Pragma("unroll") for (int n = 0; n < 2; ++n) \
        asm volatile("v_mfma_scale_f32_16x16x128_f8f6f4 %0, %1, %2, 0, %3, %4 op_sel_hi:[0,0,0]" : "=v"(acc[ai][bj][m][n]) : "v"(Bt##8[n]), "v"(At##8[m]), "v"(sc_w), "v"(sc_a));   \
        __builtin_amdgcn_s_setprio(0); } while (0)
#define PG8_WAIT_V(n) asm volatile("s_waitcnt vmcnt(" #n ")" ::: "memory")
#define PG8_WAIT_L(n) asm volatile("s_waitcnt lgkmcnt(" #n ")" ::: "memory")
#define PG8_WAIT_V8F(f) do { if constexpr (Epi::NST == 32) asm volatile("s_cmp_eq_u32 %0, 0\n\ts_cbranch_scc1 .LWV%=A\n\ts_waitcnt vmcnt(40)\n\ts_branch .LWV%=B\n.LWV%=A:\n\ts_waitcnt vmcnt(8)\n.LWV%=B:" :: "s"(f) : "memory", "scc"); \
        else if constexpr (Epi::NST == 16) asm volatile("s_cmp_eq_u32 %0, 0\n\ts_cbranch_scc1 .LWV%=A\n\ts_waitcnt vmcnt(24)\n\ts_branch .LWV%=B\n.LWV%=A:\n\ts_waitcnt vmcnt(8)\n.LWV%=B:" :: "s"(f) : "memory", "scc"); \
        else asm volatile("s_waitcnt vmcnt(8)" ::: "memory"); } while (0)
#define PG8_BAR __builtin_amdgcn_s_barrier()
#define PG8_SCHED __builtin_amdgcn_sched_barrier(0)
    Unit cur, nxt; int ui = 0;
    if (!S.next(0, cur)) return;
    if (g.stagger > 0) { const unsigned long long t0_ = __builtin_amdgcn_s_memrealtime(); while (__builtin_amdgcn_s_memrealtime() - t0_ < (unsigned long long)g.stagger) __builtin_amdgcn_s_sleep(8); }
    f32x4 acc[2][2][4][2];
    if constexpr (!F8) {
#pragma unroll
    for (int a = 0; a < 2; ++a)
#pragma unroll
        for (int b = 0; b < 2; ++b)
#pragma unroll
            for (int m = 0; m < 4; ++m)
#pragma unroll
                for (int n = 0; n < 2; ++n) acc[a][b][m][n] = (f32x4){0.f, 0.f, 0.f, 0.f};
    }
    bf16x8 At[4][2], B0[2][2], B1[2][2];
    i32x8 At8[4], B08[2], B18[2];
    int sc_w = 122, sc_a = 127; asm volatile("" : "+v"(sc_w), "+v"(sc_a));
    unsigned gc00 = 0, gc01 = 0, gc10 = 0, gc11 = 0, gn00 = 0, gn01 = 0, gn10 = 0, gn11 = 0;
#define PG8_TOK(u, t00, t01, t10, t11) do { const unsigned* lp_ = g.list + (u).lo; const int nv_ = (u).nv; \
        int tid_ = threadIdx.x; asm volatile("" : "+v"(tid_)); int R0_, C0_, R1_, C1_; stage_rc(tid_ * 16, R0_, C0_); stage_rc(tid_ * 16 + 8192, R1_, C1_);     \
        t00 = R0_ < nv_ ? lp_[R0_] : 0u; t01 = R1_ < nv_ ? lp_[R1_] : 0u; t10 = (128 + R0_) < nv_ ? lp_[128 + R0_] : 0u; t11 = (128 + R1_) < nv_ ? lp_[128 + R1_] : 0u; } while (0)
#define PG8_OFFS(t00, t01, t10, t11, o00, o01, o10, o11) do { \
        int tid_ = threadIdx.x; asm volatile("" : "+v"(tid_)); int R0_, C0_, R1_, C1_; stage_rc(tid_ * 16, R0_, C0_); stage_rc(tid_ * 16 + 8192, R1_, C1_); \
        o00 = (t00) * (unsigned)(K * 2) + (unsigned)C0_ * 2u; o01 = (t01) * (unsigned)(K * 2) + (unsigned)C1_ * 2u; o10 = (t10) * (unsigned)(K * 2) + (unsigned)C0_ * 2u; o11 = (t11) * (unsigned)(K * 2) + (unsigned)C1_ * 2u; } while (0)
#define PG8_GATH(u, o00, o01, o10, o11) do { unsigned q00_, q01_, q10_, q11_; PG8_TOK(u, q00_, q01_, q10_, q11_); PG8_OFFS(q00_, q01_, q10_, q11_, o00, o01, o10, o11); } while (0)
    unsigned tk00 = 0, tk01 = 0, tk10 = 0, tk11 = 0;
    const char* cA = GATHER ? (const char*)g.A + (size_t)cur.koff * 2 : (const char*)g.A + (size_t)cur.pm * tstep + (size_t)cur.koff * 2;
    const char* cB = (const char*)g.Bt + (size_t)cur.e * g.bstride + (size_t)cur.pn * tstep + (size_t)cur.koff * 2;
    if constexpr (GATHER) { PG8_GATH(cur, gc00, gc01, gc10, gc11); Unit n1_; if (S.next(1, n1_)) PG8_TOK(n1_, tk00, tk01, tk10, tk11); }
    PG8_STAGE_B(PG8_SB(0, 0), cB); PG8_STAGE_B(PG8_SB(0, 1), cB + hstep); PG8_STAGE_A(PG8_SA(0, 0), cA, 0, gc00, gc01); PG8_STAGE_A(PG8_SA(0, 1), cA, 1, gc10, gc11);
    if (wr == 1) PG8_BAR;
    PG8_WAIT_V(2); PG8_BAR;
    PG8_STAGE_B(PG8_SB(1, 0), cB + kstep); PG8_STAGE_A(PG8_SA(1, 0), cA + kstep, 0, gc00, gc01); PG8_STAGE_B(PG8_SB(1, 1), cB + hstep + kstep);
    PG8_WAIT_V(6); PG8_BAR;
    for (;;) {
        const bool has_next = S.next(ui + 1, nxt);
        const char* nA = has_next ? (GATHER ? (const char*)g.A + (size_t)nxt.koff * 2 : (const char*)g.A + (size_t)nxt.pm * tstep + (size_t)nxt.koff * 2) : cA;
        const char* nB = has_next ? (const char*)g.Bt + (size_t)nxt.e * g.bstride + (size_t)nxt.pn * tstep + (size_t)nxt.koff * 2 : cB;
        if constexpr (GATHER) { if (has_next) PG8_OFFS(tk00, tk01, tk10, tk11, gn00, gn01, gn10, gn11); else { gn00 = gc00; gn01 = gc01; gn10 = gc10; gn11 = gc11; }
            Unit n2_; if (S.next(ui + 2, n2_)) PG8_TOK(n2_, tk00, tk01, tk10, tk11); }
        const int nt = cur.nt;
        for (int t = 0; t < nt; t += 2) {
            const bool last = (t == nt - 2);
            const char* a1 = cA + (size_t)(t + 1) * kstep;
            const char* a2 = last ? nA : cA + (size_t)(t + 2) * kstep; const char* b2 = last ? nB : cB + (size_t)(t + 2) * kstep;
            const char* a3 = a2 + kstep; const char* b3 = b2 + kstep;
            const unsigned s00 = last ? gn00 : gc00, s01 = last ? gn01 : gc01, s10 = last ? gn10 : gc10, s11 = last ? gn11 : gc11;
            const int fresh = __builtin_amdgcn_readfirstlane(((Epi::NST > 0) && (ui > 0) && (t == 0)) ? 1 : 0);
            PG8_LDB(B0, 0, 0); PG8_LDB(B1, 0, 1); PG8_SCHED; PG8_LDA(At, 0, 0); PG8_STAGE_A(PG8_SA(1, 1), a1, 1, gc10, gc11);
            PG8_WAIT_V8F(fresh);
            PG8_WAIT_L(0); PG8_BAR; if (F8 && t == 0) { PG8_MMA0(0, 0, At, B0); PG8_MMA0(0, 1, At, B1); } else { PG8_MMA(0, 0, At, B0); PG8_MMA(0, 1, At, B1); } PG8_BAR; PG8_SCHED;
            PG8_LDA(At, 0, 1); PG8_STAGE_B(PG8_SB(0, 0), b2); PG8_STAGE_B(PG8_SB(0, 1), b2 + hstep); PG8_STAGE_A(PG8_SA(0, 0), a2, 0, s00, s01);
            PG8_WAIT_V8F(fresh);
            PG8_WAIT_L(0); PG8_BAR; if (F8 && t == 0) { PG8_MMA0(1, 0, At, B0); PG8_MMA0(1, 1, At, B1); } else { PG8_MMA(1, 0, At, B0); PG8_MMA(1, 1, At, B1); } PG8_BAR; PG8_SCHED;
            PG8_LDB(B0, 1, 0); PG8_LDB(B1, 1, 1); PG8_SCHED; PG8_LDA(At, 1, 0); PG8_STAGE_A(PG8_SA(0, 1), a2, 1, s10, s11);
            PG8_WAIT_V(8); PG8_WAIT_L(0); PG8_BAR; PG8_MMA(0, 0, At, B0); PG8_MMA(0, 1, At, B1); PG8_BAR; PG8_SCHED;
            PG8_LDA(At, 1, 1); PG8_STAGE_B(PG8_SB(1, 0), b3); PG8_STAGE_B(PG8_SB(1, 1), b3 + hstep); PG8_STAGE_A(PG8_SA(1, 0), a3, 0, s00, s01);
            PG8_WAIT_V(8); PG8_WAIT_L(0); PG8_BAR; PG8_MMA(1, 0, At, B0); PG8_MMA(1, 1, At, B1); PG8_BAR; PG8_SCHED;
        }
        if constexpr (ALIGN_EPI) { if (wr == 0) PG8_BAR; }
        if constexpr (F8) asm volatile("s_nop 15\n\ts_nop 7" ::: "memory");
        { int te_ = threadIdx.x; asm volatile("" : "+v"(te_));
          const int we_ = __builtin_amdgcn_readfirstlane(te_ >> 6), le_ = te_ & 63; E(acc, cur, we_ >> 2, we_ & 3, le_ & 15, le_ >> 4); }
        if (!has_next) break;
        bool zero_acc = true; if constexpr (Epi::KEEPS) zero_acc = !E.keep(cur);
        if (!F8 && zero_acc) {
#pragma unroll
        for (int a = 0; a < 2; ++a)
#pragma unroll
            for (int b = 0; b < 2; ++b)
#pragma unroll
                for (int m = 0; m < 4; ++m)
#pragma unroll
                    for (int n = 0; n < 2; ++n) acc[a][b][m][n] = (f32x4){0.f, 0.f, 0.f, 0.f};
        }
        cur = nxt; cA = nA; cB = nB; ++ui;
        if constexpr (GATHER) { gc00 = gn00; gc01 = gn01; gc10 = gn10; gc11 = gn11; }
        if constexpr (ALIGN_EPI) { if (wr == 1) PG8_BAR; }
    }
    PG8_WAIT_V(0);
    if constexpr (!ALIGN_EPI) { if (wr == 0) PG8_BAR; }
    PG8_BAR;
#undef PG8_SA
#undef PG8_SB
#undef PG8_GLDS
#undef PG8_STAGE_A
#undef PG8_STAGE_B
#undef PG8_LDA
#undef PG8_LDB
#undef PG8_MMA
#undef PG8_MMA0
#undef PG8_CAT8
#undef PG8_WAIT_V
#undef PG8_WAIT_L
#undef PG8_WAIT_V8F
#undef PG8_BAR
#undef PG8_SCHED
#undef PG8_GATH
#undef PG8_TOK
#undef PG8_OFFS
}

__device__ __forceinline__ u32x4 pack8(const f32x4 a, const f32x4 b) { u32x4 w; w.x = cvt_pk_bf16(a[0], a[1]); w.y = cvt_pk_bf16(a[2], a[3]); w.z = cvt_pk_bf16(b[0], b[1]); w.w = cvt_pk_bf16(b[2], b[3]); return w; }
__device__ __forceinline__ u32x2 pack4(const f32x4 a) { u32x2 w; w.x = cvt_pk_bf16(a[0], a[1]); w.y = cvt_pk_bf16(a[2], a[3]); return w; }

__device__ __forceinline__ size_t gfrag(int pm, int pg, int wid, int k, int lane) { return ((((size_t)(pm * 12 + pg) * 8 + wid) * 16 + k) * 64 + lane) * 8; }
__device__ __forceinline__ size_t gfrag8(int pm, int pg, int wid, int k, int lane) { return ((((size_t)(pm * 12 + pg) * 8 + wid) * 8 + k) * 64 + lane) * 16; }
constexpr float ATT_C2 = 0.125f * 1.4426950408889634f;
constexpr float NORM_EPS = 1e-6f;

struct EpiInProj {
    static constexpr bool PERM = true; static constexpr int NST = 0; static constexpr bool KEEPS = false;
    bf16_t *P, *Z, *Q, *Kb, *Vb; const PG8_LAS float *qg, *kg;
    __device__ __forceinline__ void operator()(const f32x4 (&acc)[2][2][4][2], const Unit& u, int wr, int wc, int fr, int fq) const {
        const int row0 = u.pm * BM + wr * 64 + fr; const int pn = u.pn;
        if (pn == 0) {
#pragma unroll
            for (int ai = 0; ai < 2; ++ai)
#pragma unroll
                for (int m = 0; m < 4; ++m) { bf16_t* rowp = P + (size_t)(row0 + ai * HALF + m * 16) * 256 + wc * 32 + 8 * fq;
#pragma unroll
                    for (int bj = 0; bj < 2; ++bj) *(u32x4*)(rowp + bj * HALF) = pack8(acc[ai][bj][m][0], acc[ai][bj][m][1]); asm volatile("" ::: "memory"); }
        } else if (pn <= 2) {
            const int t = pn - 1;
#pragma unroll
            for (int ai = 0; ai < 2; ++ai)
#pragma unroll
                for (int m = 0; m < 4; ++m) { bf16_t* rowp = Z + (size_t)(row0 + ai * HALF + m * 16) * 256 + t * 128 + 16 * wc + 4 * fq;
#pragma unroll
                    for (int bj = 0; bj < 2; ++bj) { const f32x4 a = acc[ai][bj][m][0], gt = acc[ai][bj][m][1]; f32x4 z;
                        z = a * rsig4_(gt);
                        *(u32x2*)(rowp + 64 * bj) = pack4(z); } asm volatile("" ::: "memory"); }
        } else if (pn <= 6) {
            const bool isq = pn <= 4; const int t = isq ? pn - 3 : pn - 5; const PG8_LAS float* gs = isq ? qg : kg;
            f32x4 gv[2][2];
#pragma unroll
            for (int bj = 0; bj < 2; ++bj)
#pragma unroll
                for (int n = 0; n < 2; ++n) gv[bj][n] = *(const PG8_LAS f32x4*)(gs + 32 * bj + 8 * fq + 4 * n);
            const float sc = isq ? ATT_C2 : 1.0f; const int head = 4 * t + wc;
#pragma unroll
            for (int ai = 0; ai < 2; ++ai)
#pragma unroll
                for (int m = 0; m < 4; ++m) { float ss = 0.f;
#pragma unroll
                    for (int bj = 0; bj < 2; ++bj)
#pragma unroll
                        for (int n = 0; n < 2; ++n) { const f32x4 x = acc[ai][bj][m][n]; ss += (x[0] * x[0] + x[1] * x[1]) + (x[2] * x[2] + x[3] * x[3]); }
                    { const int ln = 16 * fq + fr; ss += __int_as_float(__builtin_amdgcn_ds_bpermute((ln ^ 16) << 2, __float_as_int(ss))); ss += __int_as_float(__builtin_amdgcn_ds_bpermute((ln ^ 32) << 2, __float_as_int(ss))); }
                    const float rs = __builtin_amdgcn_rsqf(ss * (1.0f / 64.0f) + NORM_EPS) * sc;
                    const size_t r = (size_t)(row0 + ai * HALF + m * 16);
                    bf16_t* rowp = isq ? Q + r * 1024 + 64 * head + 8 * fq : Kb + r * 512 + 64 * head + 8 * fq;
#pragma unroll
                    for (int bj = 0; bj < 2; ++bj) *(u32x4*)(rowp + 32 * bj) = pack8(acc[ai][bj][m][0] * rs * gv[bj][0], acc[ai][bj][m][1] * rs * gv[bj][1]); asm volatile("" ::: "memory"); }
        } else {
            const int t = pn - 7;
#pragma unroll
            for (int ai = 0; ai < 2; ++ai)
#pragma unroll
                for (int m = 0; m < 4; ++m) { bf16_t* rowp = Vb + (size_t)(row0 + ai * HALF + m * 16) * 512 + 256 * t + wc * 32 + 8 * fq;
#pragma unroll
                    for (int bj = 0; bj < 2; ++bj) *(u32x4*)(rowp + bj * HALF) = pack8(acc[ai][bj][m][0], acc[ai][bj][m][1]); asm volatile("" ::: "memory"); }

        }
    }
};

constexpr float GATE_EMAX = 448.0f;
struct EpiGate {
    static constexpr bool PERM = true; static constexpr int NST = 0; static constexpr bool KEEPS = false;
    unsigned char* G8; const PG8_LAS float* bgate;
    __device__ __forceinline__ void operator()(const f32x4 (&acc)[2][2][4][2], const Unit& u, int wr, int wc, int fr, int fq) const {
        const int c0 = 256 * u.pn + wc * 32 + 8 * fq;
        f32x4 bv[2][2];
#pragma unroll
        for (int bj = 0; bj < 2; ++bj)
#pragma unroll
            for (int n = 0; n < 2; ++n) bv[bj][n] = *(const PG8_LAS f32x4*)(bgate + c0 + bj * HALF + 4 * n);
#pragma unroll
        for (int ai = 0; ai < 2; ++ai)
#pragma unroll
            for (int m = 0; m < 4; ++m) { int w[4];
#pragma unroll
                for (int bj = 0; bj < 2; ++bj) { f32x4 v0 = acc[ai][bj][m][0] + bv[bj][0], v1 = acc[ai][bj][m][1] + bv[bj][1];
#pragma unroll
                    for (int i = 0; i < 4; ++i) { v0[i] = fminf(__builtin_amdgcn_exp2f(-v0[i]), GATE_EMAX); v1[i] = fminf(__builtin_amdgcn_exp2f(-v1[i]), GATE_EMAX); }
                    int lo = 0, hi = 0;
                    lo = __builtin_amdgcn_cvt_pk_fp8_f32(v0[0], v0[1], lo, false); lo = __builtin_amdgcn_cvt_pk_fp8_f32(v0[2], v0[3], lo, true);
                    hi = __builtin_amdgcn_cvt_pk_fp8_f32(v1[0], v1[1], hi, false); hi = __builtin_amdgcn_cvt_pk_fp8_f32(v1[2], v1[3], hi, true);
                    w[2 * bj] = lo; w[2 * bj + 1] = hi; }
                *(u32x4*)(G8 + gfrag8(u.pm, u.pn, wr * 4 + wc, ai * 4 + m, fq * 16 + fr)) = (u32x4){(unsigned)w[0], (unsigned)w[1], (unsigned)w[2], (unsigned)w[3]}; asm volatile("" ::: "memory"); }
    }
};
struct EpiInProjNS {
    static constexpr bool PERM = true; static constexpr int NST = 0; static constexpr bool KEEPS = false;
    bf16_t *P, *Z, *Q, *Kb, *Vb, *G; const float *qg, *kg, *bgate;
    __device__ __forceinline__ void operator()(const f32x4 (&acc)[2][2][4][2], const Unit& u, int wr, int wc, int fr, int fq) const {
        const int row0 = u.pm * BM + wr * 64 + fr; const int pn = u.pn;
        if (pn == 0) {
#pragma unroll
            for (int ai = 0; ai < 2; ++ai)
#pragma unroll
                for (int m = 0; m < 4; ++m) { bf16_t* rowp = P + (size_t)(row0 + ai * HALF + m * 16) * 256 + wc * 32 + 8 * fq;
#pragma unroll
                    for (int bj = 0; bj < 2; ++bj) { const u32x4 t_ = pack8(acc[ai][bj][m][0], acc[ai][bj][m][1]); asm volatile("" :: "v"(t_)); } asm volatile("" ::: "memory"); }
        } else if (pn <= 2) {
            const int t = pn - 1;
#pragma unroll
            for (int ai = 0; ai < 2; ++ai)
#pragma unroll
                for (int m = 0; m < 4; ++m) { bf16_t* rowp = Z + (size_t)(row0 + ai * HALF + m * 16) * 256 + t * 128 + 16 * wc + 4 * fq;
#pragma unroll
                    for (int bj = 0; bj < 2; ++bj) { const f32x4 a = acc[ai][bj][m][0], gt = acc[ai][bj][m][1]; f32x4 z;
#pragma unroll
                        for (int i = 0; i < 4; ++i) z[i] = a[i] * sigmoidf_(gt[i]);
                        { const u32x2 t_ = pack4(z); asm volatile("" :: "v"(t_)); } } asm volatile("" ::: "memory"); }
        } else if (pn <= 6) {
            const bool isq = pn <= 4; const int t = isq ? pn - 3 : pn - 5; const float* gs = isq ? qg : kg;
            f32x4 gv[2][2];
#pragma unroll
            for (int bj = 0; bj < 2; ++bj)
#pragma unroll
                for (int n = 0; n < 2; ++n) gv[bj][n] = *(const f32x4*)(gs + 32 * bj + 8 * fq + 4 * n);
            const float sc = isq ? ATT_C2 : 1.0f; const int head = 4 * t + wc;
#pragma unroll
            for (int ai = 0; ai < 2; ++ai)
#pragma unroll
                for (int m = 0; m < 4; ++m) { float ss = 0.f;
#pragma unroll
                    for (int bj = 0; bj < 2; ++bj)
#pragma unroll
                        for (int n = 0; n < 2; ++n) { const f32x4 x = acc[ai][bj][m][n]; ss += (x[0] * x[0] + x[1] * x[1]) + (x[2] * x[2] + x[3] * x[3]); }
                    { const int ln = 16 * fq + fr; ss += __int_as_float(__builtin_amdgcn_ds_bpermute((ln ^ 16) << 2, __float_as_int(ss))); ss += __int_as_float(__builtin_amdgcn_ds_bpermute((ln ^ 32) << 2, __float_as_int(ss))); }
                    const float rs = __builtin_amdgcn_rsqf(ss * (1.0f / 64.0f) + NORM_EPS) * sc;
                    const size_t r = (size_t)(row0 + ai * HALF + m * 16);
                    bf16_t* rowp = isq ? Q + r * 1024 + 64 * head + 8 * fq : Kb + r * 512 + 64 * head + 8 * fq;
#pragma unroll
                    for (int bj = 0; bj < 2; ++bj) { const u32x4 t_ = pack8(acc[ai][bj][m][0] * rs * gv[bj][0], acc[ai][bj][m][1] * rs * gv[bj][1]); asm volatile("" :: "v"(t_)); } asm volatile("" ::: "memory"); }
        } else if (pn <= 8) {
            const int t = pn - 7;
#pragma unroll
            for (int ai = 0; ai < 2; ++ai)
#pragma unroll
                for (int m = 0; m < 4; ++m) { bf16_t* rowp = Vb + (size_t)(row0 + ai * HALF + m * 16) * 512 + 256 * t + wc * 32 + 8 * fq;
#pragma unroll
                    for (int bj = 0; bj < 2; ++bj) { const u32x4 t_ = pack8(acc[ai][bj][m][0], acc[ai][bj][m][1]); asm volatile("" :: "v"(t_)); } asm volatile("" ::: "memory"); }
        } else {
            const int c0 = 256 * (pn - 9) + wc * 32 + 8 * fq;
            f32x4 bv[2][2];
#pragma unroll
            for (int bj = 0; bj < 2; ++bj)
#pragma unroll
                for (int n = 0; n < 2; ++n) bv[bj][n] = *(const f32x4*)(bgate + c0 + bj * HALF + 4 * n);
#pragma unroll
            for (int ai = 0; ai < 2; ++ai)
#pragma unroll
                for (int m = 0; m < 4; ++m) { bf16_t* rowp = G + (size_t)(row0 + ai * HALF + m * 16) * 3072 + c0;
#pragma unroll
                    for (int bj = 0; bj < 2; ++bj) { f32x4 v0 = acc[ai][bj][m][0] + bv[bj][0], v1 = acc[ai][bj][m][1] + bv[bj][1];
#pragma unroll
                        for (int i = 0; i < 4; ++i) { v0[i] = sigmoidf_(v0[i]); v1[i] = sigmoidf_(v1[i]); }
                        { const u32x4 t_ = pack8(v0, v1); asm volatile("" :: "v"(t_)); } } asm volatile("" ::: "memory"); }
        }
    }
};

template <int LINEAR> struct EpiStoreProbe {
    static constexpr bool PERM = true; static constexpr int NST = 0; static constexpr bool KEEPS = false;
    bf16_t* S;
    __device__ __forceinline__ void operator()(const f32x4 (&acc)[2][2][4][2], const Unit& u, int wr, int wc, int fr, int fq) const {
        const int row0 = wr * 64 + fr; const size_t tbase = ((size_t)(blockIdx.x) * 256) * 256;
        const int wid = wr * 4 + wc, lane = fq * 16 + fr;
#pragma unroll
        for (int ai = 0; ai < 2; ++ai)
#pragma unroll
            for (int m = 0; m < 4; ++m)
#pragma unroll
                for (int bj = 0; bj < 2; ++bj) {
                    bf16_t* p = LINEAR ? S + tbase + (size_t)(((ai * 4 + m) * 2 + bj) * 8 + wid) * 512 + lane * 8
                                       : S + tbase + (size_t)(row0 + ai * HALF + m * 16) * 256 + bj * HALF + wc * 32 + 8 * fq;
                    *(u32x4*)p = pack8(acc[ai][bj][m][0], acc[ai][bj][m][1]); }
    }
};
struct EpiNull {
    static constexpr bool PERM = true; static constexpr int NST = 0; static constexpr bool KEEPS = false;
    __device__ __forceinline__ void operator()(const f32x4 (&acc)[2][2][4][2], const Unit& u, int wr, int wc, int fr, int fq) const {
#pragma unroll
        for (int a = 0; a < 2; ++a)
#pragma unroll
            for (int b = 0; b < 2; ++b)
#pragma unroll
                for (int m = 0; m < 4; ++m)
#pragma unroll
                    for (int n = 0; n < 2; ++n) asm volatile("" :: "v"(acc[a][b][m][n])); }
};
struct EpiMerge {
    static constexpr bool PERM = true; static constexpr int NST = 0; static constexpr bool KEEPS = true;
    const unsigned char* G8; bf16_t* MG;
    __device__ __forceinline__ bool keep(const Unit& u) const { return u.e != 2; }
    __device__ __forceinline__ void operator()(f32x4 (&acc)[2][2][4][2], const Unit& u, int wr, int wc, int fr, int fq) const {
        const int row0 = u.pm * BM + wr * 64 + fr, col0 = u.pn * BM + wc * 32 + 8 * fq; const int seg = u.e;
        const int wid = wr * 4 + wc, ln = fq * 16 + fr;
        const unsigned char* Ga = G8 + gfrag8(u.pm, seg * 4 + u.pn, wid, 0, ln);
        const unsigned char* Gb = G8 + gfrag8(u.pm, (seg != 2 ? seg + 1 : seg) * 4 + u.pn, wid, 0, ln);
        u32x4 ga[2][4], gb[2][4];
#pragma unroll
        for (int ai = 0; ai < 2; ++ai)
#pragma unroll
            for (int m = 0; m < 4; ++m) { const int k = ai * 4 + m; ga[ai][m] = *(const u32x4*)(Ga + 1024 * k); if (seg != 2) gb[ai][m] = *(const u32x4*)(Gb + 1024 * k); else gb[ai][m] = (u32x4){0u, 0u, 0u, 0u}; }
        asm volatile("" ::: "memory");
#define EM_UNPACK8(wx, wy, lo4, hi4) f32x4 lo4, hi4; { const f32x2 p0_ = __builtin_amdgcn_cvt_pk_f32_fp8((int)(wx), false), p1_ = __builtin_amdgcn_cvt_pk_f32_fp8((int)(wx), true), p2_ = __builtin_amdgcn_cvt_pk_f32_fp8((int)(wy), false), p3_ = __builtin_amdgcn_cvt_pk_f32_fp8((int)(wy), true); \
            lo4 = (f32x4){p0_[0], p0_[1], p1_[0], p1_[1]}; hi4 = (f32x4){p2_[0], p2_[1], p3_[0], p3_[1]}; }
#pragma unroll
        for (int ai = 0; ai < 2; ++ai)
#pragma unroll
            for (int m = 0; m < 4; ++m) { bf16_t* mp = MG + (size_t)(row0 + ai * HALF + m * 16) * 1024 + col0;
#pragma unroll
                for (int bj = 0; bj < 2; ++bj) { const u32x4 a4 = ga[ai][m], b4 = gb[ai][m];
                    EM_UNPACK8(bj ? a4.z : a4.x, bj ? a4.w : a4.y, na0, na1); EM_UNPACK8(bj ? b4.z : b4.x, bj ? b4.w : b4.y, nb0, nb1);
                    { const f32x4 da0 = na0 + 1.0f, da1 = na1 + 1.0f;
                      const f32x4 ra0 = (f32x4){__builtin_amdgcn_rcpf(da0[0]), __builtin_amdgcn_rcpf(da0[1]), __builtin_amdgcn_rcpf(da0[2]), __builtin_amdgcn_rcpf(da0[3])}, ra1 = (f32x4){__builtin_amdgcn_rcpf(da1[0]), __builtin_amdgcn_rcpf(da1[1]), __builtin_amdgcn_rcpf(da1[2]), __builtin_amdgcn_rcpf(da1[3])};
                      acc[ai][bj][m][0] *= (nb0 + 1.0f) * ra0; acc[ai][bj][m][1] *= (nb1 + 1.0f) * ra1; }
                    if (seg == 2) *(u32x4*)(mp + bj * HALF) = pack8(acc[ai][bj][m][0], acc[ai][bj][m][1]); }
                asm volatile("" ::: "memory"); }
#undef EM_UNPACK8
    }
};

template <bool SRC_F32> struct EpiResid {
    static constexpr bool PERM = true; static constexpr int NST = 0; static constexpr bool KEEPS = false;
    const void* src; bf16_t* out;
    __device__ __forceinline__ void operator()(const f32x4 (&acc)[2][2][4][2], const Unit& u, int wr, int wc, int fr, int fq) const {
        const int row0 = u.pm * BM + wr * 64 + fr, col0 = u.pn * BM + wc * 32 + 8 * fq;
        if constexpr (SRC_F32) {
#pragma unroll
        for (int ai = 0; ai < 2; ++ai) {
            f32x4 b[4][2][2];
#pragma unroll
            for (int m = 0; m < 4; ++m) { const size_t off = (size_t)(row0 + ai * HALF + m * 16) * 1024 + col0;
#pragma unroll
                for (int bj = 0; bj < 2; ++bj) { b[m][bj][0] = *(const f32x4*)((const float*)src + off + bj * HALF); b[m][bj][1] = *(const f32x4*)((const float*)src + off + bj * HALF + 4); } }
#pragma unroll
            for (int m = 0; m < 4; ++m) { const size_t off = (size_t)(row0 + ai * HALF + m * 16) * 1024 + col0;
#pragma unroll
                for (int bj = 0; bj < 2; ++bj) *(u32x4*)(out + off + bj * HALF) = pack8(b[m][bj][0] + acc[ai][bj][m][0], b[m][bj][1] + acc[ai][bj][m][1]); }
            asm volatile("" ::: "memory");
        }
        } else {
            u32x4 b[2][4][2];
#pragma unroll
            for (int ai = 0; ai < 2; ++ai)
#pragma unroll
                for (int m = 0; m < 4; ++m) { const size_t off = (size_t)(row0 + ai * HALF + m * 16) * 1024 + col0;
#pragma unroll
                    for (int bj = 0; bj < 2; ++bj) b[ai][m][bj] = *(const u32x4*)((const bf16_t*)src + off + bj * HALF); }
            asm volatile("" ::: "memory");
#pragma unroll
            for (int ai = 0; ai < 2; ++ai) {
#pragma unroll
                for (int m = 0; m < 4; ++m) { const size_t off = (size_t)(row0 + ai * HALF + m * 16) * 1024 + col0;
#pragma unroll
                    for (int bj = 0; bj < 2; ++bj) { const u32x4 w = b[ai][m][bj];
                        const f32x4 lo = (f32x4){bf_lo(w.x), bf_hi(w.x), bf_lo(w.y), bf_hi(w.y)}, hi = (f32x4){bf_lo(w.z), bf_hi(w.z), bf_lo(w.w), bf_hi(w.w)};
                        *(u32x4*)(out + off + bj * HALF) = pack8(lo + acc[ai][bj][m][0], hi + acc[ai][bj][m][1]); } }
                asm volatile("" ::: "memory"); }
        }
    }
};

struct EpiSwiGLU {
    static constexpr bool PERM = true; static constexpr int NST = 0; static constexpr bool KEEPS = false;
    bf16_t* H; int ldh;
    __device__ __forceinline__ void operator()(const f32x4 (&acc)[2][2][4][2], const Unit& u, int wr, int wc, int fr, int fq) const {
        const int row0 = u.pm * BM + wr * 64 + fr, ch0 = u.pn * 128 + 32 * wc + 8 * fq;
#pragma unroll
        for (int ai = 0; ai < 2; ++ai)
#pragma unroll
            for (int m = 0; m < 4; ++m) { f32x4 z[2];
#pragma unroll
                for (int n = 0; n < 2; ++n) { const f32x4 a = acc[ai][0][m][n], b = acc[ai][1][m][n];
                    z[n] = (a * b) * rsig4_(a); }
                *(u32x4*)(H + (size_t)(row0 + ai * HALF + m * 16) * ldh + ch0) = pack8(z[0], z[1]); asm volatile("" ::: "memory"); }
    }
};

struct EpiSwiGLU8 {
    static constexpr bool PERM = true; static constexpr int NST = 0; static constexpr bool KEEPS = false;
    unsigned char* H8; int ldh;
    __device__ __forceinline__ void operator()(const f32x4 (&acc)[2][2][4][2], const Unit& u, int wr, int wc, int fr, int fq) const {
        const int row0 = u.pm * BM + wr * 64 + fr, ch0 = u.pn * 128 + 32 * wc + 8 * fq;
#pragma unroll
        for (int ai = 0; ai < 2; ++ai)
#pragma unroll
            for (int m = 0; m < 4; ++m) { int w[2];
#pragma unroll
                for (int n = 0; n < 2; ++n) { const f32x4 a = acc[ai][0][m][n], b = acc[ai][1][m][n]; f32x4 z;
                    z = (a * b) * rsig4_(a);
                    int t = 0; t = __builtin_amdgcn_cvt_pk_fp8_f32(z[0], z[1], t, false); t = __builtin_amdgcn_cvt_pk_fp8_f32(z[2], z[3], t, true); w[n] = t; }
                *(u32x2*)(H8 + (size_t)(row0 + ai * HALF + m * 16) * ldh + ch0) = (u32x2){(unsigned)w[0], (unsigned)w[1]}; asm volatile("" ::: "memory"); }
    }
};

template <bool DST_F32> struct EpiMoeDown {
    static constexpr bool PERM = true; static constexpr int NST = 0; static constexpr bool KEEPS = false;
    const bf16_t* xb; void* out; const unsigned* list; const float* wgt; int ntfull;
    __device__ __forceinline__ void operator()(const f32x4 (&acc)[2][2][4][2], const Unit& u, int wr, int wc, int fr, int fq) const {
        const int col0 = u.pn * BM + wc * 32 + 8 * fq; const unsigned* lp = list + u.lo; const int nv = u.nv;
        unsigned tok[2][4]; float w[2][4];
#pragma unroll
        for (int ai = 0; ai < 2; ++ai)
#pragma unroll
            for (int m = 0; m < 4; ++m) { const int rl = ai * HALF + wr * 64 + m * 16 + fr; tok[ai][m] = rl < nv ? lp[rl] : 0u; }
#pragma unroll
        for (int ai = 0; ai < 2; ++ai)
#pragma unroll
            for (int m = 0; m < 4; ++m) w[ai][m] = wgt[tok[ai][m]];
        u32x4 b[4][2];
#pragma unroll
        for (int m = 0; m < 4; ++m) { const bf16_t* xp = xb + (size_t)tok[0][m] * 1024 + col0;
#pragma unroll
            for (int bj = 0; bj < 2; ++bj) b[m][bj] = *(const u32x4*)(xp + bj * HALF); }
        asm volatile("" ::: "memory");
#pragma unroll
        for (int ai = 0; ai < 2; ++ai) {
#pragma unroll
            for (int m = 0; m < 4; ++m) { const int rl = ai * HALF + wr * 64 + m * 16 + fr; const size_t off = (size_t)tok[ai][m] * 1024 + col0;
                const u32x4 q0 = b[m][0], q1 = b[m][1];
                if (ai == 0) { const bf16_t* xp = xb + (size_t)tok[1][m] * 1024 + col0; b[m][0] = *(const u32x4*)xp; b[m][1] = *(const u32x4*)(xp + HALF); }
                if (rl < nv) {
#pragma unroll
                    for (int bj = 0; bj < 2; ++bj) { const u32x4 q = bj ? q1 : q0;
                        const f32x4 v0 = (f32x4){bf_lo(q.x), bf_hi(q.x), bf_lo(q.y), bf_hi(q.y)} + acc[ai][bj][m][0] * w[ai][m], v1 = (f32x4){bf_lo(q.z), bf_hi(q.z), bf_lo(q.w), bf_hi(q.w)} + acc[ai][bj][m][1] * w[ai][m];
                        if constexpr (DST_F32) { *(f32x4*)((float*)out + off + bj * HALF) = v0; *(f32x4*)((float*)out + off + bj * HALF + 4) = v1; }
                        else *(u32x4*)((bf16_t*)out + off + bj * HALF) = pack8(v0, v1); } }
                asm volatile("" ::: "memory"); }
        }
    }
};
}
#include <hip/hip_bf16.h>
#include <cmath>
namespace attn_body {
using bf16=__hip_bfloat16;
using bf16x8=__attribute__((ext_vector_type(8)))short;
using s16x4=__attribute__((ext_vector_type(4)))short;
using f32x16=__attribute__((ext_vector_type(16)))float;
using u32x4=__attribute__((ext_vector_type(4)))unsigned;
constexpr int BATCH=8,NHEAD=8,SEQ=8192,D=64,KVP=NHEAD*D,QP=1024;
constexpr int NW=8,QBLK=32,QB=QBLK*NW,KVBLK=64,NQB=SEQ/QB;
constexpr int ATTN_UNIT_ROWS=QB;
__device__ __forceinline__ int crow(int r,int hi){return (r&3)+8*(r>>2)+4*hi;}
#define SBAR() __builtin_amdgcn_sched_barrier(0)
__device__ __forceinline__ void cmask(f32x16&p0,f32x16&p1,int jb,int qrel,int hi){
  const float NEG=-INFINITY; int kb=64*jb+4*hi;
  #pragma unroll
  for(int r=0;r<16;++r){int kv=kb+(r&3)+8*(r>>2); if(kv>qrel)p0[r]=NEG; if(kv+32>qrel)p1[r]=NEG;}
}

constexpr int NSLOT=3, SLOTB=8192;
constexpr int LDS_K=0, LDS_V=NSLOT*SLOTB, LDS_WS=2*NSLOT*SLOTB, LDS_OST=LDS_WS+NW*64*4, LDS_CT=LDS_OST+NW*4096, LDS_BYTES=LDS_CT+SEQ*4;
constexpr float C2=0.125f*1.4426950408889634f;
__device__ __forceinline__ void glds16(const void*gsrc,unsigned lds_dst){unsigned keep;
  asm volatile("s_mov_b32 %0, m0\n\ts_mov_b32 m0, %2\n\ts_nop 0\n\tglobal_load_lds_dwordx4 %1, off\n\ts_mov_b32 m0, %0":"=&s"(keep):"v"(gsrc),"s"(lds_dst):"memory");}
__device__ __forceinline__ float max3f(float a,float b,float c){float r;asm("v_max3_f32 %0, %1, %2, %3":"=v"(r):"v"(a),"v"(b),"v"(c));return r;}
__device__ __forceinline__ float max2f(float a,float b){float r;asm("v_max_f32_e32 %0, %1, %2":"=v"(r):"v"(a),"v"(b));return r;}
__device__ __forceinline__ float fadd_s(float a,float b){float r;asm("v_add_f32_e32 %0, %1, %2":"=v"(r):"v"(a),"v"(b));return r;}
__device__ __forceinline__ float fsub_s(float a,float b){float r;asm("v_sub_f32_e32 %0, %1, %2":"=v"(r):"v"(a),"v"(b));return r;}
typedef float f32x2_t __attribute__((ext_vector_type(2))); typedef __bf16 bf16x2_t __attribute__((ext_vector_type(2)));
__device__ __forceinline__ unsigned cvtpk_s(float lo,float hi){f32x2_t v={lo,hi};bf16x2_t b=__builtin_convertvector(v,bf16x2_t);return __builtin_bit_cast(unsigned,b);}
#define WAIT_BAR(N) asm volatile("s_waitcnt vmcnt(" #N ") lgkmcnt(0)\n\ts_barrier":::"memory")

__device__ __forceinline__ void qkt(f32x16&p0,f32x16&p1,const char*Kslot,const bf16x8*qr,int r32,int hi){
  const char*kb=Kslot+hi*1024+r32*16;
  #pragma unroll
  for(int d0=0;d0<4;++d0){
    const bf16x8 b0=*reinterpret_cast<const bf16x8*>(kb+d0*2048);
    const bf16x8 b1=*reinterpret_cast<const bf16x8*>(kb+d0*2048+512);
    {p0=__builtin_amdgcn_mfma_f32_32x32x16_bf16(b0,qr[d0],p0,0,0,0);p1=__builtin_amdgcn_mfma_f32_32x32x16_bf16(b1,qr[d0],p1,0,0,0);}}
}
typedef __attribute__((address_space(3))) const char* lds_cptr;
typedef short v4i16_t __attribute__((ext_vector_type(4)));
__device__ __forceinline__ void kload8(bf16x8*kf,lds_cptr kp){
  kf[0]=*(const __attribute__((address_space(3))) bf16x8*)(kp);      kf[1]=*(const __attribute__((address_space(3))) bf16x8*)(kp+512);
  kf[2]=*(const __attribute__((address_space(3))) bf16x8*)(kp+2048); kf[3]=*(const __attribute__((address_space(3))) bf16x8*)(kp+2560);
  kf[4]=*(const __attribute__((address_space(3))) bf16x8*)(kp+4096); kf[5]=*(const __attribute__((address_space(3))) bf16x8*)(kp+4608);
  kf[6]=*(const __attribute__((address_space(3))) bf16x8*)(kp+6144); kf[7]=*(const __attribute__((address_space(3))) bf16x8*)(kp+6656);
}
__device__ __forceinline__ void kload2(bf16x8*kf,lds_cptr kp,int j){ kf[2*j]=*(const __attribute__((address_space(3))) bf16x8*)(kp+j*2048); kf[2*j+1]=*(const __attribute__((address_space(3))) bf16x8*)(kp+j*2048+512); }
__device__ __forceinline__ s16x4 vtr(lds_cptr p){ return __builtin_bit_cast(s16x4,__builtin_amdgcn_ds_read_tr16_b64_v4i16((__attribute__((address_space(3))) v4i16_t*)p)); }
__device__ __forceinline__ float rowmax(const f32x16&p0,const f32x16&p1){
  float a=max3f(p0[0],p0[1],p1[0]),b=max3f(p0[2],p0[3],p1[1]);a=max3f(a,p1[2],p1[3]);
  #pragma unroll
  for(int r=4;r<16;r+=4){a=max3f(a,p0[r],p0[r+1]);b=max3f(b,p0[r+2],p0[r+3]);a=max3f(a,p1[r],p1[r+1]);b=max3f(b,p1[r+2],p1[r+3]);}
  const float m=max2f(a,b);
  auto rr=__builtin_amdgcn_permlane32_swap(__float_as_uint(m),__float_as_uint(m),false,false);
  return max2f(__uint_as_float(rr[0]),__uint_as_float(rr[1]));
}
__device__ __forceinline__ void pv(f32x16*o,int vb,bf16x8 pa0,bf16x8 pa1,bf16x8 pa2,bf16x8 pa3){
  #pragma unroll
  for(int d0=0;d0<2;++d0){s16x4 lo[4],hi[4];
    #pragma unroll
    for(int ks=0;ks<4;++ks){
      asm volatile("ds_read_b64_tr_b16 %0,%1 offset:%c2":"=&v"(lo[ks]):"v"(vb),"i"(d0*4096+ks*1024):"memory");
      asm volatile("ds_read_b64_tr_b16 %0,%1 offset:%c2":"=&v"(hi[ks]):"v"(vb),"i"(d0*4096+ks*1024+512):"memory");}
    asm volatile("s_waitcnt lgkmcnt(0)":::"memory");SBAR();
    #define PK(k) (bf16x8){lo[k][0],lo[k][1],lo[k][2],lo[k][3],hi[k][0],hi[k][1],hi[k][2],hi[k][3]}
    o[d0]=__builtin_amdgcn_mfma_f32_32x32x16_bf16(pa0,PK(0),o[d0],0,0,0);
    o[d0]=__builtin_amdgcn_mfma_f32_32x32x16_bf16(pa1,PK(1),o[d0],0,0,0);
    o[d0]=__builtin_amdgcn_mfma_f32_32x32x16_bf16(pa2,PK(2),o[d0],0,0,0);
    o[d0]=__builtin_amdgcn_mfma_f32_32x32x16_bf16(pa3,PK(3),o[d0],0,0,0);
    #undef PK
  }
}

#ifndef ATTN_STORE16
#define ATTN_STORE16(p,v) (*(u32x4*)(p)=(v))
#endif
template<int THRL> __device__ __forceinline__ void attn_unit(int b,int h,int qb,int t0,const bf16*Q,const bf16*__restrict__ K,const bf16*__restrict__ V,bf16*O,const float*__restrict__ NCL,char*shm){
  int tid_o=threadIdx.x; asm volatile("":"+v"(tid_o));
  const int tid=tid_o,lane=tid&63,r32=lane&31,hi=lane>>5; const int wid=__builtin_amdgcn_readfirstlane(tid>>6);
  const long rowbase=(long)b*SEQ; const int q0=qb*QB;
  const bf16*Qw=Q+(rowbase+q0+wid*QBLK)*QP+h*D;
  const bf16*Kh=K+(rowbase+(long)t0*KVBLK)*KVP+h*D,*Vh=V+(rowbase+(long)t0*KVBLK)*KVP+h*D;
  const unsigned lds0=(unsigned)(uintptr_t)shm;
  float*wsf=(float*)(shm+LDS_WS)+wid*64;
  const bf16*ksrc=Kh+(long)lane*KVP+wid*8;
  const bf16*vsrc=Vh+(long)(16*(wid&3)+(lane>>2))*KVP+(wid>>2)*32+(lane&3)*8;
  const unsigned kdst=lds0+LDS_K+wid*1024, vdst=lds0+LDS_V+wid*1024;
  #define DMA_K(t,slot) glds16(ksrc+(long)(t)*KVBLK*KVP,(unsigned)__builtin_amdgcn_readfirstlane(kdst+(slot)))
  #define DMA_V(t,slot) glds16(vsrc+(long)(t)*KVBLK*KVP,(unsigned)__builtin_amdgcn_readfirstlane(vdst+(slot)))
  const int vb0=(int)(lds0+LDS_V)+((lane>>4)&1)*32+(lane&3)*8+(4*hi+((lane&15)>>2))*64;
  const char*Kbase=shm+LDS_K; bf16x8 kf[8];
  const lds_cptr shm3=(lds_cptr)shm; const lds_cptr kp0=shm3+LDS_K+hi*1024+r32*16; const lds_cptr vp0=shm3+LDS_V+((lane>>4)&1)*32+(lane&3)*8+(4*hi+((lane&15)>>2))*64;
  const int NT=(q0+QB)/KVBLK-t0;
  DMA_K(0,0);DMA_V(0,0);DMA_K(1,SLOTB);
  { typedef float f32x4_t __attribute__((ext_vector_type(4))); __attribute__((address_space(3))) float* ct=(__attribute__((address_space(3))) float*)(shm3+LDS_CT);
    const int i0_=t0*KVBLK+tid*4, iend_=q0+QB; f32x4_t tv_[4];
    _Pragma("unroll") for(int k_=0;k_<4;++k_){ const int i=i0_+k_*(NW*64*4); tv_[k_]=(i<iend_)?*(const f32x4_t*)(NCL+i):(f32x4_t){0.f,0.f,0.f,0.f}; }
    _Pragma("unroll") for(int k_=0;k_<4;++k_){ const int i=i0_+k_*(NW*64*4); if(i<iend_) *(__attribute__((address_space(3))) f32x4_t*)(ct+i)=tv_[k_]; } }
  const __attribute__((address_space(3))) float* ctl=(const __attribute__((address_space(3))) float*)(shm3+LDS_CT)+t0*KVBLK+4*hi;
  #define CINIT(C0,C1,t) do{ typedef float f32x4_t __attribute__((ext_vector_type(4))); const float nm_=-mhat; const __attribute__((address_space(3))) float* cb_=ctl+64*(t); \
    _Pragma("unroll") for(int g_=0;g_<4;++g_){ const f32x4_t b0_=*(const __attribute__((address_space(3))) f32x4_t*)(cb_+8*g_), b1_=*(const __attribute__((address_space(3))) f32x4_t*)(cb_+32+8*g_); \
      _Pragma("unroll") for(int i_=0;i_<4;++i_){ C0[4*g_+i_]=nm_+b0_[i_]; C1[4*g_+i_]=nm_+b1_[i_]; } } }while(0)
  bf16x8 qr[4];
  #pragma unroll
  for(int d0=0;d0<4;++d0)qr[d0]=*reinterpret_cast<const bf16x8*>(&Qw[(long)r32*QP+d0*16+hi*8]);
  float mhat=0.f,l_reg=0.f;f32x16 o[2];o[0]=f32x16{};o[1]=f32x16{};
  const int qrel=wid*QBLK+r32;
  #define CMASK(P0,P1,t) do{int jb_=(t)-(NT-4); if(jb_>=0)cmask(P0,P1,jb_,qrel,hi);}while(0)
  bool resc=false;
  #define START(P0,P1) do{ const float rm=rowmax(P0,P1); resc=false; \
    { const float dl=rm; mhat=fadd_s(mhat,dl); \
      _Pragma("unroll") for(int r=0;r<16;++r){P0[r]=fsub_s(P0[r],dl);P1[r]=fsub_s(P1[r],dl);} \
      } \
    _Pragma("unroll") for(int r=0;r<16;++r)P0[r]=__builtin_amdgcn_exp2f(P0[r]); }while(0)
  #define RESC() do{ if(resc){ asm volatile("s_waitcnt lgkmcnt(0)":::"memory"); \
      _Pragma("unroll") for(int d_=0;d_<2;++d_) _Pragma("unroll") for(int r=0;r<16;++r)o[d_][r]*=wsf[crow(r,hi)]; } }while(0)
  f32x16 pA0,pA1,pB0,pB1;
  int sl_prev=0,sl_cur=0,sl_next=SLOTB;
  #define ROT() do{sl_prev=sl_cur;sl_cur=sl_next;sl_next=(sl_next==(NSLOT-1)*SLOTB)?0:sl_next+SLOTB;}while(0)
  DMA_K(2,2*SLOTB);
  WAIT_BAR(3);
  CINIT(pA0,pA1,0); qkt(pA0,pA1,Kbase,qr,r32,hi);asm volatile("s_nop 15\n\ts_nop 7":"+v"(pA0),"+v"(pA1));CMASK(pA0,pA1,0);
  START(pA0,pA1);
  _Pragma("unroll") for(int r=0;r<16;++r)pA1[r]=__builtin_amdgcn_exp2f(pA1[r]);
  WAIT_BAR(0);
  DMA_K(3,0);DMA_V(1,SLOTB);
  ROT();
  kload8(kf,kp0+sl_cur);
  WAIT_BAR(2);
  s16x4 vlo[8],vhi[8]; u32x4 pw0,pw1,pw2,pw3;
  #define PKW(P,B) cvtpk_s(P[B],P[B+1])
  #define PAF(k) __builtin_bit_cast(bf16x8,pw##k)
  #define VFR(i) (bf16x8){vlo[i][0],vlo[i][1],vlo[i][2],vlo[i][3],vhi[i][0],vhi[i][1],vhi[i][2],vhi[i][3]}
  #define PIN(x) asm volatile("":"+v"(x))
  #define MX3(a,b,c) __builtin_fmaxf(__builtin_fmaxf((a),(b)),(c))
  #define GAPA(MF,A0,A1,A2,A3,W0,W1,PW) do{ MF; sacc+=A0; sacc+=A1; sacc+=A2; sacc+=A3; PIN(sacc); W0; W1; PIN(PW); SBAR(); }while(0)
  #define EX(v) __builtin_amdgcn_exp2f(v)
  #define GAPB(MF,X,B) do{ MF; X[B]=EX(X[B]); X[B+1]=EX(X[B+1]); X[B+2]=EX(X[B+2]); X[B+3]=EX(X[B+3]); PIN(X); SBAR(); }while(0)
  #define VRD(i) do{ vlo[i]=vtr(vp_+(((i)>>2)*4096+((i)&3)*1024)); vhi[i]=vtr(vp_+(((i)>>2)*4096+((i)&3)*1024+512)); }while(0)
  #define KRD(G,j) do{ if(G){ kload2(kf,kp0+sl_next,j); SBAR(); } }while(0)
  #define STEP(C0,C1,P0,P1,t,GK,GV,GL) do{ SBAR(); CINIT(C0,C1,t); SBAR(); \
    const lds_cptr vp_=vp0+sl_prev; \
    VRD(0); SBAR(); float sacc=(P0[0]+P0[1]); \
    GAPA(C0=__builtin_amdgcn_mfma_f32_32x32x16_bf16(kf[0],qr[0],C0,0,0,0), P0[2],P0[3],P0[4],P0[5],     pw0[0]=PKW(P0,0), pw0[1]=PKW(P0,2), pw0); \
    VRD(4); SBAR(); GAPA(C1=__builtin_amdgcn_mfma_f32_32x32x16_bf16(kf[1],qr[0],C1,0,0,0), P0[6],P0[7],P0[8],P0[9],     pw0[2]=PKW(P0,4), pw0[3]=PKW(P0,6), pw0); \
    VRD(1); SBAR(); GAPA(C0=__builtin_amdgcn_mfma_f32_32x32x16_bf16(kf[2],qr[1],C0,0,0,0),   P0[10],P0[11],P0[12],P0[13], pw1[0]=PKW(P0,8), pw1[1]=PKW(P0,10), pw1); \
    VRD(5); SBAR(); GAPA(C1=__builtin_amdgcn_mfma_f32_32x32x16_bf16(kf[3],qr[1],C1,0,0,0),   P0[14],P0[15],P1[0],P1[1],   pw1[2]=PKW(P0,12),pw1[3]=PKW(P0,14), pw1); \
    VRD(2); SBAR(); GAPA(C0=__builtin_amdgcn_mfma_f32_32x32x16_bf16(kf[4],qr[2],C0,0,0,0),   P1[2],P1[3],P1[4],P1[5],     pw2[0]=PKW(P1,0), pw2[1]=PKW(P1,2), pw2); \
    VRD(6); SBAR(); GAPA(C1=__builtin_amdgcn_mfma_f32_32x32x16_bf16(kf[5],qr[2],C1,0,0,0),   P1[6],P1[7],P1[8],P1[9],     pw2[2]=PKW(P1,4), pw2[3]=PKW(P1,6), pw2); \
    VRD(3); SBAR(); GAPA(C0=__builtin_amdgcn_mfma_f32_32x32x16_bf16(kf[6],qr[3],C0,0,0,0),   P1[10],P1[11],P1[12],P1[13], pw3[0]=PKW(P1,8), pw3[1]=PKW(P1,10), pw3); \
    VRD(7); SBAR(); GAPA(C1=__builtin_amdgcn_mfma_f32_32x32x16_bf16(kf[7],qr[3],C1,0,0,0),   P1[14],P1[15],0.f,0.f,       pw3[2]=PKW(P1,12),pw3[3]=PKW(P1,14), pw3); \
    l_reg+=sacc; \
    if(GK){DMA_K((t)+3,sl_cur);} if(GV){DMA_V((t)+1,sl_next);} \
    CMASK(C0,C1,t); \
    { float a=MX3(C0[0],C0[1],C1[0]),b=MX3(C0[2],C0[3],C1[1]); a=MX3(a,C1[2],C1[3]); \
      _Pragma("unroll") for(int r=4;r<16;r+=4){a=MX3(a,C0[r],C0[r+1]);b=MX3(b,C0[r+2],C0[r+3]);a=MX3(a,C1[r],C1[r+1]);b=MX3(b,C1[r+2],C1[r+3]);} \
      float rm=__builtin_fmaxf(a,b); { auto rr=__builtin_amdgcn_permlane32_swap(__float_as_uint(rm),__float_as_uint(rm),false,false); rm=__builtin_fmaxf(__uint_as_float(rr[0]),__uint_as_float(rr[1])); } \
      resc=false; \
      if(__builtin_expect(__any(rm>(float)THRL),0)){ const float dl=__builtin_fmaxf(rm,0.f); mhat+=dl; \
        _Pragma("unroll") for(int r=0;r<16;++r){C0[r]-=dl;C1[r]-=dl;} \
        const float f=__builtin_amdgcn_exp2f(-dl); l_reg*=f; if(hi==0)wsf[r32]=f; resc=true; } } \
    SBAR(); \
    GAPB(o[0]=__builtin_amdgcn_mfma_f32_32x32x16_bf16(PAF(0),VFR(0),o[0],0,0,0), C0,0); \
    GAPB(o[1]=__builtin_amdgcn_mfma_f32_32x32x16_bf16(PAF(0),VFR(4),o[1],0,0,0), C0,4); \
    KRD(GL,0); GAPB(o[0]=__builtin_amdgcn_mfma_f32_32x32x16_bf16(PAF(1),VFR(1),o[0],0,0,0), C0,8); \
    KRD(GL,1); GAPB(o[1]=__builtin_amdgcn_mfma_f32_32x32x16_bf16(PAF(1),VFR(5),o[1],0,0,0), C0,12); \
    KRD(GL,2); GAPB(o[0]=__builtin_amdgcn_mfma_f32_32x32x16_bf16(PAF(2),VFR(2),o[0],0,0,0), C1,0); \
    KRD(GL,3); GAPB(o[1]=__builtin_amdgcn_mfma_f32_32x32x16_bf16(PAF(2),VFR(6),o[1],0,0,0), C1,4); \
    GAPB(o[0]=__builtin_amdgcn_mfma_f32_32x32x16_bf16(PAF(3),VFR(3),o[0],0,0,0), C1,8); \
    GAPB(o[1]=__builtin_amdgcn_mfma_f32_32x32x16_bf16(PAF(3),VFR(7),o[1],0,0,0), C1,12); \
    }while(0)
  int t=1;
  #undef CMASK
  #define CMASK(P0,P1,t) do{}while(0)
  for(;t+5<NT;t+=2){
    STEP(pB0,pB1,pA0,pA1,t,true,true,true);     WAIT_BAR(2); RESC(); ROT();
    STEP(pA0,pA1,pB0,pB1,t+1,true,true,true);   WAIT_BAR(2); RESC(); ROT();
  }
  #undef CMASK
  #define CMASK(P0,P1,t) do{int jb_=(t)-(NT-4); if(jb_>=0)cmask(P0,P1,jb_,qrel,hi);}while(0)
  #define ENDW(tt) do{ if((tt)+3<NT){WAIT_BAR(2);} else if((tt)+2<NT){WAIT_BAR(1);} else {WAIT_BAR(0);} }while(0)
  for(;t+1<NT;t+=2){
    STEP(pB0,pB1,pA0,pA1,t,(t+3<NT),(t+1<NT),(t+1<NT));       ENDW(t);   RESC(); ROT();
    STEP(pA0,pA1,pB0,pB1,t+1,(t+4<NT),(t+2<NT),(t+2<NT));     ENDW(t+1); RESC(); ROT();
  }
  STEP(pB0,pB1,pA0,pA1,NT-1,false,false,false); RESC();
  { float sacc=pB0[0]+pB0[1]; _Pragma("unroll") for(int r=2;r<16;++r)sacc+=pB0[r]; _Pragma("unroll") for(int r=0;r<16;++r)sacc+=pB1[r]; l_reg+=sacc;
    pw0=(u32x4){PKW(pB0,0),PKW(pB0,2),PKW(pB0,4),PKW(pB0,6)};pw1=(u32x4){PKW(pB0,8),PKW(pB0,10),PKW(pB0,12),PKW(pB0,14)};pw2=(u32x4){PKW(pB1,0),PKW(pB1,2),PKW(pB1,4),PKW(pB1,6)};pw3=(u32x4){PKW(pB1,8),PKW(pB1,10),PKW(pB1,12),PKW(pB1,14)};
    SBAR(); pv(o,vb0+sl_cur,PAF(0),PAF(1),PAF(2),PAF(3)); }
  #undef PKW
  #undef PAF
  #undef VFR
  #undef PIN
  #undef MX3
  #undef GAPA
  #undef GAPB
  #undef EX
  #undef VRD
  #undef KRD
  #undef STEP
  #undef ENDW
  {auto rr=__builtin_amdgcn_permlane32_swap(__float_as_uint(l_reg),__float_as_uint(l_reg),false,false);l_reg=__uint_as_float(rr[0])+__uint_as_float(rr[1]);}
  if(hi==0)wsf[32+r32]=l_reg;asm volatile("s_waitcnt lgkmcnt(0)":::"memory");
  float rli[16];
  #pragma unroll
  for(int r=0;r<16;++r)rli[r]=__builtin_amdgcn_rcpf(wsf[32+crow(r,hi)]);
  bf16*Ow=O+(rowbase+q0+wid*QBLK)*QP+h*D;
  { bf16*stg=(bf16*)(shm+LDS_OST)+wid*2048;
    #pragma unroll
    for(int r=0;r<16;++r){const int orow=crow(r,hi);
      #pragma unroll
      for(int d0=0;d0<2;++d0)stg[orow*64+d0*32+r32]=__float2bfloat16(o[d0][r]*rli[r]);}
    asm volatile("s_waitcnt lgkmcnt(0)":::"memory");
    #pragma unroll
    for(int i=0;i<4;++i){const int row=i*8+(lane>>3),ch=lane&7; const u32x4 v=*(const u32x4*)(stg+row*64+ch*8); ATTN_STORE16(Ow+(long)row*QP+ch*8,v);} }
  asm volatile("s_waitcnt lgkmcnt(0)\n\ts_barrier":::"memory");
  #undef DMA_K
  #undef DMA_V
  #undef CMASK
  #undef START
  #undef RESC
  #undef ROT
  #undef CINIT
}
constexpr int ATTN_LDS_BYTES=LDS_BYTES;
struct AttnTensors { const bf16* Q; const bf16* K; const bf16* V; bf16* O; const float* NCL; };
struct AttnUnit { int bh; int qb; };
struct AttnQueue { unsigned* cnt; float th; int xcc; volatile __attribute__((address_space(3))) unsigned* slot; };
template<int THRL=8,class Hook> __device__ __forceinline__ void attn_phase_dyn(char*lds,const AttnTensors&T_,const AttnQueue&Qd,const Hook&hook){
  AttnTensors T;
  { unsigned long long q_=(unsigned long long)T_.Q,k_=(unsigned long long)T_.K,v_=(unsigned long long)T_.V,o_=(unsigned long long)T_.O,c_=(unsigned long long)T_.NCL; asm volatile("":"+s"(q_),"+s"(k_),"+s"(v_),"+s"(o_),"+s"(c_));
    typedef __attribute__((address_space(1))) bf16 gbf; typedef __attribute__((address_space(1))) float gf;
    T.Q=(const bf16*)(const gbf*)q_; T.K=(const bf16*)(const gbf*)k_; T.V=(const bf16*)(const gbf*)v_; T.O=(bf16*)(gbf*)o_; T.NCL=(const float*)(const gf*)c_; }
  int it=0;
  for(int qq=0;qq<BATCH;++qq){ const int b=(Qd.xcc+qq)&(BATCH-1);
    for(;;++it){
      int tid_=threadIdx.x; asm volatile("":"+v"(tid_));
      if(tid_==0) Qd.slot[it&1]=__hip_atomic_fetch_add(Qd.cnt+64*b,1u,__ATOMIC_RELAXED,__HIP_MEMORY_SCOPE_AGENT);
      __syncthreads();
      const int u=__builtin_amdgcn_readfirstlane((int)Qd.slot[it&1]);
      if(u>=NHEAD*NQB) break;
      const int qb=NQB-1-(u>>3),h=u&(NHEAD-1),bh=b*NHEAD+h;
      const float* nrow=T.NCL+(long)bh*SEQ; const int ntile=4*(qb+1),lane_=tid_&63;
      const float ref=nrow[qb*QB]-Qd.th;
      const bool ok0=(lane_<ntile)&&(nrow[(lane_<ntile?lane_:0)*KVBLK+KVBLK-1]<=ref), ok1=(lane_+64<ntile)&&(nrow[(lane_+64<ntile?lane_+64:0)*KVBLK+KVBLK-1]<=ref);
      int t0=__builtin_popcountll(__ballot(ok0))+__builtin_popcountll(__ballot(ok1)); t0&=~1; if(t0>ntile-4)t0=ntile-4;
      t0=__builtin_amdgcn_readfirstlane(t0);
      attn_unit<THRL>(b,h,qb,t0,T.Q,T.K,T.V,T.O,nrow,lds);
      hook(b,u);
    }
    ++it;
  }
}
#undef SBAR
#undef WAIT_BAR
}

constexpr int NWAVES = 8;
#ifndef MK_PER_PHASE
#define MK_PER_PHASE 0
#endif

constexpr int D = 1024, BATCH = 8, SEQ = 8192, M = BATCH * SEQ, DEPTH = 4;
constexpr int IN_COLS = 5384, OFF_CONV = 256, OFF_Q = 768, OFF_K = 1280, OFF_V = 1792, OFF_F = 2304, OFF_G = 2312;
constexpr int NIN = 5376;
constexpr int DFF = 2816, DFFE = 3584, NEXP = 8, CONVK = 31;
constexpr float LOG2E = 1.4426950408889634f;

constexpr size_t MiB = 1u << 20;
constexpr size_t WS_CTL = 0, CTL_ZERO_BYTES = 256 * 1024;
constexpr size_t WS_NLF = 1 * MiB;
constexpr size_t WS_NCL = 3 * MiB;
constexpr size_t WS_WIN = 5 * MiB;
constexpr size_t WS_WBR = 16 * MiB;
constexpr size_t WS_WOUT = 18 * MiB;
constexpr size_t WS_WFF = 20 * MiB;
constexpr size_t WS_HB = 188 * MiB;
constexpr size_t WS_Y = 316 * MiB;
constexpr size_t WS_K = 444 * MiB, WS_V = 508 * MiB;
constexpr size_t WS_P = 572 * MiB, WS_Z = 604 * MiB;
constexpr size_t WS_G = 636 * MiB;
constexpr size_t WS_HID = 316 * MiB;
constexpr size_t HID_SLOT = 232 * MiB;
constexpr int MOE_SKIPR = 3;
static_assert((size_t)264 * 256 * DFFE <= HID_SLOT && WS_HID + 2 * HID_SLOT <= 800 * MiB, "MoE hidden slots");
constexpr size_t WS_LIST = 800 * MiB;
constexpr size_t WS_MOEW = 808 * MiB;
constexpr size_t WS_XBW = 820 * MiB;
constexpr size_t WS_END = 1020 * MiB;
constexpr size_t WFF_W2_DENSE = (size_t)2 * DFF * D * 2;
constexpr size_t WFF_W13_E = (size_t)2 * DFFE * D * 2, WFF_W2_E = (size_t)D * DFFE * 2, WFF_W2_MOE = 8 * WFF_W13_E;
constexpr size_t WS_WG8 = WS_WIN + (size_t)2304 * D * 2;
constexpr size_t WS_H8 = WS_WFF + 100 * MiB;
constexpr int DENSE8_FROM = 2;
constexpr size_t WFF8_W2_DENSE = (size_t)2 * DFF * D;
constexpr size_t WFF8_W13_E = (size_t)2 * DFFE * D, WFF8_W2_E = (size_t)D * DFFE, WFF8_W2_OFF = 8 * WFF8_W13_E;
static_assert(WS_WIN + (size_t)NIN * D * 2 <= WS_WBR && WS_WFF + WFF_W2_MOE + 8 * WFF_W2_E <= WS_HB && WS_G + (size_t)M * 3072 * 2 <= WS_END && WS_HID + (size_t)264 * 256 * DFFE * 2 <= WS_LIST, "d_ws map");
constexpr int CW_TMO = 0;
constexpr int CW_MOECNT = 64;
constexpr int CW_ATTQ = 8192;
constexpr int CW_BAR = 4096;

constexpr int RING_OFF = 0, RING_BYTES = 131072;
constexpr int LDSCTL_OFF = RING_BYTES, MISC_OFF = LDSCTL_OFF + 320;
constexpr int MOETAB_OFF = LDSCTL_OFF + 1024;
constexpr int LDS_BYTES = 147456;
constexpr int GBIAS_OFF = MOETAB_OFF + 272 * 4;
static_assert(MISC_OFF + 128 <= MOETAB_OFF && GBIAS_OFF % 16 == 0 && GBIAS_OFF + (3072 + 128) * 4 <= LDS_BYTES, "LDS map");

#define GAS __attribute__((address_space(1)))
#define LAS __attribute__((address_space(3)))
typedef unsigned short bf16;
typedef unsigned v4u __attribute__((ext_vector_type(4)));
typedef unsigned v2u __attribute__((ext_vector_type(2)));
typedef float f32x4 __attribute__((ext_vector_type(4)));
typedef GAS unsigned gu32;
#define RLX_AGENT __ATOMIC_RELAXED, __HIP_MEMORY_SCOPE_AGENT
#define LDS_WAIT() asm volatile("s_waitcnt lgkmcnt(0)" ::: "memory")
#define VM_WAIT() asm volatile("s_waitcnt vmcnt(0)" ::: "memory")
__device__ __forceinline__ unsigned f2bf(float f) { unsigned u = __builtin_bit_cast(unsigned, f); return (u + 0x7fffu + ((u >> 16) & 1u)) >> 16; }
__device__ __forceinline__ unsigned pk2(float lo, float hi) { return f2bf(lo) | (f2bf(hi) << 16); }
__device__ __forceinline__ float bflo(unsigned w) { return __uint_as_float(w << 16); }
__device__ __forceinline__ float bfhi(unsigned w) { return __uint_as_float(w & 0xffff0000u); }

#define XB_TMO      128
#define XB_XCNT(j)  (256  + 64 * (j))
#define XB_XSUB(j)  (1280 + 64 * (j))
#define XB_XGEN(j)  (2304 + 64 * (j))
#define XB_TOP      3328
#define XB_TOPGEN   3392
#define XCD_BAR_WORDS 3456
#define XB_SPIN_CAP (1u << 18)

__device__ __forceinline__ unsigned xb_ld(unsigned* p)              { return __hip_atomic_load(p, __ATOMIC_RELAXED, __HIP_MEMORY_SCOPE_AGENT); }
__device__ __forceinline__ unsigned xb_add(unsigned* p, unsigned v) { return __hip_atomic_fetch_add(p, v, __ATOMIC_RELAXED, __HIP_MEMORY_SCOPE_AGENT); }
__device__ __forceinline__ unsigned xb_xcc_id() { return (unsigned)__builtin_amdgcn_s_getreg((3 << 11) | 20) & 0xFu; }
#define XB_SPIN(cond, bar) do { unsigned _sp = 0; while (cond) { __builtin_amdgcn_s_sleep(1); \
    if ((++_sp & 255u) == 0u) { if (xb_ld(&(bar)[XB_TMO])) break; if (_sp > XB_SPIN_CAP) { atomicAdd(&(bar)[XB_TMO], 1u); break; } } } } while (0)

struct XcdBarrier {
    unsigned* bar; unsigned x;
    volatile LAS unsigned* st;
};

__device__ __forceinline__ XcdBarrier xcd_barrier_post(unsigned* bar, volatile LAS unsigned* st) {
    XcdBarrier b; b.bar = bar; b.x = xb_xcc_id(); b.st = st;
    if (threadIdx.x == 0) (void)xb_add(&bar[XB_XCNT(b.x)], 1u);
    return b;
}
__device__ __forceinline__ void xcd_barrier_complete(unsigned* bar, unsigned x, unsigned& nloc, unsigned& nx) {
    const unsigned G = gridDim.x * gridDim.y * gridDim.z;
    unsigned sum, cnt, mine, sp = 0u;
    for (;;) {
        sum = 0u; cnt = 0u; mine = 0u;
#pragma unroll
        for (unsigned j = 0; j < 16; ++j) { const unsigned c = xb_ld(&bar[XB_XCNT(j)]); sum += c; cnt += (c > 0u) ? 1u : 0u; mine = (j == x) ? c : mine; }
        if (sum == G) break;
        __builtin_amdgcn_s_sleep(1);
        if ((++sp & 255u) == 0u) { if (xb_ld(&bar[XB_TMO])) break; if (sp > XB_SPIN_CAP) { atomicAdd(&bar[XB_TMO], 1u); break; } }
    }
    nloc = mine > 0u ? mine : 1u; nx = cnt > 0u ? cnt : 1u;
}

__device__ __forceinline__ void xcd_barrier(const XcdBarrier& b) {
    asm volatile("s_waitcnt vmcnt(0)" ::: "memory");
    __syncthreads();
    if (threadIdx.x == 0) {
        unsigned* bar = b.bar;
        __builtin_amdgcn_s_waitcnt(0);
        unsigned nloc = b.st[0], nx = b.st[1];
        if (nloc == 0u) { xcd_barrier_complete(bar, b.x, nloc, nx); b.st[0] = nloc; b.st[1] = nx; }
        const unsigned old = xb_add(&bar[XB_XSUB(b.x)], 1u);
        const unsigned gen = old / nloc;
        if (old + 1u == (gen + 1u) * nloc) {
            __builtin_amdgcn_fence(__ATOMIC_RELEASE, "agent");
            asm volatile("s_waitcnt vmcnt(0)" ::: "memory");
            const unsigned og = xb_add(&bar[XB_TOP], 1u);
            const unsigned tg = og / nx;
            if (og + 1u == (tg + 1u) * nx) xb_add(&bar[XB_TOPGEN], 1u);
            else XB_SPIN(xb_ld(&bar[XB_TOPGEN]) == tg, bar);
            __builtin_amdgcn_fence(__ATOMIC_ACQUIRE, "agent");
            xb_add(&bar[XB_XGEN(b.x)], 1u);
            asm volatile("s_waitcnt vmcnt(0)" ::: "memory");
        } else {
            XB_SPIN(xb_ld(&bar[XB_XGEN(b.x)]) == gen, bar);
            __builtin_amdgcn_fence(__ATOMIC_ACQUIRE, "agent");
            asm volatile("s_waitcnt vmcnt(0)" ::: "memory");
        }
    }
    __syncthreads();
}

struct Frame {
    LAS unsigned char* lds;
    volatile LAS unsigned* MISC;
    int vcu, G;
};
struct Site {
    gu32* ctl; unsigned char* ws; const float* const __attribute__((address_space(4)))* in; float* out;
    int tid, lane, wave;
};
__device__ __forceinline__ Site make_site() {
    Site P; int t_ = threadIdx.x; asm volatile("" : "+v"(t_)); P.tid = t_; P.lane = t_ & 63; P.wave = __builtin_amdgcn_readfirstlane(t_ >> 6);
    unsigned long long kp_ = (unsigned long long)__builtin_amdgcn_kernarg_segment_ptr(); asm volatile("" : "+s"(kp_));
    P.in = (const float* const __attribute__((address_space(4)))*)kp_;
    P.out = (float*)(GAS float*)(*(const __attribute__((address_space(4))) unsigned long long*)(kp_ + 200));
    P.ws = (unsigned char*)(GAS unsigned char*)(*(const __attribute__((address_space(4))) unsigned long long*)(kp_ + 208));
    P.ctl = (gu32*)(P.ws + WS_CTL);
    return P;
}
__device__ __forceinline__ float wave_sum(float v, int lane) {
    (void)lane;
    v += __int_as_float(__builtin_amdgcn_update_dpp(0, __float_as_int(v), 0xB1, 0xF, 0xF, true));
    v += __int_as_float(__builtin_amdgcn_update_dpp(0, __float_as_int(v), 0x4E, 0xF, 0xF, true));
    v += __int_as_float(__builtin_amdgcn_update_dpp(0, __float_as_int(v), 0x141, 0xF, 0xF, true));
    v += __int_as_float(__builtin_amdgcn_update_dpp(0, __float_as_int(v), 0x140, 0xF, 0xF, true));
    v += __int_as_float(__builtin_amdgcn_update_dpp(0, __float_as_int(v), 0x142, 0xA, 0xF, false));
    v += __int_as_float(__builtin_amdgcn_update_dpp(0, __float_as_int(v), 0x143, 0xC, 0xF, false));
    return __int_as_float(__builtin_amdgcn_readlane(__float_as_int(v), 63));
}

__device__ __forceinline__ void transpose_item(const float* colp, size_t sstride, bf16* WT, int K, int n0, int k0, LAS float* scr, int lane) {
    const float* sp = colp + (size_t)k0 * sstride;
    const float* lp = sp + (size_t)(lane >> 5) * sstride;
    LAS float* sq = scr + (lane >> 5) * 33 + (lane & 31);
#pragma unroll
    for (int hb = 0; hb < 2; ++hb) { float tv[16];
#pragma unroll
        for (int i = 0; i < 16; ++i) { tv[i] = *lp; lp += 2 * sstride; }
#pragma unroll
        for (int i = 0; i < 16; ++i) sq[(2 * (16 * hb + i)) * 33] = tv[i]; }
    LDS_WAIT(); asm volatile("" ::: "memory");
    const int c = lane & 7;
#pragma unroll
    for (int j = 0; j < 4; ++j) { const int n = (lane >> 3) + 8 * j; const LAS float* s = scr + (8 * c) * 33 + n;
        v4u o; o.x = pk2(s[0 * 33], s[1 * 33]); o.y = pk2(s[2 * 33], s[3 * 33]); o.z = pk2(s[4 * 33], s[5 * 33]); o.w = pk2(s[6 * 33], s[7 * 33]);
        *(GAS v4u*)(WT + (size_t)(n0 + n) * K + k0 + 8 * c) = o; }
    LDS_WAIT(); asm volatile("" ::: "memory");
}
__device__ __forceinline__ void transpose_item8(const float* colp, size_t sstride, unsigned char* WT8, int K, int n0, int k0, LAS float* scr, int lane, const float sc) {
    const float* sp = colp + (size_t)k0 * sstride;
    const float* lp = sp + (size_t)(lane >> 5) * sstride;
    LAS float* sq = scr + (lane >> 5) * 33 + (lane & 31);
#pragma unroll
    for (int hb = 0; hb < 2; ++hb) { float tv[16];
#pragma unroll
        for (int i = 0; i < 16; ++i) { tv[i] = *lp; lp += 2 * sstride; }
#pragma unroll
        for (int i = 0; i < 16; ++i) sq[(2 * (16 * hb + i)) * 33] = tv[i]; }
    LDS_WAIT(); asm volatile("" ::: "memory");
    const int c = lane & 7;
#pragma unroll
    for (int j = 0; j < 4; ++j) { const int n = (lane >> 3) + 8 * j; const LAS float* s = scr + (8 * c) * 33 + n;
        int lo = 0, hi = 0;
        lo = __builtin_amdgcn_cvt_pk_fp8_f32(s[0 * 33] * sc, s[1 * 33] * sc, lo, false); lo = __builtin_amdgcn_cvt_pk_fp8_f32(s[2 * 33] * sc, s[3 * 33] * sc, lo, true);
        hi = __builtin_amdgcn_cvt_pk_fp8_f32(s[4 * 33] * sc, s[5 * 33] * sc, hi, false); hi = __builtin_amdgcn_cvt_pk_fp8_f32(s[6 * 33] * sc, s[7 * 33] * sc, hi, true);
        *(GAS v2u*)(WT8 + (size_t)(n0 + n) * K + k0 + 8 * c) = (v2u){(unsigned)lo, (unsigned)hi}; }
    LDS_WAIT(); asm volatile("" ::: "memory");
}
__device__ __forceinline__ int inproj_src_col(int p) {
    const int t = p >> 8, q = p & 255;
    if (t == 0) return q;
    if (t <= 2) { const int ch = (t - 1) * 128 + 4 * (q >> 3) + (q & 3); return OFF_CONV + ((q >> 2) & 1) * 256 + ch; }
    if (t <= 6) { const int base = t <= 4 ? OFF_Q + 256 * (t - 3) : OFF_K + 256 * (t - 5); return base + 64 * ((q >> 5) & 3) + 32 * (q >> 7) + (q & 31); }
    if (t <= 8) return OFF_V + 256 * (t - 7) + q;
    return OFF_G + 256 * (t - 9) + q;
}
template <bool F8> __device__ __forceinline__ void convert_block64(const float* sp, size_t ss, unsigned char* dp) {
    float v[64];
#pragma unroll
    for (int j = 0; j < 64; ++j) { v[j] = *sp; sp += ss; }
    if constexpr (F8) {
#pragma unroll
        for (int q = 0; q < 4; ++q) { int t[4];
#pragma unroll
            for (int c = 0; c < 4; ++c) { const int i = 16 * q + 4 * c; int w = 0;
                w = __builtin_amdgcn_cvt_pk_fp8_f32(v[i] * 32.f, v[i + 1] * 32.f, w, false); w = __builtin_amdgcn_cvt_pk_fp8_f32(v[i + 2] * 32.f, v[i + 3] * 32.f, w, true); t[c] = w; }
            *(GAS v4u*)(dp + 16 * q) = (v4u){(unsigned)t[0], (unsigned)t[1], (unsigned)t[2], (unsigned)t[3]}; }
    } else {
#pragma unroll
        for (int q = 0; q < 8; ++q) { const int i = 8 * q; v4u o; o.x = pk2(v[i], v[i + 1]); o.y = pk2(v[i + 2], v[i + 3]); o.z = pk2(v[i + 4], v[i + 5]); o.w = pk2(v[i + 6], v[i + 7]);
            *(GAS v4u*)(dp + 16 * q) = o; }
    }
}
__device__ __forceinline__ void convert_ffn_slice(const Site& P, int l, int slice) {
    const bool moe = (l & 1) != 0; const int li = l >> 1, lane = P.lane;
    if (!moe) {
        constexpr int I13 = 16 * (2 * DFF / 64), I2 = (DFF / 64) * 16;
        const int it = slice * 8 + P.wave; if (it >= I13 + I2) return;
        const float* w1 = P.in[18] + (size_t)li * D * DFF; const float* w3 = P.in[19] + (size_t)li * D * DFF; const float* w2 = P.in[20] + (size_t)li * DFF * D;
        const bool d8 = l >= DENSE8_FROM;
        unsigned char* W13 = P.ws + WS_WFF; unsigned char* W2 = P.ws + WS_WFF + (d8 ? WFF8_W2_DENSE : WFF_W2_DENSE);
        const float* sp; size_t ss; size_t doff; unsigned char* db;
        if (it < I13) { const int kb = it / (2 * DFF / 64), nb = it % (2 * DFF / 64); const int p = 64 * nb + lane; const int ch = (p >> 8) * 128 + (p & 127);
            sp = (((p >> 7) & 1) ? w3 : w1) + (size_t)(64 * kb) * DFF + ch; ss = DFF; db = W13; doff = (size_t)p * D + 64 * kb; }
        else { const int r = it - I13; const int kb = r / 16, nb = r % 16; const int n = 64 * nb + lane;
            sp = w2 + (size_t)(64 * kb) * D + n; ss = D; db = W2; doff = (size_t)n * DFF + 64 * kb; }
        if (d8) convert_block64<true>(sp, ss, db + doff); else convert_block64<false>(sp, ss, db + 2 * doff);
    } else {
        constexpr int I13 = 16 * (2 * DFFE / 64), I2 = (DFFE / 64) * 16, IE = I13 + I2;
        for (int j = 0; j < 2; ++j) { const int it = slice * 16 + j * 8 + P.wave; if (it >= 8 * IE) break;
            const int e = it / IE; const int r = it - e * IE;
            const float* w1 = P.in[22] + ((size_t)li * NEXP + e) * D * DFFE; const float* w3 = P.in[23] + ((size_t)li * NEXP + e) * D * DFFE; const float* w2 = P.in[24] + ((size_t)li * NEXP + e) * DFFE * D;
            unsigned char* W13 = P.ws + WS_WFF + (size_t)e * WFF8_W13_E; unsigned char* W2 = P.ws + WS_WFF + WFF8_W2_OFF + (size_t)e * WFF8_W2_E;
            const float* sp; size_t ss; unsigned char* dp;
            if (r < I13) { const int kb = r / (2 * DFFE / 64), nb = r % (2 * DFFE / 64); const int p = 64 * nb + lane; const int ch = (p >> 8) * 128 + (p & 127);
                sp = (((p >> 7) & 1) ? w3 : w1) + (size_t)(64 * kb) * DFFE + ch; ss = DFFE; dp = W13 + (size_t)p * D + 64 * kb; }
            else { const int r2 = r - I13; const int kb = r2 / 16, nb = r2 % 16; const int n = 64 * nb + lane;
                sp = w2 + (size_t)(64 * kb) * D + n; ss = D; dp = W2 + (size_t)n * DFFE + 64 * kb; }
            convert_block64<true>(sp, ss, dp); }
    }
}
__device__ __forceinline__ void convert_layer_weights(const Frame& F, const Site& P, int l) {
    LAS float* scr = (LAS float*)(F.lds + RING_OFF + P.wave * 16384);
    const int gw = F.vcu * NWAVES + P.wave, NGW = F.G * NWAVES, lane = P.lane;
    bf16* WIN = (bf16*)(P.ws + WS_WIN); bf16* WBR = (bf16*)(P.ws + WS_WBR); bf16* WOUT = (bf16*)(P.ws + WS_WOUT);
    const float* w_in = P.in[2] + (size_t)l * D * IN_COLS;
    const float* w_brc = P.in[14] + (size_t)l * 256 * D; const float* w_bra = P.in[15] + (size_t)l * 512 * D; const float* w_out = P.in[16] + (size_t)l * D * D;
    constexpr int I_IN = 16 * (NIN / 32), I_BC = 4 * 32, I_BA = 8 * 32, I_OUT = 16 * 32;
    const int NITEMS = I_IN + I_BC + I_BA + I_OUT;
    for (int it = gw; it < NITEMS; it += NGW) {
        int r = it;
        if (r < I_IN) { const int kb = r / (NIN / 32), nb = r % (NIN / 32); const int p = 32 * nb + (lane & 31);
            if (nb < 2304 / 32) transpose_item(w_in + inproj_src_col(p), IN_COLS, WIN, D, 32 * nb, 64 * kb, scr, lane);
            else transpose_item8(w_in + inproj_src_col(p), IN_COLS, P.ws + WS_WG8, D, 32 * nb - 2304, 64 * kb, scr, lane, 32.f * LOG2E);
            continue; } r -= I_IN;
        if (r < I_BC) { const int kb = r / 32, nb = r % 32;
            transpose_item(w_brc + 32 * nb + (lane & 31), D, WBR + 256, D, 32 * nb, 64 * kb, scr, lane); continue; } r -= I_BC;
        if (r < I_BA) { const int kb = r / 32, nb = r % 32;
            transpose_item(w_bra + 32 * nb + (lane & 31), D, WBR + 512, D, 32 * nb, 64 * kb, scr, lane); continue; } r -= I_BA;
        if (r < I_OUT) { const int kb = r / 32, nb = r % 32;
            transpose_item(w_out + 32 * nb + (lane & 31), D, WOUT, D, 32 * nb, 64 * kb, scr, lane); }
    }
    {
        const float* pw = P.in[5] + (size_t)l * 4 * 64 * 64; const float* ps = P.in[6] + (size_t)l * 256; const float* wbp = P.in[13] + (size_t)l * 256 * D;
        const int gt = F.vcu * (NWAVES * 64) + P.tid, NT = F.G * NWAVES * 64;
        for (int item = gt; item < 1024 * 32; item += NT) {
            const int n = item & 1023, kb = item >> 10, k0 = 8 * kb, g = k0 >> 6, c0 = k0 & 63;
            float a[8];
#pragma unroll
            for (int j = 0; j < 8; ++j) a[j] = 0.f;
            for (int cp = 0; cp < 64; ++cp) { const float wv = ps[g * 64 + cp] * wbp[(size_t)(g * 64 + cp) * D + n];
#pragma unroll
                for (int j = 0; j < 8; ++j) a[j] += pw[(size_t)(g * 64 + c0 + j) * 64 + cp] * wv; }
            v4u o; o.x = pk2(a[0], a[1]); o.y = pk2(a[2], a[3]); o.z = pk2(a[4], a[5]); o.w = pk2(a[6], a[7]);
            *(GAS v4u*)(WBR + (size_t)n * D + k0) = o;
        }
    }
}

template <bool XBF> struct RowRaw;
template <> struct RowRaw<false> { f32x4 a[4]; };
template <> struct RowRaw<true> { v4u a[2]; };
template <bool XBF> __device__ __forceinline__ RowRaw<XBF> load_row(const void* xsrc, int row, int lane) {
    RowRaw<XBF> r;
    if constexpr (XBF) { const GAS v4u* p = (const GAS v4u*)((const bf16*)xsrc + (size_t)row * D) + lane; r.a[0] = p[0]; r.a[1] = p[64]; }
    else { const GAS f32x4* p = (const GAS f32x4*)((const float*)xsrc + (size_t)row * D) + 2 * lane;
#pragma unroll
        for (int j = 0; j < 4; ++j) r.a[j] = p[128 * (j >> 1) + (j & 1)]; }
    return r;
}
template <bool XBF> __device__ __forceinline__ void unpack_row(const RowRaw<XBF>& r, f32x4 (&v)[4]) {
    if constexpr (XBF) {
#pragma unroll
        for (int j2 = 0; j2 < 2; ++j2) { const v4u w = r.a[j2]; v[2 * j2] = (f32x4){bflo(w.x), bfhi(w.x), bflo(w.y), bfhi(w.y)}; v[2 * j2 + 1] = (f32x4){bflo(w.z), bfhi(w.z), bflo(w.w), bfhi(w.w)}; } }
    else {
#pragma unroll
        for (int j = 0; j < 4; ++j) v[j] = r.a[j]; }
}
#ifndef NORM_AHEAD
#define NORM_AHEAD 4
#endif
template <int MODE, bool XBF, bool H8 = (MODE == 2)>
__device__ __forceinline__ void norm_phase(const Frame& F, const Site& P, const void* xsrc, const float* gvec, const float* w8, size_t w8stride, const float* b8, unsigned* gcnt) {
    const int lane = P.lane;
    bf16* HB = (bf16*)(P.ws + WS_HB);
    int kb[4];
#pragma unroll
    for (int j = 0; j < 4; ++j) kb[j] = 8 * lane + 512 * (j >> 1) + 4 * (j & 1);
    f32x4 gv[4];
#pragma unroll
    for (int j = 0; j < 4; ++j) gv[j] = *(const f32x4*)(gvec + kb[j]);
    LAS unsigned* lcnt = (LAS unsigned*)(F.lds + RING_OFF);
    LAS float* wfs = (LAS float*)(F.lds + RING_OFF + 1024);
    if constexpr (MODE != 1) {
        for (int idx = P.tid; idx < 8 * D; idx += NWAVES * 64) { const int k = idx >> 3, h = idx & 7; wfs[h * D + k] = w8[(size_t)k * w8stride + h] * gvec[k]; }
        __syncthreads();
    }
    float* NLF = (float*)(P.ws + WS_NLF);
    unsigned* list = (unsigned*)(P.ws + WS_LIST); float* moew = (float*)(P.ws + WS_MOEW);
    for (int rb = F.vcu; rb < M / 256; rb += F.G) {
        const int row0 = rb * 256 + P.wave * 32;
        if constexpr (MODE == 2) { if (P.tid < 32) lcnt[P.tid] = 0u; __syncthreads(); }
        int my_e0 = 0, my_e1 = 0; float my_w0 = 0.f, my_w1 = 0.f;
        constexpr int AH = XBF ? NORM_AHEAD : 2;
        RowRaw<XBF> nr[AH];
#pragma unroll
        for (int a = 0; a < AH; ++a) nr[a] = load_row<XBF>(xsrc, row0 + a, lane);
#pragma unroll 1
        for (int i = 0; i < 32; ++i) {
            f32x4 v[4]; float s = 0.f;
            { unpack_row<XBF>(nr[0], v);
#pragma unroll
              for (int a = 0; a + 1 < AH; ++a) nr[a] = nr[a + 1];
              nr[AH - 1] = load_row<XBF>(xsrc, row0 + (i + AH < 32 ? i + AH : 31), lane); }
            {
            const int row = row0 + i;
#pragma unroll
            for (int j = 0; j < 4; ++j) s += (v[j].x * v[j].x + v[j].y * v[j].y) + (v[j].z * v[j].z + v[j].w * v[j].w);
            const float rstd = __builtin_amdgcn_rsqf(wave_sum(s, lane) * (1.f / D) + 1e-6f);
            {
                v2u q8[2];
#pragma unroll
                for (int j2 = 0; j2 < 2; ++j2) { const f32x4 a = v[2 * j2] * rstd * gv[2 * j2], b = v[2 * j2 + 1] * rstd * gv[2 * j2 + 1];
                    if constexpr (H8 || MODE == 0) { int lo = 0, hi = 0;
                        lo = __builtin_amdgcn_cvt_pk_fp8_f32(a.x, a.y, lo, false); lo = __builtin_amdgcn_cvt_pk_fp8_f32(a.z, a.w, lo, true);
                        hi = __builtin_amdgcn_cvt_pk_fp8_f32(b.x, b.y, hi, false); hi = __builtin_amdgcn_cvt_pk_fp8_f32(b.z, b.w, hi, true);
                        q8[j2] = (v2u){(unsigned)lo, (unsigned)hi}; }
                    if constexpr (!H8) *((GAS v4u*)(HB + (size_t)row * D) + lane + 64 * j2) = (v4u){pk2(a.x, a.y), pk2(a.z, a.w), pk2(b.x, b.y), pk2(b.z, b.w)}; }
                if constexpr (H8 || MODE == 0) {
                    unsigned char* r8 = (H8 ? (unsigned char*)HB : P.ws + WS_H8) + (size_t)row * D;
                    const bool odd = (lane & 1) != 0;
                    const unsigned s0 = odd ? q8[0].x : q8[1].x, s1 = odd ? q8[0].y : q8[1].y;
                    const unsigned g0 = (unsigned)__builtin_amdgcn_update_dpp(0, (int)s0, 0xB1, 0xF, 0xF, true), g1 = (unsigned)__builtin_amdgcn_update_dpp(0, (int)s1, 0xB1, 0xF, 0xF, true);
                    const v4u o = odd ? (v4u){g0, g1, q8[1].x, q8[1].y} : (v4u){q8[0].x, q8[0].y, g0, g1};
                    *(GAS v4u*)(r8 + (odd ? 512 : 0) + 8 * (lane & ~1)) = o; }
            }
            if constexpr (MODE != 1) {
                float f[8];
#pragma unroll
                for (int h = 0; h < 8; ++h) { f32x4 fa = v[0] * *(const LAS f32x4*)(wfs + h * D + kb[0]);
#pragma unroll
                    for (int j = 1; j < 4; ++j) fa += v[j] * *(const LAS f32x4*)(wfs + h * D + kb[j]);
                    f[h] = (fa[0] + fa[1]) + (fa[2] + fa[3]); }
                float red;
                { const bool b5 = (lane & 32) != 0, b4 = (lane & 16) != 0, b3 = (lane & 8) != 0;
#define XCH(v, o) __int_as_float(__builtin_amdgcn_ds_bpermute((lane ^ (o)) << 2, __float_as_int(v)))
                  float g4[4];
#pragma unroll
                  for (int j = 0; j < 4; ++j) { const float send = b5 ? f[j] : f[4 + j], keep = b5 ? f[4 + j] : f[j]; g4[j] = keep + XCH(send, 32); }
                  float g2[2];
#pragma unroll
                  for (int j = 0; j < 2; ++j) { const float send = b4 ? g4[j] : g4[2 + j], keep = b4 ? g4[2 + j] : g4[j]; g2[j] = keep + XCH(send, 16); }
                  { const float send = b3 ? g2[0] : g2[1], keep = b3 ? g2[1] : g2[0]; red = keep + XCH(send, 8); }
                  red += XCH(red, 4); red += XCH(red, 2); red += XCH(red, 1);
#undef XCH
                  red *= rstd; }
                if constexpr (MODE == 0) {
                    if ((lane & 7) == 0) { const int h = lane >> 3; const float z = red + b8[h];
                        NLF[(size_t)row * 8 + h] = fmaxf(-z, 0.f) * LOG2E + __builtin_amdgcn_logf(1.0f + __builtin_amdgcn_exp2f(-fabsf(z) * LOG2E)); }
                } else {
#pragma unroll
                    for (int h = 0; h < 8; ++h) f[h] = __int_as_float(__builtin_amdgcn_readlane(__float_as_int(red), 8 * h));
                    int e0 = 0; float v0 = f[0];
#pragma unroll
                    for (int h = 1; h < 8; ++h) if (f[h] > v0) { v0 = f[h]; e0 = h; }
                    int e1 = (e0 == 0) ? 1 : 0; float v1 = -INFINITY;
#pragma unroll
                    for (int h = 0; h < 8; ++h) if (h != e0 && f[h] > v1) { v1 = f[h]; e1 = h; }
                    const float w0 = __builtin_amdgcn_rcpf(1.0f + __builtin_amdgcn_exp2f((v1 - v0) * LOG2E));
                    if (lane == i) { my_e0 = e0; my_e1 = e1; my_w0 = w0; my_w1 = 1.0f - w0; }
                }
            }
            }
        }
        if constexpr (MODE == 2) {
            unsigned p0 = 0, p1 = 0;
            if (lane < 32) { p0 = __hip_atomic_fetch_add(&lcnt[my_e0], 1u, __ATOMIC_RELAXED, __HIP_MEMORY_SCOPE_WORKGROUP); p1 = __hip_atomic_fetch_add(&lcnt[8 + my_e1], 1u, __ATOMIC_RELAXED, __HIP_MEMORY_SCOPE_WORKGROUP);
                moew[row0 + lane] = my_w0; moew[M + row0 + lane] = my_w1; }
            __syncthreads();
            if (P.tid < 16) lcnt[16 + P.tid] = __hip_atomic_fetch_add(gcnt + P.tid, lcnt[P.tid], RLX_AGENT);
            __syncthreads();
            if (lane < 32) { list[(size_t)my_e0 * M + lcnt[16 + my_e0] + p0] = (unsigned)(row0 + lane); list[(size_t)(8 + my_e1) * M + lcnt[24 + my_e1] + p1] = (unsigned)(row0 + lane); }
            __syncthreads();
        }
    }
}

__device__ __forceinline__ void scan_phase(const Frame& F, const Site& P) {
    const float* NLF = (const float*)(P.ws + WS_NLF); float* NCL = (float*)(P.ws + WS_NCL);
    LAS float* wt = (LAS float*)(F.lds + RING_OFF);
    for (int seq = F.vcu; seq < BATCH * 8; seq += F.G) {
        const int b = seq >> 3, h = seq & 7, t0 = P.tid * 16;
        float v[16]; float s = 0.f;
#pragma unroll
        for (int i = 0; i < 16; ++i) { v[i] = NLF[((size_t)b * SEQ + t0 + i) * 8 + h]; s += v[i]; v[i] = s; }
        float incl = s;
#pragma unroll
        for (int o = 1; o < 64; o <<= 1) { const float up = __int_as_float(__builtin_amdgcn_ds_bpermute((P.lane - o) << 2, __float_as_int(incl))); if (P.lane >= o) incl += up; }
        if (P.lane == 63) wt[P.wave] = incl;
        __syncthreads();
        float base = incl - s;
        for (int w = 0; w < P.wave; ++w) base += wt[w];
        float* dst = NCL + (size_t)seq * SEQ + t0;
#pragma unroll
        for (int i = 0; i < 16; i += 4) *(f32x4*)(dst + i) = (f32x4){base + v[i], base + v[i + 1], base + v[i + 2], base + v[i + 3]};
        __syncthreads();
    }
}

__device__ __forceinline__ void store_row_pair(bf16* base, int lane, v2u ra, v2u rb) {
    const bool odd = (lane & 1) != 0;
    const unsigned s0 = odd ? ra.x : rb.x, s1 = odd ? ra.y : rb.y;
    const unsigned g0 = (unsigned)__builtin_amdgcn_update_dpp(0, (int)s0, 0xB1, 0xF, 0xF, true), g1 = (unsigned)__builtin_amdgcn_update_dpp(0, (int)s1, 0xB1, 0xF, 0xF, true);
    const v4u o = odd ? (v4u){g0, g1, rb.x, rb.y} : (v4u){ra.x, ra.y, g0, g1};
    *(GAS v4u*)(base + (size_t)(odd ? 1024 : 0) + 4 * (lane & ~1)) = o;
}
__device__ __forceinline__ void poolconv_phase(const Frame& F, const Site& P, int l) {
    const int lane = P.lane;
    const bf16* PIN = (const bf16*)(P.ws + WS_P); const bf16* Z = (const bf16*)(P.ws + WS_Z); bf16* Y = (bf16*)(P.ws + WS_Y);
    const float* cw = P.in[7] + (size_t)l * CONVK * 256; const float* cb = P.in[8] + (size_t)l * 256; const float* lg = P.in[9] + (size_t)l * 256; const float* lb = P.in[10] + (size_t)l * 256;
    f32x4 w[CONVK];
#pragma unroll
    for (int j = 0; j < CONVK; ++j) w[j] = *(const f32x4*)(cw + j * 256 + 4 * lane);
    const f32x4 cbv = *(const f32x4*)(cb + 4 * lane), lgv = *(const f32x4*)(lg + 4 * lane), lbv = *(const f32x4*)(lb + 4 * lane);
    LAS unsigned char* zt = F.lds + RING_OFF;
    const int pw = 2 << (lane >> 4);
#if defined(DBG_COPY)
    for (int ch = F.vcu; ch < M / 128; ch += F.G) { const int r0 = ch * 128;
        for (int i = 0; i < 16; ++i) { const int row = r0 + 16 * P.wave + i;
            *(GAS v2u*)(Y + (size_t)row * 1024 + 4 * lane) = *(const GAS v2u*)(PIN + (size_t)row * 256 + 4 * lane);
            *(GAS v2u*)(Y + (size_t)row * 1024 + 256 + 4 * lane) = *(const GAS v2u*)(Z + (size_t)row * 256 + 4 * lane); } }
    return;
#endif
    for (int ch = F.vcu; ch < M / 128; ch += F.G) {
        const int r0 = ch * 128; const int tseq0 = r0 & (SEQ - 1);
        { v4u sv[10];
#pragma unroll
          for (int k = 0; k < 10; ++k) { const int p0 = P.tid + k * (NWAVES * 64); const int p = p0 < 158 * 32 ? p0 : 158 * 32 - 1; const int lr = p >> 5, c16 = p & 31; const int tr = tseq0 - 30 + lr;
              const int lrc = tr >= 0 ? lr : 30;
              sv[k] = *(const GAS v4u*)(Z + (size_t)(r0 - 30 + lrc) * 256 + c16 * 8);
              if (tr < 0) sv[k] = (v4u){0u, 0u, 0u, 0u}; }
#pragma unroll
          for (int k = 0; k < 10; ++k) { const int p = P.tid + k * (NWAVES * 64); if (p < 158 * 32) *(LAS v4u*)(zt + (p >> 5) * 512 + (p & 31) * 16) = sv[k]; } }
        __syncthreads();
#if defined(DBG_POOLCOPY)
        for (int i = 0; i < 16; ++i) { const int row = r0 + 16 * P.wave + i; *(GAS v2u*)(Y + (size_t)row * 1024 + 4 * lane) = *(const GAS v2u*)(PIN + (size_t)row * 256 + 4 * lane); }
        if (false)
#endif
        { const int rw = r0 + 16 * P.wave, tw = tseq0 + 16 * P.wave;
          auto ldp = [&](int rrow) -> f32x4 { const v2u q = *(const GAS v2u*)(PIN + (size_t)rrow * 256 + 4 * lane); return (f32x4){bflo(q.x), bfhi(q.x), bflo(q.y), bfhi(q.y)}; };
          f32x4 s = (f32x4){0.f, 0.f, 0.f, 0.f};
#pragma unroll
          for (int d = 1; d < 16; ++d) { const int dd = d <= tw ? d : tw; const float mk = (d < pw && d <= tw) ? 1.0f : 0.0f; s += ldp(rw - dd) * mk; }
          v2u ovp = (v2u){0u, 0u};
#pragma unroll
          for (int i = 0; i < 16; ++i) { const int t = tw + i;
              const f32x4 cur = ldp(rw + i);
              s += cur;
              const float inv = 1.0f / (float)((t + 1) < pw ? (t + 1) : pw);
              const f32x4 o = s * inv - cur;
              v2u ov; ov.x = pk2(o[0], o[1]); ov.y = pk2(o[2], o[3]);
              if (i & 1) store_row_pair(Y + (size_t)(rw + i - 1) * 1024, lane, ovp, ov); else ovp = ov;
              const int told = t - pw + 1; const int back = told >= 0 ? pw - 1 : t;
              s -= ldp(rw + i - back) * (told >= 0 ? 1.0f : 0.0f); } }
#if defined(DBG_CONVCOPY)
        for (int i = 0; i < 16; ++i) { const int row = r0 + 16 * P.wave + i; *(GAS v2u*)(Y + (size_t)row * 1024 + 256 + 4 * lane) = *(const GAS v2u*)(Z + (size_t)row * 256 + 4 * lane); }
        if (false)
#endif
        for (int grp = 0; grp < 4; ++grp) {
            const int lr0 = 16 * P.wave + 4 * grp;
            f32x4 a[4];
#pragma unroll
            for (int o = 0; o < 4; ++o) a[o] = cbv;
#pragma unroll
            for (int jj = 0; jj < CONVK + 3; ++jj) {
                const v2u q = *(const LAS v2u*)(zt + (lr0 + jj) * 512 + lane * 8); const f32x4 z = (f32x4){bflo(q.x), bfhi(q.x), bflo(q.y), bfhi(q.y)};
#pragma unroll
                for (int o = 0; o < 4; ++o) { const int j = jj - o; if (j >= 0 && j < CONVK) a[o] += w[j] * z; }
            }
            v2u ovc = (v2u){0u, 0u};
#pragma unroll
            for (int o = 0; o < 4; ++o) {
                const float mu = wave_sum((a[o][0] + a[o][1]) + (a[o][2] + a[o][3]), lane) * (1.f / 256.f);
                const f32x4 dv = a[o] - mu;
                const float var = wave_sum((dv[0] * dv[0] + dv[1] * dv[1]) + (dv[2] * dv[2] + dv[3] * dv[3]), lane) * (1.f / 256.f);
                const float rs = __builtin_amdgcn_rsqf(var + 1e-6f);
                f32x4 y = dv * rs * lgv + lbv;
#pragma unroll
                for (int c = 0; c < 4; ++c) y[c] = y[c] * __builtin_amdgcn_rcpf(1.0f + __builtin_amdgcn_exp2f(-1.4426950408889634f * y[c]));
                v2u ov; ov.x = pk2(y[0], y[1]); ov.y = pk2(y[2], y[3]);
                if (o & 1) store_row_pair(Y + (size_t)(r0 + lr0 + o - 1) * 1024 + 256, lane, ovc, ov); else ovc = ov;
            }
        }
        __syncthreads();
    }
}

#ifndef DBG_MAXPHASE
#define DBG_MAXPHASE 1000
#endif
#ifndef ONLY_SITE
#define ONLY_SITE -1
#endif
#ifndef DBL_MASK
#define DBL_MASK 0
#endif
#define DBL(k) for (int rep_ = 0; rep_ < (((DBL_MASK >> (k)) & 1) ? 2 : 1); ++rep_)
#ifndef SITE_OFF_MASK
#define SITE_OFF_MASK 0
#endif
#define SITE(k) ((ONLY_SITE < 0 || ONLY_SITE == (k)) && !((SITE_OFF_MASK >> (k)) & 1))
#ifndef STAGGER_TICKS
#define STAGGER_TICKS 1500
#endif
constexpr int NPH = 10;
struct Args { const float* in[25]; float* out; unsigned char* ws; int ph_lo, ph_hi; };

struct FfnConvHook { const Site* P; int l; __device__ __forceinline__ void operator()(int b, int u) const { convert_ffn_slice(*P, l, u * 8 + b); } };

__global__ void __launch_bounds__(NWAVES * 64, 2) trunk_fwd(Args args) {
    extern __shared__ __attribute__((aligned(16))) unsigned char lds[];
    Frame F;
    F.lds = (LAS unsigned char*)lds;
    F.MISC = (volatile LAS unsigned*)(F.lds + MISC_OFF);
    F.G = gridDim.x; { const int bx = blockIdx.x; F.vcu = (F.G % 8 == 0) ? (bx % 8) * (F.G / 8) + bx / 8 : bx; }
    for (int u = threadIdx.x; u < (LDS_BYTES - LDSCTL_OFF) / 4; u += NWAVES * 64) ((LAS unsigned*)(F.lds + LDSCTL_OFF))[u] = 0u;
    __syncthreads();
    XcdBarrier bar; bar.bar = (unsigned*)((gu32*)(args.ws + WS_CTL) + CW_BAR); bar.x = 0; bar.st = nullptr;
    if (!MK_PER_PHASE) bar = xcd_barrier_post((unsigned*)((gu32*)(args.ws + WS_CTL) + CW_BAR), F.MISC + 8);
    const int lo = args.ph_lo, hi = args.ph_hi;
#define IN(k) (lo <= (k) && (k) < hi)
#define SEAM(k) do { if (IN(k) && IN((k) + 1)) { if (MK_PER_PHASE) { if (threadIdx.x == 0) __hip_atomic_store((gu32*)(args.ws + WS_CTL) + CW_TMO, 0xBADBA0u, RLX_AGENT); } else xcd_barrier(bar); } } while (0)

#define WSB(off) ((bf16*)(P.ws + (off)))
#define INP(k) (P.in[k])
#define XBD() ((bf16*)P.out)
#define XBW() WSB(WS_XBW)
    const int cgemm = (int)blockIdx.x;

    for (int l = 0; l < DEPTH; ++l) {
        const int pb = l * NPH;
        const bool moe = (l & 1) != 0; const int li = l >> 1;

        if (IN(pb + 0)) { const Site P = make_site();
            DBL(0) if constexpr (SITE(0)) convert_layer_weights(F, P, l);
#if defined(DBG_FILLG)
            { v4u fv = (v4u){0x3f003f00u, 0x3f003f00u, 0x3f003f00u, 0x3f003f00u}; GAS v4u* gp = (GAS v4u*)WSB(WS_G);
              for (size_t i = (size_t)blockIdx.x * 512 + P.tid; i < (size_t)M * 3072 / 8; i += (size_t)F.G * 512) gp[i] = fv; }
#endif
            __syncthreads();
            if constexpr (SITE(1)) { if (l == 0) norm_phase<0, false>(F, P, INP(0), INP(1) + (size_t)l * D, INP(2) + (size_t)l * D * IN_COLS + OFF_F, IN_COLS, INP(4) + (size_t)l * 8, nullptr);
                else norm_phase<0, true>(F, P, XBD(), INP(1) + (size_t)l * D, INP(2) + (size_t)l * D * IN_COLS + OFF_F, IN_COLS, INP(4) + (size_t)l * 8, nullptr); }
        }
        SEAM(pb + 0);

        if (IN(pb + 1)) { const Site P = make_site();
#if !defined(DBG_NOSCAN)
            if constexpr (SITE(2)) scan_phase(F, P);
#endif
            LAS float* bl = (LAS float*)(F.lds + GBIAS_OFF); LAS float* gl = bl + 3 * D;
            for (int i = P.tid; i < 3 * D; i += NWAVES * 64) bl[i] = INP(3)[(size_t)l * 3 * D + i] * LOG2E;
            if (P.tid < 128) gl[P.tid] = P.tid < 64 ? INP(11)[(size_t)l * 64 + P.tid] : INP(12)[(size_t)l * 64 + P.tid - 64];
            __syncthreads();
            {
                pg8::Gemm g{WSB(WS_HB), WSB(WS_WIN), D, 0, nullptr, 0};
                pg8::SchedPlain S{M / 256, 2304 / 256, F.G, cgemm, D / 64};
                pg8::EpiInProj E{WSB(WS_P), WSB(WS_Z), WSB(WS_Y) + 512, WSB(WS_K), WSB(WS_V), (const LAS float*)gl, (const LAS float*)(gl + 64)};
                if constexpr (SITE(3)) pg8::gemm_phase<pg8::EpiInProj, pg8::SchedPlain, true, false>(F.lds + RING_OFF, g, S, E);
            }
            {   pg8::Gemm g8{(const bf16*)(P.ws + WS_H8), (const bf16*)(P.ws + WS_WG8), D / 2, 0, nullptr, 0};
                pg8::SchedPlain S8{M / 256, 3072 / 256, F.G, cgemm, D / 128};
                pg8::EpiGate E8{P.ws + WS_G, (const LAS float*)bl};
                if constexpr (SITE(3)) pg8::gemm_phase<pg8::EpiGate, pg8::SchedPlain, true, false, true>(F.lds + RING_OFF, g8, S8, E8);
            }
        }
        SEAM(pb + 1);

        if (IN(pb + 2)) { const Site P = make_site();
            DBL(4) if constexpr (SITE(4)) poolconv_phase(F, P, l);
#if defined(DBG_FENCE)
            asm volatile("s_waitcnt vmcnt(0)" ::: "memory"); __threadfence_system(); asm volatile("s_waitcnt vmcnt(0)" ::: "memory");
#endif
            const attn_body::AttnTensors AT{(const attn_body::bf16*)(WSB(WS_Y) + 512), (const attn_body::bf16*)WSB(WS_K), (const attn_body::bf16*)WSB(WS_V), (attn_body::bf16*)(WSB(WS_Y) + 512), (const float*)(P.ws + WS_NCL)};
            float gq = fabsf(INP(11)[(size_t)l * 64 + P.lane]), gk = fabsf(INP(12)[(size_t)l * 64 + P.lane]);
#pragma unroll
            for (int o = 1; o < 64; o <<= 1) { gq = fmaxf(gq, __int_as_float(__builtin_amdgcn_ds_bpermute((P.lane ^ o) << 2, __float_as_int(gq)))); gk = fmaxf(gk, __int_as_float(__builtin_amdgcn_ds_bpermute((P.lane ^ o) << 2, __float_as_int(gk)))); }
            const float th = 2.0f * (64.0f * gq * gk * pg8::ATT_C2 * 1.02f) + 38.0f;
            const attn_body::AttnQueue Qd{(unsigned*)(P.ctl + CW_ATTQ + l * 8 * 64), __int_as_float(__builtin_amdgcn_readfirstlane(__float_as_int(th))), (int)(xb_xcc_id() & 7u), F.MISC + 16};
            const FfnConvHook hook{&P, l};
            if constexpr (SITE(5)) attn_body::attn_phase_dyn<8>((char*)lds + RING_OFF, AT, Qd, hook);
        }
        SEAM(pb + 2);

        if (IN(pb + 3)) { const Site P = make_site();
            pg8::Gemm g{WSB(WS_Y), WSB(WS_WBR), D, 0, nullptr, 0};
#if defined(DBG_MERGE1)
            pg8::SchedPlain S{M / 256, D / 256, F.G, cgemm, D / 64};
#else
            pg8::SchedMerge S{M / 256, D / 256, F.G, cgemm};
#endif
            pg8::EpiMerge E{P.ws + WS_G, WSB(WS_HB)};
#if defined(DBG_MERGE1)
            if constexpr (SITE(6)) pg8::gemm_phase<pg8::EpiMerge, pg8::SchedPlain, true, false>(F.lds + RING_OFF, g, S, E);
#else
            DBL(6) if constexpr (SITE(6)) pg8::gemm_phase<pg8::EpiMerge, pg8::SchedMerge, true, false>(F.lds + RING_OFF, g, S, E);
#endif
        }
        SEAM(pb + 3);

        if (IN(pb + 4)) { const Site P = make_site();
            pg8::Gemm g{WSB(WS_HB), WSB(WS_WOUT), D, 0, nullptr, 0};
            pg8::SchedPlain S{M / 256, D / 256, F.G, cgemm, D / 64};
            bf16* xdst = (l == DEPTH - 1) ? XBW() : XBD();
            if constexpr (SITE(7)) { if (l == 0) { pg8::EpiResid<true> E{INP(0), xdst}; pg8::gemm_phase<pg8::EpiResid<true>, pg8::SchedPlain, true, false>(F.lds + RING_OFF, g, S, E); }
                else { pg8::EpiResid<false> E{XBD(), xdst}; pg8::gemm_phase<pg8::EpiResid<false>, pg8::SchedPlain, true, false>(F.lds + RING_OFF, g, S, E); } }
        }
        SEAM(pb + 4);

        if (IN(pb + 5)) { const Site P = make_site();
            const bf16* xcur = (l == DEPTH - 1) ? XBW() : XBD();
            if constexpr (SITE(8)) { if (!moe && l >= DENSE8_FROM) norm_phase<1, true, true>(F, P, xcur, INP(17) + (size_t)l * D, nullptr, 0, nullptr, nullptr);
            else if (!moe) norm_phase<1, true, false>(F, P, xcur, INP(17) + (size_t)l * D, nullptr, 0, nullptr, nullptr);
            else norm_phase<2, true>(F, P, xcur, INP(17) + (size_t)l * D, INP(21) + (size_t)li * D * NEXP, NEXP, nullptr, (unsigned*)(P.ctl + CW_MOECNT + 64 * li)); }
        }
        SEAM(pb + 5);

        if (!moe) {
            if (IN(pb + 6)) { const Site P = make_site();
                if (l >= DENSE8_FROM) {
                pg8::Gemm g{WSB(WS_HB), WSB(WS_WFF), D / 2, 0, nullptr, 0};
                pg8::SchedPlain S{M / 256, 2 * DFF / 256, F.G, cgemm, D / 128};
                pg8::EpiSwiGLU8 E{P.ws + WS_HID, DFF};
                if constexpr (SITE(9)) pg8::gemm_phase<pg8::EpiSwiGLU8, pg8::SchedPlain, true, false, true>(F.lds + RING_OFF, g, S, E);
                } else {
                pg8::Gemm g{WSB(WS_HB), WSB(WS_WFF), D, 0, nullptr, 0};
                pg8::SchedPlain S{M / 256, 2 * DFF / 256, F.G, cgemm, D / 64};
                pg8::EpiSwiGLU E{WSB(WS_HID), DFF};
                if constexpr (SITE(9)) pg8::gemm_phase<pg8::EpiSwiGLU, pg8::SchedPlain, true, false>(F.lds + RING_OFF, g, S, E);
                }
            }
            SEAM(pb + 6);
            if (IN(pb + 7)) { const Site P = make_site();
                pg8::EpiResid<false> E{XBD(), XBD()};
                if (l >= DENSE8_FROM) {
                pg8::Gemm g{WSB(WS_HID), WSB(WS_WFF + WFF8_W2_DENSE), DFF / 2, 0, nullptr, 0};
                pg8::SchedPlain S{M / 256, D / 256, F.G, cgemm, DFF / 128};
                if constexpr (SITE(10)) pg8::gemm_phase<pg8::EpiResid<false>, pg8::SchedPlain, true, false, true>(F.lds + RING_OFF, g, S, E);
                } else {
                pg8::Gemm g{WSB(WS_HID), WSB(WS_WFF + WFF_W2_DENSE), DFF, 0, nullptr, 0};
                pg8::SchedPlain S{M / 256, D / 256, F.G, cgemm, DFF / 64};
                if constexpr (SITE(10)) pg8::gemm_phase<pg8::EpiResid<false>, pg8::SchedPlain, true, false>(F.lds + RING_OFF, g, S, E);
                }
            }
            if (l + 1 < DEPTH) SEAM(pb + 7);
        } else {
#define MOE_TAB(slot_, ntiles_) do { LAS unsigned* tab = (LAS unsigned*)(F.lds + MOETAB_OFF);     \
                __syncthreads(); \
                int cnt[8]; \
                _Pragma("unroll") for (int e = 0; e < 8; ++e) cnt[e] = __builtin_amdgcn_readfirstlane((int)__hip_atomic_load(P.ctl + CW_MOECNT + 64 * li + (slot_) * 8 + e, RLX_AGENT)); \
                int rt = 0; \
                _Pragma("unroll") for (int e = 0; e < 8; ++e) { const int nte = (cnt[e] + 255) >> 8; \
                    for (int j = P.tid; j < nte; j += NWAVES * 64) { const int nv = (cnt[e] - 256 * j) < 256 ? (cnt[e] - 256 * j) : 256; if (rt + j < 264) tab[rt + j] = (unsigned)e | ((unsigned)j << 8) | ((unsigned)(nv - 1) << 20); } \
                    rt += nte; } \
                ntiles_ = rt < 264 ? rt : 264; \
                __syncthreads(); } while (0)
#define MOE_UP(slot_, ntiles_, skipc_, skipr_) do { \
                  \
                pg8::Gemm g{WSB(WS_HB), WSB(WS_WFF), D / 2, WFF8_W13_E, (const unsigned*)(P.ws + WS_LIST), 0}; \
                pg8::SchedMoe S{ntiles_, 2 * DFFE / 256, F.G, cgemm, D / 128, slot_, (const LAS unsigned*)(F.lds + MOETAB_OFF), skipc_, skipr_}; \
                pg8::EpiSwiGLU8 E{P.ws + WS_HID + (size_t)(slot_) * HID_SLOT, DFFE}; \
                if constexpr (SITE(11)) pg8::gemm_phase<pg8::EpiSwiGLU8, pg8::SchedMoe, true, true, true>(F.lds + RING_OFF, g, S, E); } while (0)
#define MOE_DOWN(slot_, ntiles_) do { \
                pg8::Gemm g{(const bf16*)(P.ws + WS_HID + (size_t)(slot_) * HID_SLOT), WSB(WS_WFF + WFF8_W2_OFF), DFFE / 2, WFF8_W2_E, nullptr, 0};     \
                pg8::SchedMoe S{ntiles_, D / 256, F.G, cgemm, DFFE / 128, slot_, (const LAS unsigned*)(F.lds + MOETAB_OFF), 0, 0};     \
                bf16* xcur = (l == DEPTH - 1) ? XBW() : XBD(); \
                if constexpr (SITE(12)) { \
                    if (l == DEPTH - 1 && (slot_) == 1) { pg8::EpiMoeDown<true> E{xcur, P.out, (const unsigned*)(P.ws + WS_LIST), (const float*)(P.ws + WS_MOEW) + (size_t)(slot_) * M, DFFE / 128};     \
                        pg8::gemm_phase<pg8::EpiMoeDown<true>, pg8::SchedMoe, true, false, true>(F.lds + RING_OFF, g, S, E); } \
                    else { pg8::EpiMoeDown<false> E{xcur, xcur, (const unsigned*)(P.ws + WS_LIST), (const float*)(P.ws + WS_MOEW) + (size_t)(slot_) * M, DFFE / 128}; \
                        pg8::gemm_phase<pg8::EpiMoeDown<false>, pg8::SchedMoe, true, false, true>(F.lds + RING_OFF, g, S, E); } } } while (0)
            if (IN(pb + 6)) { const Site P = make_site(); int nt0 = 0; MOE_TAB(0, nt0); MOE_UP(0, nt0, 0, 0); }
            SEAM(pb + 6);
            if (IN(pb + 7)) { int skipc = 0;
                { const Site P = make_site(); int nt0 = 0; MOE_TAB(0, nt0); MOE_DOWN(0, nt0);
                  const int xd = (nt0 * (D / 256)) % F.G; skipc = (xd + 7) & ~7; if (skipc > F.G) skipc = F.G; }
                { const Site P = make_site(); int nt1 = 0; MOE_TAB(1, nt1); MOE_UP(1, nt1, skipc, MOE_SKIPR); }
            }
            SEAM(pb + 7);
            if (IN(pb + 8)) { const Site P = make_site(); int nt1 = 0; MOE_TAB(1, nt1); MOE_DOWN(1, nt1); }
            if (l + 1 < DEPTH) SEAM(pb + 8);
#undef MOE_TAB
#undef MOE_UP
#undef MOE_DOWN
        }
    }
#undef IN
#undef SEAM
#undef WSB
#undef INP
#undef XBD
#undef XBW
}

extern "C" void kernel_launch(void* const* d_in, const int* in_sizes, int n_in, void* d_out, int out_size, void* d_ws, size_t ws_size, hipStream_t stream) {
    static int grid = 0;
    if (grid == 0) {
        if (n_in != 25 || in_sizes[0] != M * D || out_size != M * D || ws_size < WS_END) { fprintf(stderr, "kernel_launch: built for 25 inputs, x and out of %d floats, >= %zu bytes of workspace; got n_in %d, in0 %d, out %d, ws %zu; nothing launched\n", M * D, (size_t)WS_END, n_in, n_in > 0 ? in_sizes[0] : -1, out_size, ws_size); grid = -1; return; }
        int dev = 0, cus = 0, per_cu = 0;
        if (hipGetDevice(&dev) != hipSuccess || hipDeviceGetAttribute(&cus, hipDeviceAttributeMultiprocessorCount, dev) != hipSuccess) { fprintf(stderr, "kernel_launch: hipGetDevice / hipDeviceGetAttribute failed; nothing launched\n"); grid = -1; return; }
        if (hipFuncSetAttribute((const void*)trunk_fwd, hipFuncAttributeMaxDynamicSharedMemorySize, LDS_BYTES) != hipSuccess) { fprintf(stderr, "kernel_launch: hipFuncSetAttribute failed\n"); grid = -1; return; }
        if (hipOccupancyMaxActiveBlocksPerMultiprocessor(&per_cu, (const void*)trunk_fwd, NWAVES * 64, LDS_BYTES) != hipSuccess || per_cu < 1)
            fprintf(stderr, "kernel_launch: note: the occupancy query reports %d workgroups per CU\n", per_cu);
        (void)hipGetLastError();
        grid = cus;
    }
    if (grid < 0) return;
    if (hipMemsetAsync((char*)d_ws + WS_CTL, 0, CTL_ZERO_BYTES, stream) != hipSuccess) { fprintf(stderr, "kernel_launch: hipMemsetAsync failed\n"); return; }
    Args a{};
    for (int i = 0; i < 25; ++i) a.in[i] = (const float*)d_in[i];
    a.out = (float*)d_out; a.ws = (unsigned char*)d_ws;
#if MK_PER_PHASE
    for (int l = 0; l < DEPTH; ++l) { const int np = (l & 1) ? 10 : 8;
        for (int p = 0; p < np; ++p) { a.ph_lo = l * NPH + p; a.ph_hi = a.ph_lo + 1; if (a.ph_lo > DBG_MAXPHASE) continue; hipLaunchKernelGGL(trunk_fwd, dim3(grid), dim3(NWAVES * 64), LDS_BYTES, stream, a); } }
#else
    a.ph_lo = 0; a.ph_hi = DEPTH * NPH;
    hipLaunchKernelGGL(trunk_fwd, dim3(grid), dim3(NWAVES * 64), LDS_BYTES, stream, a);
#endif
    const hipError_t le = hipPeekAtLastError();
    if (le != hipSuccess) fprintf(stderr, "kernel_launch: launch failed: %s (grid %d x %d threads, %d B LDS)\n", hipGetErrorName(le), grid, NWAVES * 64, LDS_BYTES);
}
```

```cpp
#include <hip/hip_runtime.h>
#include <hip/hip_bf16.h>
#include <cstdio>
#include <cstdint>
#include <cmath>

namespace pg8 {
#define PG8_LAS __attribute__((address_space(3)))
typedef unsigned short bf16_t;
typedef short bf16x8 __attribute__((ext_vector_type(8)));
typedef float f32x4 __attribute__((ext_vector_type(4)));
typedef float f32x2 __attribute__((ext_vector_type(2)));
typedef unsigned u32x4 __attribute__((ext_vector_type(4)));
typedef unsigned u32x2 __attribute__((ext_vector_type(2)));
typedef int i32x4 __attribute__((ext_vector_type(4)));
typedef int i32x8 __attribute__((ext_vector_type(8)));
constexpr int BM = 256, BK = 64, HALF = 128, HTB = HALF * BK * 2  , STAGE_BYTES = 8 * HTB, NXCD = 8, WGM = 8;

__host__ __device__ __forceinline__ int lds_byte(int r, int c) { const int st = (r >> 4) * 2 + (c >> 5), rr = r & 15, cc = c & 31, ob = rr * 64 + cc * 2; return st * 1024 + (ob ^ (((ob >> 9) & 1) << 5)); }
__host__ __device__ __forceinline__ void stage_rc(int b, int& R, int& C) { const int st = b / 1024, sb = b % 1024, swz = sb ^ (((sb >> 9) & 1) << 5); R = (st >> 1) * 16 + swz / 64; C = (st & 1) * 32 + (swz % 64) / 2; }
__host__ __device__ __forceinline__ int perm32(int rho) { const int n = rho >> 4, i = rho & 15; return 8 * (i >> 2) + 4 * n + (i & 3); }

struct Unit { int pm, pn, e, koff, nt, lo, nv; };
struct Gemm { const bf16_t* A; const bf16_t* Bt; int K; size_t bstride; const unsigned* list; int stagger; };

__device__ __forceinline__ void tile_of(int L, int nM, int nN, int& pm, int& pn) {
    const int nwg = nM * nN; int wgid = L;
    { const int q = nwg / NXCD, r = nwg % NXCD, xcd = wgid % NXCD, off = wgid / NXCD; wgid = (xcd < r ? xcd * (q + 1) : r * (q + 1) + (xcd - r) * q) + off; }
    const int nig = WGM * nN, gid = wgid / nig, fm = gid * WGM, gsz = (nM - fm) < WGM ? (nM - fm) : WGM;
    pm = fm + ((wgid % nig) % gsz); pn = (wgid % nig) / gsz;
}
struct SchedPlain {
    int nM, nN, G, c, nt;
    __device__ __forceinline__ bool next(int i, Unit& u) const {
        const long L = (long)i * G + c; if (L >= (long)nM * nN) return false;
        tile_of((int)L, nM, nN, u.pm, u.pn); u.e = 0; u.koff = 0; u.nt = nt; u.lo = 0; u.nv = 256; return true;
    }
};
struct SchedPanel {
    int nM, nN, G, c, nt;
    __device__ __forceinline__ bool next(int i, Unit& u) const {
        const int j = i / nN; u.pn = i - j * nN; u.pm = c + G * j; if (u.pm >= nM) return false;
        u.e = 0; u.koff = 0; u.nt = nt; u.lo = 0; u.nv = 256; return true;
    }
};
struct SchedMerge {
    int nM, nN, G, c;
    __device__ __forceinline__ bool next(int i, Unit& u) const {
        const int tile = i / 3, seg = i - 3 * tile; const long L = (long)tile * G + c; if (L >= (long)nM * nN) return false;
        tile_of((int)L, nM, nN, u.pm, u.pn); u.e = seg; u.koff = seg == 0 ? 0 : (seg == 1 ? 256 : 512); u.nt = seg == 2 ? 8 : 4; u.lo = 0; u.nv = 256; return true;
    }
};
struct SchedMoe {
    int nM, nN, G, c, nt, slot; const PG8_LAS unsigned* tab; int skipc, skipr;
    __device__ __forceinline__ bool next(int i, Unit& u) const {
        const int nwg = nM * nN;
        const int r = (c < skipc) ? i + skipr : i;
        const long L0 = (r < skipr) ? (long)r * (G - skipc) + (c - skipc) : (long)skipr * (G - skipc) + (long)(r - skipr) * G + c;
        if (L0 >= nwg) return false;
        const int L = (int)L0;
        tile_of(L, nM, nN, u.pm, u.pn);
        const unsigned w = (unsigned)__builtin_amdgcn_readfirstlane((int)tab[u.pm]);
        u.e = (int)(w & 0xffu); const int j = (int)((w >> 8) & 0xfffu); u.nv = (int)(w >> 20) + 1;
        u.lo = (slot * 8 + u.e) * 65536 + 256 * j; u.nt = nt; u.koff = 0; return true;
    }
};

typedef __bf16 bf16x2_cv __attribute__((ext_vector_type(2)));
__device__ __forceinline__ unsigned cvt_pk_bf16(float lo, float hi) { const f32x2 v = {lo, hi}; const bf16x2_cv b = __builtin_convertvector(v, bf16x2_cv); return __builtin_bit_cast(unsigned, b); }
__device__ __forceinline__ float bf_lo(unsigned w) { return __uint_as_float(w << 16); }
__device__ __forceinline__ float bf_hi(unsigned w) { return __uint_as_float(w & 0xffff0000u); }
__device__ __forceinline__ float sigmoidf_(float x) { return __builtin_amdgcn_rcpf(1.0f + __builtin_amdgcn_exp2f(-1.4426950408889634f * x)); }
__device__ __forceinline__ f32x4 rsig4_(const f32x4 x) { const f32x4 t = x * -1.4426950408889634f; f32x4 e; e[0] = __builtin_amdgcn_exp2f(t[0]); e[1] = __builtin_amdgcn_exp2f(t[1]); e[2] = __builtin_amdgcn_exp2f(t[2]); e[3] = __builtin_amdgcn_exp2f(t[3]);
    const f32x4 d = e + 1.0f; return (f32x4){__builtin_amdgcn_rcpf(d[0]), __builtin_amdgcn_rcpf(d[1]), __builtin_amdgcn_rcpf(d[2]), __builtin_amdgcn_rcpf(d[3])}; }

template <class Epi, class Sched, bool ALIGN_EPI, bool GATHER, bool F8 = false>
__device__ __forceinline__ void gemm_phase(PG8_LAS unsigned char* lds, const Gemm g_, const Sched& S, const Epi& E) {
    Gemm g = g_;
    {
        unsigned long long a_ = (unsigned long long)g_.A, b_ = (unsigned long long)g_.Bt, l_ = (unsigned long long)g_.list; asm volatile("" : "+s"(a_), "+s"(b_), "+s"(l_));
        g.A = (const bf16_t*)(const __attribute__((address_space(1))) bf16_t*)a_; g.Bt = (const bf16_t*)(const __attribute__((address_space(1))) bf16_t*)b_; g.list = (const unsigned*)(const __attribute__((address_space(1))) unsigned*)l_; }
    int tid_o = threadIdx.x; asm volatile("" : "+v"(tid_o));
    const int tid = tid_o, wid = __builtin_amdgcn_readfirstlane(tid >> 6), lane = tid & 63, wr = wid >> 2, wc = wid & 3, fr = lane & 15, fq = lane >> 4;
    const int K = g.K;
    unsigned voffA[2], voffB[2];
#pragma unroll
    for (int i = 0; i < 2; ++i) { int R, C; stage_rc(tid * 16 + i * 8192, R, C); const int Rb = Epi::PERM ? ((R & ~31) + perm32(R & 31)) : R;
        voffA[i] = (unsigned)(R * K + C) * 2u; voffB[i] = (unsigned)(Rb * K + C) * 2u; }
    const size_t kstep = (size_t)(BK * 2);
    const size_t hstep = (size_t)HALF * K * 2;
    const size_t tstep = 2 * hstep;
    const unsigned ldsw = (unsigned)wid * 1024u;
    const int aoff = lds_byte(wr * 64 + fr, fq * 8), boff = lds_byte(wc * 32 + fr, fq * 8);
#define PG8_SA(b, h) (((b) * 2 + (h)) * HTB)
#define PG8_SB(b, h) ((4 + (b) * 2 + (h)) * HTB)
#define PG8_GLDS(src, bufoff, i_) __builtin_amdgcn_global_load_lds((const unsigned*)(src), (PG8_LAS unsigned*)(lds + (bufoff) + ldsw + (i_) * 8192), 16, 0, 0)
#define PG8_STAGE_B(bufoff, gbase) do { _Pragma("unroll") for (int _i = 0; _i < 2; ++_i) PG8_GLDS((const char*)(gbase) + voffB[_i], bufoff, _i); } while (0)
#define PG8_STAGE_A(bufoff, ga, h, o0, o1) do { if constexpr (GATHER) { PG8_GLDS((const char*)(ga) + (o0), bufoff, 0); PG8_GLDS((const char*)(ga) + (o1), bufoff, 1); } \
        else { _Pragma("unroll") for (int _i = 0; _i < 2; ++_i) PG8_GLDS((const char*)(ga) + (h) * hstep + voffA[_i], bufoff, _i); } } while (0)
#define PG8_LDA(dst, b, h) do { _Pragma("unroll") for (int m = 0; m < 4; ++m) { if constexpr (F8) { dst##8[m].lo = *(const PG8_LAS i32x4*)(lds + PG8_SA(b, h) + aoff + m * 2048); dst##8[m].hi = *(const PG8_LAS i32x4*)(lds + PG8_SA(b, h) + aoff + m * 2048 + 1024); } \
        else { _Pragma("unroll") for (int k = 0; k < 2; ++k) dst[m][k] = *(const PG8_LAS bf16x8*)(lds + PG8_SA(b, h) + aoff + m * 2048 + k * 1024); } } } while (0)
#define PG8_LDB(dst, b, h) do { _Pragma("unroll") for (int n = 0; n < 2; ++n) { if constexpr (F8) { dst##8[n].lo = *(const PG8_LAS i32x4*)(lds + PG8_SB(b, h) + boff + n * 2048); dst##8[n].hi = *(const PG8_LAS i32x4*)(lds + PG8_SB(b, h) + boff + n * 2048 + 1024); } \
        else { _Pragma("unroll") for (int k = 0; k < 2; ++k) dst[n][k] = *(const PG8_LAS bf16x8*)(lds + PG8_SB(b, h) + boff + n * 2048 + k * 1024); } } } while (0)
#define PG8_CAT8(x0, x1) __builtin_shufflevector(__builtin_bit_cast(i32x4, x0), __builtin_bit_cast(i32x4, x1), 0, 1, 2, 3, 4, 5, 6, 7)
#define PG8_MMA(ai, bj, At, Bt) do { __builtin_amdgcn_s_setprio(1); _Pragma("unroll") for (int m = 0; m < 4; ++m) _Pragma("unroll") for (int n = 0; n < 2; ++n) { \
        if constexpr (F8) asm volatile("v_mfma_scale_f32_16x16x128_f8f6f4 %0, %1, %2, %0, %3, %4 op_sel_hi:[0,0,0]" : "+v"(acc[ai][bj][m][n]) : "v"(Bt##8[n]), "v"(At##8[m]), "v"(sc_w), "v"(sc_a));   \
        else { _Pragma("unroll") for (int k = 0; k < 2; ++k) acc[ai][bj][m][n] = __builtin_amdgcn_mfma_f32_16x16x32_bf16(Bt[n][k], At[m][k], acc[ai][bj][m][n], 0, 0, 0); } } __builtin_amdgcn_s_setprio(0); } while (0)
#define PG8_MMA0(ai, bj, At, Bt) do { __builtin_amdgcn_s_setprio(1); _Pragma("unroll") for (int m = 0; m < 4; ++m) _Pragma("unroll") for (int n = 0; n < 2; ++n) \
        asm volatile("v_mfma_scale_f32_16x16x128_f8f6f4 %0, %1, %2, 0, %3, %4 op_sel_hi:[0,0,0]" : "=v"(acc[ai][bj][m][n]) : "v"(Bt##8[n]), "v"(At##8[m]), "v"(sc_w), "v"(sc_a));   \
        __builtin_amdgcn_s_setprio(0); } while (0)
#define PG8_WAIT_V(n) asm volatile("s_waitcnt vmcnt(" #n ")" ::: "memory")
#define PG8_WAIT_L(n) asm volatile("s_waitcnt lgkmcnt(" #n ")" ::: "memory")
#define PG8_WAIT_V8F(f) do { if constexpr (Epi::NST == 32) asm volatile("s_cmp_eq_u32 %0, 0\n\ts_cbranch_scc1 .LWV%=A\n\ts_waitcnt vmcnt(40)\n\ts_branch .LWV%=B\n.LWV%=A:\n\ts_waitcnt vmcnt(8)\n.LWV%=B:" :: "s"(f) : "memory", "scc"); \
        else if constexpr (Epi::NST == 16) asm volatile("s_cmp_eq_u32 %0, 0\n\ts_cbranch_scc1 .LWV%=A\n\ts_waitcnt vmcnt(24)\n\ts_branch .LWV%=B\n.LWV%=A:\n\ts_waitcnt vmcnt(8)\n.LWV%=B:" :: "s"(f) : "memory", "scc"); \
        else asm volatile("s_waitcnt vmcnt(8)" ::: "memory"); } while (0)
#define PG8_BAR __builtin_amdgcn_s_barrier()
#define PG8_SCHED __builtin_amdgcn_sched_barrier(0)
    Unit cur, nxt; int ui = 0;
    if (!S.next(0, cur)) return;
    if (g.stagger > 0) { const unsigned long long t0_ = __builtin_amdgcn_s_memrealtime(); while (__builtin_amdgcn_s_memrealtime() - t0_ < (unsigned long long)g.stagger) __builtin_amdgcn_s_sleep(8); }
    f32x4 acc[2][2][4][2];
    if constexpr (!F8) {
#pragma unroll
    for (int a = 0; a < 2; ++a)
#pragma unroll
        for (int b = 0; b < 2; ++b)
#pragma unroll
            for (int m = 0; m < 4; ++m)
#pragma unroll
                for (int n = 0; n < 2; ++n) acc[a][b][m][n] = (f32x4){0.f, 0.f, 0.f, 0.f};
    }
    bf16x8 At[4][2], B0[2][2], B1[2][2];
    i32x8 At8[4], B08[2], B18[2];
    int sc_w = 122, sc_a = 127; asm volatile("" : "+v"(sc_w), "+v"(sc_a));
    unsigned gc00 = 0, gc01 = 0, gc10 = 0, gc11 = 0, gn00 = 0, gn01 = 0, gn10 = 0, gn11 = 0;
#define PG8_TOK(u, t00, t01, t10, t11) do { const unsigned* lp_ = g.list + (u).lo; const int nv_ = (u).nv; \
        int tid_ = threadIdx.x; asm volatile("" : "+v"(tid_)); int R0_, C0_, R1_, C1_; stage_rc(tid_ * 16, R0_, C0_); stage_rc(tid_ * 16 + 8192, R1_, C1_);     \
        t00 = R0_ < nv_ ? lp_[R0_] : 0u; t01 = R1_ < nv_ ? lp_[R1_] : 0u; t10 = (128 + R0_) < nv_ ? lp_[128 + R0_] : 0u; t11 = (128 + R1_) < nv_ ? lp_[128 + R1_] : 0u; } while (0)
#define PG8_OFFS(t00, t01, t10, t11, o00, o01, o10, o11) do { \
        int tid_ = threadIdx.x; asm volatile("" : "+v"(tid_)); int R0_, C0_, R1_, C1_; stage_rc(tid_ * 16, R0_, C0_); stage_rc(tid_ * 16 + 8192, R1_, C1_); \
        o00 = (t00) * (unsigned)(K * 2) + (unsigned)C0_ * 2u; o01 = (t01) * (unsigned)(K * 2) + (unsigned)C1_ * 2u; o10 = (t10) * (unsigned)(K * 2) + (unsigned)C0_ * 2u; o11 = (t11) * (unsigned)(K * 2) + (unsigned)C1_ * 2u; } while (0)
#define PG8_GATH(u, o00, o01, o10, o11) do { unsigned q00_, q01_, q10_, q11_; PG8_TOK(u, q00_, q01_, q10_, q11_); PG8_OFFS(q00_, q01_, q10_, q11_, o00, o01, o10, o11); } while (0)
    unsigned tk00 = 0, tk01 = 0, tk10 = 0, tk11 = 0;
    const char* cA = GATHER ? (const char*)g.A + (size_t)cur.koff * 2 : (const char*)g.A + (size_t)cur.pm * tstep + (size_t)cur.koff * 2;
    const char* cB = (const char*)g.Bt + (size_t)cur.e * g.bstride + (size_t)cur.pn * tstep + (size_t)cur.koff * 2;
    if constexpr (GATHER) { PG8_GATH(cur, gc00, gc01, gc10, gc11); Unit n1_; if (S.next(1, n1_)) PG8_TOK(n1_, tk00, tk01, tk10, tk11); }
    PG8_STAGE_B(PG8_SB(0, 0), cB); PG8_STAGE_B(PG8_SB(0, 1), cB + hstep); PG8_STAGE_A(PG8_SA(0, 0), cA, 0, gc00, gc01); PG8_STAGE_A(PG8_SA(0, 1), cA, 1, gc10, gc11);
    if (wr == 1) PG8_BAR;
    PG8_WAIT_V(2); PG8_BAR;
    PG8_STAGE_B(PG8_SB(1, 0), cB + kstep); PG8_STAGE_A(PG8_SA(1, 0), cA + kstep, 0, gc00, gc01); PG8_STAGE_B(PG8_SB(1, 1), cB + hstep + kstep);
    PG8_WAIT_V(6); PG8_BAR;
    for (;;) {
        const bool has_next = S.next(ui + 1, nxt);
        const char* nA = has_next ? (GATHER ? (const char*)g.A + (size_t)nxt.koff * 2 : (const char*)g.A + (size_t)nxt.pm * tstep + (size_t)nxt.koff * 2) : cA;
        const char* nB = has_next ? (const char*)g.Bt + (size_t)nxt.e * g.bstride + (size_t)nxt.pn * tstep + (size_t)nxt.koff * 2 : cB;
        if constexpr (GATHER) { if (has_next) PG8_OFFS(tk00, tk01, tk10, tk11, gn00, gn01, gn10, gn11); else { gn00 = gc00; gn01 = gc01; gn10 = gc10; gn11 = gc11; }
            Unit n2_; if (S.next(ui + 2, n2_)) PG8_TOK(n2_, tk00, tk01, tk10, tk11); }
        const int nt = cur.nt;
        for (int t = 0; t < nt; t += 2) {
            const bool last = (t == nt - 2);
            const char* a1 = cA + (size_t)(t + 1) * kstep;
            const char* a2 = last ? nA : cA + (size_t)(t + 2) * kstep; const char* b2 = last ? nB : cB + (size_t)(t + 2) * kstep;
            const char* a3 = a2 + kstep; const char* b3 = b2 + kstep;
            const unsigned s00 = last ? gn00 : gc00, s01 = last ? gn01 : gc01, s10 = last ? gn10 : gc10, s11 = last ? gn11 : gc11;
            const int fresh = __builtin_amdgcn_readfirstlane(((Epi::NST > 0) && (ui > 0) && (t == 0)) ? 1 : 0);
            PG8_LDB(B0, 0, 0); PG8_LDB(B1, 0, 1); PG8_SCHED; PG8_LDA(At, 0, 0); PG8_STAGE_A(PG8_SA(1, 1), a1, 1, gc10, gc11);
            PG8_WAIT_V8F(fresh);
            PG8_WAIT_L(0); PG8_BAR; if (F8 && t == 0) { PG8_MMA0(0, 0, At, B0); PG8_MMA0(0, 1, At, B1); } else { PG8_MMA(0, 0, At, B0); PG8_MMA(0, 1, At, B1); } PG8_BAR; PG8_SCHED;
            PG8_LDA(At, 0, 1); PG8_STAGE_B(PG8_SB(0, 0), b2); PG8_STAGE_B(PG8_SB(0, 1), b2 + hstep); PG8_STAGE_A(PG8_SA(0, 0), a2, 0, s00, s01);
            PG8_WAIT_V8F(fresh);
            PG8_WAIT_L(0); PG8_BAR; if (F8 && t == 0) { PG8_MMA0(1, 0, At, B0); PG8_MMA0(1, 1, At, B1); } else { PG8_MMA(1, 0, At, B0); PG8_MMA(1, 1, At, B1); } PG8_BAR; PG8_SCHED;
            PG8_LDB(B0, 1, 0); PG8_LDB(B1, 1, 1); PG8_SCHED; PG8_LDA(At, 1, 0); PG8_STAGE_A(PG8_SA(0, 1), a2, 1, s10, s11);
            PG8_WAIT_V(8); PG8_WAIT_L(0); PG8_BAR; PG8_MMA(0, 0, At, B0); PG8_MMA(0, 1, At, B1); PG8_BAR; PG8_SCHED;
            PG8_LDA(At, 1, 1); PG8_STAGE_B(PG8_SB(1, 0), b3); PG8_STAGE_B(PG8_SB(1, 1), b3 + hstep); PG8_STAGE_A(PG8_SA(1, 0), a3, 0, s00, s01);
            PG8_WAIT_V(8); PG8_WAIT_L(0); PG8_BAR; PG8_MMA(1, 0, At, B0); PG8_MMA(1, 1, At, B1); PG8_BAR; PG8_SCHED;
        }
        if constexpr (ALIGN_EPI) { if (wr == 0) PG8_BAR; }
        if constexpr (F8) asm volatile("s_nop 15\n\ts_nop 7" ::: "memory");
        { int te_ = threadIdx.x; asm volatile("" : "+v"(te_));
          const int we_ = __builtin_amdgcn_readfirstlane(te_ >> 6), le_ = te_ & 63; E(acc, cur, we_ >> 2, we_ & 3, le_ & 15, le_ >> 4); }
        if (!has_next) break;
        bool zero_acc = true; if constexpr (Epi::KEEPS) zero_acc = !E.keep(cur);
        if (!F8 && zero_acc) {
#pragma unroll
        for (int a = 0; a < 2; ++a)
#pragma unroll
            for (int b = 0; b < 2; ++b)
#pragma unroll
                for (int m = 0; m < 4; ++m)
#pragma unroll
                    for (int n = 0; n < 2; ++n) acc[a][b][m][n] = (f32x4){0.f, 0.f, 0.f, 0.f};
        }
        cur = nxt; cA = nA; cB = nB; ++ui;
        if constexpr (GATHER) { gc00 = gn00; gc01 = gn01; gc10 = gn10; gc11 = gn11; }
        if constexpr (ALIGN_EPI) { if (wr == 1) PG8_BAR; }
    }
    PG8_WAIT_V(0);
    if constexpr (!ALIGN_EPI) { if (wr == 0) PG8_BAR; }
    PG8_BAR;
#undef PG8_SA
#undef PG8_SB
#undef PG8_GLDS
#undef PG8_STAGE_A
#undef PG8_STAGE_B
#undef PG8_LDA
#undef PG8_LDB
#undef PG8_MMA
#undef PG8_MMA0
#undef PG8_CAT8
#undef PG8_WAIT_V
#undef PG8_WAIT_L
#undef PG8_WAIT_V8F
#undef PG8_BAR
#undef PG8_SCHED
#undef PG8_GATH
#undef PG8_TOK
#undef PG8_OFFS
}

__device__ __forceinline__ u32x4 pack8(const f32x4 a, const f32x4 b) { u32x4 w; w.x = cvt_pk_bf16(a[0], a[1]); w.y = cvt_pk_bf16(a[2], a[3]); w.z = cvt_pk_bf16(b[0], b[1]); w.w = cvt_pk_bf16(b[2], b[3]); return w; }
__device__ __forceinline__ u32x2 pack4(const f32x4 a) { u32x2 w; w.x = cvt_pk_bf16(a[0], a[1]); w.y = cvt_pk_bf16(a[2], a[3]); return w; }

__device__ __forceinline__ size_t gfrag(int pm, int pg, int wid, int k, int lane) { return ((((size_t)(pm * 12 + pg) * 8 + wid) * 16 + k) * 64 + lane) * 8; }
__device__ __forceinline__ size_t gfrag8(int pm, int pg, int wid, int k, int lane) { return ((((size_t)(pm * 12 + pg) * 8 + wid) * 8 + k) * 64 + lane) * 16; }
constexpr float ATT_C2 = 0.125f * 1.4426950408889634f;
constexpr float NORM_EPS = 1e-6f;

struct EpiInProj {
    static constexpr bool PERM = true; static constexpr int NST = 0; static constexpr bool KEEPS = false;
    bf16_t *P, *Z, *Q, *Kb, *Vb; const PG8_LAS float *qg, *kg;
    __device__ __forceinline__ void operator()(const f32x4 (&acc)[2][2][4][2], const Unit& u, int wr, int wc, int fr, int fq) const {
        const int row0 = u.pm * BM + wr * 64 + fr; const int pn = u.pn;
        if (pn == 0) {
#pragma unroll
            for (int ai = 0; ai < 2; ++ai)
#pragma unroll
                for (int m = 0; m < 4; ++m) { bf16_t* rowp = P + (size_t)(row0 + ai * HALF + m * 16) * 256 + wc * 32 + 8 * fq;
#pragma unroll
                    for (int bj = 0; bj < 2; ++bj) *(u32x4*)(rowp + bj * HALF) = pack8(acc[ai][bj][m][0], acc[ai][bj][m][1]); asm volatile("" ::: "memory"); }
        } else if (pn <= 2) {
            const int t = pn - 1;
#pragma unroll
            for (int ai = 0; ai < 2; ++ai)
#pragma unroll
                for (int m = 0; m < 4; ++m) { bf16_t* rowp = Z + (size_t)(row0 + ai * HALF + m * 16) * 256 + t * 128 + 16 * wc + 4 * fq;
#pragma unroll
                    for (int bj = 0; bj < 2; ++bj) { const f32x4 a = acc[ai][bj][m][0], gt = acc[ai][bj][m][1]; f32x4 z;
                        z = a * rsig4_(gt);
                        *(u32x2*)(rowp + 64 * bj) = pack4(z); } asm volatile("" ::: "memory"); }
        } else if (pn <= 6) {
            const bool isq = pn <= 4; const int t = isq ? pn - 3 : pn - 5; const PG8_LAS float* gs = isq ? qg : kg;
            f32x4 gv[2][2];
#pragma unroll
            for (int bj = 0; bj < 2; ++bj)
#pragma unroll
                for (int n = 0; n < 2; ++n) gv[bj][n] = *(const PG8_LAS f32x4*)(gs + 32 * bj + 8 * fq + 4 * n);
            const float sc = isq ? ATT_C2 : 1.0f; const int head = 4 * t + wc;
#pragma unroll
            for (int ai = 0; ai < 2; ++ai)
#pragma unroll
                for (int m = 0; m < 4; ++m) { float ss = 0.f;
#pragma unroll
                    for (int bj = 0; bj < 2; ++bj)
#pragma unroll
                        for (int n = 0; n < 2; ++n) { const f32x4 x = acc[ai][bj][m][n]; ss += (x[0] * x[0] + x[1] * x[1]) + (x[2] * x[2] + x[3] * x[3]); }
                    { const int ln = 16 * fq + fr; ss += __int_as_float(__builtin_amdgcn_ds_bpermute((ln ^ 16) << 2, __float_as_int(ss))); ss += __int_as_float(__builtin_amdgcn_ds_bpermute((ln ^ 32) << 2, __float_as_int(ss))); }
                    const float rs = __builtin_amdgcn_rsqf(ss * (1.0f / 64.0f) + NORM_EPS) * sc;
                    const size_t r = (size_t)(row0 + ai * HALF + m * 16);
                    bf16_t* rowp = isq ? Q + r * 1024 + 64 * head + 8 * fq : Kb + r * 512 + 64 * head + 8 * fq;
#pragma unroll
                    for (int bj = 0; bj < 2; ++bj) *(u32x4*)(rowp + 32 * bj) = pack8(acc[ai][bj][m][0] * rs * gv[bj][0], acc[ai][bj][m][1] * rs * gv[bj][1]); asm volatile("" ::: "memory"); }
        } else {
            const int t = pn - 7;
#pragma unroll
            for (int ai = 0; ai < 2; ++ai)
#pragma unroll
                for (int m = 0; m < 4; ++m) { bf16_t* rowp = Vb + (size_t)(row0 + ai * HALF + m * 16) * 512 + 256 * t + wc * 32 + 8 * fq;
#pragma unroll
                    for (int bj = 0; bj < 2; ++bj) *(u32x4*)(rowp + bj * HALF) = pack8(acc[ai][bj][m][0], acc[ai][bj][m][1]); asm volatile("" ::: "memory"); }

        }
    }
};

constexpr float GATE_EMAX = 448.0f;
struct EpiGate {
    static constexpr bool PERM = true; static constexpr int NST = 0; static constexpr bool KEEPS = false;
    unsigned char* G8; const PG8_LAS float* bgate;
    __device__ __forceinline__ void operator()(const f32x4 (&acc)[2][2][4][2], const Unit& u, int wr, int wc, int fr, int fq) const {
        const int c0 = 256 * u.pn + wc * 32 + 8 * fq;
        f32x4 bv[2][2];
#pragma unroll
        for (int bj = 0; bj < 2; ++bj)
#pragma unroll
            for (int n = 0; n < 2; ++n) bv[bj][n] = *(const PG8_LAS f32x4*)(bgate + c0 + bj * HALF + 4 * n);
#pragma unroll
        for (int ai = 0; ai < 2; ++ai)
#pragma unroll
            for (int m = 0; m < 4; ++m) { int w[4];
#pragma unroll
                for (int bj = 0; bj < 2; ++bj) { f32x4 v0 = acc[ai][bj][m][0] + bv[bj][0], v1 = acc[ai][bj][m][1] + bv[bj][1];
#pragma unroll
                    for (int i = 0; i < 4; ++i) { v0[i] = fminf(__builtin_amdgcn_exp2f(-v0[i]), GATE_EMAX); v1[i] = fminf(__builtin_amdgcn_exp2f(-v1[i]), GATE_EMAX); }
                    int lo = 0, hi = 0;
                    lo = __builtin_amdgcn_cvt_pk_fp8_f32(v0[0], v0[1], lo, false); lo = __builtin_amdgcn_cvt_pk_fp8_f32(v0[2], v0[3], lo, true);
                    hi = __builtin_amdgcn_cvt_pk_fp8_f32(v1[0], v1[1], hi, false); hi = __builtin_amdgcn_cvt_pk_fp8_f32(v1[2], v1[3], hi, true);
                    w[2 * bj] = lo; w[2 * bj + 1] = hi; }
                *(u32x4*)(G8 + gfrag8(u.pm, u.pn, wr * 4 + wc, ai * 4 + m, fq * 16 + fr)) = (u32x4){(unsigned)w[0], (unsigned)w[1], (unsigned)w[2], (unsigned)w[3]}; asm volatile("" ::: "memory"); }
    }
};
struct EpiInProjNS {
    static constexpr bool PERM = true; static constexpr int NST = 0; static constexpr bool KEEPS = false;
    bf16_t *P, *Z, *Q, *Kb, *Vb, *G; const float *qg, *kg, *bgate;
    __device__ __forceinline__ void operator()(const f32x4 (&acc)[2][2][4][2], const Unit& u, int wr, int wc, int fr, int fq) const {
        const int row0 = u.pm * BM + wr * 64 + fr; const int pn = u.pn;
        if (pn == 0) {
#pragma unroll
            for (int ai = 0; ai < 2; ++ai)
#pragma unroll
                for (int m = 0; m < 4; ++m) { bf16_t* rowp = P + (size_t)(row0 + ai * HALF + m * 16) * 256 + wc * 32 + 8 * fq;
#pragma unroll
                    for (int bj = 0; bj < 2; ++bj) { const u32x4 t_ = pack8(acc[ai][bj][m][0], acc[ai][bj][m][1]); asm volatile("" :: "v"(t_)); } asm volatile("" ::: "memory"); }
        } else if (pn <= 2) {
            const int t = pn - 1;
#pragma unroll
            for (int ai = 0; ai < 2; ++ai)
#pragma unroll
                for (int m = 0; m < 4; ++m) { bf16_t* rowp = Z + (size_t)(row0 + ai * HALF + m * 16) * 256 + t * 128 + 16 * wc + 4 * fq;
#pragma unroll
                    for (int bj = 0; bj < 2; ++bj) { const f32x4 a = acc[ai][bj][m][0], gt = acc[ai][bj][m][1]; f32x4 z;
#pragma unroll
                        for (int i = 0; i < 4; ++i) z[i] = a[i] * sigmoidf_(gt[i]);
                        { const u32x2 t_ = pack4(z); asm volatile("" :: "v"(t_)); } } asm volatile("" ::: "memory"); }
        } else if (pn <= 6) {
            const bool isq = pn <= 4; const int t = isq ? pn - 3 : pn - 5; const float* gs = isq ? qg : kg;
            f32x4 gv[2][2];
#pragma unroll
            for (int bj = 0; bj < 2; ++bj)
#pragma unroll
                for (int n = 0; n < 2; ++n) gv[bj][n] = *(const f32x4*)(gs + 32 * bj + 8 * fq + 4 * n);
            const float sc = isq ? ATT_C2 : 1.0f; const int head = 4 * t + wc;
#pragma unroll
            for (int ai = 0; ai < 2; ++ai)
#pragma unroll
                for (int m = 0; m < 4; ++m) { float ss = 0.f;
#pragma unroll
                    for (int bj = 0; bj < 2; ++bj)
#pragma unroll
                        for (int n = 0; n < 2; ++n) { const f32x4 x = acc[ai][bj][m][n]; ss += (x[0] * x[0] + x[1] * x[1]) + (x[2] * x[2] + x[3] * x[3]); }
                    { const int ln = 16 * fq + fr; ss += __int_as_float(__builtin_amdgcn_ds_bpermute((ln ^ 16) << 2, __float_as_int(ss))); ss += __int_as_float(__builtin_amdgcn_ds_bpermute((ln ^ 32) << 2, __float_as_int(ss))); }
                    const float rs = __builtin_amdgcn_rsqf(ss * (1.0f / 64.0f) + NORM_EPS) * sc;
                    const size_t r = (size_t)(row0 + ai * HALF + m * 16);
                    bf16_t* rowp = isq ? Q + r * 1024 + 64 * head + 8 * fq : Kb + r * 512 + 64 * head + 8 * fq;
#pragma unroll
                    for (int bj = 0; bj < 2; ++bj) { const u32x4 t_ = pack8(acc[ai][bj][m][0] * rs * gv[bj][0], acc[ai][bj][m][1] * rs * gv[bj][1]); asm volatile("" :: "v"(t_)); } asm volatile("" ::: "memory"); }
        } else if (pn <= 8) {
            const int t = pn - 7;
#pragma unroll
            for (int ai = 0; ai < 2; ++ai)
#pragma unroll
                for (int m = 0; m < 4; ++m) { bf16_t* rowp = Vb + (size_t)(row0 + ai * HALF + m * 16) * 512 + 256 * t + wc * 32 + 8 * fq;
#pragma unroll
                    for (int bj = 0; bj < 2; ++bj) { const u32x4 t_ = pack8(acc[ai][bj][m][0], acc[ai][bj][m][1]); asm volatile("" :: "v"(t_)); } asm volatile("" ::: "memory"); }
        } else {
            const int c0 = 256 * (pn - 9) + wc * 32 + 8 * fq;
            f32x4 bv[2][2];
#pragma unroll
            for (int bj = 0; bj < 2; ++bj)
#pragma unroll
                for (int n = 0; n < 2; ++n) bv[bj][n] = *(const f32x4*)(bgate + c0 + bj * HALF + 4 * n);
#pragma unroll
            for (int ai = 0; ai < 2; ++ai)
#pragma unroll
                for (int m = 0; m < 4; ++m) { bf16_t* rowp = G + (size_t)(row0 + ai * HALF + m * 16) * 3072 + c0;
#pragma unroll
                    for (int bj = 0; bj < 2; ++bj) { f32x4 v0 = acc[ai][bj][m][0] + bv[bj][0], v1 = acc[ai][bj][m][1] + bv[bj][1];
#pragma unroll
                        for (int i = 0; i < 4; ++i) { v0[i] = sigmoidf_(v0[i]); v1[i] = sigmoidf_(v1[i]); }
                        { const u32x4 t_ = pack8(v0, v1); asm volatile("" :: "v"(t_)); } } asm volatile("" ::: "memory"); }
        }
    }
};

template <int LINEAR> struct EpiStoreProbe {
    static constexpr bool PERM = true; static constexpr int NST = 0; static constexpr bool KEEPS = false;
    bf16_t* S;
    __device__ __forceinline__ void operator()(const f32x4 (&acc)[2][2][4][2], const Unit& u, int wr, int wc, int fr, int fq) const {
        const int row0 = wr * 64 + fr; const size_t tbase = ((size_t)(blockIdx.x) * 256) * 256;
        const int wid = wr * 4 + wc, lane = fq * 16 + fr;
#pragma unroll
        for (int ai = 0; ai < 2; ++ai)
#pragma unroll
            for (int m = 0; m < 4; ++m)
#pragma unroll
                for (int bj = 0; bj < 2; ++bj) {
                    bf16_t* p = LINEAR ? S + tbase + (size_t)(((ai * 4 + m) * 2 + bj) * 8 + wid) * 512 + lane * 8
                                       : S + tbase + (size_t)(row0 + ai * HALF + m * 16) * 256 + bj * HALF + wc * 32 + 8 * fq;
                    *(u32x4*)p = pack8(acc[ai][bj][m][0], acc[ai][bj][m][1]); }
    }
};
struct EpiNull {
    static constexpr bool PERM = true; static constexpr int NST = 0; static constexpr bool KEEPS = false;
    __device__ __forceinline__ void operator()(const f32x4 (&acc)[2][2][4][2], const Unit& u, int wr, int wc, int fr, int fq) const {
#pragma unroll
        for (int a = 0; a < 2; ++a)
#pragma unroll
            for (int b = 0; b < 2; ++b)
#pragma unroll
                for (int m = 0; m < 4; ++m)
#pragma unroll
                    for (int n = 0; n < 2; ++n) asm volatile("" :: "v"(acc[a][b][m][n])); }
};
struct EpiMerge {
    static constexpr bool PERM = true; static constexpr int NST = 0; static constexpr bool KEEPS = true;
    const unsigned char* G8; bf16_t* MG;
    __device__ __forceinline__ bool keep(const Unit& u) const { return u.e != 2; }
    __device__ __forceinline__ void operator()(f32x4 (&acc)[2][2][4][2], const Unit& u, int wr, int wc, int fr, int fq) const {
        const int row0 = u.pm * BM + wr * 64 + fr, col0 = u.pn * BM + wc * 32 + 8 * fq; const int seg = u.e;
        const int wid = wr * 4 + wc, ln = fq * 16 + fr;
        const unsigned char* Ga = G8 + gfrag8(u.pm, seg * 4 + u.pn, wid, 0, ln);
        const unsigned char* Gb = G8 + gfrag8(u.pm, (seg != 2 ? seg + 1 : seg) * 4 + u.pn, wid, 0, ln);
        u32x4 ga[2][4], gb[2][4];
#pragma unroll
        for (int ai = 0; ai < 2; ++ai)
#pragma unroll
            for (int m = 0; m < 4; ++m) { const int k = ai * 4 + m; ga[ai][m] = *(const u32x4*)(Ga + 1024 * k); if (seg != 2) gb[ai][m] = *(const u32x4*)(Gb + 1024 * k); else gb[ai][m] = (u32x4){0u, 0u, 0u, 0u}; }
        asm volatile("" ::: "memory");
#define EM_UNPACK8(wx, wy, lo4, hi4) f32x4 lo4, hi4; { const f32x2 p0_ = __builtin_amdgcn_cvt_pk_f32_fp8((int)(wx), false), p1_ = __builtin_amdgcn_cvt_pk_f32_fp8((int)(wx), true), p2_ = __builtin_amdgcn_cvt_pk_f32_fp8((int)(wy), false), p3_ = __builtin_amdgcn_cvt_pk_f32_fp8((int)(wy), true); \
            lo4 = (f32x4){p0_[0], p0_[1], p1_[0], p1_[1]}; hi4 = (f32x4){p2_[0], p2_[1], p3_[0], p3_[1]}; }
#pragma unroll
        for (int ai = 0; ai < 2; ++ai)
#pragma unroll
            for (int m = 0; m < 4; ++m) { bf16_t* mp = MG + (size_t)(row0 + ai * HALF + m * 16) * 1024 + col0;
#pragma unroll
                for (int bj = 0; bj < 2; ++bj) { const u32x4 a4 = ga[ai][m], b4 = gb[ai][m];
                    EM_UNPACK8(bj ? a4.z : a4.x, bj ? a4.w : a4.y, na0, na1); EM_UNPACK8(bj ? b4.z : b4.x, bj ? b4.w : b4.y, nb0, nb1);
                    { const f32x4 da0 = na0 + 1.0f, da1 = na1 + 1.0f;
                      const f32x4 ra0 = (f32x4){__builtin_amdgcn_rcpf(da0[0]), __builtin_amdgcn_rcpf(da0[1]), __builtin_amdgcn_rcpf(da0[2]), __builtin_amdgcn_rcpf(da0[3])}, ra1 = (f32x4){__builtin_amdgcn_rcpf(da1[0]), __builtin_amdgcn_rcpf(da1[1]), __builtin_amdgcn_rcpf(da1[2]), __builtin_amdgcn_rcpf(da1[3])};
                      acc[ai][bj][m][0] *= (nb0 + 1.0f) * ra0; acc[ai][bj][m][1] *= (nb1 + 1.0f) * ra1; }
                    if (seg == 2) *(u32x4*)(mp + bj * HALF) = pack8(acc[ai][bj][m][0], acc[ai][bj][m][1]); }
                asm volatile("" ::: "memory"); }
#undef EM_UNPACK8
    }
};

template <bool SRC_F32> struct EpiResid {
    static constexpr bool PERM = true; static constexpr int NST = 0; static constexpr bool KEEPS = false;
    const void* src; bf16_t* out;
    __device__ __forceinline__ void operator()(const f32x4 (&acc)[2][2][4][2], const Unit& u, int wr, int wc, int fr, int fq) const {
        const int row0 = u.pm * BM + wr * 64 + fr, col0 = u.pn * BM + wc * 32 + 8 * fq;
        if constexpr (SRC_F32) {
#pragma unroll
        for (int ai = 0; ai < 2; ++ai) {
            f32x4 b[4][2][2];
#pragma unroll
            for (int m = 0; m < 4; ++m) { const size_t off = (size_t)(row0 + ai * HALF + m * 16) * 1024 + col0;
#pragma unroll
                for (int bj = 0; bj < 2; ++bj) { b[m][bj][0] = *(const f32x4*)((const float*)src + off + bj * HALF); b[m][bj][1] = *(const f32x4*)((const float*)src + off + bj * HALF + 4); } }
#pragma unroll
            for (int m = 0; m < 4; ++m) { const size_t off = (size_t)(row0 + ai * HALF + m * 16) * 1024 + col0;
#pragma unroll
                for (int bj = 0; bj < 2; ++bj) *(u32x4*)(out + off + bj * HALF) = pack8(b[m][bj][0] + acc[ai][bj][m][0], b[m][bj][1] + acc[ai][bj][m][1]); }
            asm volatile("" ::: "memory");
        }
        } else {
            u32x4 b[2][4][2];
#pragma unroll
            for (int ai = 0; ai < 2; ++ai)
#pragma unroll
                for (int m = 0; m < 4; ++m) { const size_t off = (size_t)(row0 + ai * HALF + m * 16) * 1024 + col0;
#pragma unroll
                    for (int bj = 0; bj < 2; ++bj) b[ai][m][bj] = *(const u32x4*)((const bf16_t*)src + off + bj * HALF); }
            asm volatile("" ::: "memory");
#pragma unroll
            for (int ai = 0; ai < 2; ++ai) {
#pragma unroll
                for (int m = 0; m < 4; ++m) { const size_t off = (size_t)(row0 + ai * HALF + m * 16) * 1024 + col0;
#pragma unroll
                    for (int bj = 0; bj < 2; ++bj) { const u32x4 w = b[ai][m][bj];
                        const f32x4 lo = (f32x4){bf_lo(w.x), bf_hi(w.x), bf_lo(w.y), bf_hi(w.y)}, hi = (f32x4){bf_lo(w.z), bf_hi(w.z), bf_lo(w.w), bf_hi(w.w)};
                        *(u32x4*)(out + off + bj * HALF) = pack8(lo + acc[ai][bj][m][0], hi + acc[ai][bj][m][1]); } }
                asm volatile("" ::: "memory"); }
        }
    }
};

struct EpiSwiGLU {
    static constexpr bool PERM = true; static constexpr int NST = 0; static constexpr bool KEEPS = false;
    bf16_t* H; int ldh;
    __device__ __forceinline__ void operator()(const f32x4 (&acc)[2][2][4][2], const Unit& u, int wr, int wc, int fr, int fq) const {
        const int row0 = u.pm * BM + wr * 64 + fr, ch0 = u.pn * 128 + 32 * wc + 8 * fq;
#pragma unroll
        for (int ai = 0; ai < 2; ++ai)
#pragma unroll
            for (int m = 0; m < 4; ++m) { f32x4 z[2];
#pragma unroll
                for (int n = 0; n < 2; ++n) { const f32x4 a = acc[ai][0][m][n], b = acc[ai][1][m][n];
                    z[n] = (a * b) * rsig4_(a); }
                *(u32x4*)(H + (size_t)(row0 + ai * HALF + m * 16) * ldh + ch0) = pack8(z[0], z[1]); asm volatile("" ::: "memory"); }
    }
};

struct EpiSwiGLU8 {
    static constexpr bool PERM = true; static constexpr int NST = 0; static constexpr bool KEEPS = false;
    unsigned char* H8; int ldh;
    __device__ __forceinline__ void operator()(const f32x4 (&acc)[2][2][4][2], const Unit& u, int wr, int wc, int fr, int fq) const {
        const int row0 = u.pm * BM + wr * 64 + fr, ch0 = u.pn * 128 + 32 * wc + 8 * fq;
#pragma unroll
        for (int ai = 0; ai < 2; ++ai)
#pragma unroll
            for (int m = 0; m < 4; ++m) { int w[2];
#pragma unroll
                for (int n = 0; n < 2; ++n) { const f32x4 a = acc[ai][0][m][n], b = acc[ai][1][m][n]; f32x4 z;
                    z = (a * b) * rsig4_(a);
                    int t = 0; t = __builtin_amdgcn_cvt_pk_fp8_f32(z[0], z[1], t, false); t = __builtin_amdgcn_cvt_pk_fp8_f32(z[2], z[3], t, true); w[n] = t; }
                *(u32x2*)(H8 + (size_t)(row0 + ai * HALF + m * 16) * ldh + ch0) = (u32x2){(unsigned)w[0], (unsigned)w[1]}; asm volatile("" ::: "memory"); }
    }
};

template <bool DST_F32> struct EpiMoeDown {
    static constexpr bool PERM = true; static constexpr int NST = 0; static constexpr bool KEEPS = false;
    const bf16_t* xb; void* out; const unsigned* list; const float* wgt; int ntfull;
    __device__ __forceinline__ void operator()(const f32x4 (&acc)[2][2][4][2], const Unit& u, int wr, int wc, int fr, int fq) const {
        const int col0 = u.pn * BM + wc * 32 + 8 * fq; const unsigned* lp = list + u.lo; const int nv = u.nv;
        unsigned tok[2][4]; float w[2][4];
#pragma unroll
        for (int ai = 0; ai < 2; ++ai)
#pragma unroll
            for (int m = 0; m < 4; ++m) { const int rl = ai * HALF + wr * 64 + m * 16 + fr; tok[ai][m] = rl < nv ? lp[rl] : 0u; }
#pragma unroll
        for (int ai = 0; ai < 2; ++ai)
#pragma unroll
            for (int m = 0; m < 4; ++m) w[ai][m] = wgt[tok[ai][m]];
        u32x4 b[4][2];
#pragma unroll
        for (int m = 0; m < 4; ++m) { const bf16_t* xp = xb + (size_t)tok[0][m] * 1024 + col0;
#pragma unroll
            for (int bj = 0; bj < 2; ++bj) b[m][bj] = *(const u32x4*)(xp + bj * HALF); }
        asm volatile("" ::: "memory");
#pragma unroll
        for (int ai = 0; ai < 2; ++ai) {
#pragma unroll
            for (int m = 0; m < 4; ++m) { const int rl = ai * HALF + wr * 64 + m * 16 + fr; const size_t off = (size_t)tok[ai][m] * 1024 + col0;
                const u32x4 q0 = b[m][0], q1 = b[m][1];
                if (ai == 0) { const bf16_t* xp = xb + (size_t)tok[1][m] * 1024 + col0; b[m][0] = *(const u32x4*)xp; b[m][1] = *(const u32x4*)(xp + HALF); }
                if (rl < nv) {
#pragma unroll
                    for (int bj = 0; bj < 2; ++bj) { const u32x4 q = bj ? q1 : q0;
                        const f32x4 v0 = (f32x4){bf_lo(q.x), bf_hi(q.x), bf_lo(q.y), bf_hi(q.y)} + acc[ai][bj][m][0] * w[ai][m], v1 = (f32x4){bf_lo(q.z), bf_hi(q.z), bf_lo(q.w), bf_hi(q.w)} + acc[ai][bj][m][1] * w[ai][m];
                        if constexpr (DST_F32) { *(f32x4*)((float*)out + off + bj * HALF) = v0; *(f32x4*)((float*)out + off + bj * HALF + 4) = v1; }
                        else *(u32x4*)((bf16_t*)out + off + bj * HALF) = pack8(v0, v1); } }
                asm volatile("" ::: "memory"); }
        }
    }
};
}
#include <hip/hip_bf16.h>
#include <cmath>
namespace attn_body {
using bf16=__hip_bfloat16;
using bf16x8=__attribute__((ext_vector_type(8)))short;
using s16x4=__attribute__((ext_vector_type(4)))short;
using f32x16=__attribute__((ext_vector_type(16)))float;
using u32x4=__attribute__((ext_vector_type(4)))unsigned;
constexpr int BATCH=8,NHEAD=8,SEQ=8192,D=64,KVP=NHEAD*D,QP=1024;
constexpr int NW=8,QBLK=32,QB=QBLK*NW,KVBLK=64,NQB=SEQ/QB;
constexpr int ATTN_UNIT_ROWS=QB;
__device__ __forceinline__ int crow(int r,int hi){return (r&3)+8*(r>>2)+4*hi;}
#define SBAR() __builtin_amdgcn_sched_barrier(0)
__device__ __forceinline__ void cmask(f32x16&p0,f32x16&p1,int jb,int qrel,int hi){
  const float NEG=-INFINITY; int kb=64*jb+4*hi;
  #pragma unroll
  for(int r=0;r<16;++r){int kv=kb+(r&3)+8*(r>>2); if(kv>qrel)p0[r]=NEG; if(kv+32>qrel)p1[r]=NEG;}
}

constexpr int NSLOT=3, SLOTB=8192;
constexpr int LDS_K=0, LDS_V=NSLOT*SLOTB, LDS_WS=2*NSLOT*SLOTB, LDS_OST=LDS_WS+NW*64*4, LDS_CT=LDS_OST+NW*4096, LDS_BYTES=LDS_CT+SEQ*4;
constexpr float C2=0.125f*1.4426950408889634f;
__device__ __forceinline__ void glds16(const void*gsrc,unsigned lds_dst){unsigned keep;
  asm volatile("s_mov_b32 %0, m0\n\ts_mov_b32 m0, %2\n\ts_nop 0\n\tglobal_load_lds_dwordx4 %1, off\n\ts_mov_b32 m0, %0":"=&s"(keep):"v"(gsrc),"s"(lds_dst):"memory");}
__device__ __forceinline__ float max3f(float a,float b,float c){float r;asm("v_max3_f32 %0, %1, %2, %3":"=v"(r):"v"(a),"v"(b),"v"(c));return r;}
__device__ __forceinline__ float max2f(float a,float b){float r;asm("v_max_f32_e32 %0, %1, %2":"=v"(r):"v"(a),"v"(b));return r;}
__device__ __forceinline__ float fadd_s(float a,float b){float r;asm("v_add_f32_e32 %0, %1, %2":"=v"(r):"v"(a),"v"(b));return r;}
__device__ __forceinline__ float fsub_s(float a,float b){float r;asm("v_sub_f32_e32 %0, %1, %2":"=v"(r):"v"(a),"v"(b));return r;}
typedef float f32x2_t __attribute__((ext_vector_type(2))); typedef __bf16 bf16x2_t __attribute__((ext_vector_type(2)));
__device__ __forceinline__ unsigned cvtpk_s(float lo,float hi){f32x2_t v={lo,hi};bf16x2_t b=__builtin_convertvector(v,bf16x2_t);return __builtin_bit_cast(unsigned,b);}
#define WAIT_BAR(N) asm volatile("s_waitcnt vmcnt(" #N ") lgkmcnt(0)\n\ts_barrier":::"memory")

__device__ __forceinline__ void qkt(f32x16&p0,f32x16&p1,const char*Kslot,const bf16x8*qr,int r32,int hi){
  const char*kb=Kslot+hi*1024+r32*16;
  #pragma unroll
  for(int d0=0;d0<4;++d0){
    const bf16x8 b0=*reinterpret_cast<const bf16x8*>(kb+d0*2048);
    const bf16x8 b1=*reinterpret_cast<const bf16x8*>(kb+d0*2048+512);
    {p0=__builtin_amdgcn_mfma_f32_32x32x16_bf16(b0,qr[d0],p0,0,0,0);p1=__builtin_amdgcn_mfma_f32_32x32x16_bf16(b1,qr[d0],p1,0,0,0);}}
}
typedef __attribute__((address_space(3))) const char* lds_cptr;
typedef short v4i16_t __attribute__((ext_vector_type(4)));
__device__ __forceinline__ void kload8(bf16x8*kf,lds_cptr kp){
  kf[0]=*(const __attribute__((address_space(3))) bf16x8*)(kp);      kf[1]=*(const __attribute__((address_space(3))) bf16x8*)(kp+512);
  kf[2]=*(const __attribute__((address_space(3))) bf16x8*)(kp+2048); kf[3]=*(const __attribute__((address_space(3))) bf16x8*)(kp+2560);
  kf[4]=*(const __attribute__((address_space(3))) bf16x8*)(kp+4096); kf[5]=*(const __attribute__((address_space(3))) bf16x8*)(kp+4608);
  kf[6]=*(const __attribute__((address_space(3))) bf16x8*)(kp+6144); kf[7]=*(const __attribute__((address_space(3))) bf16x8*)(kp+6656);
}
__device__ __forceinline__ void kload2(bf16x8*kf,lds_cptr kp,int j){ kf[2*j]=*(const __attribute__((address_space(3))) bf16x8*)(kp+j*2048); kf[2*j+1]=*(const __attribute__((address_space(3))) bf16x8*)(kp+j*2048+512); }
__device__ __forceinline__ s16x4 vtr(lds_cptr p){ return __builtin_bit_cast(s16x4,__builtin_amdgcn_ds_read_tr16_b64_v4i16((__attribute__((address_space(3))) v4i16_t*)p)); }
__device__ __forceinline__ float rowmax(const f32x16&p0,const f32x16&p1){
  float a=max3f(p0[0],p0[1],p1[0]),b=max3f(p0[2],p0[3],p1[1]);a=max3f(a,p1[2],p1[3]);
  #pragma unroll
  for(int r=4;r<16;r+=4){a=max3f(a,p0[r],p0[r+1]);b=max3f(b,p0[r+2],p0[r+3]);a=max3f(a,p1[r],p1[r+1]);b=max3f(b,p1[r+2],p1[r+3]);}
  const float m=max2f(a,b);
  auto rr=__builtin_amdgcn_permlane32_swap(__float_as_uint(m),__float_as_uint(m),false,false);
  return max2f(__uint_as_float(rr[0]),__uint_as_float(rr[1]));
}
__device__ __forceinline__ void pv(f32x16*o,int vb,bf16x8 pa0,bf16x8 pa1,bf16x8 pa2,bf16x8 pa3){
  #pragma unroll
  for(int d0=0;d0<2;++d0){s16x4 lo[4],hi[4];
    #pragma unroll
    for(int ks=0;ks<4;++ks){
      asm volatile("ds_read_b64_tr_b16 %0,%1 offset:%c2":"=&v"(lo[ks]):"v"(vb),"i"(d0*4096+ks*1024):"memory");
      asm volatile("ds_read_b64_tr_b16 %0,%1 offset:%c2":"=&v"(hi[ks]):"v"(vb),"i"(d0*4096+ks*1024+512):"memory");}
    asm volatile("s_waitcnt lgkmcnt(0)":::"memory");SBAR();
    #define PK(k) (bf16x8){lo[k][0],lo[k][1],lo[k][2],lo[k][3],hi[k][0],hi[k][1],hi[k][2],hi[k][3]}
    o[d0]=__builtin_amdgcn_mfma_f32_32x32x16_bf16(pa0,PK(0),o[d0],0,0,0);
    o[d0]=__builtin_amdgcn_mfma_f32_32x32x16_bf16(pa1,PK(1),o[d0],0,0,0);
    o[d0]=__builtin_amdgcn_mfma_f32_32x32x16_bf16(pa2,PK(2),o[d0],0,0,0);
    o[d0]=__builtin_amdgcn_mfma_f32_32x32x16_bf16(pa3,PK(3),o[d0],0,0,0);
    #undef PK
  }
}

#ifndef ATTN_STORE16
#define ATTN_STORE16(p,v) (*(u32x4*)(p)=(v))
#endif
template<int THRL> __device__ __forceinline__ void attn_unit(int b,int h,int qb,int t0,const bf16*Q,const bf16*__restrict__ K,const bf16*__restrict__ V,bf16*O,const float*__restrict__ NCL,char*shm){
  int tid_o=threadIdx.x; asm volatile("":"+v"(tid_o));
  const int tid=tid_o,lane=tid&63,r32=lane&31,hi=lane>>5; const int wid=__builtin_amdgcn_readfirstlane(tid>>6);
  const long rowbase=(long)b*SEQ; const int q0=qb*QB;
  const bf16*Qw=Q+(rowbase+q0+wid*QBLK)*QP+h*D;
  const bf16*Kh=K+(rowbase+(long)t0*KVBLK)*KVP+h*D,*Vh=V+(rowbase+(long)t0*KVBLK)*KVP+h*D;
  const unsigned lds0=(unsigned)(uintptr_t)shm;
  float*wsf=(float*)(shm+LDS_WS)+wid*64;
  const bf16*ksrc=Kh+(long)lane*KVP+wid*8;
  const bf16*vsrc=Vh+(long)(16*(wid&3)+(lane>>2))*KVP+(wid>>2)*32+(lane&3)*8;
  const unsigned kdst=lds0+LDS_K+wid*1024, vdst=lds0+LDS_V+wid*1024;
  #define DMA_K(t,slot) glds16(ksrc+(long)(t)*KVBLK*KVP,(unsigned)__builtin_amdgcn_readfirstlane(kdst+(slot)))
  #define DMA_V(t,slot) glds16(vsrc+(long)(t)*KVBLK*KVP,(unsigned)__builtin_amdgcn_readfirstlane(vdst+(slot)))
  const int vb0=(int)(lds0+LDS_V)+((lane>>4)&1)*32+(lane&3)*8+(4*hi+((lane&15)>>2))*64;
  const char*Kbase=shm+LDS_K; bf16x8 kf[8];
  const lds_cptr shm3=(lds_cptr)shm; const lds_cptr kp0=shm3+LDS_K+hi*1024+r32*16; const lds_cptr vp0=shm3+LDS_V+((lane>>4)&1)*32+(lane&3)*8+(4*hi+((lane&15)>>2))*64;
  const int NT=(q0+QB)/KVBLK-t0;
  DMA_K(0,0);DMA_V(0,0);DMA_K(1,SLOTB);
  { typedef float f32x4_t __attribute__((ext_vector_type(4))); __attribute__((address_space(3))) float* ct=(__attribute__((address_space(3))) float*)(shm3+LDS_CT);
    const int i0_=t0*KVBLK+tid*4, iend_=q0+QB; f32x4_t tv_[4];
    _Pragma("unroll") for(int k_=0;k_<4;++k_){ const int i=i0_+k_*(NW*64*4); tv_[k_]=(i<iend_)?*(const f32x4_t*)(NCL+i):(f32x4_t){0.f,0.f,0.f,0.f}; }
    _Pragma("unroll") for(int k_=0;k_<4;++k_){ const int i=i0_+k_*(NW*64*4); if(i<iend_) *(__attribute__((address_space(3))) f32x4_t*)(ct+i)=tv_[k_]; } }
  const __attribute__((address_space(3))) float* ctl=(const __attribute__((address_space(3))) float*)(shm3+LDS_CT)+t0*KVBLK+4*hi;
  #define CINIT(C0,C1,t) do{ typedef float f32x4_t __attribute__((ext_vector_type(4))); const float nm_=-mhat; const __attribute__((address_space(3))) float* cb_=ctl+64*(t); \
    _Pragma("unroll") for(int g_=0;g_<4;++g_){ const f32x4_t b0_=*(const __attribute__((address_space(3))) f32x4_t*)(cb_+8*g_), b1_=*(const __attribute__((address_space(3))) f32x4_t*)(cb_+32+8*g_); \
      _Pragma("unroll") for(int i_=0;i_<4;++i_){ C0[4*g_+i_]=nm_+b0_[i_]; C1[4*g_+i_]=nm_+b1_[i_]; } } }while(0)
  bf16x8 qr[4];
  #pragma unroll
  for(int d0=0;d0<4;++d0)qr[d0]=*reinterpret_cast<const bf16x8*>(&Qw[(long)r32*QP+d0*16+hi*8]);
  float mhat=0.f,l_reg=0.f;f32x16 o[2];o[0]=f32x16{};o[1]=f32x16{};
  const int qrel=wid*QBLK+r32;
  #define CMASK(P0,P1,t) do{int jb_=(t)-(NT-4); if(jb_>=0)cmask(P0,P1,jb_,qrel,hi);}while(0)
  bool resc=false;
  #define START(P0,P1) do{ const float rm=rowmax(P0,P1); resc=false; \
    { const float dl=rm; mhat=fadd_s(mhat,dl); \
      _Pragma("unroll") for(int r=0;r<16;++r){P0[r]=fsub_s(P0[r],dl);P1[r]=fsub_s(P1[r],dl);} \
      } \
    _Pragma("unroll") for(int r=0;r<16;++r)P0[r]=__builtin_amdgcn_exp2f(P0[r]); }while(0)
  #define RESC() do{ if(resc){ asm volatile("s_waitcnt lgkmcnt(0)":::"memory"); \
      _Pragma("unroll") for(int d_=0;d_<2;++d_) _Pragma("unroll") for(int r=0;r<16;++r)o[d_][r]*=wsf[crow(r,hi)]; } }while(0)
  f32x16 pA0,pA1,pB0,pB1;
  int sl_prev=0,sl_cur=0,sl_next=SLOTB;
  #define ROT() do{sl_prev=sl_cur;sl_cur=sl_next;sl_next=(sl_next==(NSLOT-1)*SLOTB)?0:sl_next+SLOTB;}while(0)
  DMA_K(2,2*SLOTB);
  WAIT_BAR(3);
  CINIT(pA0,pA1,0); qkt(pA0,pA1,Kbase,qr,r32,hi);asm volatile("s_nop 15\n\ts_nop 7":"+v"(pA0),"+v"(pA1));CMASK(pA0,pA1,0);
  START(pA0,pA1);
  _Pragma("unroll") for(int r=0;r<16;++r)pA1[r]=__builtin_amdgcn_exp2f(pA1[r]);
  WAIT_BAR(0);
  DMA_K(3,0);DMA_V(1,SLOTB);
  ROT();
  kload8(kf,kp0+sl_cur);
  WAIT_BAR(2);
  s16x4 vlo[8],vhi[8]; u32x4 pw0,pw1,pw2,pw3;
  #define PKW(P,B) cvtpk_s(P[B],P[B+1])
  #define PAF(k) __builtin_bit_cast(bf16x8,pw##k)
  #define VFR(i) (bf16x8){vlo[i][0],vlo[i][1],vlo[i][2],vlo[i][3],vhi[i][0],vhi[i][1],vhi[i][2],vhi[i][3]}
  #define PIN(x) asm volatile("":"+v"(x))
  #define MX3(a,b,c) __builtin_fmaxf(__builtin_fmaxf((a),(b)),(c))
  #define GAPA(MF,A0,A1,A2,A3,W0,W1,PW) do{ MF; sacc+=A0; sacc+=A1; sacc+=A2; sacc+=A3; PIN(sacc); W0; W1; PIN(PW); SBAR(); }while(0)
  #define EX(v) __builtin_amdgcn_exp2f(v)
  #define GAPB(MF,X,B) do{ MF; X[B]=EX(X[B]); X[B+1]=EX(X[B+1]); X[B+2]=EX(X[B+2]); X[B+3]=EX(X[B+3]); PIN(X); SBAR(); }while(0)
  #define VRD(i) do{ vlo[i]=vtr(vp_+(((i)>>2)*4096+((i)&3)*1024)); vhi[i]=vtr(vp_+(((i)>>2)*4096+((i)&3)*1024+512)); }while(0)
  #define KRD(G,j) do{ if(G){ kload2(kf,kp0+sl_next,j); SBAR(); } }while(0)
  #define STEP(C0,C1,P0,P1,t,GK,GV,GL) do{ SBAR(); CINIT(C0,C1,t); SBAR(); \
    const lds_cptr vp_=vp0+sl_prev; \
    VRD(0); SBAR(); float sacc=(P0[0]+P0[1]); \
    GAPA(C0=__builtin_amdgcn_mfma_f32_32x32x16_bf16(kf[0],qr[0],C0,0,0,0), P0[2],P0[3],P0[4],P0[5],     pw0[0]=PKW(P0,0), pw0[1]=PKW(P0,2), pw0); \
    VRD(4); SBAR(); GAPA(C1=__builtin_amdgcn_mfma_f32_32x32x16_bf16(kf[1],qr[0],C1,0,0,0), P0[6],P0[7],P0[8],P0[9],     pw0[2]=PKW(P0,4), pw0[3]=PKW(P0,6), pw0); \
    VRD(1); SBAR(); GAPA(C0=__builtin_amdgcn_mfma_f32_32x32x16_bf16(kf[2],qr[1],C0,0,0,0),   P0[10],P0[11],P0[12],P0[13], pw1[0]=PKW(P0,8), pw1[1]=PKW(P0,10), pw1); \
    VRD(5); SBAR(); GAPA(C1=__builtin_amdgcn_mfma_f32_32x32x16_bf16(kf[3],qr[1],C1,0,0,0),   P0[14],P0[15],P1[0],P1[1],   pw1[2]=PKW(P0,12),pw1[3]=PKW(P0,14), pw1); \
    VRD(2); SBAR(); GAPA(C0=__builtin_amdgcn_mfma_f32_32x32x16_bf16(kf[4],qr[2],C0,0,0,0),   P1[2],P1[3],P1[4],P1[5],     pw2[0]=PKW(P1,0), pw2[1]=PKW(P1,2), pw2); \
    VRD(6); SBAR(); GAPA(C1=__builtin_amdgcn_mfma_f32_32x32x16_bf16(kf[5],qr[2],C1,0,0,0),   P1[6],P1[7],P1[8],P1[9],     pw2[2]=PKW(P1,4), pw2[3]=PKW(P1,6), pw2); \
    VRD(3); SBAR(); GAPA(C0=__builtin_amdgcn_mfma_f32_32x32x16_bf16(kf[6],qr[3],C0,0,0,0),   P1[10],P1[11],P1[12],P1[13], pw3[0]=PKW(P1,8), pw3[1]=PKW(P1,10), pw3); \
    VRD(7); SBAR(); GAPA(C1=__builtin_amdgcn_mfma_f32_32x32x16_bf16(kf[7],qr[3],C1,0,0,0),   P1[14],P1[15],0.f,0.f,       pw3[2]=PKW(P1,12),pw3[3]=PKW(P1,14), pw3); \
    l_reg+=sacc; \
    if(GK){DMA_K((t)+3,sl_cur);} if(GV){DMA_V((t)+1,sl_next);} \
    CMASK(C0,C1,t); \
    { float a=MX3(C0[0],C0[1],C1[0]),b=MX3(C0[2],C0[3],C1[1]); a=MX3(a,C1[2],C1[3]); \
      _Pragma("unroll") for(int r=4;r<16;r+=4){a=MX3(a,C0[r],C0[r+1]);b=MX3(b,C0[r+2],C0[r+3]);a=MX3(a,C1[r],C1[r+1]);b=MX3(b,C1[r+2],C1[r+3]);} \
      float rm=__builtin_fmaxf(a,b); { auto rr=__builtin_amdgcn_permlane32_swap(__float_as_uint(rm),__float_as_uint(rm),false,false); rm=__builtin_fmaxf(__uint_as_float(rr[0]),__uint_as_float(rr[1])); } \
      resc=false; \
      if(__builtin_expect(__any(rm>(float)THRL),0)){ const float dl=__builtin_fmaxf(rm,0.f); mhat+=dl; \
        _Pragma("unroll") for(int r=0;r<16;++r){C0[r]-=dl;C1[r]-=dl;} \
        const float f=__builtin_amdgcn_exp2f(-dl); l_reg*=f; if(hi==0)wsf[r32]=f; resc=true; } } \
    SBAR(); \
    GAPB(o[0]=__builtin_amdgcn_mfma_f32_32x32x16_bf16(PAF(0),VFR(0),o[0],0,0,0), C0,0); \
    GAPB(o[1]=__builtin_amdgcn_mfma_f32_32x32x16_bf16(PAF(0),VFR(4),o[1],0,0,0), C0,4); \
    KRD(GL,0); GAPB(o[0]=__builtin_amdgcn_mfma_f32_32x32x16_bf16(PAF(1),VFR(1),o[0],0,0,0), C0,8); \
    KRD(GL,1); GAPB(o[1]=__builtin_amdgcn_mfma_f32_32x32x16_bf16(PAF(1),VFR(5),o[1],0,0,0), C0,12); \
    KRD(GL,2); GAPB(o[0]=__builtin_amdgcn_mfma_f32_32x32x16_bf16(PAF(2),VFR(2),o[0],0,0,0), C1,0); \
    KRD(GL,3); GAPB(o[1]=__builtin_amdgcn_mfma_f32_32x32x16_bf16(PAF(2),VFR(6),o[1],0,0,0), C1,4); \
    GAPB(o[0]=__builtin_amdgcn_mfma_f32_32x32x16_bf16(PAF(3),VFR(3),o[0],0,0,0), C1,8); \
    GAPB(o[1]=__builtin_amdgcn_mfma_f32_32x32x16_bf16(PAF(3),VFR(7),o[1],0,0,0), C1,12); \
    }while(0)
  int t=1;
  #undef CMASK
  #define CMASK(P0,P1,t) do{}while(0)
  for(;t+5<NT;t+=2){
    STEP(pB0,pB1,pA0,pA1,t,true,true,true);     WAIT_BAR(2); RESC(); ROT();
    STEP(pA0,pA1,pB0,pB1,t+1,true,true,true);   WAIT_BAR(2); RESC(); ROT();
  }
  #undef CMASK
  #define CMASK(P0,P1,t) do{int jb_=(t)-(NT-4); if(jb_>=0)cmask(P0,P1,jb_,qrel,hi);}while(0)
  #define ENDW(tt) do{ if((tt)+3<NT){WAIT_BAR(2);} else if((tt)+2<NT){WAIT_BAR(1);} else {WAIT_BAR(0);} }while(0)
  for(;t+1<NT;t+=2){
    STEP(pB0,pB1,pA0,pA1,t,(t+3<NT),(t+1<NT),(t+1<NT));       ENDW(t);   RESC(); ROT();
    STEP(pA0,pA1,pB0,pB1,t+1,(t+4<NT),(t+2<NT),(t+2<NT));     ENDW(t+1); RESC(); ROT();
  }
  STEP(pB0,pB1,pA0,pA1,NT-1,false,false,false); RESC();
  { float sacc=pB0[0]+pB0[1]; _Pragma("unroll") for(int r=2;r<16;++r)sacc+=pB0[r]; _Pragma("unroll") for(int r=0;r<16;++r)sacc+=pB1[r]; l_reg+=sacc;
    pw0=(u32x4){PKW(pB0,0),PKW(pB0,2),PKW(pB0,4),PKW(pB0,6)};pw1=(u32x4){PKW(pB0,8),PKW(pB0,10),PKW(pB0,12),PKW(pB0,14)};pw2=(u32x4){PKW(pB1,0),PKW(pB1,2),PKW(pB1,4),PKW(pB1,6)};pw3=(u32x4){PKW(pB1,8),PKW(pB1,10),PKW(pB1,12),PKW(pB1,14)};
    SBAR(); pv(o,vb0+sl_cur,PAF(0),PAF(1),PAF(2),PAF(3)); }
  #undef PKW
  #undef PAF
  #undef VFR
  #undef PIN
  #undef MX3
  #undef GAPA
  #undef GAPB
  #undef EX
  #undef VRD
  #undef KRD
  #undef STEP
  #undef ENDW
  {auto rr=__builtin_amdgcn_permlane32_swap(__float_as_uint(l_reg),__float_as_uint(l_reg),false,false);l_reg=__uint_as_float(rr[0])+__uint_as_float(rr[1]);}
  if(hi==0)wsf[32+r32]=l_reg;asm volatile("s_waitcnt lgkmcnt(0)":::"memory");
  float rli[16];
  #pragma unroll
  for(int r=0;r<16;++r)rli[r]=__builtin_amdgcn_rcpf(wsf[32+crow(r,hi)]);
  bf16*Ow=O+(rowbase+q0+wid*QBLK)*QP+h*D;
  { bf16*stg=(bf16*)(shm+LDS_OST)+wid*2048;
    #pragma unroll
    for(int r=0;r<16;++r){const int orow=crow(r,hi);
      #pragma unroll
      for(int d0=0;d0<2;++d0)stg[orow*64+d0*32+r32]=__float2bfloat16(o[d0][r]*rli[r]);}
    asm volatile("s_waitcnt lgkmcnt(0)":::"memory");
    #pragma unroll
    for(int i=0;i<4;++i){const int row=i*8+(lane>>3),ch=lane&7; const u32x4 v=*(const u32x4*)(stg+row*64+ch*8); ATTN_STORE16(Ow+(long)row*QP+ch*8,v);} }
  asm volatile("s_waitcnt lgkmcnt(0)\n\ts_barrier":::"memory");
  #undef DMA_K
  #undef DMA_V
  #undef CMASK
  #undef START
  #undef RESC
  #undef ROT
  #undef CINIT
}
constexpr int ATTN_LDS_BYTES=LDS_BYTES;
struct AttnTensors { const bf16* Q; const bf16* K; const bf16* V; bf16* O; const float* NCL; };
struct AttnUnit { int bh; int qb; };
struct AttnQueue { unsigned* cnt; float th; int xcc; volatile __attribute__((address_space(3))) unsigned* slot; };
template<int THRL=8,class Hook> __device__ __forceinline__ void attn_phase_dyn(char*lds,const AttnTensors&T_,const AttnQueue&Qd,const Hook&hook){
  AttnTensors T;
  { unsigned long long q_=(unsigned long long)T_.Q,k_=(unsigned long long)T_.K,v_=(unsigned long long)T_.V,o_=(unsigned long long)T_.O,c_=(unsigned long long)T_.NCL; asm volatile("":"+s"(q_),"+s"(k_),"+s"(v_),"+s"(o_),"+s"(c_));
    typedef __attribute__((address_space(1))) bf16 gbf; typedef __attribute__((address_space(1))) float gf;
    T.Q=(const bf16*)(const gbf*)q_; T.K=(const bf16*)(const gbf*)k_; T.V=(const bf16*)(const gbf*)v_; T.O=(bf16*)(gbf*)o_; T.NCL=(const float*)(const gf*)c_; }
  int it=0;
  for(int qq=0;qq<BATCH;++qq){ const int b=(Qd.xcc+qq)&(BATCH-1);
    for(;;++it){
      int tid_=threadIdx.x; asm volatile("":"+v"(tid_));
      if(tid_==0) Qd.slot[it&1]=__hip_atomic_fetch_add(Qd.cnt+64*b,1u,__ATOMIC_RELAXED,__HIP_MEMORY_SCOPE_AGENT);
      __syncthreads();
      const int u=__builtin_amdgcn_readfirstlane((int)Qd.slot[it&1]);
      if(u>=NHEAD*NQB) break;
      const int qb=NQB-1-(u>>3),h=u&(NHEAD-1),bh=b*NHEAD+h;
      const float* nrow=T.NCL+(long)bh*SEQ; const int ntile=4*(qb+1),lane_=tid_&63;
      const float ref=nrow[qb*QB]-Qd.th;
      const bool ok0=(lane_<ntile)&&(nrow[(lane_<ntile?lane_:0)*KVBLK+KVBLK-1]<=ref), ok1=(lane_+64<ntile)&&(nrow[(lane_+64<ntile?lane_+64:0)*KVBLK+KVBLK-1]<=ref);
      int t0=__builtin_popcountll(__ballot(ok0))+__builtin_popcountll(__ballot(ok1)); t0&=~1; if(t0>ntile-4)t0=ntile-4;
      t0=__builtin_amdgcn_readfirstlane(t0);
      attn_unit<THRL>(b,h,qb,t0,T.Q,T.K,T.V,T.O,nrow,lds);
      hook(b,u);
    }
    ++it;
  }
}
#undef SBAR
#undef WAIT_BAR
}

constexpr int NWAVES = 8;
#ifndef MK_PER_PHASE
#define MK_PER_PHASE 0
#endif

constexpr int D = 1024, BATCH = 8, SEQ = 8192, M = BATCH * SEQ, DEPTH = 4;
constexpr int IN_COLS = 5384, OFF_CONV = 256, OFF_Q = 768, OFF_K = 1280, OFF_V = 1792, OFF_F = 2304, OFF_G = 2312;
constexpr int NIN = 5376;
constexpr int DFF = 2816, DFFE = 3584, NEXP = 8, CONVK = 31;
constexpr float LOG2E = 1.4426950408889634f;

constexpr size_t MiB = 1u << 20;
constexpr size_t WS_CTL = 0, CTL_ZERO_BYTES = 256 * 1024;
constexpr size_t WS_NLF = 1 * MiB;
constexpr size_t WS_NCL = 3 * MiB;
constexpr size_t WS_WIN = 5 * MiB;
constexpr size_t WS_WBR = 16 * MiB;
constexpr size_t WS_WOUT = 18 * MiB;
constexpr size_t WS_WFF = 20 * MiB;
constexpr size_t WS_HB = 188 * MiB;
constexpr size_t WS_Y = 316 * MiB;
constexpr size_t WS_K = 444 * MiB, WS_V = 508 * MiB;
constexpr size_t WS_P = 572 * MiB, WS_Z = 604 * MiB;
constexpr size_t WS_G = 636 * MiB;
constexpr size_t WS_HID = 316 * MiB;
constexpr size_t HID_SLOT = 232 * MiB;
constexpr int MOE_SKIPR = 3;
static_assert((size_t)264 * 256 * DFFE <= HID_SLOT && WS_HID + 2 * HID_SLOT <= 800 * MiB, "MoE hidden slots");
constexpr size_t WS_LIST = 800 * MiB;
constexpr size_t WS_MOEW = 808 * MiB;
constexpr size_t WS_XBW = 820 * MiB;
constexpr size_t WS_END = 1020 * MiB;
constexpr size_t WFF_W2_DENSE = (size_t)2 * DFF * D * 2;
constexpr size_t WFF_W13_E = (size_t)2 * DFFE * D * 2, WFF_W2_E = (size_t)D * DFFE * 2, WFF_W2_MOE = 8 * WFF_W13_E;
constexpr size_t WS_WG8 = WS_WIN + (size_t)2304 * D * 2;
constexpr size_t WS_H8 = WS_WFF + 100 * MiB;
constexpr int DENSE8_FROM = 2;
constexpr size_t WFF8_W2_DENSE = (size_t)2 * DFF * D;
constexpr size_t WFF8_W13_E = (size_t)2 * DFFE * D, WFF8_W2_E = (size_t)D * DFFE, WFF8_W2_OFF = 8 * WFF8_W13_E;
static_assert(WS_WIN + (size_t)NIN * D * 2 <= WS_WBR && WS_WFF + WFF_W2_MOE + 8 * WFF_W2_E <= WS_HB && WS_G + (size_t)M * 3072 * 2 <= WS_END && WS_HID + (size_t)264 * 256 * DFFE * 2 <= WS_LIST, "d_ws map");
constexpr int CW_TMO = 0;
constexpr int CW_MOECNT = 64;
constexpr int CW_ATTQ = 8192;
constexpr int CW_BAR = 4096;

constexpr int RING_OFF = 0, RING_BYTES = 131072;
constexpr int LDSCTL_OFF = RING_BYTES, MISC_OFF = LDSCTL_OFF + 320;
constexpr int MOETAB_OFF = LDSCTL_OFF + 1024;
constexpr int LDS_BYTES = 147456;
constexpr int GBIAS_OFF = MOETAB_OFF + 272 * 4;
static_assert(MISC_OFF + 128 <= MOETAB_OFF && GBIAS_OFF % 16 == 0 && GBIAS_OFF + (3072 + 128) * 4 <= LDS_BYTES, "LDS map");

#define GAS __attribute__((address_space(1)))
#define LAS __attribute__((address_space(3)))
typedef unsigned short bf16;
typedef unsigned v4u __attribute__((ext_vector_type(4)));
typedef unsigned v2u __attribute__((ext_vector_type(2)));
typedef float f32x4 __attribute__((ext_vector_type(4)));
typedef GAS unsigned gu32;
#define RLX_AGENT __ATOMIC_RELAXED, __HIP_MEMORY_SCOPE_AGENT
#define LDS_WAIT() asm volatile("s_waitcnt lgkmcnt(0)" ::: "memory")
#define VM_WAIT() asm volatile("s_waitcnt vmcnt(0)" ::: "memory")
__device__ __forceinline__ unsigned f2bf(float f) { unsigned u = __builtin_bit_cast(unsigned, f); return (u + 0x7fffu + ((u >> 16) & 1u)) >> 16; }
__device__ __forceinline__ unsigned pk2(float lo, float hi) { return f2bf(lo) | (f2bf(hi) << 16); }
__device__ __forceinline__ float bflo(unsigned w) { return __uint_as_float(w << 16); }
__device__ __forceinline__ float bfhi(unsigned w) { return __uint_as_float(w & 0xffff0000u); }

#define XB_TMO      128
#define XB_XCNT(j)  (256  + 64 * (j))
#define XB_XSUB(j)  (1280 + 64 * (j))
#define XB_XGEN(j)  (2304 + 64 * (j))
#define XB_TOP      3328
#define XB_TOPGEN   3392
#define XCD_BAR_WORDS 3456
#define XB_SPIN_CAP (1u << 18)

__device__ __forceinline__ unsigned xb_ld(unsigned* p)              { return __hip_atomic_load(p, __ATOMIC_RELAXED, __HIP_MEMORY_SCOPE_AGENT); }
__device__ __forceinline__ unsigned xb_add(unsigned* p, unsigned v) { return __hip_atomic_fetch_add(p, v, __ATOMIC_RELAXED, __HIP_MEMORY_SCOPE_AGENT); }
__device__ __forceinline__ unsigned xb_xcc_id() { return (unsigned)__builtin_amdgcn_s_getreg((3 << 11) | 20) & 0xFu; }
#define XB_SPIN(cond, bar) do { unsigned _sp = 0; while (cond) { __builtin_amdgcn_s_sleep(1); \
    if ((++_sp & 255u) == 0u) { if (xb_ld(&(bar)[XB_TMO])) break; if (_sp > XB_SPIN_CAP) { atomicAdd(&(bar)[XB_TMO], 1u); break; } } } } while (0)

struct XcdBarrier {
    unsigned* bar; unsigned x;
    volatile LAS unsigned* st;
};

__device__ __forceinline__ XcdBarrier xcd_barrier_post(unsigned* bar, volatile LAS unsigned* st) {
    XcdBarrier b; b.bar = bar; b.x = xb_xcc_id(); b.st = st;
    if (threadIdx.x == 0) (void)xb_add(&bar[XB_XCNT(b.x)], 1u);
    return b;
}
__device__ __forceinline__ void xcd_barrier_complete(unsigned* bar, unsigned x, unsigned& nloc, unsigned& nx) {
    const unsigned G = gridDim.x * gridDim.y * gridDim.z;
    unsigned sum, cnt, mine, sp = 0u;
    for (;;) {
        sum = 0u; cnt = 0u; mine = 0u;
#pragma unroll
        for (unsigned j = 0; j < 16; ++j) { const unsigned c = xb_ld(&bar[XB_XCNT(j)]); sum += c; cnt += (c > 0u) ? 1u : 0u; mine = (j == x) ? c : mine; }
        if (sum == G) break;
        __builtin_amdgcn_s_sleep(1);
        if ((++sp & 255u) == 0u) { if (xb_ld(&bar[XB_TMO])) break; if (sp > XB_SPIN_CAP) { atomicAdd(&bar[XB_TMO], 1u); break; } }
    }
    nloc = mine > 0u ? mine : 1u; nx = cnt > 0u ? cnt : 1u;
}

__device__ __forceinline__ void xcd_barrier(const XcdBarrier& b) {
    asm volatile("s_waitcnt vmcnt(0)" ::: "memory");
    __syncthreads();
    if (threadIdx.x == 0) {
        unsigned* bar = b.bar;
        __builtin_amdgcn_s_waitcnt(0);
        unsigned nloc = b.st[0], nx = b.st[1];
        if (nloc == 0u) { xcd_barrier_complete(bar, b.x, nloc, nx); b.st[0] = nloc; b.st[1] = nx; }
        const unsigned old = xb_add(&bar[XB_XSUB(b.x)], 1u);
        const unsigned gen = old / nloc;
        if (old + 1u == (gen + 1u) * nloc) {
            __builtin_amdgcn_fence(__ATOMIC_RELEASE, "agent");
            asm volatile("s_waitcnt vmcnt(0)" ::: "memory");
            const unsigned og = xb_add(&bar[XB_TOP], 1u);
            const unsigned tg = og / nx;
            if (og + 1u == (tg + 1u) * nx) xb_add(&bar[XB_TOPGEN], 1u);
            else XB_SPIN(xb_ld(&bar[XB_TOPGEN]) == tg, bar);
            __builtin_amdgcn_fence(__ATOMIC_ACQUIRE, "agent");
            xb_add(&bar[XB_XGEN(b.x)], 1u);
            asm volatile("s_waitcnt vmcnt(0)" ::: "memory");
        } else {
            XB_SPIN(xb_ld(&bar[XB_XGEN(b.x)]) == gen, bar);
            __builtin_amdgcn_fence(__ATOMIC_ACQUIRE, "agent");
            asm volatile("s_waitcnt vmcnt(0)" ::: "memory");
        }
    }
    __syncthreads();
}

struct Frame {
    LAS unsigned char* lds;
    volatile LAS unsigned* MISC;
    int vcu, G;
};
struct Site {
    gu32* ctl; unsigned char* ws; const float* const __attribute__((address_space(4)))* in; float* out;
    int tid, lane, wave;
};
__device__ __forceinline__ Site make_site() {
    Site P; int t_ = threadIdx.x; asm volatile("" : "+v"(t_)); P.tid = t_; P.lane = t_ & 63; P.wave = __builtin_amdgcn_readfirstlane(t_ >> 6);
    unsigned long long kp_ = (unsigned long long)__builtin_amdgcn_kernarg_segment_ptr(); asm volatile("" : "+s"(kp_));
    P.in = (const float* const __attribute__((address_space(4)))*)kp_;
    P.out = (float*)(GAS float*)(*(const __attribute__((address_space(4))) unsigned long long*)(kp_ + 200));
    P.ws = (unsigned char*)(GAS unsigned char*)(*(const __attribute__((address_space(4))) unsigned long long*)(kp_ + 208));
    P.ctl = (gu32*)(P.ws + WS_CTL);
    return P;
}
__device__ __forceinline__ float wave_sum(float v, int lane) {
    (void)lane;
    v += __int_as_float(__builtin_amdgcn_update_dpp(0, __float_as_int(v), 0xB1, 0xF, 0xF, true));
    v += __int_as_float(__builtin_amdgcn_update_dpp(0, __float_as_int(v), 0x4E, 0xF, 0xF, true));
    v += __int_as_float(__builtin_amdgcn_update_dpp(0, __float_as_int(v), 0x141, 0xF, 0xF, true));
    v += __int_as_float(__builtin_amdgcn_update_dpp(0, __float_as_int(v), 0x140, 0xF, 0xF, true));
    v += __int_as_float(__builtin_amdgcn_update_dpp(0, __float_as_int(v), 0x142, 0xA, 0xF, false));
    v += __int_as_float(__builtin_amdgcn_update_dpp(0, __float_as_int(v), 0x143, 0xC, 0xF, false));
    return __int_as_float(__builtin_amdgcn_readlane(__float_as_int(v), 63));
}

__device__ __forceinline__ void transpose_item(const float* colp, size_t sstride, bf16* WT, int K, int n0, int k0, LAS float* scr, int lane) {
    const float* sp = colp + (size_t)k0 * sstride;
    const float* lp = sp + (size_t)(lane >> 5) * sstride;
    LAS float* sq = scr + (lane >> 5) * 33 + (lane & 31);
#pragma unroll
    for (int hb = 0; hb < 2; ++hb) { float tv[16];
#pragma unroll
        for (int i = 0; i < 16; ++i) { tv[i] = *lp; lp += 2 * sstride; }
#pragma unroll
        for (int i = 0; i < 16; ++i) sq[(2 * (16 * hb + i)) * 33] = tv[i]; }
    LDS_WAIT(); asm volatile("" ::: "memory");
    const int c = lane & 7;
#pragma unroll
    for (int j = 0; j < 4; ++j) { const int n = (lane >> 3) + 8 * j; const LAS float* s = scr + (8 * c) * 33 + n;
        v4u o; o.x = pk2(s[0 * 33], s[1 * 33]); o.y = pk2(s[2 * 33], s[3 * 33]); o.z = pk2(s[4 * 33], s[5 * 33]); o.w = pk2(s[6 * 33], s[7 * 33]);
        *(GAS v4u*)(WT + (size_t)(n0 + n) * K + k0 + 8 * c) = o; }
    LDS_WAIT(); asm volatile("" ::: "memory");
}
__device__ __forceinline__ void transpose_item8(const float* colp, size_t sstride, unsigned char* WT8, int K, int n0, int k0, LAS float* scr, int lane, const float sc) {
    const float* sp = colp + (size_t)k0 * sstride;
    const float* lp = sp + (size_t)(lane >> 5) * sstride;
    LAS float* sq = scr + (lane >> 5) * 33 + (lane & 31);
#pragma unroll
    for (int hb = 0; hb < 2; ++hb) { float tv[16];
#pragma unroll
        for (int i = 0; i < 16; ++i) { tv[i] = *lp; lp += 2 * sstride; }
#pragma unroll
        for (int i = 0; i < 16; ++i) sq[(2 * (16 * hb + i)) * 33] = tv[i]; }
    LDS_WAIT(); asm volatile("" ::: "memory");
    const int c = lane & 7;
#pragma unroll
    for (int j = 0; j < 4; ++j) { const int n = (lane >> 3) + 8 * j; const LAS float* s = scr + (8 * c) * 33 + n;
        int lo = 0, hi = 0;
        lo = __builtin_amdgcn_cvt_pk_fp8_f32(s[0 * 33] * sc, s[1 * 33] * sc, lo, false); lo = __builtin_amdgcn_cvt_pk_fp8_f32(s[2 * 33] * sc, s[3 * 33] * sc, lo, true);
        hi = __builtin_amdgcn_cvt_pk_fp8_f32(s[4 * 33] * sc, s[5 * 33] * sc, hi, false); hi = __builtin_amdgcn_cvt_pk_fp8_f32(s[6 * 33] * sc, s[7 * 33] * sc, hi, true);
        *(GAS v2u*)(WT8 + (size_t)(n0 + n) * K + k0 + 8 * c) = (v2u){(unsigned)lo, (unsigned)hi}; }
    LDS_WAIT(); asm volatile("" ::: "memory");
}
__device__ __forceinline__ int inproj_src_col(int p) {
    const int t = p >> 8, q = p & 255;
    if (t == 0) return q;
    if (t <= 2) { const int ch = (t - 1) * 128 + 4 * (q >> 3) + (q & 3); return OFF_CONV + ((q >> 2) & 1) * 256 + ch; }
    if (t <= 6) { const int base = t <= 4 ? OFF_Q + 256 * (t - 3) : OFF_K + 256 * (t - 5); return base + 64 * ((q >> 5) & 3) + 32 * (q >> 7) + (q & 31); }
    if (t <= 8) return OFF_V + 256 * (t - 7) + q;
    return OFF_G + 256 * (t - 9) + q;
}
template <bool F8> __device__ __forceinline__ void convert_block64(const float* sp, size_t ss, unsigned char* dp) {
    float v[64];
#pragma unroll
    for (int j = 0; j < 64; ++j) { v[j] = *sp; sp += ss; }
    if constexpr (F8) {
#pragma unroll
        for (int q = 0; q < 4; ++q) { int t[4];
#pragma unroll
            for (int c = 0; c < 4; ++c) { const int i = 16 * q + 4 * c; int w = 0;
                w = __builtin_amdgcn_cvt_pk_fp8_f32(v[i] * 32.f, v[i + 1] * 32.f, w, false); w = __builtin_amdgcn_cvt_pk_fp8_f32(v[i + 2] * 32.f, v[i + 3] * 32.f, w, true); t[c] = w; }
            *(GAS v4u*)(dp + 16 * q) = (v4u){(unsigned)t[0], (unsigned)t[1], (unsigned)t[2], (unsigned)t[3]}; }
    } else {
#pragma unroll
        for (int q = 0; q < 8; ++q) { const int i = 8 * q; v4u o; o.x = pk2(v[i], v[i + 1]); o.y = pk2(v[i + 2], v[i + 3]); o.z = pk2(v[i + 4], v[i + 5]); o.w = pk2(v[i + 6], v[i + 7]);
            *(GAS v4u*)(dp + 16 * q) = o; }
    }
}
__device__ __forceinline__ void convert_ffn_slice(const Site& P, int l, int slice) {
    const bool moe = (l & 1) != 0; const int li = l >> 1, lane = P.lane;
    if (!moe) {
        constexpr int I13 = 16 * (2 * DFF / 64), I2 = (DFF / 64) * 16;
        const int it = slice * 8 + P.wave; if (it >= I13 + I2) return;
        const float* w1 = P.in[18] + (size_t)li * D * DFF; const float* w3 = P.in[19] + (size_t)li * D * DFF; const float* w2 = P.in[20] + (size_t)li * DFF * D;
        const bool d8 = l >= DENSE8_FROM;
        unsigned char* W13 = P.ws + WS_WFF; unsigned char* W2 = P.ws + WS_WFF + (d8 ? WFF8_W2_DENSE : WFF_W2_DENSE);
        const float* sp; size_t ss; size_t doff; unsigned char* db;
        if (it < I13) { const int kb = it / (2 * DFF / 64), nb = it % (2 * DFF / 64); const int p = 64 * nb + lane; const int ch = (p >> 8) * 128 + (p & 127);
            sp = (((p >> 7) & 1) ? w3 : w1) + (size_t)(64 * kb) * DFF + ch; ss = DFF; db = W13; doff = (size_t)p * D + 64 * kb; }
        else { const int r = it - I13; const int kb = r / 16, nb = r % 16; const int n = 64 * nb + lane;
            sp = w2 + (size_t)(64 * kb) * D + n; ss = D; db = W2; doff = (size_t)n * DFF + 64 * kb; }
        if (d8) convert_block64<true>(sp, ss, db + doff); else convert_block64<false>(sp, ss, db + 2 * doff);
    } else {
        constexpr int I13 = 16 * (2 * DFFE / 64), I2 = (DFFE / 64) * 16, IE = I13 + I2;
        for (int j = 0; j < 2; ++j) { const int it = slice * 16 + j * 8 + P.wave; if (it >= 8 * IE) break;
            const int e = it / IE; const int r = it - e * IE;
            const float* w1 = P.in[22] + ((size_t)li * NEXP + e) * D * DFFE; const float* w3 = P.in[23] + ((size_t)li * NEXP + e) * D * DFFE; const float* w2 = P.in[24] + ((size_t)li * NEXP + e) * DFFE * D;
            unsigned char* W13 = P.ws + WS_WFF + (size_t)e * WFF8_W13_E; unsigned char* W2 = P.ws + WS_WFF + WFF8_W2_OFF + (size_t)e * WFF8_W2_E;
            const float* sp; size_t ss; unsigned char* dp;
            if (r < I13) { const int kb = r / (2 * DFFE / 64), nb = r % (2 * DFFE / 64); const int p = 64 * nb + lane; const int ch = (p >> 8) * 128 + (p & 127);
                sp = (((p >> 7) & 1) ? w3 : w1) + (size_t)(64 * kb) * DFFE + ch; ss = DFFE; dp = W13 + (size_t)p * D + 64 * kb; }
            else { const int r2 = r - I13; const int kb = r2 / 16, nb = r2 % 16; const int n = 64 * nb + lane;
                sp = w2 + (size_t)(64 * kb) * D + n; ss = D; dp = W2 + (size_t)n * DFFE + 64 * kb; }
            convert_block64<true>(sp, ss, dp); }
    }
}
__device__ __forceinline__ void convert_layer_weights(const Frame& F, const Site& P, int l) {
    LAS float* scr = (LAS float*)(F.lds + RING_OFF + P.wave * 16384);
    const int gw = F.vcu * NWAVES + P.wave, NGW = F.G * NWAVES, lane = P.lane;
    bf16* WIN = (bf16*)(P.ws + WS_WIN); bf16* WBR = (bf16*)(P.ws + WS_WBR); bf16* WOUT = (bf16*)(P.ws + WS_WOUT);
    const float* w_in = P.in[2] + (size_t)l * D * IN_COLS;
    const float* w_brc = P.in[14] + (size_t)l * 256 * D; const float* w_bra = P.in[15] + (size_t)l * 512 * D; const float* w_out = P.in[16] + (size_t)l * D * D;
    constexpr int I_IN = 16 * (NIN / 32), I_BC = 4 * 32, I_BA = 8 * 32, I_OUT = 16 * 32;
    const int NITEMS = I_IN + I_BC + I_BA + I_OUT;
    for (int it = gw; it < NITEMS; it += NGW) {
        int r = it;
        if (r < I_IN) { const int kb = r / (NIN / 32), nb = r % (NIN / 32); const int p = 32 * nb + (lane & 31);
            if (nb < 2304 / 32) transpose_item(w_in + inproj_src_col(p), IN_COLS, WIN, D, 32 * nb, 64 * kb, scr, lane);
            else transpose_item8(w_in + inproj_src_col(p), IN_COLS, P.ws + WS_WG8, D, 32 * nb - 2304, 64 * kb, scr, lane, 32.f * LOG2E);
            continue; } r -= I_IN;
        if (r < I_BC) { const int kb = r / 32, nb = r % 32;
            transpose_item(w_brc + 32 * nb + (lane & 31), D, WBR + 256, D, 32 * nb, 64 * kb, scr, lane); continue; } r -= I_BC;
        if (r < I_BA) { const int kb = r / 32, nb = r % 32;
            transpose_item(w_bra + 32 * nb + (lane & 31), D, WBR + 512, D, 32 * nb, 64 * kb, scr, lane); continue; } r -= I_BA;
        if (r < I_OUT) { const int kb = r / 32, nb = r % 32;
            transpose_item(w_out + 32 * nb + (lane & 31), D, WOUT, D, 32 * nb, 64 * kb, scr, lane); }
    }
    {
        const float* pw = P.in[5] + (size_t)l * 4 * 64 * 64; const float* ps = P.in[6] + (size_t)l * 256; const float* wbp = P.in[13] + (size_t)l * 256 * D;
        const int gt = F.vcu * (NWAVES * 64) + P.tid, NT = F.G * NWAVES * 64;
        for (int item = gt; item < 1024 * 32; item += NT) {
            const int n = item & 1023, kb = item >> 10, k0 = 8 * kb, g = k0 >> 6, c0 = k0 & 63;
            float a[8];
#pragma unroll
            for (int j = 0; j < 8; ++j) a[j] = 0.f;
            for (int cp = 0; cp < 64; ++cp) { const float wv = ps[g * 64 + cp] * wbp[(size_t)(g * 64 + cp) * D + n];
#pragma unroll
                for (int j = 0; j < 8; ++j) a[j] += pw[(size_t)(g * 64 + c0 + j) * 64 + cp] * wv; }
            v4u o; o.x = pk2(a[0], a[1]); o.y = pk2(a[2], a[3]); o.z = pk2(a[4], a[5]); o.w = pk2(a[6], a[7]);
            *(GAS v4u*)(WBR + (size_t)n * D + k0) = o;
        }
    }
}

template <bool XBF> struct RowRaw;
template <> struct RowRaw<false> { f32x4 a[4]; };
template <> struct RowRaw<true> { v4u a[2]; };
template <bool XBF> __device__ __forceinline__ RowRaw<XBF> load_row(const void* xsrc, int row, int lane) {
    RowRaw<XBF> r;
    if constexpr (XBF) { const GAS v4u* p = (const GAS v4u*)((const bf16*)xsrc + (size_t)row * D) + lane; r.a[0] = p[0]; r.a[1] = p[64]; }
    else { const GAS f32x4* p = (const GAS f32x4*)((const float*)xsrc + (size_t)row * D) + 2 * lane;
#pragma unroll
        for (int j = 0; j < 4; ++j) r.a[j] = p[128 * (j >> 1) + (j & 1)]; }
    return r;
}
template <bool XBF> __device__ __forceinline__ void unpack_row(const RowRaw<XBF>& r, f32x4 (&v)[4]) {
    if constexpr (XBF) {
#pragma unroll
        for (int j2 = 0; j2 < 2; ++j2) { const v4u w = r.a[j2]; v[2 * j2] = (f32x4){bflo(w.x), bfhi(w.x), bflo(w.y), bfhi(w.y)}; v[2 * j2 + 1] = (f32x4){bflo(w.z), bfhi(w.z), bflo(w.w), bfhi(w.w)}; } }
    else {
#pragma unroll
        for (int j = 0; j < 4; ++j) v[j] = r.a[j]; }
}
#ifndef NORM_AHEAD
#define NORM_AHEAD 4
#endif
template <int MODE, bool XBF, bool H8 = (MODE == 2)>
__device__ __forceinline__ void norm_phase(const Frame& F, const Site& P, const void* xsrc, const float* gvec, const float* w8, size_t w8stride, const float* b8, unsigned* gcnt) {
    const int lane = P.lane;
    bf16* HB = (bf16*)(P.ws + WS_HB);
    int kb[4];
#pragma unroll
    for (int j = 0; j < 4; ++j) kb[j] = 8 * lane + 512 * (j >> 1) + 4 * (j & 1);
    f32x4 gv[4];
#pragma unroll
    for (int j = 0; j < 4; ++j) gv[j] = *(const f32x4*)(gvec + kb[j]);
    LAS unsigned* lcnt = (LAS unsigned*)(F.lds + RING_OFF);
    LAS float* wfs = (LAS float*)(F.lds + RING_OFF + 1024);
    if constexpr (MODE != 1) {
        for (int idx = P.tid; idx < 8 * D; idx += NWAVES * 64) { const int k = idx >> 3, h = idx & 7; wfs[h * D + k] = w8[(size_t)k * w8stride + h] * gvec[k]; }
        __syncthreads();
    }
    float* NLF = (float*)(P.ws + WS_NLF);
    unsigned* list = (unsigned*)(P.ws + WS_LIST); float* moew = (float*)(P.ws + WS_MOEW);
    for (int rb = F.vcu; rb < M / 256; rb += F.G) {
        const int row0 = rb * 256 + P.wave * 32;
        if constexpr (MODE == 2) { if (P.tid < 32) lcnt[P.tid] = 0u; __syncthreads(); }
        int my_e0 = 0, my_e1 = 0; float my_w0 = 0.f, my_w1 = 0.f;
        float nacc = 0.f; float b8h = 0.f; if constexpr (MODE == 0) b8h = b8[lane >> 3];
        constexpr int AH = XBF ? NORM_AHEAD : 2;
        RowRaw<XBF> nr[AH];
#pragma unroll
        for (int a = 0; a < AH; ++a) nr[a] = load_row<XBF>(xsrc, row0 + a, lane);
#pragma unroll 1
        for (int i = 0; i < 32; ++i) {
            f32x4 v[4]; float s = 0.f;
            { unpack_row<XBF>(nr[0], v);
#pragma unroll
              for (int a = 0; a + 1 < AH; ++a) nr[a] = nr[a + 1];
              nr[AH - 1] = load_row<XBF>(xsrc, row0 + (i + AH < 32 ? i + AH : 31), lane); }
            {
            const int row = row0 + i;
#pragma unroll
            for (int j = 0; j < 4; ++j) s += (v[j].x * v[j].x + v[j].y * v[j].y) + (v[j].z * v[j].z + v[j].w * v[j].w);
            const float rstd = __builtin_amdgcn_rsqf(wave_sum(s, lane) * (1.f / D) + 1e-6f);
            {
                v2u q8[2];
#pragma unroll
                for (int j2 = 0; j2 < 2; ++j2) { const f32x4 a = v[2 * j2] * rstd * gv[2 * j2], b = v[2 * j2 + 1] * rstd * gv[2 * j2 + 1];
                    if constexpr (H8 || MODE == 0) { int lo = 0, hi = 0;
                        lo = __builtin_amdgcn_cvt_pk_fp8_f32(a.x, a.y, lo, false); lo = __builtin_amdgcn_cvt_pk_fp8_f32(a.z, a.w, lo, true);
                        hi = __builtin_amdgcn_cvt_pk_fp8_f32(b.x, b.y, hi, false); hi = __builtin_amdgcn_cvt_pk_fp8_f32(b.z, b.w, hi, true);
                        q8[j2] = (v2u){(unsigned)lo, (unsigned)hi}; }
                    if constexpr (!H8) *((GAS v4u*)(HB + (size_t)row * D) + lane + 64 * j2) = (v4u){pk2(a.x, a.y), pk2(a.z, a.w), pk2(b.x, b.y), pk2(b.z, b.w)}; }
                if constexpr (H8 || MODE == 0) {
                    unsigned char* r8 = (H8 ? (unsigned char*)HB : P.ws + WS_H8) + (size_t)row * D;
                    const bool odd = (lane & 1) != 0;
                    const unsigned s0 = odd ? q8[0].x : q8[1].x, s1 = odd ? q8[0].y : q8[1].y;
                    const unsigned g0 = (unsigned)__builtin_amdgcn_update_dpp(0, (int)s0, 0xB1, 0xF, 0xF, true), g1 = (unsigned)__builtin_amdgcn_update_dpp(0, (int)s1, 0xB1, 0xF, 0xF, true);
                    const v4u o = odd ? (v4u){g0, g1, q8[1].x, q8[1].y} : (v4u){q8[0].x, q8[0].y, g0, g1};
                    *(GAS v4u*)(r8 + (odd ? 512 : 0) + 8 * (lane & ~1)) = o; }
            }
            if constexpr (MODE != 1) {
                float f[8];
#pragma unroll
                for (int h = 0; h < 8; ++h) { f32x4 fa = v[0] * *(const LAS f32x4*)(wfs + h * D + kb[0]);
#pragma unroll
                    for (int j = 1; j < 4; ++j) fa += v[j] * *(const LAS f32x4*)(wfs + h * D + kb[j]);
                    f[h] = (fa[0] + fa[1]) + (fa[2] + fa[3]); }
                float red;
                { const bool b5 = (lane & 32) != 0, b4 = (lane & 16) != 0, b3 = (lane & 8) != 0;
#define XCH(v, o) __int_as_float(__builtin_amdgcn_ds_bpermute((lane ^ (o)) << 2, __float_as_int(v)))
                  float g4[4];
#pragma unroll
                  for (int j = 0; j < 4; ++j) { const float send = b5 ? f[j] : f[4 + j], keep = b5 ? f[4 + j] : f[j]; g4[j] = keep + XCH(send, 32); }
                  float g2[2];
#pragma unroll
                  for (int j = 0; j < 2; ++j) { const float send = b4 ? g4[j] : g4[2 + j], keep = b4 ? g4[2 + j] : g4[j]; g2[j] = keep + XCH(send, 16); }
                  { const float send = b3 ? g2[0] : g2[1], keep = b3 ? g2[1] : g2[0]; red = keep + XCH(send, 8); }
                  red += XCH(red, 4); red += XCH(red, 2); red += XCH(red, 1);
#undef XCH
                  red *= rstd; }
                if constexpr (MODE == 0) {
                    const float z = red + b8h;
                    const float spv = fmaxf(-z, 0.f) * LOG2E + __builtin_amdgcn_logf(1.0f + __builtin_amdgcn_exp2f(-fabsf(z) * LOG2E));
                    const float tv = __int_as_float(__builtin_amdgcn_ds_bpermute((8 * (lane & 7)) << 2, __float_as_int(spv)));
                    if ((lane >> 3) == (i & 7)) nacc = tv;
                    if ((i & 7) == 7) NLF[(size_t)(row - 7) * 8 + lane] = nacc;
                } else {
#pragma unroll
                    for (int h = 0; h < 8; ++h) f[h] = __int_as_float(__builtin_amdgcn_readlane(__float_as_int(red), 8 * h));
                    int e0 = 0; float v0 = f[0];
#pragma unroll
                    for (int h = 1; h < 8; ++h) if (f[h] > v0) { v0 = f[h]; e0 = h; }
                    int e1 = (e0 == 0) ? 1 : 0; float v1 = -INFINITY;
#pragma unroll
                    for (int h = 0; h < 8; ++h) if (h != e0 && f[h] > v1) { v1 = f[h]; e1 = h; }
                    const float w0 = __builtin_amdgcn_rcpf(1.0f + __builtin_amdgcn_exp2f((v1 - v0) * LOG2E));
                    if (lane == i) { my_e0 = e0; my_e1 = e1; my_w0 = w0; my_w1 = 1.0f - w0; }
                }
            }
            }
        }
        if constexpr (MODE == 2) {
            unsigned p0 = 0, p1 = 0;
            if (lane < 32) { p0 = __hip_atomic_fetch_add(&lcnt[my_e0], 1u, __ATOMIC_RELAXED, __HIP_MEMORY_SCOPE_WORKGROUP); p1 = __hip_atomic_fetch_add(&lcnt[8 + my_e1], 1u, __ATOMIC_RELAXED, __HIP_MEMORY_SCOPE_WORKGROUP);
                moew[row0 + lane] = my_w0; moew[M + row0 + lane] = my_w1; }
            __syncthreads();
            if (P.tid < 16) lcnt[16 + P.tid] = __hip_atomic_fetch_add(gcnt + P.tid, lcnt[P.tid], RLX_AGENT);
            __syncthreads();
            if (lane < 32) { list[(size_t)my_e0 * M + lcnt[16 + my_e0] + p0] = (unsigned)(row0 + lane); list[(size_t)(8 + my_e1) * M + lcnt[24 + my_e1] + p1] = (unsigned)(row0 + lane); }
            __syncthreads();
        }
    }
}

__device__ __forceinline__ void scan_phase(const Frame& F, const Site& P) {
    const float* NLF = (const float*)(P.ws + WS_NLF); float* NCL = (float*)(P.ws + WS_NCL);
    LAS float* wt = (LAS float*)(F.lds + RING_OFF);
    for (int seq = F.vcu; seq < BATCH * 8; seq += F.G) {
        const int b = seq >> 3, h = seq & 7, t0 = P.tid * 16;
        float v[16]; float s = 0.f;
#pragma unroll
        for (int i = 0; i < 16; ++i) { v[i] = NLF[((size_t)b * SEQ + t0 + i) * 8 + h]; s += v[i]; v[i] = s; }
        float incl = s;
#pragma unroll
        for (int o = 1; o < 64; o <<= 1) { const float up = __int_as_float(__builtin_amdgcn_ds_bpermute((P.lane - o) << 2, __float_as_int(incl))); if (P.lane >= o) incl += up; }
        if (P.lane == 63) wt[P.wave] = incl;
        __syncthreads();
        float base = incl - s;
        for (int w = 0; w < P.wave; ++w) base += wt[w];
        float* dst = NCL + (size_t)seq * SEQ + t0;
#pragma unroll
        for (int i = 0; i < 16; i += 4) *(f32x4*)(dst + i) = (f32x4){base + v[i], base + v[i + 1], base + v[i + 2], base + v[i + 3]};
        __syncthreads();
    }
}

__device__ __forceinline__ void store_row_pair(bf16* base, int lane, v2u ra, v2u rb) {
    const bool odd = (lane & 1) != 0;
    const unsigned s0 = odd ? ra.x : rb.x, s1 = odd ? ra.y : rb.y;
    const unsigned g0 = (unsigned)__builtin_amdgcn_update_dpp(0, (int)s0, 0xB1, 0xF, 0xF, true), g1 = (unsigned)__builtin_amdgcn_update_dpp(0, (int)s1, 0xB1, 0xF, 0xF, true);
    const v4u o = odd ? (v4u){g0, g1, rb.x, rb.y} : (v4u){ra.x, ra.y, g0, g1};
    *(GAS v4u*)(base + (size_t)(odd ? 1024 : 0) + 4 * (lane & ~1)) = o;
}
__device__ __forceinline__ void poolconv_phase(const Frame& F, const Site& P, int l) {
    const int lane = P.lane;
    const bf16* PIN = (const bf16*)(P.ws + WS_P); const bf16* Z = (const bf16*)(P.ws + WS_Z); bf16* Y = (bf16*)(P.ws + WS_Y);
    const float* cw = P.in[7] + (size_t)l * CONVK * 256; const float* cb = P.in[8] + (size_t)l * 256; const float* lg = P.in[9] + (size_t)l * 256; const float* lb = P.in[10] + (size_t)l * 256;
    f32x4 w[CONVK];
#pragma unroll
    for (int j = 0; j < CONVK; ++j) w[j] = *(const f32x4*)(cw + j * 256 + 4 * lane);
    const f32x4 cbv = *(const f32x4*)(cb + 4 * lane), lgv = *(const f32x4*)(lg + 4 * lane), lbv = *(const f32x4*)(lb + 4 * lane);
    LAS unsigned char* zt = F.lds + RING_OFF;
    const int pw = 2 << (lane >> 4);
#if defined(DBG_COPY)
    for (int ch = F.vcu; ch < M / 128; ch += F.G) { const int r0 = ch * 128;
        for (int i = 0; i < 16; ++i) { const int row = r0 + 16 * P.wave + i;
            *(GAS v2u*)(Y + (size_t)row * 1024 + 4 * lane) = *(const GAS v2u*)(PIN + (size_t)row * 256 + 4 * lane);
            *(GAS v2u*)(Y + (size_t)row * 1024 + 256 + 4 * lane) = *(const GAS v2u*)(Z + (size_t)row * 256 + 4 * lane); } }
    return;
#endif
    for (int ch = F.vcu; ch < M / 128; ch += F.G) {
        const int r0 = ch * 128; const int tseq0 = r0 & (SEQ - 1);
        { v4u sv[10];
#pragma unroll
          for (int k = 0; k < 10; ++k) { const int p0 = P.tid + k * (NWAVES * 64); const int p = p0 < 158 * 32 ? p0 : 158 * 32 - 1; const int lr = p >> 5, c16 = p & 31; const int tr = tseq0 - 30 + lr;
              const int lrc = tr >= 0 ? lr : 30;
              sv[k] = *(const GAS v4u*)(Z + (size_t)(r0 - 30 + lrc) * 256 + c16 * 8);
              if (tr < 0) sv[k] = (v4u){0u, 0u, 0u, 0u}; }
#pragma unroll
          for (int k = 0; k < 10; ++k) { const int p = P.tid + k * (NWAVES * 64); if (p < 158 * 32) *(LAS v4u*)(zt + (p >> 5) * 512 + (p & 31) * 16) = sv[k]; } }
        __syncthreads();
#if defined(DBG_POOLCOPY)
        for (int i = 0; i < 16; ++i) { const int row = r0 + 16 * P.wave + i; *(GAS v2u*)(Y + (size_t)row * 1024 + 4 * lane) = *(const GAS v2u*)(PIN + (size_t)row * 256 + 4 * lane); }
        if (false)
#endif
        { const int rw = r0 + 16 * P.wave, tw = tseq0 + 16 * P.wave;
          auto ldp = [&](int rrow) -> f32x4 { const v2u q = *(const GAS v2u*)(PIN + (size_t)rrow * 256 + 4 * lane); return (f32x4){bflo(q.x), bfhi(q.x), bflo(q.y), bfhi(q.y)}; };
          f32x4 s = (f32x4){0.f, 0.f, 0.f, 0.f};
#pragma unroll
          for (int d = 1; d < 16; ++d) { const int dd = d <= tw ? d : tw; const float mk = (d < pw && d <= tw) ? 1.0f : 0.0f; s += ldp(rw - dd) * mk; }
          v2u ovp = (v2u){0u, 0u};
#pragma unroll
          for (int i = 0; i < 16; ++i) { const int t = tw + i;
              const f32x4 cur = ldp(rw + i);
              s += cur;
              const float inv = 1.0f / (float)((t + 1) < pw ? (t + 1) : pw);
              const f32x4 o = s * inv - cur;
              v2u ov; ov.x = pk2(o[0], o[1]); ov.y = pk2(o[2], o[3]);
              if (i & 1) store_row_pair(Y + (size_t)(rw + i - 1) * 1024, lane, ovp, ov); else ovp = ov;
              const int told = t - pw + 1; const int back = told >= 0 ? pw - 1 : t;
              s -= ldp(rw + i - back) * (told >= 0 ? 1.0f : 0.0f); } }
#if defined(DBG_CONVCOPY)
        for (int i = 0; i < 16; ++i) { const int row = r0 + 16 * P.wave + i; *(GAS v2u*)(Y + (size_t)row * 1024 + 256 + 4 * lane) = *(const GAS v2u*)(Z + (size_t)row * 256 + 4 * lane); }
        if (false)
#endif
        for (int grp = 0; grp < 4; ++grp) {
            const int lr0 = 16 * P.wave + 4 * grp;
            f32x4 a[4];
#pragma unroll
            for (int o = 0; o < 4; ++o) a[o] = cbv;
#pragma unroll
            for (int jj = 0; jj < CONVK + 3; ++jj) {
                const v2u q = *(const LAS v2u*)(zt + (lr0 + jj) * 512 + lane * 8); const f32x4 z = (f32x4){bflo(q.x), bfhi(q.x), bflo(q.y), bfhi(q.y)};
#pragma unroll
                for (int o = 0; o < 4; ++o) { const int j = jj - o; if (j >= 0 && j < CONVK) a[o] += w[j] * z; }
            }
            v2u ovc = (v2u){0u, 0u};
#pragma unroll
            for (int o = 0; o < 4; ++o) {
                const float mu = wave_sum((a[o][0] + a[o][1]) + (a[o][2] + a[o][3]), lane) * (1.f / 256.f);
                const f32x4 dv = a[o] - mu;
                const float var = wave_sum((dv[0] * dv[0] + dv[1] * dv[1]) + (dv[2] * dv[2] + dv[3] * dv[3]), lane) * (1.f / 256.f);
                const float rs = __builtin_amdgcn_rsqf(var + 1e-6f);
                f32x4 y = dv * rs * lgv + lbv;
#pragma unroll
                for (int c = 0; c < 4; ++c) y[c] = y[c] * __builtin_amdgcn_rcpf(1.0f + __builtin_amdgcn_exp2f(-1.4426950408889634f * y[c]));
                v2u ov; ov.x = pk2(y[0], y[1]); ov.y = pk2(y[2], y[3]);
                if (o & 1) store_row_pair(Y + (size_t)(r0 + lr0 + o - 1) * 1024 + 256, lane, ovc, ov); else ovc = ov;
            }
        }
        __syncthreads();
    }
}

#ifndef DBG_MAXPHASE
#define DBG_MAXPHASE 1000
#endif
#ifndef ONLY_SITE
#define ONLY_SITE -1
#endif
#ifndef DBL_MASK
#define DBL_MASK 0
#endif
#define DBL(k) for (int rep_ = 0; rep_ < (((DBL_MASK >> (k)) & 1) ? 2 : 1); ++rep_)
#ifndef SITE_OFF_MASK
#define SITE_OFF_MASK 0
#endif
#define SITE(k) ((ONLY_SITE < 0 || ONLY_SITE == (k)) && !((SITE_OFF_MASK >> (k)) & 1))
#ifndef STAGGER_TICKS
#define STAGGER_TICKS 1500
#endif
constexpr int NPH = 10;
struct Args { const float* in[25]; float* out; unsigned char* ws; int ph_lo, ph_hi; };

struct FfnConvHook { const Site* P; int l; __device__ __forceinline__ void operator()(int b, int u) const { convert_ffn_slice(*P, l, u * 8 + b); } };

__global__ void __launch_bounds__(NWAVES * 64, 2) trunk_fwd(Args args) {
    extern __shared__ __attribute__((aligned(16))) unsigned char lds[];
    Frame F;
    F.lds = (LAS unsigned char*)lds;
    F.MISC = (volatile LAS unsigned*)(F.lds + MISC_OFF);
    F.G = gridDim.x; { const int bx = blockIdx.x; F.vcu = (F.G % 8 == 0) ? (bx % 8) * (F.G / 8) + bx / 8 : bx; }
    for (int u = threadIdx.x; u < (LDS_BYTES - LDSCTL_OFF) / 4; u += NWAVES * 64) ((LAS unsigned*)(F.lds + LDSCTL_OFF))[u] = 0u;
    __syncthreads();
    XcdBarrier bar; bar.bar = (unsigned*)((gu32*)(args.ws + WS_CTL) + CW_BAR); bar.x = 0; bar.st = nullptr;
    if (!MK_PER_PHASE) bar = xcd_barrier_post((unsigned*)((gu32*)(args.ws + WS_CTL) + CW_BAR), F.MISC + 8);
    const int lo = args.ph_lo, hi = args.ph_hi;
#define IN(k) (lo <= (k) && (k) < hi)
#define SEAM(k) do { if (IN(k) && IN((k) + 1)) { if (MK_PER_PHASE) { if (threadIdx.x == 0) __hip_atomic_store((gu32*)(args.ws + WS_CTL) + CW_TMO, 0xBADBA0u, RLX_AGENT); } else xcd_barrier(bar); } } while (0)

#define WSB(off) ((bf16*)(P.ws + (off)))
#define INP(k) (P.in[k])
#define XBD() ((bf16*)P.out)
#define XBW() WSB(WS_XBW)
    const int cgemm = (int)blockIdx.x;

    for (int l = 0; l < DEPTH; ++l) {
        const int pb = l * NPH;
        const bool moe = (l & 1) != 0; const int li = l >> 1;

        if (IN(pb + 0)) { const Site P = make_site();
            DBL(0) if constexpr (SITE(0)) convert_layer_weights(F, P, l);
#if defined(DBG_FILLG)
            { v4u fv = (v4u){0x3f003f00u, 0x3f003f00u, 0x3f003f00u, 0x3f003f00u}; GAS v4u* gp = (GAS v4u*)WSB(WS_G);
              for (size_t i = (size_t)blockIdx.x * 512 + P.tid; i < (size_t)M * 3072 / 8; i += (size_t)F.G * 512) gp[i] = fv; }
#endif
            __syncthreads();
            if constexpr (SITE(1)) { if (l == 0) norm_phase<0, false>(F, P, INP(0), INP(1) + (size_t)l * D, INP(2) + (size_t)l * D * IN_COLS + OFF_F, IN_COLS, INP(4) + (size_t)l * 8, nullptr);
                else norm_phase<0, true>(F, P, XBD(), INP(1) + (size_t)l * D, INP(2) + (size_t)l * D * IN_COLS + OFF_F, IN_COLS, INP(4) + (size_t)l * 8, nullptr); }
        }
        SEAM(pb + 0);

        if (IN(pb + 1)) { const Site P = make_site();
#if !defined(DBG_NOSCAN)
            if constexpr (SITE(2)) scan_phase(F, P);
#endif
            LAS float* bl = (LAS float*)(F.lds + GBIAS_OFF); LAS float* gl = bl + 3 * D;
            for (int i = P.tid; i < 3 * D; i += NWAVES * 64) bl[i] = INP(3)[(size_t)l * 3 * D + i] * LOG2E;
            if (P.tid < 128) gl[P.tid] = P.tid < 64 ? INP(11)[(size_t)l * 64 + P.tid] : INP(12)[(size_t)l * 64 + P.tid - 64];
            __syncthreads();
            {
                pg8::Gemm g{WSB(WS_HB), WSB(WS_WIN), D, 0, nullptr, 0};
                pg8::SchedPlain S{M / 256, 2304 / 256, F.G, cgemm, D / 64};
                pg8::EpiInProj E{WSB(WS_P), WSB(WS_Z), WSB(WS_Y) + 512, WSB(WS_K), WSB(WS_V), (const LAS float*)gl, (const LAS float*)(gl + 64)};
                if constexpr (SITE(3)) pg8::gemm_phase<pg8::EpiInProj, pg8::SchedPlain, true, false>(F.lds + RING_OFF, g, S, E);
            }
            {   pg8::Gemm g8{(const bf16*)(P.ws + WS_H8), (const bf16*)(P.ws + WS_WG8), D / 2, 0, nullptr, 0};
                pg8::SchedPlain S8{M / 256, 3072 / 256, F.G, cgemm, D / 128};
                pg8::EpiGate E8{P.ws + WS_G, (const LAS float*)bl};
                if constexpr (SITE(3)) pg8::gemm_phase<pg8::EpiGate, pg8::SchedPlain, true, false, true>(F.lds + RING_OFF, g8, S8, E8);
            }
        }
        SEAM(pb + 1);

        if (IN(pb + 2)) { const Site P = make_site();
            DBL(4) if constexpr (SITE(4)) poolconv_phase(F, P, l);
#if defined(DBG_FENCE)
            asm volatile("s_waitcnt vmcnt(0)" ::: "memory"); __threadfence_system(); asm volatile("s_waitcnt vmcnt(0)" ::: "memory");
#endif
            const attn_body::AttnTensors AT{(const attn_body::bf16*)(WSB(WS_Y) + 512), (const attn_body::bf16*)WSB(WS_K), (const attn_body::bf16*)WSB(WS_V), (attn_body::bf16*)(WSB(WS_Y) + 512), (const float*)(P.ws + WS_NCL)};
            float gq = fabsf(INP(11)[(size_t)l * 64 + P.lane]), gk = fabsf(INP(12)[(size_t)l * 64 + P.lane]);
#pragma unroll
            for (int o = 1; o < 64; o <<= 1) { gq = fmaxf(gq, __int_as_float(__builtin_amdgcn_ds_bpermute((P.lane ^ o) << 2, __float_as_int(gq)))); gk = fmaxf(gk, __int_as_float(__builtin_amdgcn_ds_bpermute((P.lane ^ o) << 2, __float_as_int(gk)))); }
            const float th = 2.0f * (64.0f * gq * gk * pg8::ATT_C2 * 1.02f) + 38.0f;
            const attn_body::AttnQueue Qd{(unsigned*)(P.ctl + CW_ATTQ + l * 8 * 64), __int_as_float(__builtin_amdgcn_readfirstlane(__float_as_int(th))), (int)(xb_xcc_id() & 7u), F.MISC + 16};
            const FfnConvHook hook{&P, l};
            if constexpr (SITE(5)) attn_body::attn_phase_dyn<8>((char*)lds + RING_OFF, AT, Qd, hook);
        }
        SEAM(pb + 2);

        if (IN(pb + 3)) { const Site P = make_site();
            pg8::Gemm g{WSB(WS_Y), WSB(WS_WBR), D, 0, nullptr, 0};
#if defined(DBG_MERGE1)
            pg8::SchedPlain S{M / 256, D / 256, F.G, cgemm, D / 64};
#else
            pg8::SchedMerge S{M / 256, D / 256, F.G, cgemm};
#endif
            pg8::EpiMerge E{P.ws + WS_G, WSB(WS_HB)};
#if defined(DBG_MERGE1)
            if constexpr (SITE(6)) pg8::gemm_phase<pg8::EpiMerge, pg8::SchedPlain, true, false>(F.lds + RING_OFF, g, S, E);
#else
            DBL(6) if constexpr (SITE(6)) pg8::gemm_phase<pg8::EpiMerge, pg8::SchedMerge, true, false>(F.lds + RING_OFF, g, S, E);
#endif
        }
        SEAM(pb + 3);

        if (IN(pb + 4)) { const Site P = make_site();
            pg8::Gemm g{WSB(WS_HB), WSB(WS_WOUT), D, 0, nullptr, 0};
            pg8::SchedPlain S{M / 256, D / 256, F.G, cgemm, D / 64};
            bf16* xdst = (l == DEPTH - 1) ? XBW() : XBD();
            if constexpr (SITE(7)) { if (l == 0) { pg8::EpiResid<true> E{INP(0), xdst}; pg8::gemm_phase<pg8::EpiResid<true>, pg8::SchedPlain, true, false>(F.lds + RING_OFF, g, S, E); }
                else { pg8::EpiResid<false> E{XBD(), xdst}; pg8::gemm_phase<pg8::EpiResid<false>, pg8::SchedPlain, true, false>(F.lds + RING_OFF, g, S, E); } }
        }
        SEAM(pb + 4);

        if (IN(pb + 5)) { const Site P = make_site();
            const bf16* xcur = (l == DEPTH - 1) ? XBW() : XBD();
            if constexpr (SITE(8)) { if (!moe && l >= DENSE8_FROM) norm_phase<1, true, true>(F, P, xcur, INP(17) + (size_t)l * D, nullptr, 0, nullptr, nullptr);
            else if (!moe) norm_phase<1, true, false>(F, P, xcur, INP(17) + (size_t)l * D, nullptr, 0, nullptr, nullptr);
            else norm_phase<2, true>(F, P, xcur, INP(17) + (size_t)l * D, INP(21) + (size_t)li * D * NEXP, NEXP, nullptr, (unsigned*)(P.ctl + CW_MOECNT + 64 * li)); }
        }
        SEAM(pb + 5);

        if (!moe) {
            if (IN(pb + 6)) { const Site P = make_site();
                if (l >= DENSE8_FROM) {
                pg8::Gemm g{WSB(WS_HB), WSB(WS_WFF), D / 2, 0, nullptr, 0};
                pg8::SchedPlain S{M / 256, 2 * DFF / 256, F.G, cgemm, D / 128};
                pg8::EpiSwiGLU8 E{P.ws + WS_HID, DFF};
                if constexpr (SITE(9)) pg8::gemm_phase<pg8::EpiSwiGLU8, pg8::SchedPlain, true, false, true>(F.lds + RING_OFF, g, S, E);
                } else {
                pg8::Gemm g{WSB(WS_HB), WSB(WS_WFF), D, 0, nullptr, 0};
                pg8::SchedPlain S{M / 256, 2 * DFF / 256, F.G, cgemm, D / 64};
                pg8::EpiSwiGLU E{WSB(WS_HID), DFF};
                if constexpr (SITE(9)) pg8::gemm_phase<pg8::EpiSwiGLU, pg8::SchedPlain, true, false>(F.lds + RING_OFF, g, S, E);
                }
            }
            SEAM(pb + 6);
            if (IN(pb + 7)) { const Site P = make_site();
                pg8::EpiResid<false> E{XBD(), XBD()};
                if (l >= DENSE8_FROM) {
                pg8::Gemm g{WSB(WS_HID), WSB(WS_WFF + WFF8_W2_DENSE), DFF / 2, 0, nullptr, 0};
                pg8::SchedPlain S{M / 256, D / 256, F.G, cgemm, DFF / 128};
                if constexpr (SITE(10)) pg8::gemm_phase<pg8::EpiResid<false>, pg8::SchedPlain, true, false, true>(F.lds + RING_OFF, g, S, E);
                } else {
                pg8::Gemm g{WSB(WS_HID), WSB(WS_WFF + WFF_W2_DENSE), DFF, 0, nullptr, 0};
                pg8::SchedPlain S{M / 256, D / 256, F.G, cgemm, DFF / 64};
                if constexpr (SITE(10)) pg8::gemm_phase<pg8::EpiResid<false>, pg8::SchedPlain, true, false>(F.lds + RING_OFF, g, S, E);
                }
            }
            if (l + 1 < DEPTH) SEAM(pb + 7);
        } else {
#define MOE_TAB(slot_, ntiles_) do { LAS unsigned* tab = (LAS unsigned*)(F.lds + MOETAB_OFF);     \
                __syncthreads(); \
                int cnt[8]; \
                _Pragma("unroll") for (int e = 0; e < 8; ++e) cnt[e] = __builtin_amdgcn_readfirstlane((int)__hip_atomic_load(P.ctl + CW_MOECNT + 64 * li + (slot_) * 8 + e, RLX_AGENT)); \
                int rt = 0; \
                _Pragma("unroll") for (int e = 0; e < 8; ++e) { const int nte = (cnt[e] + 255) >> 8; \
                    for (int j = P.tid; j < nte; j += NWAVES * 64) { const int nv = (cnt[e] - 256 * j) < 256 ? (cnt[e] - 256 * j) : 256; if (rt + j < 264) tab[rt + j] = (unsigned)e | ((unsigned)j << 8) | ((unsigned)(nv - 1) << 20); } \
                    rt += nte; } \
                ntiles_ = rt < 264 ? rt : 264; \
                __syncthreads(); } while (0)
#define MOE_UP(slot_, ntiles_, skipc_, skipr_) do { \
                  \
                pg8::Gemm g{WSB(WS_HB), WSB(WS_WFF), D / 2, WFF8_W13_E, (const unsigned*)(P.ws + WS_LIST), 0}; \
                pg8::SchedMoe S{ntiles_, 2 * DFFE / 256, F.G, cgemm, D / 128, slot_, (const LAS unsigned*)(F.lds + MOETAB_OFF), skipc_, skipr_}; \
                pg8::EpiSwiGLU8 E{P.ws + WS_HID + (size_t)(slot_) * HID_SLOT, DFFE}; \
                if constexpr (SITE(11)) pg8::gemm_phase<pg8::EpiSwiGLU8, pg8::SchedMoe, true, true, true>(F.lds + RING_OFF, g, S, E); } while (0)
#define MOE_DOWN(slot_, ntiles_) do { \
                pg8::Gemm g{(const bf16*)(P.ws + WS_HID + (size_t)(slot_) * HID_SLOT), WSB(WS_WFF + WFF8_W2_OFF), DFFE / 2, WFF8_W2_E, nullptr, 0};     \
                pg8::SchedMoe S{ntiles_, D / 256, F.G, cgemm, DFFE / 128, slot_, (const LAS unsigned*)(F.lds + MOETAB_OFF), 0, 0};     \
                bf16* xcur = (l == DEPTH - 1) ? XBW() : XBD(); \
                if constexpr (SITE(12)) { \
                    if (l == DEPTH - 1 && (slot_) == 1) { pg8::EpiMoeDown<true> E{xcur, P.out, (const unsigned*)(P.ws + WS_LIST), (const float*)(P.ws + WS_MOEW) + (size_t)(slot_) * M, DFFE / 128};     \
                        pg8::gemm_phase<pg8::EpiMoeDown<true>, pg8::SchedMoe, true, false, true>(F.lds + RING_OFF, g, S, E); } \
                    else { pg8::EpiMoeDown<false> E{xcur, xcur, (const unsigned*)(P.ws + WS_LIST), (const float*)(P.ws + WS_MOEW) + (size_t)(slot_) * M, DFFE / 128}; \
                        pg8::gemm_phase<pg8::EpiMoeDown<false>, pg8::SchedMoe, true, false, true>(F.lds + RING_OFF, g, S, E); } } } while (0)
            if (IN(pb + 6)) { const Site P = make_site(); int nt0 = 0; MOE_TAB(0, nt0); MOE_UP(0, nt0, 0, 0); }
            SEAM(pb + 6);
            if (IN(pb + 7)) { int skipc = 0;
                { const Site P = make_site(); int nt0 = 0; MOE_TAB(0, nt0); MOE_DOWN(0, nt0);
                  const int xd = (nt0 * (D / 256)) % F.G; skipc = (xd + 7) & ~7; if (skipc > F.G) skipc = F.G; }
                { const Site P = make_site(); int nt1 = 0; MOE_TAB(1, nt1); MOE_UP(1, nt1, skipc, MOE_SKIPR); }
            }
            SEAM(pb + 7);
            if (IN(pb + 8)) { const Site P = make_site(); int nt1 = 0; MOE_TAB(1, nt1); MOE_DOWN(1, nt1); }
            if (l + 1 < DEPTH) SEAM(pb + 8);
#undef MOE_TAB
#undef MOE_UP
#undef MOE_DOWN
        }
    }
#undef IN
#undef SEAM
#undef WSB
#undef INP
#undef XBD
#undef XBW
}

extern "C" void kernel_launch(void* const* d_in, const int* in_sizes, int n_in, void* d_out, int out_size, void* d_ws, size_t ws_size, hipStream_t stream) {
    static int grid = 0;
    if (grid == 0) {
        if (n_in != 25 || in_sizes[0] != M * D || out_size != M * D || ws_size < WS_END) { fprintf(stderr, "kernel_launch: built for 25 inputs, x and out of %d floats, >= %zu bytes of workspace; got n_in %d, in0 %d, out %d, ws %zu; nothing launched\n", M * D, (size_t)WS_END, n_in, n_in > 0 ? in_sizes[0] : -1, out_size, ws_size); grid = -1; return; }
        int dev = 0, cus = 0, per_cu = 0;
        if (hipGetDevice(&dev) != hipSuccess || hipDeviceGetAttribute(&cus, hipDeviceAttributeMultiprocessorCount, dev) != hipSuccess) { fprintf(stderr, "kernel_launch: hipGetDevice / hipDeviceGetAttribute failed; nothing launched\n"); grid = -1; return; }
        if (hipFuncSetAttribute((const void*)trunk_fwd, hipFuncAttributeMaxDynamicSharedMemorySize, LDS_BYTES) != hipSuccess) { fprintf(stderr, "kernel_launch: hipFuncSetAttribute failed\n"); grid = -1; return; }
        if (hipOccupancyMaxActiveBlocksPerMultiprocessor(&per_cu, (const void*)trunk_fwd, NWAVES * 64, LDS_BYTES) != hipSuccess || per_cu < 1)
            fprintf(stderr, "kernel_launch: note: the occupancy query reports %d workgroups per CU\n", per_cu);
        (void)hipGetLastError();
        grid = cus;
    }
    if (grid < 0) return;
    if (hipMemsetAsync((char*)d_ws + WS_CTL, 0, CTL_ZERO_BYTES, stream) != hipSuccess) { fprintf(stderr, "kernel_launch: hipMemsetAsync failed\n"); return; }
    Args a{};
    for (int i = 0; i < 25; ++i) a.in[i] = (const float*)d_in[i];
    a.out = (float*)d_out; a.ws = (unsigned char*)d_ws;
#if MK_PER_PHASE
    for (int l = 0; l < DEPTH; ++l) { const int np = (l & 1) ? 10 : 8;
        for (int p = 0; p < np; ++p) { a.ph_lo = l * NPH + p; a.ph_hi = a.ph_lo + 1; if (a.ph_lo > DBG_MAXPHASE) continue; hipLaunchKernelGGL(trunk_fwd, dim3(grid), dim3(NWAVES * 64), LDS_BYTES, stream, a); } }
#else
    a.ph_lo = 0; a.ph_hi = DEPTH * NPH;
    hipLaunchKernelGGL(trunk_fwd, dim3(grid), dim3(NWAVES * 64), LDS_BYTES, stream, a);
#endif
    const hipError_t le = hipPeekAtLastError();
    if (le != hipSuccess) fprintf(stderr, "kernel_launch: launch failed: %s (grid %d x %d threads, %d B LDS)\n", hipGetErrorName(le), grid, NWAVES * 64, LDS_BYTES);
}
```

```cpp
#include <hip/hip_runtime.h>
#include <hip/hip_bf16.h>
#include <cstdio>
#include <cstdint>
#include <cmath>

namespace pg8 {
#define PG8_LAS __attribute__((address_space(3)))
typedef unsigned short bf16_t;
typedef short bf16x8 __attribute__((ext_vector_type(8)));
typedef float f32x4 __attribute__((ext_vector_type(4)));
typedef float f32x2 __attribute__((ext_vector_type(2)));
typedef unsigned u32x4 __attribute__((ext_vector_type(4)));
typedef unsigned u32x2 __attribute__((ext_vector_type(2)));
typedef int i32x4 __attribute__((ext_vector_type(4)));
typedef int i32x8 __attribute__((ext_vector_type(8)));
constexpr int BM = 256, BK = 64, HALF = 128, HTB = HALF * BK * 2  , STAGE_BYTES = 8 * HTB, NXCD = 8, WGM = 8;

__host__ __device__ __forceinline__ int lds_byte(int r, int c) { const int st = (r >> 4) * 2 + (c >> 5), rr = r & 15, cc = c & 31, ob = rr * 64 + cc * 2; return st * 1024 + (ob ^ (((ob >> 9) & 1) << 5)); }
__host__ __device__ __forceinline__ void stage_rc(int b, int& R, int& C) { const int st = b / 1024, sb = b % 1024, swz = sb ^ (((sb >> 9) & 1) << 5); R = (st >> 1) * 16 + swz / 64; C = (st & 1) * 32 + (swz % 64) / 2; }
__host__ __device__ __forceinline__ int perm32(int rho) { const int n = rho >> 4, i = rho & 15; return 8 * (i >> 2) + 4 * n + (i & 3); }

struct Unit { int pm, pn, e, koff, nt, lo, nv; };
struct Gemm { const bf16_t* A; const bf16_t* Bt; int K; size_t bstride; const unsigned* list; int stagger; };

__device__ __forceinline__ void tile_of(int L, int nM, int nN, int& pm, int& pn) {
    const int nwg = nM * nN; int wgid = L;
    { const int q = nwg / NXCD, r = nwg % NXCD, xcd = wgid % NXCD, off = wgid / NXCD; wgid = (xcd < r ? xcd * (q + 1) : r * (q + 1) + (xcd - r) * q) + off; }
    const int nig = WGM * nN, gid = wgid / nig, fm = gid * WGM, gsz = (nM - fm) < WGM ? (nM - fm) : WGM;
    pm = fm + ((wgid % nig) % gsz); pn = (wgid % nig) / gsz;
}
struct SchedPlain {
    int nM, nN, G, c, nt;
    __device__ __forceinline__ bool next(int i, Unit& u) const {
        const long L = (long)i * G + c; if (L >= (long)nM * nN) return false;
        tile_of((int)L, nM, nN, u.pm, u.pn); u.e = 0; u.koff = 0; u.nt = nt; u.lo = 0; u.nv = 256; return true;
    }
};
struct SchedPanel {
    int nM, nN, G, c, nt;
    __device__ __forceinline__ bool next(int i, Unit& u) const {
        const int j = i / nN; u.pn = i - j * nN; u.pm = c + G * j; if (u.pm >= nM) return false;
        u.e = 0; u.koff = 0; u.nt = nt; u.lo = 0; u.nv = 256; return true;
    }
};
struct SchedMerge {
    int nM, nN, G, c;
    __device__ __forceinline__ bool next(int i, Unit& u) const {
        const int tile = i / 3, seg = i - 3 * tile; const long L = (long)tile * G + c; if (L >= (long)nM * nN) return false;
        tile_of((int)L, nM, nN, u.pm, u.pn); u.e = seg; u.koff = seg == 0 ? 0 : (seg == 1 ? 256 : 512); u.nt = seg == 2 ? 8 : 4; u.lo = 0; u.nv = 256; return true;
    }
};
struct SchedMoe {
    int nM, nN, G, c, nt, slot; const PG8_LAS unsigned* tab; int skipc, skipr;
    __device__ __forceinline__ bool next(int i, Unit& u) const {
        const int nwg = nM * nN;
        const int r = (c < skipc) ? i + skipr : i;
        const long L0 = (r < skipr) ? (long)r * (G - skipc) + (c - skipc) : (long)skipr * (G - skipc) + (long)(r - skipr) * G + c;
        if (L0 >= nwg) return false;
        const int L = (int)L0;
        tile_of(L, nM, nN, u.pm, u.pn);
        const unsigned w = (unsigned)__builtin_amdgcn_readfirstlane((int)tab[u.pm]);
        u.e = (int)(w & 0xffu); const int j = (int)((w >> 8) & 0xfffu); u.nv = (int)(w >> 20) + 1;
        u.lo = (slot * 8 + u.e) * 65536 + 256 * j; u.nt = nt; u.koff = 0; return true;
    }
};

typedef __bf16 bf16x2_cv __attribute__((ext_vector_type(2)));
__device__ __forceinline__ unsigned cvt_pk_bf16(float lo, float hi) { const f32x2 v = {lo, hi}; const bf16x2_cv b = __builtin_convertvector(v, bf16x2_cv); return __builtin_bit_cast(unsigned, b); }
__device__ __forceinline__ float bf_lo(unsigned w) { return __uint_as_float(w << 16); }
__device__ __forceinline__ float bf_hi(unsigned w) { return __uint_as_float(w & 0xffff0000u); }
__device__ __forceinline__ float sigmoidf_(float x) { return __builtin_amdgcn_rcpf(1.0f + __builtin_amdgcn_exp2f(-1.4426950408889634f * x)); }
__device__ __forceinline__ f32x4 rsig4_(const f32x4 x) { const f32x4 t = x * -1.4426950408889634f; f32x4 e; e[0] = __builtin_amdgcn_exp2f(t[0]); e[1] = __builtin_amdgcn_exp2f(t[1]); e[2] = __builtin_amdgcn_exp2f(t[2]); e[3] = __builtin_amdgcn_exp2f(t[3]);
    const f32x4 d = e + 1.0f; return (f32x4){__builtin_amdgcn_rcpf(d[0]), __builtin_amdgcn_rcpf(d[1]), __builtin_amdgcn_rcpf(d[2]), __builtin_amdgcn_rcpf(d[3])}; }

template <class Epi, class Sched, bool ALIGN_EPI, bool GATHER, bool F8 = false>
__device__ __forceinline__ void gemm_phase(PG8_LAS unsigned char* lds, const Gemm g_, const Sched& S, const Epi& E) {
    Gemm g = g_;
    {
        unsigned long long a_ = (unsigned long long)g_.A, b_ = (unsigned long long)g_.Bt, l_ = (unsigned long long)g_.list; asm volatile("" : "+s"(a_), "+s"(b_), "+s"(l_));
        g.A = (const bf16_t*)(const __attribute__((address_space(1))) bf16_t*)a_; g.Bt = (const bf16_t*)(const __attribute__((address_space(1))) bf16_t*)b_; g.list = (const unsigned*)(const __attribute__((address_space(1))) unsigned*)l_; }
    int tid_o = threadIdx.x; asm volatile("" : "+v"(tid_o));
    const int tid = tid_o, wid = __builtin_amdgcn_readfirstlane(tid >> 6), lane = tid & 63, wr = wid >> 2, wc = wid & 3, fr = lane & 15, fq = lane >> 4;
    const int K = g.K;
    unsigned voffA[2], voffB[2];
#pragma unroll
    for (int i = 0; i < 2; ++i) { int R, C; stage_rc(tid * 16 + i * 8192, R, C); const int Rb = Epi::PERM ? ((R & ~31) + perm32(R & 31)) : R;
        voffA[i] = (unsigned)(R * K + C) * 2u; voffB[i] = (unsigned)(Rb * K + C) * 2u; }
    const size_t kstep = (size_t)(BK * 2);
    const size_t hstep = (size_t)HALF * K * 2;
    const size_t tstep = 2 * hstep;
    const unsigned ldsw = (unsigned)wid * 1024u;
    const int aoff = lds_byte(wr * 64 + fr, fq * 8), boff = lds_byte(wc * 32 + fr, fq * 8);
#define PG8_SA(b, h) (((b) * 2 + (h)) * HTB)
#define PG8_SB(b, h) ((4 + (b) * 2 + (h)) * HTB)
#define PG8_GLDS(src, bufoff, i_) __builtin_amdgcn_global_load_lds((const unsigned*)(src), (PG8_LAS unsigned*)(lds + (bufoff) + ldsw + (i_) * 8192), 16, 0, 0)
#define PG8_STAGE_B(bufoff, gbase) do { _Pragma("unroll") for (int _i = 0; _i < 2; ++_i) PG8_GLDS((const char*)(gbase) + voffB[_i], bufoff, _i); } while (0)
#define PG8_STAGE_A(bufoff, ga, h, o0, o1) do { if constexpr (GATHER) { PG8_GLDS((const char*)(ga) + (o0), bufoff, 0); PG8_GLDS((const char*)(ga) + (o1), bufoff, 1); } \
        else { _Pragma("unroll") for (int _i = 0; _i < 2; ++_i) PG8_GLDS((const char*)(ga) + (h) * hstep + voffA[_i], bufoff, _i); } } while (0)
#define PG8_LDA(dst, b, h) do { _Pragma("unroll") for (int m = 0; m < 4; ++m) { if constexpr (F8) { dst##8[m].lo = *(const PG8_LAS i32x4*)(lds + PG8_SA(b, h) + aoff + m * 2048); dst##8[m].hi = *(const PG8_LAS i32x4*)(lds + PG8_SA(b, h) + aoff + m * 2048 + 1024); } \
        else { _Pragma("unroll") for (int k = 0; k < 2; ++k) dst[m][k] = *(const PG8_LAS bf16x8*)(lds + PG8_SA(b, h) + aoff + m * 2048 + k * 1024); } } } while (0)
#define PG8_LDB(dst, b, h) do { _Pragma("unroll") for (int n = 0; n < 2; ++n) { if constexpr (F8) { dst##8[n].lo = *(const PG8_LAS i32x4*)(lds + PG8_SB(b, h) + boff + n * 2048); dst##8[n].hi = *(const PG8_LAS i32x4*)(lds + PG8_SB(b, h) + boff + n * 2048 + 1024); } \
        else { _Pragma("unroll") for (int k = 0; k < 2; ++k) dst[n][k] = *(const PG8_LAS bf16x8*)(lds + PG8_SB(b, h) + boff + n * 2048 + k * 1024); } } } while (0)
#define PG8_CAT8(x0, x1) __builtin_shufflevector(__builtin_bit_cast(i32x4, x0), __builtin_bit_cast(i32x4, x1), 0, 1, 2, 3, 4, 5, 6, 7)
#define PG8_MMA(ai, bj, At, Bt) do { __builtin_amdgcn_s_setprio(1); _Pragma("unroll") for (int m = 0; m < 4; ++m) _Pragma("unroll") for (int n = 0; n < 2; ++n) { \
        if constexpr (F8) asm volatile("v_mfma_scale_f32_16x16x128_f8f6f4 %0, %1, %2, %0, %3, %4 op_sel_hi:[0,0,0]" : "+v"(acc[ai][bj][m][n]) : "v"(Bt##8[n]), "v"(At##8[m]), "v"(sc_w), "v"(sc_a));   \
        else { _Pragma("unroll") for (int k = 0; k < 2; ++k) acc[ai][bj][m][n] = __builtin_amdgcn_mfma_f32_16x16x32_bf16(Bt[n][k], At[m][k], acc[ai][bj][m][n], 0, 0, 0); } } __builtin_amdgcn_s_setprio(0); } while (0)
#define PG8_MMA0(ai, bj, At, Bt) do { __builtin_amdgcn_s_setprio(1); _Pragma("unroll") for (int m = 0; m < 4; ++m) _Pragma("unroll") for (int n = 0; n < 2; ++n) \
        asm volatile("v_mfma_scale_f32_16x16x128_f8f6f4 %0, %1, %2, 0, %3, %4 op_sel_hi:[0,0,0]" : "=v"(acc[ai][bj][m][n]) : "v"(Bt##8[n]), "v"(At##8[m]), "v"(sc_w), "v"(sc_a));   \
        __builtin_amdgcn_s_setprio(0); } while (0)
#define PG8_WAIT_V(n) asm volatile("s_waitcnt vmcnt(" #n ")" ::: "memory")
#define PG8_WAIT_L(n) asm volatile("s_waitcnt lgkmcnt(" #n ")" ::: "memory")
#define PG8_WAIT_V8F(f) do { if constexpr (Epi::NST == 32) asm volatile("s_cmp_eq_u32 %0, 0\n\ts_cbranch_scc1 .LWV%=A\n\ts_waitcnt vmcnt(40)\n\ts_branch .LWV%=B\n.LWV%=A:\n\ts_waitcnt vmcnt(8)\n.LWV%=B:" :: "s"(f) : "memory", "scc"); \
        else if constexpr (Epi::NST == 16) asm volatile("s_cmp_eq_u32 %0, 0\n\ts_cbranch_scc1 .LWV%=A\n\ts_waitcnt vmcnt(24)\n\ts_branch .LWV%=B\n.LWV%=A:\n\ts_waitcnt vmcnt(8)\n.LWV%=B:" :: "s"(f) : "memory", "scc"); \
        else asm volatile("s_waitcnt vmcnt(8)" ::: "memory"); } while (0)
#define PG8_BAR __builtin_amdgcn_s_barrier()
#define PG8_SCHED __builtin_amdgcn_sched_barrier(0)
    Unit cur, nxt; int ui = 0;
    if (!S.next(0, cur)) return;
    if (g.stagger > 0) { const unsigned long long t0_ = __builtin_amdgcn_s_memrealtime(); while (__builtin_amdgcn_s_memrealtime() - t0_ < (unsigned long long)g.stagger) __builtin_amdgcn_s_sleep(8); }
    f32x4 acc[2][2][4][2];
    if constexpr (!F8) {
#pragma unroll
    for (int a = 0; a < 2; ++a)
#pragma unroll
        for (int b = 0; b < 2; ++b)
#pragma unroll
            for (int m = 0; m < 4; ++m)
#pragma unroll
                for (int n = 0; n < 2; ++n) acc[a][b][m][n] = (f32x4){0.f, 0.f, 0.f, 0.f};
    }
    bf16x8 At[4][2], B0[2][2], B1[2][2];
    i32x8 At8[4], B08[2], B18[2];
    int sc_w = 122, sc_a = 127; asm volatile("" : "+v"(sc_w), "+v"(sc_a));
    unsigned gc00 = 0, gc01 = 0, gc10 = 0, gc11 = 0, gn00 = 0, gn01 = 0, gn10 = 0, gn11 = 0;
#define PG8_TOK(u, t00, t01, t10, t11) do { const unsigned* lp_ = g.list + (u).lo; const int nv_ = (u).nv; \
        int tid_ = threadIdx.x; asm volatile("" : "+v"(tid_)); int R0_, C0_, R1_, C1_; stage_rc(tid_ * 16, R0_, C0_); stage_rc(tid_ * 16 + 8192, R1_, C1_);     \
        t00 = R0_ < nv_ ? lp_[R0_] : 0u; t01 = R1_ < nv_ ? lp_[R1_] : 0u; t10 = (128 + R0_) < nv_ ? lp_[128 + R0_] : 0u; t11 = (128 + R1_) < nv_ ? lp_[128 + R1_] : 0u; } while (0)
#define PG8_OFFS(t00, t01, t10, t11, o00, o01, o10, o11) do { \
        int tid_ = threadIdx.x; asm volatile("" : "+v"(tid_)); int R0_, C0_, R1_, C1_; stage_rc(tid_ * 16, R0_, C0_); stage_rc(tid_ * 16 + 8192, R1_, C1_); \
        o00 = (t00) * (unsigned)(K * 2) + (unsigned)C0_ * 2u; o01 = (t01) * (unsigned)(K * 2) + (unsigned)C1_ * 2u; o10 = (t10) * (unsigned)(K * 2) + (unsigned)C0_ * 2u; o11 = (t11) * (unsigned)(K * 2) + (unsigned)C1_ * 2u; } while (0)
#define PG8_GATH(u, o00, o01, o10, o11) do { unsigned q00_, q01_, q10_, q11_; PG8_TOK(u, q00_, q01_, q10_, q11_); PG8_OFFS(q00_, q01_, q10_, q11_, o00, o01, o10, o11); } while (0)
    unsigned tk00 = 0, tk01 = 0, tk10 = 0, tk11 = 0;
    const char* cA = GATHER ? (const char*)g.A + (size_t)cur.koff * 2 : (const char*)g.A + (size_t)cur.pm * tstep + (size_t)cur.koff * 2;
    const char* cB = (const char*)g.Bt + (size_t)cur.e * g.bstride + (size_t)cur.pn * tstep + (size_t)cur.koff * 2;
    if constexpr (GATHER) { PG8_GATH(cur, gc00, gc01, gc10, gc11); Unit n1_; if (S.next(1, n1_)) PG8_TOK(n1_, tk00, tk01, tk10, tk11); }
    PG8_STAGE_B(PG8_SB(0, 0), cB); PG8_STAGE_B(PG8_SB(0, 1), cB + hstep); PG8_STAGE_A(PG8_SA(0, 0), cA, 0, gc00, gc01); PG8_STAGE_A(PG8_SA(0, 1), cA, 1, gc10, gc11);
    if (wr == 1) PG8_BAR;
    PG8_WAIT_V(2); PG8_BAR;
    PG8_STAGE_B(PG8_SB(1, 0), cB + kstep); PG8_STAGE_A(PG8_SA(1, 0), cA + kstep, 0, gc00, gc01); PG8_STAGE_B(PG8_SB(1, 1), cB + hstep + kstep);
    PG8_WAIT_V(6); PG8_BAR;
    for (;;) {
        const bool has_next = S.next(ui + 1, nxt);
        const char* nA = has_next ? (GATHER ? (const char*)g.A + (size_t)nxt.koff * 2 : (const char*)g.A + (size_t)nxt.pm * tstep + (size_t)nxt.koff * 2) : cA;
        const char* nB = has_next ? (const char*)g.Bt + (size_t)nxt.e * g.bstride + (size_t)nxt.pn * tstep + (size_t)nxt.koff * 2 : cB;
        if constexpr (GATHER) { if (has_next) PG8_OFFS(tk00, tk01, tk10, tk11, gn00, gn01, gn10, gn11); else { gn00 = gc00; gn01 = gc01; gn10 = gc10; gn11 = gc11; }
            Unit n2_; if (S.next(ui + 2, n2_)) PG8_TOK(n2_, tk00, tk01, tk10, tk11); }
        const int nt = cur.nt;
        for (int t = 0; t < nt; t += 2) {
            const bool last = (t == nt - 2);
            const char* a1 = cA + (size_t)(t + 1) * kstep;
            const char* a2 = last ? nA : cA + (size_t)(t + 2) * kstep; const char* b2 = last ? nB : cB + (size_t)(t + 2) * kstep;
            const char* a3 = a2 + kstep; const char* b3 = b2 + kstep;
            const unsigned s00 = last ? gn00 : gc00, s01 = last ? gn01 : gc01, s10 = last ? gn10 : gc10, s11 = last ? gn11 : gc11;
            const int fresh = __builtin_amdgcn_readfirstlane(((Epi::NST > 0) && (ui > 0) && (t == 0)) ? 1 : 0);
            PG8_LDB(B0, 0, 0); PG8_LDB(B1, 0, 1); PG8_SCHED; PG8_LDA(At, 0, 0); PG8_STAGE_A(PG8_SA(1, 1), a1, 1, gc10, gc11);
            PG8_WAIT_V8F(fresh);
            PG8_WAIT_L(0); PG8_BAR; if (F8 && t == 0) { PG8_MMA0(0, 0, At, B0); PG8_MMA0(0, 1, At, B1); } else { PG8_MMA(0, 0, At, B0); PG8_MMA(0, 1, At, B1); } PG8_BAR; PG8_SCHED;
            PG8_LDA(At, 0, 1); PG8_STAGE_B(PG8_SB(0, 0), b2); PG8_STAGE_B(PG8_SB(0, 1), b2 + hstep); PG8_STAGE_A(PG8_SA(0, 0), a2, 0, s00, s01);
            PG8_WAIT_V8F(fresh);
            PG8_WAIT_L(0); PG8_BAR; if (F8 && t == 0) { PG8_MMA0(1, 0, At, B0); PG8_MMA0(1, 1, At, B1); } else { PG8_MMA(1, 0, At, B0); PG8_MMA(1, 1, At, B1); } PG8_BAR; PG8_SCHED;
            PG8_LDB(B0, 1, 0); PG8_LDB(B1, 1, 1); PG8_SCHED; PG8_LDA(At, 1, 0); PG8_STAGE_A(PG8_SA(0, 1), a2, 1, s10, s11);
            PG8_WAIT_V(8); PG8_WAIT_L(0); PG8_BAR; PG8_MMA(0, 0, At, B0); PG8_MMA(0, 1, At, B1); PG8_BAR; PG8_SCHED;
            PG8_LDA(At, 1, 1); PG8_STAGE_B(PG8_SB(1, 0), b3); PG8_STAGE_B(PG8_SB(1, 1), b3 + hstep); PG8_STAGE_A(PG8_SA(1, 0), a3, 0, s00, s01);
            PG8_WAIT_V(8); PG8_WAIT_L(0); PG8_BAR; PG8_MMA(1, 0, At, B0); PG8_MMA(1, 1, At, B1); PG8_BAR; PG8_SCHED;
        }
        if constexpr (ALIGN_EPI) { if (wr == 0) PG8_BAR; }
        if constexpr (F8) asm volatile("s_nop 15\n\ts_nop 7" ::: "memory");
        { int te_ = threadIdx.x; asm volatile("" : "+v"(te_));
          const int we_ = __builtin_amdgcn_readfirstlane(te_ >> 6), le_ = te_ & 63; E(acc, cur, we_ >> 2, we_ & 3, le_ & 15, le_ >> 4); }
        if (!has_next) break;
        bool zero_acc = true; if constexpr (Epi::KEEPS) zero_acc = !E.keep(cur);
        if (!F8 && zero_acc) {
#pragma unroll
        for (int a = 0; a < 2; ++a)
#pragma unroll
            for (int b = 0; b < 2; ++b)
#pragma unroll
                for (int m = 0; m < 4; ++m)
#pragma unroll
                    for (int n = 0; n < 2; ++n) acc[a][b][m][n] = (f32x4){0.f, 0.f, 0.f, 0.f};
        }
        cur = nxt; cA = nA; cB = nB; ++ui;
        if constexpr (GATHER) { gc00 = gn00; gc01 = gn01; gc10 = gn10; gc11 = gn11; }
        if constexpr (ALIGN_EPI) { if (wr == 1) PG8_BAR; }
    }
    PG8_WAIT_V(0);
    if constexpr (!ALIGN_EPI) { if (wr == 0) PG8_BAR; }
    PG8_BAR;
#undef PG8_SA
#undef PG8_SB
#undef PG8_GLDS
#undef PG8_STAGE_A
#undef PG8_STAGE_B
#undef PG8_LDA
#undef PG8_LDB
#undef PG8_MMA
#undef PG8_MMA0
#undef PG8_CAT8
#undef PG8_WAIT_V
#undef PG8_WAIT_L
#undef PG8_WAIT_V8F
#undef PG8_BAR
#undef PG8_SCHED
#undef PG8_GATH
#undef PG8_TOK
#undef PG8_OFFS
}

__device__ __forceinline__ u32x4 pack8(const f32x4 a, const f32x4 b) { u32x4 w; w.x = cvt_pk_bf16(a[0], a[1]); w.y = cvt_pk_bf16(a[2], a[3]); w.z = cvt_pk_bf16(b[0], b[1]); w.w = cvt_pk_bf16(b[2], b[3]); return w; }
__device__ __forceinline__ u32x2 pack4(const f32x4 a) { u32x2 w; w.x = cvt_pk_bf16(a[0], a[1]); w.y = cvt_pk_bf16(a[2], a[3]); return w; }

__device__ __forceinline__ size_t gfrag(int pm, int pg, int wid, int k, int lane) { return ((((size_t)(pm * 12 + pg) * 8 + wid) * 16 + k) * 64 + lane) * 8; }
__device__ __forceinline__ size_t gfrag8(int pm, int pg, int wid, int k, int lane) { return ((((size_t)(pm * 12 + pg) * 8 + wid) * 8 + k) * 64 + lane) * 16; }
constexpr float ATT_C2 = 0.125f * 1.4426950408889634f;
constexpr float NORM_EPS = 1e-6f;

struct EpiInProj {
    static constexpr bool PERM = true; static constexpr int NST = 0; static constexpr bool KEEPS = false;
    bf16_t *P, *Z, *Q, *Kb, *Vb; const PG8_LAS float *qg, *kg;
    __device__ __forceinline__ void operator()(const f32x4 (&acc)[2][2][4][2], const Unit& u, int wr, int wc, int fr, int fq) const {
        const int row0 = u.pm * BM + wr * 64 + fr; const int pn = u.pn;
        if (pn == 0) {
#pragma unroll
            for (int ai = 0; ai < 2; ++ai)
#pragma unroll
                for (int m = 0; m < 4; ++m) { bf16_t* rowp = P + (size_t)(row0 + ai * HALF + m * 16) * 256 + wc * 32 + 8 * fq;
#pragma unroll
                    for (int bj = 0; bj < 2; ++bj) *(u32x4*)(rowp + bj * HALF) = pack8(acc[ai][bj][m][0], acc[ai][bj][m][1]); asm volatile("" ::: "memory"); }
        } else if (pn <= 2) {
            const int t = pn - 1;
#pragma unroll
            for (int ai = 0; ai < 2; ++ai)
#pragma unroll
                for (int m = 0; m < 4; ++m) { bf16_t* rowp = Z + (size_t)(row0 + ai * HALF + m * 16) * 256 + t * 128 + 16 * wc + 4 * fq;
#pragma unroll
                    for (int bj = 0; bj < 2; ++bj) { const f32x4 a = acc[ai][bj][m][0], gt = acc[ai][bj][m][1]; f32x4 z;
                        z = a * rsig4_(gt);
                        *(u32x2*)(rowp + 64 * bj) = pack4(z); } asm volatile("" ::: "memory"); }
        } else if (pn <= 6) {
            const bool isq = pn <= 4; const int t = isq ? pn - 3 : pn - 5; const PG8_LAS float* gs = isq ? qg : kg;
            f32x4 gv[2][2];
#pragma unroll
            for (int bj = 0; bj < 2; ++bj)
#pragma unroll
                for (int n = 0; n < 2; ++n) gv[bj][n] = *(const PG8_LAS f32x4*)(gs + 32 * bj + 8 * fq + 4 * n);
            const float sc = isq ? ATT_C2 : 1.0f; const int head = 4 * t + wc;
#pragma unroll
            for (int ai = 0; ai < 2; ++ai)
#pragma unroll
                for (int m = 0; m < 4; ++m) { float ss = 0.f;
#pragma unroll
                    for (int bj = 0; bj < 2; ++bj)
#pragma unroll
                        for (int n = 0; n < 2; ++n) { const f32x4 x = acc[ai][bj][m][n]; ss += (x[0] * x[0] + x[1] * x[1]) + (x[2] * x[2] + x[3] * x[3]); }
                    { const int ln = 16 * fq + fr; ss += __int_as_float(__builtin_amdgcn_ds_bpermute((ln ^ 16) << 2, __float_as_int(ss))); ss += __int_as_float(__builtin_amdgcn_ds_bpermute((ln ^ 32) << 2, __float_as_int(ss))); }
                    const float rs = __builtin_amdgcn_rsqf(ss * (1.0f / 64.0f) + NORM_EPS) * sc;
                    const size_t r = (size_t)(row0 + ai * HALF + m * 16);
                    bf16_t* rowp = isq ? Q + r * 1024 + 64 * head + 8 * fq : Kb + r * 512 + 64 * head + 8 * fq;
#pragma unroll
                    for (int bj = 0; bj < 2; ++bj) *(u32x4*)(rowp + 32 * bj) = pack8(acc[ai][bj][m][0] * rs * gv[bj][0], acc[ai][bj][m][1] * rs * gv[bj][1]); asm volatile("" ::: "memory"); }
        } else {
            const int t = pn - 7;
#pragma unroll
            for (int ai = 0; ai < 2; ++ai)
#pragma unroll
                for (int m = 0; m < 4; ++m) { bf16_t* rowp = Vb + (size_t)(row0 + ai * HALF + m * 16) * 512 + 256 * t + wc * 32 + 8 * fq;
#pragma unroll
                    for (int bj = 0; bj < 2; ++bj) *(u32x4*)(rowp + bj * HALF) = pack8(acc[ai][bj][m][0], acc[ai][bj][m][1]); asm volatile("" ::: "memory"); }

        }
    }
};

constexpr float GATE_EMAX = 448.0f;
struct EpiGate {
    static constexpr bool PERM = true; static constexpr int NST = 0; static constexpr bool KEEPS = false;
    unsigned char* G8; const PG8_LAS float* bgate;
    __device__ __forceinline__ void operator()(const f32x4 (&acc)[2][2][4][2], const Unit& u, int wr, int wc, int fr, int fq) const {
        const int c0 = 256 * u.pn + wc * 32 + 8 * fq;
        f32x4 bv[2][2];
#pragma unroll
        for (int bj = 0; bj < 2; ++bj)
#pragma unroll
            for (int n = 0; n < 2; ++n) bv[bj][n] = *(const PG8_LAS f32x4*)(bgate + c0 + bj * HALF + 4 * n);
#pragma unroll
        for (int ai = 0; ai < 2; ++ai)
#pragma unroll
            for (int m = 0; m < 4; ++m) { int w[4];
#pragma unroll
                for (int bj = 0; bj < 2; ++bj) { f32x4 v0 = acc[ai][bj][m][0] + bv[bj][0], v1 = acc[ai][bj][m][1] + bv[bj][1];
#pragma unroll
                    for (int i = 0; i < 4; ++i) { v0[i] = fminf(__builtin_amdgcn_exp2f(-v0[i]), GATE_EMAX); v1[i] = fminf(__builtin_amdgcn_exp2f(-v1[i]), GATE_EMAX); }
                    int lo = 0, hi = 0;
                    lo = __builtin_amdgcn_cvt_pk_fp8_f32(v0[0], v0[1], lo, false); lo = __builtin_amdgcn_cvt_pk_fp8_f32(v0[2], v0[3], lo, true);
                    hi = __builtin_amdgcn_cvt_pk_fp8_f32(v1[0], v1[1], hi, false); hi = __builtin_amdgcn_cvt_pk_fp8_f32(v1[2], v1[3], hi, true);
                    w[2 * bj] = lo; w[2 * bj + 1] = hi; }
                *(u32x4*)(G8 + gfrag8(u.pm, u.pn, wr * 4 + wc, ai * 4 + m, fq * 16 + fr)) = (u32x4){(unsigned)w[0], (unsigned)w[1], (unsigned)w[2], (unsigned)w[3]}; asm volatile("" ::: "memory"); }
    }
};
struct EpiInProjNS {
    static constexpr bool PERM = true; static constexpr int NST = 0; static constexpr bool KEEPS = false;
    bf16_t *P, *Z, *Q, *Kb, *Vb, *G; const float *qg, *kg, *bgate;
    __device__ __forceinline__ void operator()(const f32x4 (&acc)[2][2][4][2], const Unit& u, int wr, int wc, int fr, int fq) const {
        const int row0 = u.pm * BM + wr * 64 + fr; const int pn = u.pn;
        if (pn == 0) {
#pragma unroll
            for (int ai = 0; ai < 2; ++ai)
#pragma unroll
                for (int m = 0; m < 4; ++m) { bf16_t* rowp = P + (size_t)(row0 + ai * HALF + m * 16) * 256 + wc * 32 + 8 * fq;
#pragma unroll
                    for (int bj = 0; bj < 2; ++bj) { const u32x4 t_ = pack8(acc[ai][bj][m][0], acc[ai][bj][m][1]); asm volatile("" :: "v"(t_)); } asm volatile("" ::: "memory"); }
        } else if (pn <= 2) {
            const int t = pn - 1;
#pragma unroll
            for (int ai = 0; ai < 2; ++ai)
#pragma unroll
                for (int m = 0; m < 4; ++m) { bf16_t* rowp = Z + (size_t)(row0 + ai * HALF + m * 16) * 256 + t * 128 + 16 * wc + 4 * fq;
#pragma unroll
                    for (int bj = 0; bj < 2; ++bj) { const f32x4 a = acc[ai][bj][m][0], gt = acc[ai][bj][m][1]; f32x4 z;
#pragma unroll
                        for (int i = 0; i < 4; ++i) z[i] = a[i] * sigmoidf_(gt[i]);
                        { const u32x2 t_ = pack4(z); asm volatile("" :: "v"(t_)); } } asm volatile("" ::: "memory"); }
        } else if (pn <= 6) {
            const bool isq = pn <= 4; const int t = isq ? pn - 3 : pn - 5; const float* gs = isq ? qg : kg;
            f32x4 gv[2][2];
#pragma unroll
            for (int bj = 0; bj < 2; ++bj)
#pragma unroll
                for (int n = 0; n < 2; ++n) gv[bj][n] = *(const f32x4*)(gs + 32 * bj + 8 * fq + 4 * n);
            const float sc = isq ? ATT_C2 : 1.0f; const int head = 4 * t + wc;
#pragma unroll
            for (int ai = 0; ai < 2; ++ai)
#pragma unroll
                for (int m = 0; m < 4; ++m) { float ss = 0.f;
#pragma unroll
                    for (int bj = 0; bj < 2; ++bj)
#pragma unroll
                        for (int n = 0; n < 2; ++n) { const f32x4 x = acc[ai][bj][m][n]; ss += (x[0] * x[0] + x[1] * x[1]) + (x[2] * x[2] + x[3] * x[3]); }
                    { const int ln = 16 * fq + fr; ss += __int_as_float(__builtin_amdgcn_ds_bpermute((ln ^ 16) << 2, __float_as_int(ss))); ss += __int_as_float(__builtin_amdgcn_ds_bpermute((ln ^ 32) << 2, __float_as_int(ss))); }
                    const float rs = __builtin_amdgcn_rsqf(ss * (1.0f / 64.0f) + NORM_EPS) * sc;
                    const size_t r = (size_t)(row0 + ai * HALF + m * 16);
                    bf16_t* rowp = isq ? Q + r * 1024 + 64 * head + 8 * fq : Kb + r * 512 + 64 * head + 8 * fq;
#pragma unroll
                    for (int bj = 0; bj < 2; ++bj) { const u32x4 t_ = pack8(acc[ai][bj][m][0] * rs * gv[bj][0], acc[ai][bj][m][1] * rs * gv[bj][1]); asm volatile("" :: "v"(t_)); } asm volatile("" ::: "memory"); }
        } else if (pn <= 8) {
            const int t = pn - 7;
#pragma unroll
            for (int ai = 0; ai < 2; ++ai)
#pragma unroll
                for (int m = 0; m < 4; ++m) { bf16_t* rowp = Vb + (size_t)(row0 + ai * HALF + m * 16) * 512 + 256 * t + wc * 32 + 8 * fq;
#pragma unroll
                    for (int bj = 0; bj < 2; ++bj) { const u32x4 t_ = pack8(acc[ai][bj][m][0], acc[ai][bj][m][1]); asm volatile("" :: "v"(t_)); } asm volatile("" ::: "memory"); }
        } else {
            const int c0 = 256 * (pn - 9) + wc * 32 + 8 * fq;
            f32x4 bv[2][2];
#pragma unroll
            for (int bj = 0; bj < 2; ++bj)
#pragma unroll
                for (int n = 0; n < 2; ++n) bv[bj][n] = *(const f32x4*)(bgate + c0 + bj * HALF + 4 * n);
#pragma unroll
            for (int ai = 0; ai < 2; ++ai)
#pragma unroll
                for (int m = 0; m < 4; ++m) { bf16_t* rowp = G + (size_t)(row0 + ai * HALF + m * 16) * 3072 + c0;
#pragma unroll
                    for (int bj = 0; bj < 2; ++bj) { f32x4 v0 = acc[ai][bj][m][0] + bv[bj][0], v1 = acc[ai][bj][m][1] + bv[bj][1];
#pragma unroll
                        for (int i = 0; i < 4; ++i) { v0[i] = sigmoidf_(v0[i]); v1[i] = sigmoidf_(v1[i]); }
                        { const u32x4 t_ = pack8(v0, v1); asm volatile("" :: "v"(t_)); } } asm volatile("" ::: "memory"); }
        }
    }
};

template <int LINEAR> struct EpiStoreProbe {
    static constexpr bool PERM = true; static constexpr int NST = 0; static constexpr bool KEEPS = false;
    bf16_t* S;
    __device__ __forceinline__ void operator()(const f32x4 (&acc)[2][2][4][2], const Unit& u, int wr, int wc, int fr, int fq) const {
        const int row0 = wr * 64 + fr; const size_t tbase = ((size_t)(blockIdx.x) * 256) * 256;
        const int wid = wr * 4 + wc, lane = fq * 16 + fr;
#pragma unroll
        for (int ai = 0; ai < 2; ++ai)
#pragma unroll
            for (int m = 0; m < 4; ++m)
#pragma unroll
                for (int bj = 0; bj < 2; ++bj) {
                    bf16_t* p = LINEAR ? S + tbase + (size_t)(((ai * 4 + m) * 2 + bj) * 8 + wid) * 512 + lane * 8
                                       : S + tbase + (size_t)(row0 + ai * HALF + m * 16) * 256 + bj * HALF + wc * 32 + 8 * fq;
                    *(u32x4*)p = pack8(acc[ai][bj][m][0], acc[ai][bj][m][1]); }
    }
};
struct EpiNull {
    static constexpr bool PERM = true; static constexpr int NST = 0; static constexpr bool KEEPS = false;
    __device__ __forceinline__ void operator()(const f32x4 (&acc)[2][2][4][2], const Unit& u, int wr, int wc, int fr, int fq) const {
#pragma unroll
        for (int a = 0; a < 2; ++a)
#pragma unroll
            for (int b = 0; b < 2; ++b)
#pragma unroll
                for (int m = 0; m < 4; ++m)
#pragma unroll
                    for (int n = 0; n < 2; ++n) asm volatile("" :: "v"(acc[a][b][m][n])); }
};
struct EpiMerge {
    static constexpr bool PERM = true; static constexpr int NST = 0; static constexpr bool KEEPS = true;
    const unsigned char* G8; bf16_t* MG;
    __device__ __forceinline__ bool keep(const Unit& u) const { return u.e != 2; }
    __device__ __forceinline__ void operator()(f32x4 (&acc)[2][2][4][2], const Unit& u, int wr, int wc, int fr, int fq) const {
        const int row0 = u.pm * BM + wr * 64 + fr, col0 = u.pn * BM + wc * 32 + 8 * fq; const int seg = u.e;
        const int wid = wr * 4 + wc, ln = fq * 16 + fr;
        const unsigned char* Ga = G8 + gfrag8(u.pm, seg * 4 + u.pn, wid, 0, ln);
        const unsigned char* Gb = G8 + gfrag8(u.pm, (seg != 2 ? seg + 1 : seg) * 4 + u.pn, wid, 0, ln);
        u32x4 ga[2][4], gb[2][4];
#pragma unroll
        for (int ai = 0; ai < 2; ++ai)
#pragma unroll
            for (int m = 0; m < 4; ++m) { const int k = ai * 4 + m; ga[ai][m] = *(const u32x4*)(Ga + 1024 * k); if (seg != 2) gb[ai][m] = *(const u32x4*)(Gb + 1024 * k); else gb[ai][m] = (u32x4){0u, 0u, 0u, 0u}; }
        asm volatile("" ::: "memory");
#define EM_UNPACK8(wx, wy, lo4, hi4) f32x4 lo4, hi4; { const f32x2 p0_ = __builtin_amdgcn_cvt_pk_f32_fp8((int)(wx), false), p1_ = __builtin_amdgcn_cvt_pk_f32_fp8((int)(wx), true), p2_ = __builtin_amdgcn_cvt_pk_f32_fp8((int)(wy), false), p3_ = __builtin_amdgcn_cvt_pk_f32_fp8((int)(wy), true); \
            lo4 = (f32x4){p0_[0], p0_[1], p1_[0], p1_[1]}; hi4 = (f32x4){p2_[0], p2_[1], p3_[0], p3_[1]}; }
#pragma unroll
        for (int ai = 0; ai < 2; ++ai)
#pragma unroll
            for (int m = 0; m < 4; ++m) { bf16_t* mp = MG + (size_t)(row0 + ai * HALF + m * 16) * 1024 + col0;
#pragma unroll
                for (int bj = 0; bj < 2; ++bj) { const u32x4 a4 = ga[ai][m], b4 = gb[ai][m];
                    EM_UNPACK8(bj ? a4.z : a4.x, bj ? a4.w : a4.y, na0, na1); EM_UNPACK8(bj ? b4.z : b4.x, bj ? b4.w : b4.y, nb0, nb1);
                    { const f32x4 da0 = na0 + 1.0f, da1 = na1 + 1.0f;
                      const f32x4 ra0 = (f32x4){__builtin_amdgcn_rcpf(da0[0]), __builtin_amdgcn_rcpf(da0[1]), __builtin_amdgcn_rcpf(da0[2]), __builtin_amdgcn_rcpf(da0[3])}, ra1 = (f32x4){__builtin_amdgcn_rcpf(da1[0]), __builtin_amdgcn_rcpf(da1[1]), __builtin_amdgcn_rcpf(da1[2]), __builtin_amdgcn_rcpf(da1[3])};
                      acc[ai][bj][m][0] *= (nb0 + 1.0f) * ra0; acc[ai][bj][m][1] *= (nb1 + 1.0f) * ra1; }
                    if (seg == 2) *(u32x4*)(mp + bj * HALF) = pack8(acc[ai][bj][m][0], acc[ai][bj][m][1]); }
                asm volatile("" ::: "memory"); }
#undef EM_UNPACK8
    }
};

template <bool SRC_F32> struct EpiResid {
    static constexpr bool PERM = true; static constexpr int NST = 0; static constexpr bool KEEPS = false;
    const void* src; bf16_t* out;
    __device__ __forceinline__ void operator()(const f32x4 (&acc)[2][2][4][2], const Unit& u, int wr, int wc, int fr, int fq) const {
        const int row0 = u.pm * BM + wr * 64 + fr, col0 = u.pn * BM + wc * 32 + 8 * fq;
        if constexpr (SRC_F32) {
#pragma unroll
        for (int ai = 0; ai < 2; ++ai) {
            f32x4 b[4][2][2];
#pragma unroll
            for (int m = 0; m < 4; ++m) { const size_t off = (size_t)(row0 + ai * HALF + m * 16) * 1024 + col0;
#pragma unroll
                for (int bj = 0; bj < 2; ++bj) { b[m][bj][0] = *(const f32x4*)((const float*)src + off + bj * HALF); b[m][bj][1] = *(const f32x4*)((const float*)src + off + bj * HALF + 4); } }
#pragma unroll
            for (int m = 0; m < 4; ++m) { const size_t off = (size_t)(row0 + ai * HALF + m * 16) * 1024 + col0;
#pragma unroll
                for (int bj = 0; bj < 2; ++bj) *(u32x4*)(out + off + bj * HALF) = pack8(b[m][bj][0] + acc[ai][bj][m][0], b[m][bj][1] + acc[ai][bj][m][1]); }
            asm volatile("" ::: "memory");
        }
        } else {
            u32x4 b[2][4][2];
#pragma unroll
            for (int ai = 0; ai < 2; ++ai)
#pragma unroll
                for (int m = 0; m < 4; ++m) { const size_t off = (size_t)(row0 + ai * HALF + m * 16) * 1024 + col0;
#pragma unroll
                    for (int bj = 0; bj < 2; ++bj) b[ai][m][bj] = *(const u32x4*)((const bf16_t*)src + off + bj * HALF); }
            asm volatile("" ::: "memory");
#pragma unroll
            for (int ai = 0; ai < 2; ++ai) {
#pragma unroll
                for (int m = 0; m < 4; ++m) { const size_t off = (size_t)(row0 + ai * HALF + m * 16) * 1024 + col0;
#pragma unroll
                    for (int bj = 0; bj < 2; ++bj) { const u32x4 w = b[ai][m][bj];
                        const f32x4 lo = (f32x4){bf_lo(w.x), bf_hi(w.x), bf_lo(w.y), bf_hi(w.y)}, hi = (f32x4){bf_lo(w.z), bf_hi(w.z), bf_lo(w.w), bf_hi(w.w)};
                        *(u32x4*)(out + off + bj * HALF) = pack8(lo + acc[ai][bj][m][0], hi + acc[ai][bj][m][1]); } }
                asm volatile("" ::: "memory"); }
        }
    }
};

struct EpiSwiGLU {
    static constexpr bool PERM = true; static constexpr int NST = 0; static constexpr bool KEEPS = false;
    bf16_t* H; int ldh;
    __device__ __forceinline__ void operator()(const f32x4 (&acc)[2][2][4][2], const Unit& u, int wr, int wc, int fr, int fq) const {
        const int row0 = u.pm * BM + wr * 64 + fr, ch0 = u.pn * 128 + 32 * wc + 8 * fq;
#pragma unroll
        for (int ai = 0; ai < 2; ++ai)
#pragma unroll
            for (int m = 0; m < 4; ++m) { f32x4 z[2];
#pragma unroll
                for (int n = 0; n < 2; ++n) { const f32x4 a = acc[ai][0][m][n], b = acc[ai][1][m][n];
                    z[n] = (a * b) * rsig4_(a); }
                *(u32x4*)(H + (size_t)(row0 + ai * HALF + m * 16) * ldh + ch0) = pack8(z[0], z[1]); asm volatile("" ::: "memory"); }
    }
};

struct EpiSwiGLU8 {
    static constexpr bool PERM = true; static constexpr int NST = 0; static constexpr bool KEEPS = false;
    unsigned char* H8; int ldh;
    __device__ __forceinline__ void operator()(const f32x4 (&acc)[2][2][4][2], const Unit& u, int wr, int wc, int fr, int fq) const {
        const int row0 = u.pm * BM + wr * 64 + fr, ch0 = u.pn * 128 + 32 * wc + 8 * fq;
#pragma unroll
        for (int ai = 0; ai < 2; ++ai)
#pragma unroll
            for (int m = 0; m < 4; ++m) { int w[2];
#pragma unroll
                for (int n = 0; n < 2; ++n) { const f32x4 a = acc[ai][0][m][n], b = acc[ai][1][m][n]; f32x4 z;
                    z = (a * b) * rsig4_(a);
                    int t = 0; t = __builtin_amdgcn_cvt_pk_fp8_f32(z[0], z[1], t, false); t = __builtin_amdgcn_cvt_pk_fp8_f32(z[2], z[3], t, true); w[n] = t; }
                *(u32x2*)(H8 + (size_t)(row0 + ai * HALF + m * 16) * ldh + ch0) = (u32x2){(unsigned)w[0], (unsigned)w[1]}; asm volatile("" ::: "memory"); }
    }
};

template <bool DST_F32> struct EpiMoeDown {
    static constexpr bool PERM = true; static constexpr int NST = 0; static constexpr bool KEEPS = false;
    const bf16_t* xb; void* out; const unsigned* list; const float* wgt; int ntfull;
    __device__ __forceinline__ void operator()(const f32x4 (&acc)[2][2][4][2], const Unit& u, int wr, int wc, int fr, int fq) const {
        const int col0 = u.pn * BM + wc * 32 + 8 * fq; const unsigned* lp = list + u.lo; const int nv = u.nv;
        unsigned tok[2][4]; float w[2][4];
#pragma unroll
        for (int ai = 0; ai < 2; ++ai)
#pragma unroll
            for (int m = 0; m < 4; ++m) { const int rl = ai * HALF + wr * 64 + m * 16 + fr; tok[ai][m] = rl < nv ? lp[rl] : 0u; }
#pragma unroll
        for (int ai = 0; ai < 2; ++ai)
#pragma unroll
            for (int m = 0; m < 4; ++m) w[ai][m] = wgt[tok[ai][m]];
        u32x4 b[4][2];
#pragma unroll
        for (int m = 0; m < 4; ++m) { const bf16_t* xp = xb + (size_t)tok[0][m] * 1024 + col0;
#pragma unroll
            for (int bj = 0; bj < 2; ++bj) b[m][bj] = *(const u32x4*)(xp + bj * HALF); }
        asm volatile("" ::: "memory");
#pragma unroll
        for (int ai = 0; ai < 2; ++ai) {
#pragma unroll
            for (int m = 0; m < 4; ++m) { const int rl = ai * HALF + wr * 64 + m * 16 + fr; const size_t off = (size_t)tok[ai][m] * 1024 + col0;
                const u32x4 q0 = b[m][0], q1 = b[m][1];
                if (ai == 0) { const bf16_t* xp = xb + (size_t)tok[1][m] * 1024 + col0; b[m][0] = *(const u32x4*)xp; b[m][1] = *(const u32x4*)(xp + HALF); }
                if (rl < nv) {
#pragma unroll
                    for (int bj = 0; bj < 2; ++bj) { const u32x4 q = bj ? q1 : q0;
                        const f32x4 v0 = (f32x4){bf_lo(q.x), bf_hi(q.x), bf_lo(q.y), bf_hi(q.y)} + acc[ai][bj][m][0] * w[ai][m], v1 = (f32x4){bf_lo(q.z), bf_hi(q.z), bf_lo(q.w), bf_hi(q.w)} + acc[ai][bj][m][1] * w[ai][m];
                        if constexpr (DST_F32) { *(f32x4*)((float*)out + off + bj * HALF) = v0; *(f32x4*)((float*)out + off + bj * HALF + 4) = v1; }
                        else *(u32x4*)((bf16_t*)out + off + bj * HALF) = pack8(v0, v1); } }
                asm volatile("" ::: "memory"); }
        }
    }
};
}
#include <hip/hip_bf16.h>
#include <cmath>
namespace attn_body {
using bf16=__hip_bfloat16;
using bf16x8=__attribute__((ext_vector_type(8)))short;
using s16x4=__attribute__((ext_vector_type(4)))short;
using f32x16=__attribute__((ext_vector_type(16)))float;
using u32x4=__attribute__((ext_vector_type(4)))unsigned;
constexpr int BATCH=8,NHEAD=8,SEQ=8192,D=64,KVP=NHEAD*D,QP=1024;
constexpr int NW=8,QBLK=32,QB=QBLK*NW,KVBLK=64,NQB=SEQ/QB;
constexpr int ATTN_UNIT_ROWS=QB;
__device__ __forceinline__ int crow(int r,int hi){return (r&3)+8*(r>>2)+4*hi;}
#define SBAR() __builtin_amdgcn_sched_barrier(0)
__device__ __forceinline__ void cmask(f32x16&p0,f32x16&p1,int jb,int qrel,int hi){
  const float NEG=-INFINITY; int kb=64*jb+4*hi;
  #pragma unroll
  for(int r=0;r<16;++r){int kv=kb+(r&3)+8*(r>>2); if(kv>qrel)p0[r]=NEG; if(kv+32>qrel)p1[r]=NEG;}
}

constexpr int NSLOT=3, SLOTB=8192;
constexpr int LDS_K=0, LDS_V=NSLOT*SLOTB, LDS_WS=2*NSLOT*SLOTB, LDS_OST=LDS_WS+NW*64*4, LDS_CT=LDS_OST+NW*4096, LDS_BYTES=LDS_CT+SEQ*4;
constexpr float C2=0.125f*1.4426950408889634f;
__device__ __forceinline__ void glds16(const void*gsrc,unsigned lds_dst){unsigned keep;
  asm volatile("s_mov_b32 %0, m0\n\ts_mov_b32 m0, %2\n\ts_nop 0\n\tglobal_load_lds_dwordx4 %1, off\n\ts_mov_b32 m0, %0":"=&s"(keep):"v"(gsrc),"s"(lds_dst):"memory");}
__device__ __forceinline__ float max3f(float a,float b,float c){float r;asm("v_max3_f32 %0, %1, %2, %3":"=v"(r):"v"(a),"v"(b),"v"(c));return r;}
__device__ __forceinline__ float max2f(float a,float b){float r;asm("v_max_f32_e32 %0, %1, %2":"=v"(r):"v"(a),"v"(b));return r;}
__device__ __forceinline__ float fadd_s(float a,float b){float r;asm("v_add_f32_e32 %0, %1, %2":"=v"(r):"v"(a),"v"(b));return r;}
__device__ __forceinline__ float fsub_s(float a,float b){float r;asm("v_sub_f32_e32 %0, %1, %2":"=v"(r):"v"(a),"v"(b));return r;}
typedef float f32x2_t __attribute__((ext_vector_type(2))); typedef __bf16 bf16x2_t __attribute__((ext_vector_type(2)));
__device__ __forceinline__ unsigned cvtpk_s(float lo,float hi){f32x2_t v={lo,hi};bf16x2_t b=__builtin_convertvector(v,bf16x2_t);return __builtin_bit_cast(unsigned,b);}
#define WAIT_BAR(N) asm volatile("s_waitcnt vmcnt(" #N ") lgkmcnt(0)\n\ts_barrier":::"memory")

__device__ __forceinline__ void qkt(f32x16&p0,f32x16&p1,const char*Kslot,const bf16x8*qr,int r32,int hi){
  const char*kb=Kslot+hi*1024+r32*16;
  #pragma unroll
  for(int d0=0;d0<4;++d0){
    const bf16x8 b0=*reinterpret_cast<const bf16x8*>(kb+d0*2048);
    const bf16x8 b1=*reinterpret_cast<const bf16x8*>(kb+d0*2048+512);
    {p0=__builtin_amdgcn_mfma_f32_32x32x16_bf16(b0,qr[d0],p0,0,0,0);p1=__builtin_amdgcn_mfma_f32_32x32x16_bf16(b1,qr[d0],p1,0,0,0);}}
}
typedef __attribute__((address_space(3))) const char* lds_cptr;
typedef short v4i16_t __attribute__((ext_vector_type(4)));
__device__ __forceinline__ void kload8(bf16x8*kf,lds_cptr kp){
  kf[0]=*(const __attribute__((address_space(3))) bf16x8*)(kp);      kf[1]=*(const __attribute__((address_space(3))) bf16x8*)(kp+512);
  kf[2]=*(const __attribute__((address_space(3))) bf16x8*)(kp+2048); kf[3]=*(const __attribute__((address_space(3))) bf16x8*)(kp+2560);
  kf[4]=*(const __attribute__((address_space(3))) bf16x8*)(kp+4096); kf[5]=*(const __attribute__((address_space(3))) bf16x8*)(kp+4608);
  kf[6]=*(const __attribute__((address_space(3))) bf16x8*)(kp+6144); kf[7]=*(const __attribute__((address_space(3))) bf16x8*)(kp+6656);
}
__device__ __forceinline__ void kload2(bf16x8*kf,lds_cptr kp,int j){ kf[2*j]=*(const __attribute__((address_space(3))) bf16x8*)(kp+j*2048); kf[2*j+1]=*(const __attribute__((address_space(3))) bf16x8*)(kp+j*2048+512); }
__device__ __forceinline__ s16x4 vtr(lds_cptr p){ return __builtin_bit_cast(s16x4,__builtin_amdgcn_ds_read_tr16_b64_v4i16((__attribute__((address_space(3))) v4i16_t*)p)); }
__device__ __forceinline__ float rowmax(const f32x16&p0,const f32x16&p1){
  float a=max3f(p0[0],p0[1],p1[0]),b=max3f(p0[2],p0[3],p1[1]);a=max3f(a,p1[2],p1[3]);
  #pragma unroll
  for(int r=4;r<16;r+=4){a=max3f(a,p0[r],p0[r+1]);b=max3f(b,p0[r+2],p0[r+3]);a=max3f(a,p1[r],p1[r+1]);b=max3f(b,p1[r+2],p1[r+3]);}
  const float m=max2f(a,b);
  auto rr=__builtin_amdgcn_permlane32_swap(__float_as_uint(m),__float_as_uint(m),false,false);
  return max2f(__uint_as_float(rr[0]),__uint_as_float(rr[1]));
}
__device__ __forceinline__ void pv(f32x16*o,int vb,bf16x8 pa0,bf16x8 pa1,bf16x8 pa2,bf16x8 pa3){
  #pragma unroll
  for(int d0=0;d0<2;++d0){s16x4 lo[4],hi[4];
    #pragma unroll
    for(int ks=0;ks<4;++ks){
      asm volatile("ds_read_b64_tr_b16 %0,%1 offset:%c2":"=&v"(lo[ks]):"v"(vb),"i"(d0*4096+ks*1024):"memory");
      asm volatile("ds_read_b64_tr_b16 %0,%1 offset:%c2":"=&v"(hi[ks]):"v"(vb),"i"(d0*4096+ks*1024+512):"memory");}
    asm volatile("s_waitcnt lgkmcnt(0)":::"memory");SBAR();
    #define PK(k) (bf16x8){lo[k][0],lo[k][1],lo[k][2],lo[k][3],hi[k][0],hi[k][1],hi[k][2],hi[k][3]}
    o[d0]=__builtin_amdgcn_mfma_f32_32x32x16_bf16(pa0,PK(0),o[d0],0,0,0);
    o[d0]=__builtin_amdgcn_mfma_f32_32x32x16_bf16(pa1,PK(1),o[d0],0,0,0);
    o[d0]=__builtin_amdgcn_mfma_f32_32x32x16_bf16(pa2,PK(2),o[d0],0,0,0);
    o[d0]=__builtin_amdgcn_mfma_f32_32x32x16_bf16(pa3,PK(3),o[d0],0,0,0);
    #undef PK
  }
}

#ifndef ATTN_STORE16
#define ATTN_STORE16(p,v) (*(u32x4*)(p)=(v))
#endif
template<int THRL> __device__ __forceinline__ void attn_unit(int b,int h,int qb,int t0,const bf16*Q,const bf16*__restrict__ K,const bf16*__restrict__ V,bf16*O,const float*__restrict__ NCL,char*shm){
  int tid_o=threadIdx.x; asm volatile("":"+v"(tid_o));
  const int tid=tid_o,lane=tid&63,r32=lane&31,hi=lane>>5; const int wid=__builtin_amdgcn_readfirstlane(tid>>6);
  const long rowbase=(long)b*SEQ; const int q0=qb*QB;
  const bf16*Qw=Q+(rowbase+q0+wid*QBLK)*QP+h*D;
  const bf16*Kh=K+(rowbase+(long)t0*KVBLK)*KVP+h*D,*Vh=V+(rowbase+(long)t0*KVBLK)*KVP+h*D;
  const unsigned lds0=(unsigned)(uintptr_t)shm;
  float*wsf=(float*)(shm+LDS_WS)+wid*64;
  const bf16*ksrc=Kh+(long)lane*KVP+wid*8;
  const bf16*vsrc=Vh+(long)(16*(wid&3)+(lane>>2))*KVP+(wid>>2)*32+(lane&3)*8;
  const unsigned kdst=lds0+LDS_K+wid*1024, vdst=lds0+LDS_V+wid*1024;
  #define DMA_K(t,slot) glds16(ksrc+(long)(t)*KVBLK*KVP,(unsigned)__builtin_amdgcn_readfirstlane(kdst+(slot)))
  #define DMA_V(t,slot) glds16(vsrc+(long)(t)*KVBLK*KVP,(unsigned)__builtin_amdgcn_readfirstlane(vdst+(slot)))
  const int vb0=(int)(lds0+LDS_V)+((lane>>4)&1)*32+(lane&3)*8+(4*hi+((lane&15)>>2))*64;
  const char*Kbase=shm+LDS_K; bf16x8 kf[8];
  const lds_cptr shm3=(lds_cptr)shm; const lds_cptr kp0=shm3+LDS_K+hi*1024+r32*16; const lds_cptr vp0=shm3+LDS_V+((lane>>4)&1)*32+(lane&3)*8+(4*hi+((lane&15)>>2))*64;
  const int NT=(q0+QB)/KVBLK-t0;
  DMA_K(0,0);DMA_V(0,0);DMA_K(1,SLOTB);
  { typedef float f32x4_t __attribute__((ext_vector_type(4))); __attribute__((address_space(3))) float* ct=(__attribute__((address_space(3))) float*)(shm3+LDS_CT);
    const int i0_=t0*KVBLK+tid*4, iend_=q0+QB; f32x4_t tv_[4];
    _Pragma("unroll") for(int k_=0;k_<4;++k_){ const int i=i0_+k_*(NW*64*4); tv_[k_]=(i<iend_)?*(const f32x4_t*)(NCL+i):(f32x4_t){0.f,0.f,0.f,0.f}; }
    _Pragma("unroll") for(int k_=0;k_<4;++k_){ const int i=i0_+k_*(NW*64*4); if(i<iend_) *(__attribute__((address_space(3))) f32x4_t*)(ct+i)=tv_[k_]; } }
  const __attribute__((address_space(3))) float* ctl=(const __attribute__((address_space(3))) float*)(shm3+LDS_CT)+t0*KVBLK+4*hi;
  #define CINIT(C0,C1,t) do{ typedef float f32x4_t __attribute__((ext_vector_type(4))); const float nm_=-mhat; const __attribute__((address_space(3))) float* cb_=ctl+64*(t); \
    _Pragma("unroll") for(int g_=0;g_<4;++g_){ const f32x4_t b0_=*(const __attribute__((address_space(3))) f32x4_t*)(cb_+8*g_), b1_=*(const __attribute__((address_space(3))) f32x4_t*)(cb_+32+8*g_); \
      _Pragma("unroll") for(int i_=0;i_<4;++i_){ C0[4*g_+i_]=nm_+b0_[i_]; C1[4*g_+i_]=nm_+b1_[i_]; } } }while(0)
  bf16x8 qr[4];
  #pragma unroll
  for(int d0=0;d0<4;++d0)qr[d0]=*reinterpret_cast<const bf16x8*>(&Qw[(long)r32*QP+d0*16+hi*8]);
  float mhat=0.f,l_reg=0.f;f32x16 o[2];o[0]=f32x16{};o[1]=f32x16{};
  const int qrel=wid*QBLK+r32;
  #define CMASK(P0,P1,t) do{int jb_=(t)-(NT-4); if(jb_>=0)cmask(P0,P1,jb_,qrel,hi);}while(0)
  bool resc=false;
  #define START(P0,P1) do{ const float rm=rowmax(P0,P1); resc=false; \
    { const float dl=rm; mhat=fadd_s(mhat,dl); \
      _Pragma("unroll") for(int r=0;r<16;++r){P0[r]=fsub_s(P0[r],dl);P1[r]=fsub_s(P1[r],dl);} \
      } \
    _Pragma("unroll") for(int r=0;r<16;++r)P0[r]=__builtin_amdgcn_exp2f(P0[r]); }while(0)
  #define RESC() do{ if(resc){ asm volatile("s_waitcnt lgkmcnt(0)":::"memory"); \
      _Pragma("unroll") for(int d_=0;d_<2;++d_) _Pragma("unroll") for(int r=0;r<16;++r)o[d_][r]*=wsf[crow(r,hi)]; } }while(0)
  f32x16 pA0,pA1,pB0,pB1;
  int sl_prev=0,sl_cur=0,sl_next=SLOTB;
  #define ROT() do{sl_prev=sl_cur;sl_cur=sl_next;sl_next=(sl_next==(NSLOT-1)*SLOTB)?0:sl_next+SLOTB;}while(0)
  DMA_K(2,2*SLOTB);
  WAIT_BAR(3);
  CINIT(pA0,pA1,0); qkt(pA0,pA1,Kbase,qr,r32,hi);asm volatile("s_nop 15\n\ts_nop 7":"+v"(pA0),"+v"(pA1));CMASK(pA0,pA1,0);
  START(pA0,pA1);
  _Pragma("unroll") for(int r=0;r<16;++r)pA1[r]=__builtin_amdgcn_exp2f(pA1[r]);
  WAIT_BAR(0);
  DMA_K(3,0);DMA_V(1,SLOTB);
  ROT();
  kload8(kf,kp0+sl_cur);
  WAIT_BAR(2);
  s16x4 vlo[8],vhi[8]; u32x4 pw0,pw1,pw2,pw3;
  #define PKW(P,B) cvtpk_s(P[B],P[B+1])
  #define PAF(k) __builtin_bit_cast(bf16x8,pw##k)
  #define VFR(i) (bf16x8){vlo[i][0],vlo[i][1],vlo[i][2],vlo[i][3],vhi[i][0],vhi[i][1],vhi[i][2],vhi[i][3]}
  #define PIN(x) asm volatile("":"+v"(x))
  #define MX3(a,b,c) __builtin_fmaxf(__builtin_fmaxf((a),(b)),(c))
  #define GAPA(MF,A0,A1,A2,A3,W0,W1,PW) do{ MF; sacc+=A0; sacc+=A1; sacc+=A2; sacc+=A3; PIN(sacc); W0; W1; PIN(PW); SBAR(); }while(0)
  #define EX(v) __builtin_amdgcn_exp2f(v)
  #define GAPB(MF,X,B) do{ MF; X[B]=EX(X[B]); X[B+1]=EX(X[B+1]); X[B+2]=EX(X[B+2]); X[B+3]=EX(X[B+3]); PIN(X); SBAR(); }while(0)
  #define VRD(i) do{ vlo[i]=vtr(vp_+(((i)>>2)*4096+((i)&3)*1024)); vhi[i]=vtr(vp_+(((i)>>2)*4096+((i)&3)*1024+512)); }while(0)
  #define KRD(G,j) do{ if(G){ kload2(kf,kp0+sl_next,j); SBAR(); } }while(0)
  #define STEP(C0,C1,P0,P1,t,GK,GV,GL) do{ SBAR(); CINIT(C0,C1,t); SBAR(); \
    const lds_cptr vp_=vp0+sl_prev; \
    VRD(0); SBAR(); float sacc=(P0[0]+P0[1]); \
    GAPA(C0=__builtin_amdgcn_mfma_f32_32x32x16_bf16(kf[0],qr[0],C0,0,0,0), P0[2],P0[3],P0[4],P0[5],     pw0[0]=PKW(P0,0), pw0[1]=PKW(P0,2), pw0); \
    VRD(4); SBAR(); GAPA(C1=__builtin_amdgcn_mfma_f32_32x32x16_bf16(kf[1],qr[0],C1,0,0,0), P0[6],P0[7],P0[8],P0[9],     pw0[2]=PKW(P0,4), pw0[3]=PKW(P0,6), pw0); \
    VRD(1); SBAR(); GAPA(C0=__builtin_amdgcn_mfma_f32_32x32x16_bf16(kf[2],qr[1],C0,0,0,0),   P0[10],P0[11],P0[12],P0[13], pw1[0]=PKW(P0,8), pw1[1]=PKW(P0,10), pw1); \
    VRD(5); SBAR(); GAPA(C1=__builtin_amdgcn_mfma_f32_32x32x16_bf16(kf[3],qr[1],C1,0,0,0),   P0[14],P0[15],P1[0],P1[1],   pw1[2]=PKW(P0,12),pw1[3]=PKW(P0,14), pw1); \
    VRD(2); SBAR(); GAPA(C0=__builtin_amdgcn_mfma_f32_32x32x16_bf16(kf[4],qr[2],C0,0,0,0),   P1[2],P1[3],P1[4],P1[5],     pw2[0]=PKW(P1,0), pw2[1]=PKW(P1,2), pw2); \
    VRD(6); SBAR(); GAPA(C1=__builtin_amdgcn_mfma_f32_32x32x16_bf16(kf[5],qr[2],C1,0,0,0),   P1[6],P1[7],P1[8],P1[9],     pw2[2]=PKW(P1,4), pw2[3]=PKW(P1,6), pw2); \
    VRD(3); SBAR(); GAPA(C0=__builtin_amdgcn_mfma_f32_32x32x16_bf16(kf[6],qr[3],C0,0,0,0),   P1[10],P1[11],P1[12],P1[13], pw3[0]=PKW(P1,8), pw3[1]=PKW(P1,10), pw3); \
    VRD(7); SBAR(); GAPA(C1=__builtin_amdgcn_mfma_f32_32x32x16_bf16(kf[7],qr[3],C1,0,0,0),   P1[14],P1[15],0.f,0.f,       pw3[2]=PKW(P1,12),pw3[3]=PKW(P1,14), pw3); \
    l_reg+=sacc; \
    if(GK){DMA_K((t)+3,sl_cur);} if(GV){DMA_V((t)+1,sl_next);} \
    CMASK(C0,C1,t); \
    { float a=MX3(C0[0],C0[1],C1[0]),b=MX3(C0[2],C0[3],C1[1]); a=MX3(a,C1[2],C1[3]); \
      _Pragma("unroll") for(int r=4;r<16;r+=4){a=MX3(a,C0[r],C0[r+1]);b=MX3(b,C0[r+2],C0[r+3]);a=MX3(a,C1[r],C1[r+1]);b=MX3(b,C1[r+2],C1[r+3]);} \
      float rm=__builtin_fmaxf(a,b); { auto rr=__builtin_amdgcn_permlane32_swap(__float_as_uint(rm),__float_as_uint(rm),false,false); rm=__builtin_fmaxf(__uint_as_float(rr[0]),__uint_as_float(rr[1])); } \
      resc=false; \
      if(__builtin_expect(__any(rm>(float)THRL),0)){ const float dl=__builtin_fmaxf(rm,0.f); mhat+=dl; \
        _Pragma("unroll") for(int r=0;r<16;++r){C0[r]-=dl;C1[r]-=dl;} \
        const float f=__builtin_amdgcn_exp2f(-dl); l_reg*=f; if(hi==0)wsf[r32]=f; resc=true; } } \
    SBAR(); \
    GAPB(o[0]=__builtin_amdgcn_mfma_f32_32x32x16_bf16(PAF(0),VFR(0),o[0],0,0,0), C0,0); \
    GAPB(o[1]=__builtin_amdgcn_mfma_f32_32x32x16_bf16(PAF(0),VFR(4),o[1],0,0,0), C0,4); \
    KRD(GL,0); GAPB(o[0]=__builtin_amdgcn_mfma_f32_32x32x16_bf16(PAF(1),VFR(1),o[0],0,0,0), C0,8); \
    KRD(GL,1); GAPB(o[1]=__builtin_amdgcn_mfma_f32_32x32x16_bf16(PAF(1),VFR(5),o[1],0,0,0), C0,12); \
    KRD(GL,2); GAPB(o[0]=__builtin_amdgcn_mfma_f32_32x32x16_bf16(PAF(2),VFR(2),o[0],0,0,0), C1,0); \
    KRD(GL,3); GAPB(o[1]=__builtin_amdgcn_mfma_f32_32x32x16_bf16(PAF(2),VFR(6),o[1],0,0,0), C1,4); \
    GAPB(o[0]=__builtin_amdgcn_mfma_f32_32x32x16_bf16(PAF(3),VFR(3),o[0],0,0,0), C1,8); \
    GAPB(o[1]=__builtin_amdgcn_mfma_f32_32x32x16_bf16(PAF(3),VFR(7),o[1],0,0,0), C1,12); \
    }while(0)
  int t=1;
  #undef CMASK
  #define CMASK(P0,P1,t) do{}while(0)
  for(;t+5<NT;t+=2){
    STEP(pB0,pB1,pA0,pA1,t,true,true,true);     WAIT_BAR(2); RESC(); ROT();
    STEP(pA0,pA1,pB0,pB1,t+1,true,true,true);   WAIT_BAR(2); RESC(); ROT();
  }
  #undef CMASK
  #define CMASK(P0,P1,t) do{int jb_=(t)-(NT-4); if(jb_>=0)cmask(P0,P1,jb_,qrel,hi);}while(0)
  #define ENDW(tt) do{ if((tt)+3<NT){WAIT_BAR(2);} else if((tt)+2<NT){WAIT_BAR(1);} else {WAIT_BAR(0);} }while(0)
  for(;t+1<NT;t+=2){
    STEP(pB0,pB1,pA0,pA1,t,(t+3<NT),(t+1<NT),(t+1<NT));       ENDW(t);   RESC(); ROT();
    STEP(pA0,pA1,pB0,pB1,t+1,(t+4<NT),(t+2<NT),(t+2<NT));     ENDW(t+1); RESC(); ROT();
  }
  STEP(pB0,pB1,pA0,pA1,NT-1,false,false,false); RESC();
  { float sacc=pB0[0]+pB0[1]; _Pragma("unroll") for(int r=2;r<16;++r)sacc+=pB0[r]; _Pragma("unroll") for(int r=0;r<16;++r)sacc+=pB1[r]; l_reg+=sacc;
    pw0=(u32x4){PKW(pB0,0),PKW(pB0,2),PKW(pB0,4),PKW(pB0,6)};pw1=(u32x4){PKW(pB0,8),PKW(pB0,10),PKW(pB0,12),PKW(pB0,14)};pw2=(u32x4){PKW(pB1,0),PKW(pB1,2),PKW(pB1,4),PKW(pB1,6)};pw3=(u32x4){PKW(pB1,8),PKW(pB1,10),PKW(pB1,12),PKW(pB1,14)};
    SBAR(); pv(o,vb0+sl_cur,PAF(0),PAF(1),PAF(2),PAF(3)); }
  #undef PKW
  #undef PAF
  #undef VFR
  #undef PIN
  #undef MX3
  #undef GAPA
  #undef GAPB
  #undef EX
  #undef VRD
  #undef KRD
  #undef STEP
  #undef ENDW
  {auto rr=__builtin_amdgcn_permlane32_swap(__float_as_uint(l_reg),__float_as_uint(l_reg),false,false);l_reg=__uint_as_float(rr[0])+__uint_as_float(rr[1]);}
  if(hi==0)wsf[32+r32]=l_reg;asm volatile("s_waitcnt lgkmcnt(0)":::"memory");
  float rli[16];
  #pragma unroll
  for(int r=0;r<16;++r)rli[r]=__builtin_amdgcn_rcpf(wsf[32+crow(r,hi)]);
  bf16*Ow=O+(rowbase+q0+wid*QBLK)*QP+h*D;
  { bf16*stg=(bf16*)(shm+LDS_OST)+wid*2048;
    #pragma unroll
    for(int r=0;r<16;++r){const int orow=crow(r,hi);
      #pragma unroll
      for(int d0=0;d0<2;++d0)stg[orow*64+d0*32+r32]=__float2bfloat16(o[d0][r]*rli[r]);}
    asm volatile("s_waitcnt lgkmcnt(0)":::"memory");
    #pragma unroll
    for(int i=0;i<4;++i){const int row=i*8+(lane>>3),ch=lane&7; const u32x4 v=*(const u32x4*)(stg+row*64+ch*8); ATTN_STORE16(Ow+(long)row*QP+ch*8,v);} }
  asm volatile("s_waitcnt lgkmcnt(0)\n\ts_barrier":::"memory");
  #undef DMA_K
  #undef DMA_V
  #undef CMASK
  #undef START
  #undef RESC
  #undef ROT
  #undef CINIT
}
constexpr int ATTN_LDS_BYTES=LDS_BYTES;
struct AttnTensors { const bf16* Q; const bf16* K; const bf16* V; bf16* O; const float* NCL; };
struct AttnUnit { int bh; int qb; };
struct AttnQueue { unsigned* cnt; float th; int xcc; volatile __attribute__((address_space(3))) unsigned* slot; };
template<int THRL=8,class Hook> __device__ __forceinline__ void attn_phase_dyn(char*lds,const AttnTensors&T_,const AttnQueue&Qd,const Hook&hook){
  AttnTensors T;
  { unsigned long long q_=(unsigned long long)T_.Q,k_=(unsigned long long)T_.K,v_=(unsigned long long)T_.V,o_=(unsigned long long)T_.O,c_=(unsigned long long)T_.NCL; asm volatile("":"+s"(q_),"+s"(k_),"+s"(v_),"+s"(o_),"+s"(c_));
    typedef __attribute__((address_space(1))) bf16 gbf; typedef __attribute__((address_space(1))) float gf;
    T.Q=(const bf16*)(const gbf*)q_; T.K=(const bf16*)(const gbf*)k_; T.V=(const bf16*)(const gbf*)v_; T.O=(bf16*)(gbf*)o_; T.NCL=(const float*)(const gf*)c_; }
  int it=0;
  for(int qq=0;qq<BATCH;++qq){ const int b=(Qd.xcc+qq)&(BATCH-1);
    for(;;++it){
      int tid_=threadIdx.x; asm volatile("":"+v"(tid_));
      if(tid_==0) Qd.slot[it&1]=__hip_atomic_fetch_add(Qd.cnt+64*b,1u,__ATOMIC_RELAXED,__HIP_MEMORY_SCOPE_AGENT);
      __syncthreads();
      const int u=__builtin_amdgcn_readfirstlane((int)Qd.slot[it&1]);
      if(u>=NHEAD*NQB) break;
      const int qb=NQB-1-(u>>3),h=u&(NHEAD-1),bh=b*NHEAD+h;
      const float* nrow=T.NCL+(long)bh*SEQ; const int ntile=4*(qb+1),lane_=tid_&63;
      const float ref=nrow[qb*QB]-Qd.th;
      const bool ok0=(lane_<ntile)&&(nrow[(lane_<ntile?lane_:0)*KVBLK+KVBLK-1]<=ref), ok1=(lane_+64<ntile)&&(nrow[(lane_+64<ntile?lane_+64:0)*KVBLK+KVBLK-1]<=ref);
      int t0=__builtin_popcountll(__ballot(ok0))+__builtin_popcountll(__ballot(ok1)); t0&=~1; if(t0>ntile-4)t0=ntile-4;
      t0=__builtin_amdgcn_readfirstlane(t0);
      attn_unit<THRL>(b,h,qb,t0,T.Q,T.K,T.V,T.O,nrow,lds);
      hook(b,u);
    }
    ++it;
  }
}
#undef SBAR
#undef WAIT_BAR
}

constexpr int NWAVES = 8;
#ifndef MK_PER_PHASE
#define MK_PER_PHASE 0
#endif

constexpr int D = 1024, BATCH = 8, SEQ = 8192, M = BATCH * SEQ, DEPTH = 4;
constexpr int IN_COLS = 5384, OFF_CONV = 256, OFF_Q = 768, OFF_K = 1280, OFF_V = 1792, OFF_F = 2304, OFF_G = 2312;
constexpr int NIN = 5376;
constexpr int DFF = 2816, DFFE = 3584, NEXP = 8, CONVK = 31;
constexpr float LOG2E = 1.4426950408889634f;

constexpr size_t MiB = 1u << 20;
constexpr size_t WS_CTL = 0, CTL_ZERO_BYTES = 256 * 1024;
constexpr size_t WS_NLF = 1 * MiB;
constexpr size_t WS_NCL = 3 * MiB;
constexpr size_t WS_WIN = 5 * MiB;
constexpr size_t WS_WBR = 16 * MiB;
constexpr size_t WS_WOUT = 18 * MiB;
constexpr size_t WS_WFF = 20 * MiB;
constexpr size_t WS_HB = 188 * MiB;
constexpr size_t WS_Y = 316 * MiB;
constexpr size_t WS_K = 444 * MiB, WS_V = 508 * MiB;
constexpr size_t WS_P = 572 * MiB, WS_Z = 604 * MiB;
constexpr size_t WS_G = 636 * MiB;
constexpr size_t WS_HID = 316 * MiB;
constexpr size_t HID_SLOT = 232 * MiB;
constexpr int MOE_SKIPR = 3;
static_assert((size_t)264 * 256 * DFFE <= HID_SLOT && WS_HID + 2 * HID_SLOT <= 800 * MiB, "MoE hidden slots");
constexpr size_t WS_LIST = 800 * MiB;
constexpr size_t WS_MOEW = 808 * MiB;
constexpr size_t WS_XBW = 820 * MiB;
constexpr size_t WS_END = 1020 * MiB;
constexpr size_t WFF_W2_DENSE = (size_t)2 * DFF * D * 2;
constexpr size_t WFF_W13_E = (size_t)2 * DFFE * D * 2, WFF_W2_E = (size_t)D * DFFE * 2, WFF_W2_MOE = 8 * WFF_W13_E;
constexpr size_t WS_WG8 = WS_WIN + (size_t)2304 * D * 2;
constexpr size_t WS_H8 = WS_WFF + 100 * MiB;
constexpr int DENSE8_FROM = 2;
constexpr size_t WFF8_W2_DENSE = (size_t)2 * DFF * D;
constexpr size_t WFF8_W13_E = (size_t)2 * DFFE * D, WFF8_W2_E = (size_t)D * DFFE, WFF8_W2_OFF = 8 * WFF8_W13_E;
static_assert(WS_WIN + (size_t)NIN * D * 2 <= WS_WBR && WS_WFF + WFF_W2_MOE + 8 * WFF_W2_E <= WS_HB && WS_G + (size_t)M * 3072 * 2 <= WS_END && WS_HID + (size_t)264 * 256 * DFFE * 2 <= WS_LIST, "d_ws map");
constexpr int CW_TMO = 0;
constexpr int CW_MOECNT = 64;
constexpr int CW_ATTQ = 8192;
constexpr int CW_BAR = 4096;

constexpr int RING_OFF = 0, RING_BYTES = 131072;
constexpr int LDSCTL_OFF = RING_BYTES, MISC_OFF = LDSCTL_OFF + 320;
constexpr int MOETAB_OFF = LDSCTL_OFF + 1024;
constexpr int LDS_BYTES = 147456;
constexpr int GBIAS_OFF = MOETAB_OFF + 272 * 4;
static_assert(MISC_OFF + 128 <= MOETAB_OFF && GBIAS_OFF % 16 == 0 && GBIAS_OFF + (3072 + 128) * 4 <= LDS_BYTES, "LDS map");

#define GAS __attribute__((address_space(1)))
#define LAS __attribute__((address_space(3)))
typedef unsigned short bf16;
typedef unsigned v4u __attribute__((ext_vector_type(4)));
typedef unsigned v2u __attribute__((ext_vector_type(2)));
typedef float f32x4 __attribute__((ext_vector_type(4)));
typedef GAS unsigned gu32;
#define RLX_AGENT __ATOMIC_RELAXED, __HIP_MEMORY_SCOPE_AGENT
#define LDS_WAIT() asm volatile("s_waitcnt lgkmcnt(0)" ::: "memory")
#define VM_WAIT() asm volatile("s_waitcnt vmcnt(0)" ::: "memory")
__device__ __forceinline__ unsigned f2bf(float f) { unsigned u = __builtin_bit_cast(unsigned, f); return (u + 0x7fffu + ((u >> 16) & 1u)) >> 16; }
__device__ __forceinline__ unsigned pk2(float lo, float hi) { return f2bf(lo) | (f2bf(hi) << 16); }
__device__ __forceinline__ float bflo(unsigned w) { return __uint_as_float(w << 16); }
__device__ __forceinline__ float bfhi(unsigned w) { return __uint_as_float(w & 0xffff0000u); }

#define XB_TMO      128
#define XB_XCNT(j)  (256  + 64 * (j))
#define XB_XSUB(j)  (1280 + 64 * (j))
#define XB_XGEN(j)  (2304 + 64 * (j))
#define XB_TOP      3328
#define XB_TOPGEN   3392
#define XCD_BAR_WORDS 3456
#define XB_SPIN_CAP (1u << 18)

__device__ __forceinline__ unsigned xb_ld(unsigned* p)              { return __hip_atomic_load(p, __ATOMIC_RELAXED, __HIP_MEMORY_SCOPE_AGENT); }
__device__ __forceinline__ unsigned xb_add(unsigned* p, unsigned v) { return __hip_atomic_fetch_add(p, v, __ATOMIC_RELAXED, __HIP_MEMORY_SCOPE_AGENT); }
__device__ __forceinline__ unsigned xb_xcc_id() { return (unsigned)__builtin_amdgcn_s_getreg((3 << 11) | 20) & 0xFu; }
#define XB_SPIN(cond, bar) do { unsigned _sp = 0; while (cond) { __builtin_amdgcn_s_sleep(1); \
    if ((++_sp & 255u) == 0u) { if (xb_ld(&(bar)[XB_TMO])) break; if (_sp > XB_SPIN_CAP) { atomicAdd(&(bar)[XB_TMO], 1u); break; } } } } while (0)

struct XcdBarrier {
    unsigned* bar; unsigned x;
    volatile LAS unsigned* st;
};

__device__ __forceinline__ XcdBarrier xcd_barrier_post(unsigned* bar, volatile LAS unsigned* st) {
    XcdBarrier b; b.bar = bar; b.x = xb_xcc_id(); b.st = st;
    if (threadIdx.x == 0) (void)xb_add(&bar[XB_XCNT(b.x)], 1u);
    return b;
}
__device__ __forceinline__ void xcd_barrier_complete(unsigned* bar, unsigned x, unsigned& nloc, unsigned& nx) {
    const unsigned G = gridDim.x * gridDim.y * gridDim.z;
    unsigned sum, cnt, mine, sp = 0u;
    for (;;) {
        sum = 0u; cnt = 0u; mine = 0u;
#pragma unroll
        for (unsigned j = 0; j < 16; ++j) { const unsigned c = xb_ld(&bar[XB_XCNT(j)]); sum += c; cnt += (c > 0u) ? 1u : 0u; mine = (j == x) ? c : mine; }
        if (sum == G) break;
        __builtin_amdgcn_s_sleep(1);
        if ((++sp & 255u) == 0u) { if (xb_ld(&bar[XB_TMO])) break; if (sp > XB_SPIN_CAP) { atomicAdd(&bar[XB_TMO], 1u); break; } }
    }
    nloc = mine > 0u ? mine : 1u; nx = cnt > 0u ? cnt : 1u;
}

__device__ __forceinline__ void xcd_barrier(const XcdBarrier& b) {
    asm volatile("s_waitcnt vmcnt(0)" ::: "memory");
    __syncthreads();
    if (threadIdx.x == 0) {
        unsigned* bar = b.bar;
        __builtin_amdgcn_s_waitcnt(0);
        unsigned nloc = b.st[0], nx = b.st[1];
        if (nloc == 0u) { xcd_barrier_complete(bar, b.x, nloc, nx); b.st[0] = nloc; b.st[1] = nx; }
        const unsigned old = xb_add(&bar[XB_XSUB(b.x)], 1u);
        const unsigned gen = old / nloc;
        if (old + 1u == (gen + 1u) * nloc) {
            __builtin_amdgcn_fence(__ATOMIC_RELEASE, "agent");
            asm volatile("s_waitcnt vmcnt(0)" ::: "memory");
            const unsigned og = xb_add(&bar[XB_TOP], 1u);
            const unsigned tg = og / nx;
            if (og + 1u == (tg + 1u) * nx) xb_add(&bar[XB_TOPGEN], 1u);
            else XB_SPIN(xb_ld(&bar[XB_TOPGEN]) == tg, bar);
            __builtin_amdgcn_fence(__ATOMIC_ACQUIRE, "agent");
            xb_add(&bar[XB_XGEN(b.x)], 1u);
            asm volatile("s_waitcnt vmcnt(0)" ::: "memory");
        } else {
            XB_SPIN(xb_ld(&bar[XB_XGEN(b.x)]) == gen, bar);
            __builtin_amdgcn_fence(__ATOMIC_ACQUIRE, "agent");
            asm volatile("s_waitcnt vmcnt(0)" ::: "memory");
        }
    }
    __syncthreads();
}

struct Frame {
    LAS unsigned char* lds;
    volatile LAS unsigned* MISC;
    int vcu, G;
};
struct Site {
    gu32* ctl; unsigned char* ws; const float* const __attribute__((address_space(4)))* in; float* out;
    int tid, lane, wave;
};
__device__ __forceinline__ Site make_site() {
    Site P; int t_ = threadIdx.x; asm volatile("" : "+v"(t_)); P.tid = t_; P.lane = t_ & 63; P.wave = __builtin_amdgcn_readfirstlane(t_ >> 6);
    unsigned long long kp_ = (unsigned long long)__builtin_amdgcn_kernarg_segment_ptr(); asm volatile("" : "+s"(kp_));
    P.in = (const float* const __attribute__((address_space(4)))*)kp_;
    P.out = (float*)(GAS float*)(*(const __attribute__((address_space(4))) unsigned long long*)(kp_ + 200));
    P.ws = (unsigned char*)(GAS unsigned char*)(*(const __attribute__((address_space(4))) unsigned long long*)(kp_ + 208));
    P.ctl = (gu32*)(P.ws + WS_CTL);
    return P;
}
__device__ __forceinline__ float wave_sum(float v, int lane) {
    (void)lane;
    v += __int_as_float(__builtin_amdgcn_update_dpp(0, __float_as_int(v), 0xB1, 0xF, 0xF, true));
    v += __int_as_float(__builtin_amdgcn_update_dpp(0, __float_as_int(v), 0x4E, 0xF, 0xF, true));
    v += __int_as_float(__builtin_amdgcn_update_dpp(0, __float_as_int(v), 0x141, 0xF, 0xF, true));
    v += __int_as_float(__builtin_amdgcn_update_dpp(0, __float_as_int(v), 0x140, 0xF, 0xF, true));
    v += __int_as_float(__builtin_amdgcn_update_dpp(0, __float_as_int(v), 0x142, 0xA, 0xF, false));
    v += __int_as_float(__builtin_amdgcn_update_dpp(0, __float_as_int(v), 0x143, 0xC, 0xF, false));
    return __int_as_float(__builtin_amdgcn_readlane(__float_as_int(v), 63));
}

__device__ __forceinline__ void transpose_item(const float* colp, size_t sstride, bf16* WT, int K, int n0, int k0, LAS float* scr, int lane) {
    const float* sp = colp + (size_t)k0 * sstride;
    const float* lp = sp + (size_t)(lane >> 5) * sstride;
    LAS float* sq = scr + (lane >> 5) * 33 + (lane & 31);
#pragma unroll
    for (int hb = 0; hb < 2; ++hb) { float tv[16];
#pragma unroll
        for (int i = 0; i < 16; ++i) { tv[i] = *lp; lp += 2 * sstride; }
#pragma unroll
        for (int i = 0; i < 16; ++i) sq[(2 * (16 * hb + i)) * 33] = tv[i]; }
    LDS_WAIT(); asm volatile("" ::: "memory");
    const int c = lane & 7;
#pragma unroll
    for (int j = 0; j < 4; ++j) { const int n = (lane >> 3) + 8 * j; const LAS float* s = scr + (8 * c) * 33 + n;
        v4u o; o.x = pk2(s[0 * 33], s[1 * 33]); o.y = pk2(s[2 * 33], s[3 * 33]); o.z = pk2(s[4 * 33], s[5 * 33]); o.w = pk2(s[6 * 33], s[7 * 33]);
        *(GAS v4u*)(WT + (size_t)(n0 + n) * K + k0 + 8 * c) = o; }
    LDS_WAIT(); asm volatile("" ::: "memory");
}
__device__ __forceinline__ void transpose_item8(const float* colp, size_t sstride, unsigned char* WT8, int K, int n0, int k0, LAS float* scr, int lane, const float sc) {
    const float* sp = colp + (size_t)k0 * sstride;
    const float* lp = sp + (size_t)(lane >> 5) * sstride;
    LAS float* sq = scr + (lane >> 5) * 33 + (lane & 31);
#pragma unroll
    for (int hb = 0; hb < 2; ++hb) { float tv[16];
#pragma unroll
        for (int i = 0; i < 16; ++i) { tv[i] = *lp; lp += 2 * sstride; }
#pragma unroll
        for (int i = 0; i < 16; ++i) sq[(2 * (16 * hb + i)) * 33] = tv[i]; }
    LDS_WAIT(); asm volatile("" ::: "memory");
    const int c = lane & 7;
#pragma unroll
    for (int j = 0; j < 4; ++j) { const int n = (lane >> 3) + 8 * j; const LAS float* s = scr + (8 * c) * 33 + n;
        int lo = 0, hi = 0;
        lo = __builtin_amdgcn_cvt_pk_fp8_f32(s[0 * 33] * sc, s[1 * 33] * sc, lo, false); lo = __builtin_amdgcn_cvt_pk_fp8_f32(s[2 * 33] * sc, s[3 * 33] * sc, lo, true);
        hi = __builtin_amdgcn_cvt_pk_fp8_f32(s[4 * 33] * sc, s[5 * 33] * sc, hi, false); hi = __builtin_amdgcn_cvt_pk_fp8_f32(s[6 * 33] * sc, s[7 * 33] * sc, hi, true);
        *(GAS v2u*)(WT8 + (size_t)(n0 + n) * K + k0 + 8 * c) = (v2u){(unsigned)lo, (unsigned)hi}; }
    LDS_WAIT(); asm volatile("" ::: "memory");
}
__device__ __forceinline__ int inproj_src_col(int p) {
    const int t = p >> 8, q = p & 255;
    if (t == 0) return q;
    if (t <= 2) { const int ch = (t - 1) * 128 + 4 * (q >> 3) + (q & 3); return OFF_CONV + ((q >> 2) & 1) * 256 + ch; }
    if (t <= 6) { const int base = t <= 4 ? OFF_Q + 256 * (t - 3) : OFF_K + 256 * (t - 5); return base + 64 * ((q >> 5) & 3) + 32 * (q >> 7) + (q & 31); }
    if (t <= 8) return OFF_V + 256 * (t - 7) + q;
    return OFF_G + 256 * (t - 9) + q;
}
template <bool F8> __device__ __forceinline__ void convert_block64(const float* sp, size_t ss, unsigned char* dp) {
    float v[64];
#pragma unroll
    for (int j = 0; j < 64; ++j) { v[j] = *sp; sp += ss; }
    if constexpr (F8) {
#pragma unroll
        for (int q = 0; q < 4; ++q) { int t[4];
#pragma unroll
            for (int c = 0; c < 4; ++c) { const int i = 16 * q + 4 * c; int w = 0;
                w = __builtin_amdgcn_cvt_pk_fp8_f32(v[i] * 32.f, v[i + 1] * 32.f, w, false); w = __builtin_amdgcn_cvt_pk_fp8_f32(v[i + 2] * 32.f, v[i + 3] * 32.f, w, true); t[c] = w; }
            *(GAS v4u*)(dp + 16 * q) = (v4u){(unsigned)t[0], (unsigned)t[1], (unsigned)t[2], (unsigned)t[3]}; }
    } else {
#pragma unroll
        for (int q = 0; q < 8; ++q) { const int i = 8 * q; v4u o; o.x = pk2(v[i], v[i + 1]); o.y = pk2(v[i + 2], v[i + 3]); o.z = pk2(v[i + 4], v[i + 5]); o.w = pk2(v[i + 6], v[i + 7]);
            *(GAS v4u*)(dp + 16 * q) = o; }
    }
}
__device__ __forceinline__ void convert_ffn_slice(const Site& P, int l, int slice) {
    const bool moe = (l & 1) != 0; const int li = l >> 1, lane = P.lane;
    if (!moe) {
        constexpr int I13 = 16 * (2 * DFF / 64), I2 = (DFF / 64) * 16;
        const int it = slice * 8 + P.wave; if (it >= I13 + I2) return;
        const float* w1 = P.in[18] + (size_t)li * D * DFF; const float* w3 = P.in[19] + (size_t)li * D * DFF; const float* w2 = P.in[20] + (size_t)li * DFF * D;
        const bool d8 = l >= DENSE8_FROM;
        unsigned char* W13 = P.ws + WS_WFF; unsigned char* W2 = P.ws + WS_WFF + (d8 ? WFF8_W2_DENSE : WFF_W2_DENSE);
        const float* sp; size_t ss; size_t doff; unsigned char* db;
        if (it < I13) { const int kb = it / (2 * DFF / 64), nb = it % (2 * DFF / 64); const int p = 64 * nb + lane; const int ch = (p >> 8) * 128 + (p & 127);
            sp = (((p >> 7) & 1) ? w3 : w1) + (size_t)(64 * kb) * DFF + ch; ss = DFF; db = W13; doff = (size_t)p * D + 64 * kb; }
        else { const int r = it - I13; const int kb = r / 16, nb = r % 16; const int n = 64 * nb + lane;
            sp = w2 + (size_t)(64 * kb) * D + n; ss = D; db = W2; doff = (size_t)n * DFF + 64 * kb; }
        if (d8) convert_block64<true>(sp, ss, db + doff); else convert_block64<false>(sp, ss, db + 2 * doff);
    } else {
        constexpr int I13 = 16 * (2 * DFFE / 64), I2 = (DFFE / 64) * 16, IE = I13 + I2;
        for (int j = 0; j < 2; ++j) { const int it = slice * 16 + j * 8 + P.wave; if (it >= 8 * IE) break;
            const int e = it / IE; const int r = it - e * IE;
            const float* w1 = P.in[22] + ((size_t)li * NEXP + e) * D * DFFE; const float* w3 = P.in[23] + ((size_t)li * NEXP + e) * D * DFFE; const float* w2 = P.in[24] + ((size_t)li * NEXP + e) * DFFE * D;
            unsigned char* W13 = P.ws + WS_WFF + (size_t)e * WFF8_W13_E; unsigned char* W2 = P.ws + WS_WFF + WFF8_W2_OFF + (size_t)e * WFF8_W2_E;
            const float* sp; size_t ss; unsigned char* dp;
            if (r < I13) { const int kb = r / (2 * DFFE / 64), nb = r % (2 * DFFE / 64); const int p = 64 * nb + lane; const int ch = (p >> 8) * 128 + (p & 127);
                sp = (((p >> 7) & 1) ? w3 : w1) + (size_t)(64 * kb) * DFFE + ch; ss = DFFE; dp = W13 + (size_t)p * D + 64 * kb; }
            else { const int r2 = r - I13; const int kb = r2 / 16, nb = r2 % 16; const int n = 64 * nb + lane;
                sp = w2 + (size_t)(64 * kb) * D + n; ss = D; dp = W2 + (size_t)n * DFFE + 64 * kb; }
            convert_block64<true>(sp, ss, dp); }
    }
}
__device__ __forceinline__ void convert_layer_weights(const Frame& F, const Site& P, int l) {
    LAS float* scr = (LAS float*)(F.lds + RING_OFF + P.wave * 16384);
    const int gw = F.vcu * NWAVES + P.wave, NGW = F.G * NWAVES, lane = P.lane;
    bf16* WIN = (bf16*)(P.ws + WS_WIN); bf16* WBR = (bf16*)(P.ws + WS_WBR); bf16* WOUT = (bf16*)(P.ws + WS_WOUT);
    const float* w_in = P.in[2] + (size_t)l * D * IN_COLS;
    const float* w_brc = P.in[14] + (size_t)l * 256 * D; const float* w_bra = P.in[15] + (size_t)l * 512 * D; const float* w_out = P.in[16] + (size_t)l * D * D;
    constexpr int I_IN = 16 * (NIN / 32), I_BC = 4 * 32, I_BA = 8 * 32, I_OUT = 16 * 32;
    const int NITEMS = I_IN + I_BC + I_BA + I_OUT;
    for (int it = gw; it < NITEMS; it += NGW) {
        int r = it;
        if (r < I_IN) { const int kb = r / (NIN / 32), nb = r % (NIN / 32); const int p = 32 * nb + (lane & 31);
            if (nb < 2304 / 32) transpose_item(w_in + inproj_src_col(p), IN_COLS, WIN, D, 32 * nb, 64 * kb, scr, lane);
            else transpose_item8(w_in + inproj_src_col(p), IN_COLS, P.ws + WS_WG8, D, 32 * nb - 2304, 64 * kb, scr, lane, 32.f * LOG2E);
            continue; } r -= I_IN;
        if (r < I_BC) { const int kb = r / 32, nb = r % 32;
            transpose_item(w_brc + 32 * nb + (lane & 31), D, WBR + 256, D, 32 * nb, 64 * kb, scr, lane); continue; } r -= I_BC;
        if (r < I_BA) { const int kb = r / 32, nb = r % 32;
            transpose_item(w_bra + 32 * nb + (lane & 31), D, WBR + 512, D, 32 * nb, 64 * kb, scr, lane); continue; } r -= I_BA;
        if (r < I_OUT) { const int kb = r / 32, nb = r % 32;
            transpose_item(w_out + 32 * nb + (lane & 31), D, WOUT, D, 32 * nb, 64 * kb, scr, lane); }
    }
    {
        const float* pw = P.in[5] + (size_t)l * 4 * 64 * 64; const float* ps = P.in[6] + (size_t)l * 256; const float* wbp = P.in[13] + (size_t)l * 256 * D;
        const int gt = F.vcu * (NWAVES * 64) + P.tid, NT = F.G * NWAVES * 64;
        for (int item = gt; item < 1024 * 32; item += NT) {
            const int n = item & 1023, kb = item >> 10, k0 = 8 * kb, g = k0 >> 6, c0 = k0 & 63;
            float a[8];
#pragma unroll
            for (int j = 0; j < 8; ++j) a[j] = 0.f;
            for (int cp = 0; cp < 64; ++cp) { const float wv = ps[g * 64 + cp] * wbp[(size_t)(g * 64 + cp) * D + n];
#pragma unroll
                for (int j = 0; j < 8; ++j) a[j] += pw[(size_t)(g * 64 + c0 + j) * 64 + cp] * wv; }
            v4u o; o.x = pk2(a[0], a[1]); o.y = pk2(a[2], a[3]); o.z = pk2(a[4], a[5]); o.w = pk2(a[6], a[7]);
            *(GAS v4u*)(WBR + (size_t)n * D + k0) = o;
        }
    }
}

template <bool XBF> struct RowRaw;
template <> struct RowRaw<false> { f32x4 a[4]; };
template <> struct RowRaw<true> { v4u a[2]; };
template <bool XBF> __device__ __forceinline__ RowRaw<XBF> load_row(const void* xsrc, int row, int lane) {
    RowRaw<XBF> r;
    if constexpr (XBF) { const GAS v4u* p = (const GAS v4u*)((const bf16*)xsrc + (size_t)row * D) + lane; r.a[0] = p[0]; r.a[1] = p[64]; }
    else { const GAS f32x4* p = (const GAS f32x4*)((const float*)xsrc + (size_t)row * D) + 2 * lane;
#pragma unroll
        for (int j = 0; j < 4; ++j) r.a[j] = p[128 * (j >> 1) + (j & 1)]; }
    return r;
}
template <bool XBF> __device__ __forceinline__ void unpack_row(const RowRaw<XBF>& r, f32x4 (&v)[4]) {
    if constexpr (XBF) {
#pragma unroll
        for (int j2 = 0; j2 < 2; ++j2) { const v4u w = r.a[j2]; v[2 * j2] = (f32x4){bflo(w.x), bfhi(w.x), bflo(w.y), bfhi(w.y)}; v[2 * j2 + 1] = (f32x4){bflo(w.z), bfhi(w.z), bflo(w.w), bfhi(w.w)}; } }
    else {
#pragma unroll
        for (int j = 0; j < 4; ++j) v[j] = r.a[j]; }
}
#ifndef NORM_AHEAD
#define NORM_AHEAD 4
#endif
template <int MODE, bool XBF, bool H8 = (MODE == 2)>
__device__ __forceinline__ void norm_phase(const Frame& F, const Site& P, const void* xsrc, const float* gvec, const float* w8, size_t w8stride, const float* b8, unsigned* gcnt) {
    const int lane = P.lane;
    bf16* HB = (bf16*)(P.ws + WS_HB);
    int kb[4];
#pragma unroll
    for (int j = 0; j < 4; ++j) kb[j] = 8 * lane + 512 * (j >> 1) + 4 * (j & 1);
    f32x4 gv[4];
#pragma unroll
    for (int j = 0; j < 4; ++j) gv[j] = *(const f32x4*)(gvec + kb[j]);
    LAS unsigned* lcnt = (LAS unsigned*)(F.lds + RING_OFF);
    LAS float* wfs = (LAS float*)(F.lds + RING_OFF + 1024);
    if constexpr (MODE != 1) {
        for (int idx = P.tid; idx < 8 * D; idx += NWAVES * 64) { const int k = idx >> 3, h = idx & 7; wfs[h * D + k] = w8[(size_t)k * w8stride + h] * gvec[k]; }
        __syncthreads();
    }
    float* NLF = (float*)(P.ws + WS_NLF);
    unsigned* list = (unsigned*)(P.ws + WS_LIST); float* moew = (float*)(P.ws + WS_MOEW);
    for (int rb = F.vcu; rb < M / 256; rb += F.G) {
        const int row0 = rb * 256 + P.wave * 32;
        if constexpr (MODE == 2) { if (P.tid < 32) lcnt[P.tid] = 0u; __syncthreads(); }
        int my_e0 = 0, my_e1 = 0; float my_w0 = 0.f, my_w1 = 0.f;
        float nacc = 0.f; float b8h = 0.f; if constexpr (MODE == 0) b8h = b8[lane >> 3];
        constexpr int AH = XBF ? NORM_AHEAD : 2;
        RowRaw<XBF> nr[AH];
#pragma unroll
        for (int a = 0; a < AH; ++a) nr[a] = load_row<XBF>(xsrc, row0 + a, lane);
#pragma unroll 1
        for (int i = 0; i < 32; ++i) {
            f32x4 v[4]; float s = 0.f;
            { unpack_row<XBF>(nr[0], v);
#pragma unroll
              for (int a = 0; a + 1 < AH; ++a) nr[a] = nr[a + 1];
              nr[AH - 1] = load_row<XBF>(xsrc, row0 + (i + AH < 32 ? i + AH : 31), lane); }
            {
            const int row = row0 + i;
#pragma unroll
            for (int j = 0; j < 4; ++j) s += (v[j].x * v[j].x + v[j].y * v[j].y) + (v[j].z * v[j].z + v[j].w * v[j].w);
            const float rstd = __builtin_amdgcn_rsqf(wave_sum(s, lane) * (1.f / D) + 1e-6f);
            {
                v2u q8[2];
#pragma unroll
                for (int j2 = 0; j2 < 2; ++j2) { const f32x4 a = v[2 * j2] * rstd * gv[2 * j2], b = v[2 * j2 + 1] * rstd * gv[2 * j2 + 1];
                    if constexpr (H8 || MODE == 0) { int lo = 0, hi = 0;
                        lo = __builtin_amdgcn_cvt_pk_fp8_f32(a.x, a.y, lo, false); lo = __builtin_amdgcn_cvt_pk_fp8_f32(a.z, a.w, lo, true);
                        hi = __builtin_amdgcn_cvt_pk_fp8_f32(b.x, b.y, hi, false); hi = __builtin_amdgcn_cvt_pk_fp8_f32(b.z, b.w, hi, true);
                        q8[j2] = (v2u){(unsigned)lo, (unsigned)hi}; }
                    if constexpr (!H8) *((GAS v4u*)(HB + (size_t)row * D) + lane + 64 * j2) = (v4u){pk2(a.x, a.y), pk2(a.z, a.w), pk2(b.x, b.y), pk2(b.z, b.w)}; }
                if constexpr (H8 || MODE == 0) {
                    unsigned char* r8 = (H8 ? (unsigned char*)HB : P.ws + WS_H8) + (size_t)row * D;
                    const bool odd = (lane & 1) != 0;
                    const unsigned s0 = odd ? q8[0].x : q8[1].x, s1 = odd ? q8[0].y : q8[1].y;
                    const unsigned g0 = (unsigned)__builtin_amdgcn_update_dpp(0, (int)s0, 0xB1, 0xF, 0xF, true), g1 = (unsigned)__builtin_amdgcn_update_dpp(0, (int)s1, 0xB1, 0xF, 0xF, true);
                    const v4u o = odd ? (v4u){g0, g1, q8[1].x, q8[1].y} : (v4u){q8[0].x, q8[0].y, g0, g1};
                    *(GAS v4u*)(r8 + (odd ? 512 : 0) + 8 * (lane & ~1)) = o; }
            }
            if constexpr (MODE != 1) {
                float f[8];
#pragma unroll
                for (int h = 0; h < 8; ++h) { f32x4 fa = v[0] * *(const LAS f32x4*)(wfs + h * D + kb[0]);
#pragma unroll
                    for (int j = 1; j < 4; ++j) fa += v[j] * *(const LAS f32x4*)(wfs + h * D + kb[j]);
                    f[h] = (fa[0] + fa[1]) + (fa[2] + fa[3]); }
                float red;
                { const bool b5 = (lane & 32) != 0, b4 = (lane & 16) != 0, b3 = (lane & 8) != 0;
#define XCH32(v) __int_as_float(__builtin_amdgcn_ds_bpermute((lane ^ 32) << 2, __float_as_int(v)))
#define XCH16(v) __int_as_float(__builtin_amdgcn_ds_bpermute((lane ^ 16) << 2, __float_as_int(v)))
#define XCH8(v) __int_as_float(__builtin_amdgcn_update_dpp(0, __float_as_int(v), 0x128, 0xF, 0xF, true))
                  float g4[4];
#pragma unroll
                  for (int j = 0; j < 4; ++j) { const float send = b5 ? f[j] : f[4 + j], keep = b5 ? f[4 + j] : f[j]; g4[j] = keep + XCH32(send); }
                  float g2[2];
#pragma unroll
                  for (int j = 0; j < 2; ++j) { const float send = b4 ? g4[j] : g4[2 + j], keep = b4 ? g4[2 + j] : g4[j]; g2[j] = keep + XCH16(send); }
                  { const float send = b3 ? g2[0] : g2[1], keep = b3 ? g2[1] : g2[0]; red = keep + XCH8(send); }
                  red += __int_as_float(__builtin_amdgcn_update_dpp(0, __float_as_int(red), 0xB1, 0xF, 0xF, true));
                  red += __int_as_float(__builtin_amdgcn_update_dpp(0, __float_as_int(red), 0x4E, 0xF, 0xF, true));
                  red += __int_as_float(__builtin_amdgcn_update_dpp(0, __float_as_int(red), 0x141, 0xF, 0xF, true));
#undef XCH32
#undef XCH16
#undef XCH8

                  red *= rstd; }
                if constexpr (MODE == 0) {
                    const float z = red + b8h;
                    const float spv = fmaxf(-z, 0.f) * LOG2E + __builtin_amdgcn_logf(1.0f + __builtin_amdgcn_exp2f(-fabsf(z) * LOG2E));
                    const float tv = __int_as_float(__builtin_amdgcn_ds_bpermute((8 * (lane & 7)) << 2, __float_as_int(spv)));
                    if ((lane >> 3) == (i & 7)) nacc = tv;
                    if ((i & 7) == 7) NLF[(size_t)(row - 7) * 8 + lane] = nacc;
                } else {
#pragma unroll
                    for (int h = 0; h < 8; ++h) f[h] = __int_as_float(__builtin_amdgcn_readlane(__float_as_int(red), 8 * h));
                    int e0 = 0; float v0 = f[0];
#pragma unroll
                    for (int h = 1; h < 8; ++h) if (f[h] > v0) { v0 = f[h]; e0 = h; }
                    int e1 = (e0 == 0) ? 1 : 0; float v1 = -INFINITY;
#pragma unroll
                    for (int h = 0; h < 8; ++h) if (h != e0 && f[h] > v1) { v1 = f[h]; e1 = h; }
                    const float w0 = __builtin_amdgcn_rcpf(1.0f + __builtin_amdgcn_exp2f((v1 - v0) * LOG2E));
                    if (lane == i) { my_e0 = e0; my_e1 = e1; my_w0 = w0; my_w1 = 1.0f - w0; }
                }
            }
            }
        }
        if constexpr (MODE == 2) {
            unsigned p0 = 0, p1 = 0;
            if (lane < 32) { p0 = __hip_atomic_fetch_add(&lcnt[my_e0], 1u, __ATOMIC_RELAXED, __HIP_MEMORY_SCOPE_WORKGROUP); p1 = __hip_atomic_fetch_add(&lcnt[8 + my_e1], 1u, __ATOMIC_RELAXED, __HIP_MEMORY_SCOPE_WORKGROUP);
                moew[row0 + lane] = my_w0; moew[M + row0 + lane] = my_w1; }
            __syncthreads();
            if (P.tid < 16) lcnt[16 + P.tid] = __hip_atomic_fetch_add(gcnt + P.tid, lcnt[P.tid], RLX_AGENT);
            __syncthreads();
            if (lane < 32) { list[(size_t)my_e0 * M + lcnt[16 + my_e0] + p0] = (unsigned)(row0 + lane); list[(size_t)(8 + my_e1) * M + lcnt[24 + my_e1] + p1] = (unsigned)(row0 + lane); }
            __syncthreads();
        }
    }
}

__device__ __forceinline__ void scan_phase(const Frame& F, const Site& P) {
    const float* NLF = (const float*)(P.ws + WS_NLF); float* NCL = (float*)(P.ws + WS_NCL);
    LAS float* wt = (LAS float*)(F.lds + RING_OFF);
    for (int seq = F.vcu; seq < BATCH * 8; seq += F.G) {
        const int b = seq >> 3, h = seq & 7, t0 = P.tid * 16;
        float v[16]; float s = 0.f;
#pragma unroll
        for (int i = 0; i < 16; ++i) { v[i] = NLF[((size_t)b * SEQ + t0 + i) * 8 + h]; s += v[i]; v[i] = s; }
        float incl = s;
#pragma unroll
        for (int o = 1; o < 64; o <<= 1) { const float up = __int_as_float(__builtin_amdgcn_ds_bpermute((P.lane - o) << 2, __float_as_int(incl))); if (P.lane >= o) incl += up; }
        if (P.lane == 63) wt[P.wave] = incl;
        __syncthreads();
        float base = incl - s;
        for (int w = 0; w < P.wave; ++w) base += wt[w];
        float* dst = NCL + (size_t)seq * SEQ + t0;
#pragma unroll
        for (int i = 0; i < 16; i += 4) *(f32x4*)(dst + i) = (f32x4){base + v[i], base + v[i + 1], base + v[i + 2], base + v[i + 3]};
        __syncthreads();
    }
}

__device__ __forceinline__ void store_row_pair(bf16* base, int lane, v2u ra, v2u rb) {
    const bool odd = (lane & 1) != 0;
    const unsigned s0 = odd ? ra.x : rb.x, s1 = odd ? ra.y : rb.y;
    const unsigned g0 = (unsigned)__builtin_amdgcn_update_dpp(0, (int)s0, 0xB1, 0xF, 0xF, true), g1 = (unsigned)__builtin_amdgcn_update_dpp(0, (int)s1, 0xB1, 0xF, 0xF, true);
    const v4u o = odd ? (v4u){g0, g1, rb.x, rb.y} : (v4u){ra.x, ra.y, g0, g1};
    *(GAS v4u*)(base + (size_t)(odd ? 1024 : 0) + 4 * (lane & ~1)) = o;
}
__device__ __forceinline__ void poolconv_phase(const Frame& F, const Site& P, int l) {
    const int lane = P.lane;
    const bf16* PIN = (const bf16*)(P.ws + WS_P); const bf16* Z = (const bf16*)(P.ws + WS_Z); bf16* Y = (bf16*)(P.ws + WS_Y);
    const float* cw = P.in[7] + (size_t)l * CONVK * 256; const float* cb = P.in[8] + (size_t)l * 256; const float* lg = P.in[9] + (size_t)l * 256; const float* lb = P.in[10] + (size_t)l * 256;
    f32x4 w[CONVK];
#pragma unroll
    for (int j = 0; j < CONVK; ++j) w[j] = *(const f32x4*)(cw + j * 256 + 4 * lane);
    const f32x4 cbv = *(const f32x4*)(cb + 4 * lane), lgv = *(const f32x4*)(lg + 4 * lane), lbv = *(const f32x4*)(lb + 4 * lane);
    LAS unsigned char* zt = F.lds + RING_OFF;
    const int pw = 2 << (lane >> 4);
#if defined(DBG_COPY)
    for (int ch = F.vcu; ch < M / 128; ch += F.G) { const int r0 = ch * 128;
        for (int i = 0; i < 16; ++i) { const int row = r0 + 16 * P.wave + i;
            *(GAS v2u*)(Y + (size_t)row * 1024 + 4 * lane) = *(const GAS v2u*)(PIN + (size_t)row * 256 + 4 * lane);
            *(GAS v2u*)(Y + (size_t)row * 1024 + 256 + 4 * lane) = *(const GAS v2u*)(Z + (size_t)row * 256 + 4 * lane); } }
    return;
#endif
    for (int ch = F.vcu; ch < M / 128; ch += F.G) {
        const int r0 = ch * 128; const int tseq0 = r0 & (SEQ - 1);
        { v4u sv[10];
#pragma unroll
          for (int k = 0; k < 10; ++k) { const int p0 = P.tid + k * (NWAVES * 64); const int p = p0 < 158 * 32 ? p0 : 158 * 32 - 1; const int lr = p >> 5, c16 = p & 31; const int tr = tseq0 - 30 + lr;
              const int lrc = tr >= 0 ? lr : 30;
              sv[k] = *(const GAS v4u*)(Z + (size_t)(r0 - 30 + lrc) * 256 + c16 * 8);
              if (tr < 0) sv[k] = (v4u){0u, 0u, 0u, 0u}; }
#pragma unroll
          for (int k = 0; k < 10; ++k) { const int p = P.tid + k * (NWAVES * 64); if (p < 158 * 32) *(LAS v4u*)(zt + (p >> 5) * 512 + (p & 31) * 16) = sv[k]; } }
        __syncthreads();
#if defined(DBG_POOLCOPY)
        for (int i = 0; i < 16; ++i) { const int row = r0 + 16 * P.wave + i; *(GAS v2u*)(Y + (size_t)row * 1024 + 4 * lane) = *(const GAS v2u*)(PIN + (size_t)row * 256 + 4 * lane); }
        if (false)
#endif
        { const int rw = r0 + 16 * P.wave, tw = tseq0 + 16 * P.wave;
          auto ldp = [&](int rrow) -> f32x4 { const v2u q = *(const GAS v2u*)(PIN + (size_t)rrow * 256 + 4 * lane); return (f32x4){bflo(q.x), bfhi(q.x), bflo(q.y), bfhi(q.y)}; };
          f32x4 s = (f32x4){0.f, 0.f, 0.f, 0.f};
#pragma unroll
          for (int d = 1; d < 16; ++d) { const int dd = d <= tw ? d : tw; const float mk = (d < pw && d <= tw) ? 1.0f : 0.0f; s += ldp(rw - dd) * mk; }
          v2u ovp = (v2u){0u, 0u};
#pragma unroll
          for (int i = 0; i < 16; ++i) { const int t = tw + i;
              const f32x4 cur = ldp(rw + i);
              s += cur;
              const float inv = 1.0f / (float)((t + 1) < pw ? (t + 1) : pw);
              const f32x4 o = s * inv - cur;
              v2u ov; ov.x = pk2(o[0], o[1]); ov.y = pk2(o[2], o[3]);
              if (i & 1) store_row_pair(Y + (size_t)(rw + i - 1) * 1024, lane, ovp, ov); else ovp = ov;
              const int told = t - pw + 1; const int back = told >= 0 ? pw - 1 : t;
              s -= ldp(rw + i - back) * (told >= 0 ? 1.0f : 0.0f); } }
#if defined(DBG_CONVCOPY)
        for (int i = 0; i < 16; ++i) { const int row = r0 + 16 * P.wave + i; *(GAS v2u*)(Y + (size_t)row * 1024 + 256 + 4 * lane) = *(const GAS v2u*)(Z + (size_t)row * 256 + 4 * lane); }
        if (false)
#endif
        for (int grp = 0; grp < 4; ++grp) {
            const int lr0 = 16 * P.wave + 4 * grp;
            f32x4 a[4];
#pragma unroll
            for (int o = 0; o < 4; ++o) a[o] = cbv;
#pragma unroll
            for (int jj = 0; jj < CONVK + 3; ++jj) {
                const v2u q = *(const LAS v2u*)(zt + (lr0 + jj) * 512 + lane * 8); const f32x4 z = (f32x4){bflo(q.x), bfhi(q.x), bflo(q.y), bfhi(q.y)};
#pragma unroll
                for (int o = 0; o < 4; ++o) { const int j = jj - o; if (j >= 0 && j < CONVK) a[o] += w[j] * z; }
            }
            v2u ovc = (v2u){0u, 0u};
#pragma unroll
            for (int o = 0; o < 4; ++o) {
                const float mu = wave_sum((a[o][0] + a[o][1]) + (a[o][2] + a[o][3]), lane) * (1.f / 256.f);
                const f32x4 dv = a[o] - mu;
                const float var = wave_sum((dv[0] * dv[0] + dv[1] * dv[1]) + (dv[2] * dv[2] + dv[3] * dv[3]), lane) * (1.f / 256.f);
                const float rs = __builtin_amdgcn_rsqf(var + 1e-6f);
                f32x4 y = dv * rs * lgv + lbv;
#pragma unroll
                for (int c = 0; c < 4; ++c) y[c] = y[c] * __builtin_amdgcn_rcpf(1.0f + __builtin_amdgcn_exp2f(-1.4426950408889634f * y[c]));
                v2u ov; ov.x = pk2(y[0], y[1]); ov.y = pk2(y[2], y[3]);
                if (o & 1) store_row_pair(Y + (size_t)(r0 + lr0 + o - 1) * 1024 + 256, lane, ovc, ov); else ovc = ov;
            }
        }
        __syncthreads();
    }
}

#ifndef DBG_MAXPHASE
#define DBG_MAXPHASE 1000
#endif
#ifndef ONLY_SITE
#define ONLY_SITE -1
#endif
#ifndef DBL_MASK
#define DBL_MASK 0
#endif
#define DBL(k) for (int rep_ = 0; rep_ < (((DBL_MASK >> (k)) & 1) ? 2 : 1); ++rep_)
#ifndef SITE_OFF_MASK
#define SITE_OFF_MASK 0
#endif
#define SITE(k) ((ONLY_SITE < 0 || ONLY_SITE == (k)) && !((SITE_OFF_MASK >> (k)) & 1))
#ifndef STAGGER_TICKS
#define STAGGER_TICKS 1500
#endif
constexpr int NPH = 10;
struct Args { const float* in[25]; float* out; unsigned char* ws; int ph_lo, ph_hi; };

struct FfnConvHook { const Site* P; int l; __device__ __forceinline__ void operator()(int b, int u) const { convert_ffn_slice(*P, l, u * 8 + b); } };

__global__ void __launch_bounds__(NWAVES * 64, 2) trunk_fwd(Args args) {
    extern __shared__ __attribute__((aligned(16))) unsigned char lds[];
    Frame F;
    F.lds = (LAS unsigned char*)lds;
    F.MISC = (volatile LAS unsigned*)(F.lds + MISC_OFF);
    F.G = gridDim.x; { const int bx = blockIdx.x; F.vcu = (F.G % 8 == 0) ? (bx % 8) * (F.G / 8) + bx / 8 : bx; }
    for (int u = threadIdx.x; u < (LDS_BYTES - LDSCTL_OFF) / 4; u += NWAVES * 64) ((LAS unsigned*)(F.lds + LDSCTL_OFF))[u] = 0u;
    __syncthreads();
    XcdBarrier bar; bar.bar = (unsigned*)((gu32*)(args.ws + WS_CTL) + CW_BAR); bar.x = 0; bar.st = nullptr;
    if (!MK_PER_PHASE) bar = xcd_barrier_post((unsigned*)((gu32*)(args.ws + WS_CTL) + CW_BAR), F.MISC + 8);
    const int lo = args.ph_lo, hi = args.ph_hi;
#define IN(k) (lo <= (k) && (k) < hi)
#define SEAM(k) do { if (IN(k) && IN((k) + 1)) { if (MK_PER_PHASE) { if (threadIdx.x == 0) __hip_atomic_store((gu32*)(args.ws + WS_CTL) + CW_TMO, 0xBADBA0u, RLX_AGENT); } else xcd_barrier(bar); } } while (0)

#define WSB(off) ((bf16*)(P.ws + (off)))
#define INP(k) (P.in[k])
#define XBD() ((bf16*)P.out)
#define XBW() WSB(WS_XBW)
    const int cgemm = (int)blockIdx.x;

    for (int l = 0; l < DEPTH; ++l) {
        const int pb = l * NPH;
        const bool moe = (l & 1) != 0; const int li = l >> 1;

        if (IN(pb + 0)) { const Site P = make_site();
            DBL(0) if constexpr (SITE(0)) convert_layer_weights(F, P, l);
#if defined(DBG_FILLG)
            { v4u fv = (v4u){0x3f003f00u, 0x3f003f00u, 0x3f003f00u, 0x3f003f00u}; GAS v4u* gp = (GAS v4u*)WSB(WS_G);
              for (size_t i = (size_t)blockIdx.x * 512 + P.tid; i < (size_t)M * 3072 / 8; i += (size_t)F.G * 512) gp[i] = fv; }
#endif
            __syncthreads();
            if constexpr (SITE(1)) { if (l == 0) norm_phase<0, false>(F, P, INP(0), INP(1) + (size_t)l * D, INP(2) + (size_t)l * D * IN_COLS + OFF_F, IN_COLS, INP(4) + (size_t)l * 8, nullptr);
                else norm_phase<0, true>(F, P, XBD(), INP(1) + (size_t)l * D, INP(2) + (size_t)l * D * IN_COLS + OFF_F, IN_COLS, INP(4) + (size_t)l * 8, nullptr); }
        }
        SEAM(pb + 0);

        if (IN(pb + 1)) { const Site P = make_site();
#if !defined(DBG_NOSCAN)
            if constexpr (SITE(2)) scan_phase(F, P);
#endif
            LAS float* bl = (LAS float*)(F.lds + GBIAS_OFF); LAS float* gl = bl + 3 * D;
            for (int i = P.tid; i < 3 * D; i += NWAVES * 64) bl[i] = INP(3)[(size_t)l * 3 * D + i] * LOG2E;
            if (P.tid < 128) gl[P.tid] = P.tid < 64 ? INP(11)[(size_t)l * 64 + P.tid] : INP(12)[(size_t)l * 64 + P.tid - 64];
            __syncthreads();
            {
                pg8::Gemm g{WSB(WS_HB), WSB(WS_WIN), D, 0, nullptr, 0};
                pg8::SchedPlain S{M / 256, 2304 / 256, F.G, cgemm, D / 64};
                pg8::EpiInProj E{WSB(WS_P), WSB(WS_Z), WSB(WS_Y) + 512, WSB(WS_K), WSB(WS_V), (const LAS float*)gl, (const LAS float*)(gl + 64)};
                if constexpr (SITE(3)) pg8::gemm_phase<pg8::EpiInProj, pg8::SchedPlain, true, false>(F.lds + RING_OFF, g, S, E);
            }
            {   pg8::Gemm g8{(const bf16*)(P.ws + WS_H8), (const bf16*)(P.ws + WS_WG8), D / 2, 0, nullptr, 0};
                pg8::SchedPlain S8{M / 256, 3072 / 256, F.G, cgemm, D / 128};
                pg8::EpiGate E8{P.ws + WS_G, (const LAS float*)bl};
                if constexpr (SITE(3)) pg8::gemm_phase<pg8::EpiGate, pg8::SchedPlain, true, false, true>(F.lds + RING_OFF, g8, S8, E8);
            }
        }
        SEAM(pb + 1);

        if (IN(pb + 2)) { const Site P = make_site();
            DBL(4) if constexpr (SITE(4)) poolconv_phase(F, P, l);
#if defined(DBG_FENCE)
            asm volatile("s_waitcnt vmcnt(0)" ::: "memory"); __threadfence_system(); asm volatile("s_waitcnt vmcnt(0)" ::: "memory");
#endif
            const attn_body::AttnTensors AT{(const attn_body::bf16*)(WSB(WS_Y) + 512), (const attn_body::bf16*)WSB(WS_K), (const attn_body::bf16*)WSB(WS_V), (attn_body::bf16*)(WSB(WS_Y) + 512), (const float*)(P.ws + WS_NCL)};
            float gq = fabsf(INP(11)[(size_t)l * 64 + P.lane]), gk = fabsf(INP(12)[(size_t)l * 64 + P.lane]);
#pragma unroll
            for (int o = 1; o < 64; o <<= 1) { gq = fmaxf(gq, __int_as_float(__builtin_amdgcn_ds_bpermute((P.lane ^ o) << 2, __float_as_int(gq)))); gk = fmaxf(gk, __int_as_float(__builtin_amdgcn_ds_bpermute((P.lane ^ o) << 2, __float_as_int(gk)))); }
            const float th = 2.0f * (64.0f * gq * gk * pg8::ATT_C2 * 1.02f) + 38.0f;
            const attn_body::AttnQueue Qd{(unsigned*)(P.ctl + CW_ATTQ + l * 8 * 64), __int_as_float(__builtin_amdgcn_readfirstlane(__float_as_int(th))), (int)(xb_xcc_id() & 7u), F.MISC + 16};
            const FfnConvHook hook{&P, l};
            if constexpr (SITE(5)) attn_body::attn_phase_dyn<8>((char*)lds + RING_OFF, AT, Qd, hook);
        }
        SEAM(pb + 2);

        if (IN(pb + 3)) { const Site P = make_site();
            pg8::Gemm g{WSB(WS_Y), WSB(WS_WBR), D, 0, nullptr, 0};
#if defined(DBG_MERGE1)
            pg8::SchedPlain S{M / 256, D / 256, F.G, cgemm, D / 64};
#else
            pg8::SchedMerge S{M / 256, D / 256, F.G, cgemm};
#endif
            pg8::EpiMerge E{P.ws + WS_G, WSB(WS_HB)};
#if defined(DBG_MERGE1)
            if constexpr (SITE(6)) pg8::gemm_phase<pg8::EpiMerge, pg8::SchedPlain, true, false>(F.lds + RING_OFF, g, S, E);
#else
            DBL(6) if constexpr (SITE(6)) pg8::gemm_phase<pg8::EpiMerge, pg8::SchedMerge, true, false>(F.lds + RING_OFF, g, S, E);
#endif
        }
        SEAM(pb + 3);

        if (IN(pb + 4)) { const Site P = make_site();
            pg8::Gemm g{WSB(WS_HB), WSB(WS_WOUT), D, 0, nullptr, 0};
            pg8::SchedPlain S{M / 256, D / 256, F.G, cgemm, D / 64};
            bf16* xdst = (l == DEPTH - 1) ? XBW() : XBD();
            if constexpr (SITE(7)) { if (l == 0) { pg8::EpiResid<true> E{INP(0), xdst}; pg8::gemm_phase<pg8::EpiResid<true>, pg8::SchedPlain, true, false>(F.lds + RING_OFF, g, S, E); }
                else { pg8::EpiResid<false> E{XBD(), xdst}; pg8::gemm_phase<pg8::EpiResid<false>, pg8::SchedPlain, true, false>(F.lds + RING_OFF, g, S, E); } }
        }
        SEAM(pb + 4);

        if (IN(pb + 5)) { const Site P = make_site();
            const bf16* xcur = (l == DEPTH - 1) ? XBW() : XBD();
            if constexpr (SITE(8)) { if (!moe && l >= DENSE8_FROM) norm_phase<1, true, true>(F, P, xcur, INP(17) + (size_t)l * D, nullptr, 0, nullptr, nullptr);
            else if (!moe) norm_phase<1, true, false>(F, P, xcur, INP(17) + (size_t)l * D, nullptr, 0, nullptr, nullptr);
            else norm_phase<2, true>(F, P, xcur, INP(17) + (size_t)l * D, INP(21) + (size_t)li * D * NEXP, NEXP, nullptr, (unsigned*)(P.ctl + CW_MOECNT + 64 * li)); }
        }
        SEAM(pb + 5);

        if (!moe) {
            if (IN(pb + 6)) { const Site P = make_site();
                if (l >= DENSE8_FROM) {
                pg8::Gemm g{WSB(WS_HB), WSB(WS_WFF), D / 2, 0, nullptr, 0};
                pg8::SchedPlain S{M / 256, 2 * DFF / 256, F.G, cgemm, D / 128};
                pg8::EpiSwiGLU8 E{P.ws + WS_HID, DFF};
                if constexpr (SITE(9)) pg8::gemm_phase<pg8::EpiSwiGLU8, pg8::SchedPlain, true, false, true>(F.lds + RING_OFF, g, S, E);
                } else {
                pg8::Gemm g{WSB(WS_HB), WSB(WS_WFF), D, 0, nullptr, 0};
                pg8::SchedPlain S{M / 256, 2 * DFF / 256, F.G, cgemm, D / 64};
                pg8::EpiSwiGLU E{WSB(WS_HID), DFF};
                if constexpr (SITE(9)) pg8::gemm_phase<pg8::EpiSwiGLU, pg8::SchedPlain, true, false>(F.lds + RING_OFF, g, S, E);
                }
            }
            SEAM(pb + 6);
            if (IN(pb + 7)) { const Site P = make_site();
                pg8::EpiResid<false> E{XBD(), XBD()};
                if (l >= DENSE8_FROM) {
                pg8::Gemm g{WSB(WS_HID), WSB(WS_WFF + WFF8_W2_DENSE), DFF / 2, 0, nullptr, 0};
                pg8::SchedPlain S{M / 256, D / 256, F.G, cgemm, DFF / 128};
                if constexpr (SITE(10)) pg8::gemm_phase<pg8::EpiResid<false>, pg8::SchedPlain, true, false, true>(F.lds + RING_OFF, g, S, E);
                } else {
                pg8::Gemm g{WSB(WS_HID), WSB(WS_WFF + WFF_W2_DENSE), DFF, 0, nullptr, 0};
                pg8::SchedPlain S{M / 256, D / 256, F.G, cgemm, DFF / 64};
                if constexpr (SITE(10)) pg8::gemm_phase<pg8::EpiResid<false>, pg8::SchedPlain, true, false>(F.lds + RING_OFF, g, S, E);
                }
            }
            if (l + 1 < DEPTH) SEAM(pb + 7);
        } else {
#define MOE_TAB(slot_, ntiles_) do { LAS unsigned* tab = (LAS unsigned*)(F.lds + MOETAB_OFF);     \
                __syncthreads(); \
                int cnt[8]; \
                _Pragma("unroll") for (int e = 0; e < 8; ++e) cnt[e] = __builtin_amdgcn_readfirstlane((int)__hip_atomic_load(P.ctl + CW_MOECNT + 64 * li + (slot_) * 8 + e, RLX_AGENT)); \
                int rt = 0; \
                _Pragma("unroll") for (int e = 0; e < 8; ++e) { const int nte = (cnt[e] + 255) >> 8; \
                    for (int j = P.tid; j < nte; j += NWAVES * 64) { const int nv = (cnt[e] - 256 * j) < 256 ? (cnt[e] - 256 * j) : 256; if (rt + j < 264) tab[rt + j] = (unsigned)e | ((unsigned)j << 8) | ((unsigned)(nv - 1) << 20); } \
                    rt += nte; } \
                ntiles_ = rt < 264 ? rt : 264; \
                __syncthreads(); } while (0)
#define MOE_UP(slot_, ntiles_, skipc_, skipr_) do { \
                  \
                pg8::Gemm g{WSB(WS_HB), WSB(WS_WFF), D / 2, WFF8_W13_E, (const unsigned*)(P.ws + WS_LIST), 0}; \
                pg8::SchedMoe S{ntiles_, 2 * DFFE / 256, F.G, cgemm, D / 128, slot_, (const LAS unsigned*)(F.lds + MOETAB_OFF), skipc_, skipr_}; \
                pg8::EpiSwiGLU8 E{P.ws + WS_HID + (size_t)(slot_) * HID_SLOT, DFFE}; \
                if constexpr (SITE(11)) pg8::gemm_phase<pg8::EpiSwiGLU8, pg8::SchedMoe, true, true, true>(F.lds + RING_OFF, g, S, E); } while (0)
#define MOE_DOWN(slot_, ntiles_) do { \
                pg8::Gemm g{(const bf16*)(P.ws + WS_HID + (size_t)(slot_) * HID_SLOT), WSB(WS_WFF + WFF8_W2_OFF), DFFE / 2, WFF8_W2_E, nullptr, 0};     \
                pg8::SchedMoe S{ntiles_, D / 256, F.G, cgemm, DFFE / 128, slot_, (const LAS unsigned*)(F.lds + MOETAB_OFF), 0, 0};     \
                bf16* xcur = (l == DEPTH - 1) ? XBW() : XBD(); \
                if constexpr (SITE(12)) { \
                    if (l == DEPTH - 1 && (slot_) == 1) { pg8::EpiMoeDown<true> E{xcur, P.out, (const unsigned*)(P.ws + WS_LIST), (const float*)(P.ws + WS_MOEW) + (size_t)(slot_) * M, DFFE / 128};     \
                        pg8::gemm_phase<pg8::EpiMoeDown<true>, pg8::SchedMoe, true, false, true>(F.lds + RING_OFF, g, S, E); } \
                    else { pg8::EpiMoeDown<false> E{xcur, xcur, (const unsigned*)(P.ws + WS_LIST), (const float*)(P.ws + WS_MOEW) + (size_t)(slot_) * M, DFFE / 128}; \
                        pg8::gemm_phase<pg8::EpiMoeDown<false>, pg8::SchedMoe, true, false, true>(F.lds + RING_OFF, g, S, E); } } } while (0)
            if (IN(pb + 6)) { const Site P = make_site(); int nt0 = 0; MOE_TAB(0, nt0); MOE_UP(0, nt0, 0, 0); }
            SEAM(pb + 6);
            if (IN(pb + 7)) { int skipc = 0;
                { const Site P = make_site(); int nt0 = 0; MOE_TAB(0, nt0); MOE_DOWN(0, nt0);
                  const int xd = (nt0 * (D / 256)) % F.G; skipc = (xd + 7) & ~7; if (skipc > F.G) skipc = F.G; }
                { const Site P = make_site(); int nt1 = 0; MOE_TAB(1, nt1); MOE_UP(1, nt1, skipc, MOE_SKIPR); }
            }
            SEAM(pb + 7);
            if (IN(pb + 8)) { const Site P = make_site(); int nt1 = 0; MOE_TAB(1, nt1); MOE_DOWN(1, nt1); }
            if (l + 1 < DEPTH) SEAM(pb + 8);
#undef MOE_TAB
#undef MOE_UP
#undef MOE_DOWN
        }
    }
#undef IN
#undef SEAM
#undef WSB
#undef INP
#undef XBD
#undef XBW
}

extern "C" void kernel_launch(void* const* d_in, const int* in_sizes, int n_in, void* d_out, int out_size, void* d_ws, size_t ws_size, hipStream_t stream) {
    static int grid = 0;
    if (grid == 0) {
        if (n_in != 25 || in_sizes[0] != M * D || out_size != M * D || ws_size < WS_END) { fprintf(stderr, "kernel_launch: built for 25 inputs, x and out of %d floats, >= %zu bytes of workspace; got n_in %d, in0 %d, out %d, ws %zu; nothing launched\n", M * D, (size_t)WS_END, n_in, n_in > 0 ? in_sizes[0] : -1, out_size, ws_size); grid = -1; return; }
        int dev = 0, cus = 0, per_cu = 0;
        if (hipGetDevice(&dev) != hipSuccess || hipDeviceGetAttribute(&cus, hipDeviceAttributeMultiprocessorCount, dev) != hipSuccess) { fprintf(stderr, "kernel_launch: hipGetDevice / hipDeviceGetAttribute failed; nothing launched\n"); grid = -1; return; }
        if (hipFuncSetAttribute((const void*)trunk_fwd, hipFuncAttributeMaxDynamicSharedMemorySize, LDS_BYTES) != hipSuccess) { fprintf(stderr, "kernel_launch: hipFuncSetAttribute failed\n"); grid = -1; return; }
        if (hipOccupancyMaxActiveBlocksPerMultiprocessor(&per_cu, (const void*)trunk_fwd, NWAVES * 64, LDS_BYTES) != hipSuccess || per_cu < 1)
            fprintf(stderr, "kernel_launch: note: the occupancy query reports %d workgroups per CU\n", per_cu);
        (void)hipGetLastError();
        grid = cus;
    }
    if (grid < 0) return;
    if (hipMemsetAsync((char*)d_ws + WS_CTL, 0, CTL_ZERO_BYTES, stream) != hipSuccess) { fprintf(stderr, "kernel_launch: hipMemsetAsync failed\n"); return; }
    Args a{};
    for (int i = 0; i < 25; ++i) a.in[i] = (const float*)d_in[i];
    a.out = (float*)d_out; a.ws = (unsigned char*)d_ws;
#if MK_PER_PHASE
    for (int l = 0; l < DEPTH; ++l) { const int np = (l & 1) ? 10 : 8;
        for (int p = 0; p < np; ++p) { a.ph_lo = l * NPH + p; a.ph_hi = a.ph_lo + 1; if (a.ph_lo > DBG_MAXPHASE) continue; hipLaunchKernelGGL(trunk_fwd, dim3(grid), dim3(NWAVES * 64), LDS_BYTES, stream, a); } }
#else
    a.ph_lo = 0; a.ph_hi = DEPTH * NPH;
    hipLaunchKernelGGL(trunk_fwd, dim3(grid), dim3(NWAVES * 64), LDS_BYTES, stream, a);
#endif
    const hipError_t le = hipPeekAtLastError();
    if (le != hipSuccess) fprintf(stderr, "kernel_launch: launch failed: %s (grid %d x %d threads, %d B LDS)\n", hipGetErrorName(le), grid, NWAVES * 64, LDS_BYTES);
}
```
